# Optimizing an MI355X kernel written in HIP

```python
import math
import jax, jax.numpy as jnp
from jax import lax
import numpy as np

D_MODEL = 1024
BATCH = 8
SEQ = 2048
DEPTH = 1
DEC_BATCH = 4
DEC_SEQ = 8192
PAST_LEN = 128

MLA_HEADS = 16
QK_NOPE = 64
QK_ROPE = 32
V_DIM = 64
Q_LORA = 384
KV_LORA = 256
ROPE_THETA = 10000.0
DIL_CONFIGS = ((128, 1), (512, 4), (2048, 16))
DIL_HEADS_PER_GROUP = 4
DIL_HEADS = DIL_HEADS_PER_GROUP * len(DIL_CONFIGS)
DIL_HEAD_DIM = 64
D_FF = 2816
CONV_WIDTH = 3
Q_BLOCK = 128
EPS = 1e-6
IN_SPLITS = (Q_LORA, KV_LORA, QK_ROPE, 3 * DIL_HEADS * DIL_HEAD_DIM, D_MODEL, D_MODEL)
IN_COLS = Q_LORA + KV_LORA + QK_ROPE + 3 * DIL_HEADS * DIL_HEAD_DIM + 2 * D_MODEL

kernel_name = 'hybrid_mla_dilated_convffn_adaln_encoder'


def rmsnorm(x, g):
    xf = x.astype(jnp.float32)
    y = xf * lax.rsqrt(jnp.mean(xf * xf, axis=-1, keepdims=True) + EPS)
    return (y * g.astype(jnp.float32)).astype(x.dtype)


def rope_cos_sin(seq_len):
    inv = ROPE_THETA ** (-jnp.arange(0, QK_ROPE, 2, dtype=jnp.float32) / QK_ROPE)
    ang = jnp.arange(seq_len, dtype=jnp.float32)[:, None] * inv[None, :]
    return jnp.cos(ang), jnp.sin(ang)


def apply_rope(x, cos, sin):
    cos = cos.astype(x.dtype)
    sin = sin.astype(x.dtype)
    x1, x2 = jnp.split(x, 2, axis=-1)
    return jnp.concatenate([x1 * cos - x2 * sin, x1 * sin + x2 * cos], axis=-1)


def mla_attention(q_nope, q_rope, k_nope, k_rope, v):
    B, S, H, _ = q_nope.shape
    nb = S // Q_BLOCK
    scale = (QK_NOPE + QK_ROPE) ** -0.5
    qn = q_nope.reshape(B, nb, Q_BLOCK, H, QK_NOPE).transpose(1, 0, 2, 3, 4)
    qr = q_rope.reshape(B, nb, Q_BLOCK, H, QK_ROPE).transpose(1, 0, 2, 3, 4)

    def block(args):
        qn_b, qr_b = args
        s = (jnp.einsum('bqhd,bkhd->bhqk', qn_b, k_nope)
             + jnp.einsum('bqhr,bkr->bhqk', qr_b, k_rope)).astype(jnp.float32) * scale
        p = jax.nn.softmax(s, axis=-1)
        return jnp.einsum('bhqk,bkhd->bqhd', p.astype(v.dtype), v)

    o = lax.map(block, (qn, qr))
    return o.transpose(1, 0, 2, 3, 4).reshape(B, S, H * V_DIM)


def dilated_group_attention(q, k, v, slopes, window, dilation):
    B, S, Hg, dh = q.shape
    n_side = (window // 2) // dilation
    pad = n_side * dilation
    offsets = jnp.arange(-n_side, n_side + 1) * dilation
    kp = jnp.pad(k, ((0, 0), (pad, pad), (0, 0), (0, 0)))
    vp = jnp.pad(v, ((0, 0), (pad, pad), (0, 0), (0, 0)))
    alibi = -slopes[:, None] * jnp.abs(offsets).astype(jnp.float32)[None, :]
    scale = dh ** -0.5
    nb = S // Q_BLOCK
    qb = q.reshape(B, nb, Q_BLOCK, Hg, dh).transpose(1, 0, 2, 3, 4)
    starts = jnp.arange(nb) * Q_BLOCK

    def block(args):
        q_b, t0 = args
        pos = t0 + jnp.arange(Q_BLOCK)[:, None] + offsets[None, :]
        valid = (pos >= 0) & (pos < S)
        idx = pos + pad
        k_g = jnp.take(kp, idx, axis=1)
        v_g = jnp.take(vp, idx, axis=1)
        s = jnp.einsum('bqhd,bqjhd->bhqj', q_b, k_g).astype(jnp.float32) * scale + alibi[None, :, None, :]
        s = jnp.where(valid[None, None], s, -jnp.inf)
        lse = jax.nn.logsumexp(s, axis=-1)
        p = jnp.exp(s - lse[..., None])
        o = jnp.einsum('bhqj,bqjhd->bqhd', p.astype(v.dtype), v_g)
        return o, lse.transpose(0, 2, 1)

    o, lse = lax.map(block, (qb, starts))
    o = o.transpose(1, 0, 2, 3, 4).reshape(B, S, Hg, dh)
    lse = lse.transpose(1, 0, 2, 3).reshape(B, S, Hg)
    return o, lse


def dwconv_centered(u, w, b):
    S = u.shape[1]
    half = CONV_WIDTH // 2
    up = jnp.pad(u, ((0, 0), (half, half), (0, 0)))
    out = b
    for j in range(CONV_WIDTH):
        out = out + up[:, j:j + S] * w[j]
    return out


def encoder_layer(x, c, ada_w, ada_b, norm1_g, w_in, q_norm_g, kv_norm_g, w_uq, w_ukv,
                  p_a, p_b, w_out, norm2_g, w_up, conv_w, conv_b, w_down):
    B, S, D = x.shape
    mod = jnp.einsum('bd,de->be', jax.nn.silu(c), ada_w) + ada_b
    sh1, sc1, gt1, sh2, sc2, gt2 = jnp.split(mod, 6, axis=-1)

    h = rmsnorm(x, norm1_g) * (1 + sc1[:, None]) + sh1[:, None]
    z = jnp.einsum('bsd,de->bse', h, w_in)
    cuts = list(np.cumsum(IN_SPLITS)[:-1])
    c_q, c_kv, k_r, qkv_d, gate_a, gate_b = jnp.split(z, cuts, axis=-1)

    q = jnp.einsum('bsr,re->bse', rmsnorm(c_q, q_norm_g), w_uq).reshape(B, S, MLA_HEADS, QK_NOPE + QK_ROPE)
    q_nope, q_rope = q[..., :QK_NOPE], q[..., QK_NOPE:]
    kv = jnp.einsum('bsr,re->bse', rmsnorm(c_kv, kv_norm_g), w_ukv).reshape(B, S, MLA_HEADS, QK_NOPE + V_DIM)
    k_nope, v_a = kv[..., :QK_NOPE], kv[..., QK_NOPE:]
    cos, sin = rope_cos_sin(S)
    q_rope = apply_rope(q_rope, cos[:, None, :], sin[:, None, :])
    k_rope = apply_rope(k_r, cos, sin)
    o_a = mla_attention(q_nope, q_rope, k_nope, k_rope, v_a)

    qkv = qkv_d.reshape(B, S, 3, DIL_HEADS, DIL_HEAD_DIM)
    slopes = 2.0 ** (-8.0 * jnp.arange(1, DIL_HEADS + 1, dtype=jnp.float32) / DIL_HEADS)
    outs, lses = [], []
    for g, (window, dilation) in enumerate(DIL_CONFIGS):
        hs = slice(g * DIL_HEADS_PER_GROUP, (g + 1) * DIL_HEADS_PER_GROUP)
        o_g, lse_g = dilated_group_attention(qkv[:, :, 0, hs], qkv[:, :, 1, hs], qkv[:, :, 2, hs],
                                             slopes[hs], window, dilation)
        outs.append(o_g)
        lses.append(lse_g)
    wts = jax.nn.softmax(jnp.stack(lses, axis=0), axis=0)
    o_b = jnp.sum(wts[..., None].astype(x.dtype) * jnp.stack(outs, axis=0), axis=0)
    o_b = o_b.reshape(B, S, DIL_HEADS_PER_GROUP * DIL_HEAD_DIM)

    g_a = jax.nn.sigmoid(gate_a.astype(jnp.float32)).astype(x.dtype)
    g_b = jax.nn.sigmoid(gate_b.astype(jnp.float32)).astype(x.dtype)
    merged = g_a * jnp.einsum('bse,ed->bsd', o_a, p_a) + g_b * jnp.einsum('bse,ed->bsd', o_b, p_b)
    x = x + gt1[:, None] * jnp.einsum('bsd,de->bse', merged, w_out)

    h2 = rmsnorm(x, norm2_g) * (1 + sc2[:, None]) + sh2[:, None]
    up = jnp.einsum('bsd,df->bsf', h2, w_up)
    u, gv = jnp.split(up, 2, axis=-1)
    u = dwconv_centered(u, conv_w, conv_b)
    ff = jnp.einsum('bsf,fd->bsd', jax.nn.gelu(u) * gv, w_down)
    x = x + gt2[:, None] * ff
    return x


def setup_inputs(seed: int = 0) -> dict:
    key = jax.random.key(seed)
    ks = jax.random.split(key, 24)
    f32 = jnp.float32

    def nrm(k, shape, fan_in):
        return jax.random.normal(k, shape, f32) * (fan_in ** -0.5)

    def gain(k, shape):
        return 1.0 + 0.05 * jax.random.normal(k, shape, f32)

    L = DEPTH
    return {
        'x_prompt': jax.random.normal(ks[0], (BATCH, SEQ, D_MODEL), f32),
        'x_sample': jax.random.normal(ks[1], (DEC_BATCH, DEC_SEQ, D_MODEL), f32),
        'c_prompt': jax.random.normal(ks[2], (BATCH, D_MODEL), f32),
        'c_sample': jax.random.normal(ks[3], (DEC_BATCH, D_MODEL), f32),
        'ada_w': nrm(ks[4], (L, D_MODEL, 6 * D_MODEL), D_MODEL),
        'ada_b': 0.02 * jax.random.normal(ks[5], (L, 6 * D_MODEL), f32),
        'norm1_g': gain(ks[6], (L, D_MODEL)),
        'w_in': nrm(ks[7], (L, D_MODEL, IN_COLS), D_MODEL),
        'q_norm_g': gain(ks[8], (L, Q_LORA)),
        'kv_norm_g': gain(ks[9], (L, KV_LORA)),
        'w_uq': nrm(ks[10], (L, Q_LORA, MLA_HEADS * (QK_NOPE + QK_ROPE)), Q_LORA),
        'w_ukv': nrm(ks[11], (L, KV_LORA, MLA_HEADS * (QK_NOPE + V_DIM)), KV_LORA),
        'p_a': nrm(ks[12], (L, MLA_HEADS * V_DIM, D_MODEL), MLA_HEADS * V_DIM),
        'p_b': nrm(ks[13], (L, DIL_HEADS_PER_GROUP * DIL_HEAD_DIM, D_MODEL), DIL_HEADS_PER_GROUP * DIL_HEAD_DIM),
        'w_out': nrm(ks[14], (L, D_MODEL, D_MODEL), D_MODEL),
        'norm2_g': gain(ks[15], (L, D_MODEL)),
        'w_up': nrm(ks[16], (L, D_MODEL, 2 * D_FF), D_MODEL),
        'conv_w': nrm(ks[17], (L, CONV_WIDTH, D_FF), CONV_WIDTH),
        'conv_b': 0.02 * jax.random.normal(ks[18], (L, D_FF), f32),
        'w_down': nrm(ks[19], (L, D_FF, D_MODEL), D_FF),
        'normf_g': gain(ks[20], (D_MODEL,)),
    }


def reference(x_prompt, x_sample, c_prompt, c_sample, ada_w, ada_b, norm1_g, w_in, q_norm_g, kv_norm_g,
              w_uq, w_ukv, p_a, p_b, w_out, norm2_g, w_up, conv_w, conv_b, w_down, normf_g):
    def trunk(x, c):
        for l in range(DEPTH):
            x = encoder_layer(x, c, ada_w[l], ada_b[l], norm1_g[l], w_in[l], q_norm_g[l], kv_norm_g[l],
                              w_uq[l], w_ukv[l], p_a[l], p_b[l], w_out[l], norm2_g[l], w_up[l],
                              conv_w[l], conv_b[l], w_down[l])
        return rmsnorm(x, normf_g)

    y_prompt = trunk(x_prompt, c_prompt)
    y_sample = trunk(x_sample, c_sample)
    return (y_prompt, y_sample)
```

```cpp
#include <hip/hip_runtime.h>
#include <hip/hip_cooperative_groups.h>
#include <cstdio>
#include <cstdint>
namespace cg = cooperative_groups;

#ifndef MEGA
#define MEGA 0
#endif

#define LAS __attribute__((address_space(3)))
typedef unsigned short bf16_t;
typedef short bf16x8 __attribute__((ext_vector_type(8)));
typedef short s16x4 __attribute__((ext_vector_type(4)));
typedef float f32x2 __attribute__((ext_vector_type(2)));
typedef float f32x4 __attribute__((ext_vector_type(4)));
typedef float f32x16 __attribute__((ext_vector_type(16)));
typedef unsigned u32x2 __attribute__((ext_vector_type(2)));
typedef unsigned u32x4 __attribute__((ext_vector_type(4)));

constexpr int D = 1024, CH = 16384, NCHUNK = 3, ZLD = 5120, NUP = 5632, DFF = 2816;

constexpr float EPS = 1e-6f, LOG2E = 1.4426950408889634f, LN2 = 0.6931471805599453f;
constexpr float QSCALE = 0.10206207261596577f * LOG2E;
constexpr float DSCALE = 0.125f * LOG2E;

constexpr size_t MiB = 1u << 20;
constexpr size_t WS_WIN = 2 * MiB, WS_WUQ = 12 * MiB, WS_WUKV = 14 * MiB, WS_PA = 15 * MiB, WS_PB = 17 * MiB, WS_WOUT = 18 * MiB,
                 WS_WUP = 20 * MiB, WS_WDOWN = 31 * MiB;
constexpr size_t WS_MOD = 37 * MiB, WS_ROPE = 38 * MiB  , WS_RSTD = 39 * MiB + 512 * 1024;
constexpr size_t WS_H = 40 * MiB, WS_Z = 72 * MiB, WS_Q = 232 * MiB, WS_KF = 280 * MiB, WS_V = 328 * MiB, WS_OA = 360 * MiB, WS_OB = 392 * MiB,
                 WS_OG = 400 * MiB, WS_LSE = 448 * MiB, WS_T = 232 * MiB, WS_MERGED = 296 * MiB, WS_UP = 72 * MiB, WS_ACT = 248 * MiB, WS_END = 449 * MiB;

constexpr int LDS_BYTES = 147456;

__device__ __forceinline__ unsigned cvt_pk_bf16(float lo, float hi) { unsigned r; asm volatile("v_cvt_pk_bf16_f32 %0, %1, %2" : "=v"(r) : "v"(lo), "v"(hi)); return r; }
__device__ __forceinline__ float bf2f(unsigned short b) { return __uint_as_float((unsigned)b << 16); }
__device__ __forceinline__ float bflo(unsigned w) { return __uint_as_float(w << 16); }
__device__ __forceinline__ float bfhi(unsigned w) { return __uint_as_float(w & 0xffff0000u); }
__device__ __forceinline__ float wave_sum(float v) {
#pragma unroll
    for (int o = 1; o < 64; o <<= 1) v += __shfl_xor(v, o);
    return v;
}
__device__ __forceinline__ float swap_max(float m) { auto rr = __builtin_amdgcn_permlane32_swap(__float_as_uint(m), __float_as_uint(m), false, false); return fmaxf(__uint_as_float(rr[0]), __uint_as_float(rr[1])); }
__device__ __forceinline__ float swap_add(float m) { auto rr = __builtin_amdgcn_permlane32_swap(__float_as_uint(m), __float_as_uint(m), false, false); return __uint_as_float(rr[0]) + __uint_as_float(rr[1]); }
__device__ __forceinline__ s16x4 vtr(LAS const unsigned char* p) { return __builtin_bit_cast(s16x4, __builtin_amdgcn_ds_read_tr16_b64_v4i16((LAS s16x4*)p)); }
__device__ __forceinline__ float sigmoidf_(float x) { return __builtin_amdgcn_rcpf(1.0f + __builtin_amdgcn_exp2f(-x * LOG2E)); }

struct ChunkP { const float* x; float* out; int S, Sshift, nseq, seqbase; };

namespace pg8 {
constexpr int BM = 256, BK = 64, HALF = 128, HTB = HALF * BK * 2, STAGE_BYTES = 8 * HTB, NXCD = 8, WGM = 8;
__host__ __device__ __forceinline__ int lds_byte(int r, int c) { const int st = (r >> 4) * 2 + (c >> 5), rr = r & 15, cc = c & 31, ob = rr * 64 + cc * 2; return st * 1024 + (ob ^ (((ob >> 9) & 1) << 5)); }
__host__ __device__ __forceinline__ void stage_rc(int b, int& R, int& C) { const int st = b / 1024, sb = b % 1024, swz = sb ^ (((sb >> 9) & 1) << 5); R = (st >> 1) * 16 + swz / 64; C = (st & 1) * 32 + (swz % 64) / 2; }
__host__ __device__ __forceinline__ int perm32(int rho) { const int n = rho >> 4, i = rho & 15; return 8 * (i >> 2) + 4 * n + (i & 3); }
struct Unit { int pm, pn; };
struct Gemm { const bf16_t* A; const bf16_t* Bt; int M, N, K, lda; };
struct StaticOrder {
    int nM, nN, nwg, G, c;
    __device__ void init(int M, int N, int G_, int c_) { nM = M / BM; nN = N / BM; nwg = nM * nN; G = G_; c = c_; }
    __device__ bool next(int i, Unit& u) const {
        const long L = (long)i * G + c; if (L >= nwg) return false;
        int wgid = (int)L; { const int q = nwg / NXCD, r = nwg % NXCD, xcd = wgid % NXCD, off = wgid / NXCD; wgid = (xcd < r ? xcd * (q + 1) : r * (q + 1) + (xcd - r) * q) + off; }
        const int nig = WGM * nN, gid = wgid / nig, fm = gid * WGM, gsz = (nM - fm) < WGM ? (nM - fm) : WGM;
        u.pm = fm + ((wgid % nig) % gsz); u.pn = (wgid % nig) / gsz; return true;
    }
};

template <class Epi, class Sched>
__device__ __forceinline__ void gemm_phase(LAS unsigned char* lds, const Gemm g, const Sched& S, const Epi& E, int tid_in) {
    int tid_ = tid_in; asm volatile("" : "+v"(tid_));
    const int tid = tid_, wid = __builtin_amdgcn_readfirstlane(tid >> 6), lane = tid & 63, wr = wid >> 2, wc = wid & 3, fr = lane & 15, fq = lane >> 4;
    const int K = g.K, nt = K / BK, lda = g.lda;
    unsigned voffA[2], voffB[2];
#pragma unroll
    for (int i = 0; i < 2; ++i) { int R, C; stage_rc(tid * 16 + i * 8192, R, C); const int Rb = (R & ~31) + perm32(R & 31);
        voffA[i] = (unsigned)(R * lda + C) * 2u; voffB[i] = (unsigned)(Rb * K + C) * 2u; }
    const size_t kstep = (size_t)(BK * 2);
    const size_t hstepA = (size_t)HALF * lda * 2, hstepB = (size_t)HALF * K * 2;
    const size_t tstepA = 2 * hstepA, tstepB = 2 * hstepB;
    const unsigned ldsw = (unsigned)wid * 1024u;
    const int aoff = lds_byte(wr * 64 + fr, fq * 8), boff = lds_byte(wc * 32 + fr, fq * 8);
#define PG8_SA(b, h) (((b) * 2 + (h)) * HTB)
#define PG8_SB(b, h) ((4 + (b) * 2 + (h)) * HTB)
#define PG8_STAGE(bufoff, gbase, voff) do { _Pragma("unroll") for (int _i = 0; _i < 2; ++_i) \
        __builtin_amdgcn_global_load_lds((const unsigned*)((const char*)(gbase) + (voff)[_i]), (LAS unsigned*)(lds + (bufoff) + ldsw + _i * 8192), 16, 0, 0); } while (0)
#define PG8_LDA(dst, b, h) do { _Pragma("unroll") for (int m = 0; m < 4; ++m) _Pragma("unroll") for (int k = 0; k < 2; ++k) dst[m][k] = *(const LAS bf16x8*)(lds + PG8_SA(b, h) + aoff + m * 2048 + k * 1024); } while (0)
#define PG8_LDB(dst, b, h) do { _Pragma("unroll") for (int n = 0; n < 2; ++n) _Pragma("unroll") for (int k = 0; k < 2; ++k) dst[n][k] = *(const LAS bf16x8*)(lds + PG8_SB(b, h) + boff + n * 2048 + k * 1024); } while (0)
#define PG8_MMA(ai, bj, At, Bt) do { __builtin_amdgcn_s_setprio(1); _Pragma("unroll") for (int m = 0; m < 4; ++m) _Pragma("unroll") for (int n = 0; n < 2; ++n) _Pragma("unroll") for (int k = 0; k < 2; ++k) \
        acc[ai][bj][m][n] = __builtin_amdgcn_mfma_f32_16x16x32_bf16(Bt[n][k], At[m][k], acc[ai][bj][m][n], 0, 0, 0); __builtin_amdgcn_s_setprio(0); } while (0)
#define PG8_WAIT_V(n) asm volatile("s_waitcnt vmcnt(" #n ")" ::: "memory")
#define PG8_WAIT_L(n) asm volatile("s_waitcnt lgkmcnt(" #n ")" ::: "memory")
#define PG8_BAR __builtin_amdgcn_s_barrier()
#define PG8_SCHED __builtin_amdgcn_sched_barrier(0)
    Unit cur, nxt; int ui = 0;
    if (!S.next(0, cur)) return;
    f32x4 acc[2][2][4][2];
#pragma unroll
    for (int a = 0; a < 2; ++a)
#pragma unroll
        for (int b = 0; b < 2; ++b)
#pragma unroll
            for (int m = 0; m < 4; ++m)
#pragma unroll
                for (int n = 0; n < 2; ++n) acc[a][b][m][n] = (f32x4){0.f, 0.f, 0.f, 0.f};
    bf16x8 At[4][2], B0[2][2], B1[2][2];
    const char* cA = (const char*)g.A + (size_t)cur.pm * tstepA; const char* cB = (const char*)g.Bt + (size_t)cur.pn * tstepB;
    PG8_STAGE(PG8_SB(0, 0), cB, voffB); PG8_STAGE(PG8_SB(0, 1), cB + hstepB, voffB); PG8_STAGE(PG8_SA(0, 0), cA, voffA); PG8_STAGE(PG8_SA(0, 1), cA + hstepA, voffA);
    if (wr == 1) PG8_BAR;
    PG8_WAIT_V(2); PG8_BAR;
    PG8_STAGE(PG8_SB(1, 0), cB + kstep, voffB); PG8_STAGE(PG8_SA(1, 0), cA + kstep, voffA); PG8_STAGE(PG8_SB(1, 1), cB + hstepB + kstep, voffB);
    PG8_WAIT_V(6); PG8_BAR;
    for (;;) {
        const bool has_next = S.next(ui + 1, nxt);
        const char* nA = has_next ? (const char*)g.A + (size_t)nxt.pm * tstepA : cA; const char* nB = has_next ? (const char*)g.Bt + (size_t)nxt.pn * tstepB : cB;
        for (int t = 0; t < nt; t += 2) {
            const bool last = (t == nt - 2);
            const char* a1 = cA + (size_t)(t + 1) * kstep;
            const char* a2 = last ? nA : cA + (size_t)(t + 2) * kstep; const char* b2 = last ? nB : cB + (size_t)(t + 2) * kstep;
            const char* a3 = a2 + kstep; const char* b3 = b2 + kstep;
            PG8_LDB(B0, 0, 0); PG8_LDB(B1, 0, 1); PG8_SCHED; PG8_LDA(At, 0, 0); PG8_STAGE(PG8_SA(1, 1), a1 + hstepA, voffA);
            PG8_WAIT_V(8); PG8_WAIT_L(0); PG8_BAR; PG8_MMA(0, 0, At, B0); PG8_MMA(0, 1, At, B1); PG8_BAR; PG8_SCHED;
            PG8_LDA(At, 0, 1); PG8_STAGE(PG8_SB(0, 0), b2, voffB); PG8_STAGE(PG8_SB(0, 1), b2 + hstepB, voffB); PG8_STAGE(PG8_SA(0, 0), a2, voffA);
            PG8_WAIT_V(8); PG8_WAIT_L(0); PG8_BAR; PG8_MMA(1, 0, At, B0); PG8_MMA(1, 1, At, B1); PG8_BAR; PG8_SCHED;
            PG8_LDB(B0, 1, 0); PG8_LDB(B1, 1, 1); PG8_SCHED; PG8_LDA(At, 1, 0); PG8_STAGE(PG8_SA(0, 1), a2 + hstepA, voffA);
            PG8_WAIT_V(8); PG8_WAIT_L(0); PG8_BAR; PG8_MMA(0, 0, At, B0); PG8_MMA(0, 1, At, B1); PG8_BAR; PG8_SCHED;
            PG8_LDA(At, 1, 1); PG8_STAGE(PG8_SB(1, 0), b3, voffB); PG8_STAGE(PG8_SB(1, 1), b3 + hstepB, voffB); PG8_STAGE(PG8_SA(1, 0), a3, voffA);
            PG8_WAIT_V(8); PG8_WAIT_L(0); PG8_BAR; PG8_MMA(1, 0, At, B0); PG8_MMA(1, 1, At, B1); PG8_BAR; PG8_SCHED;
        }
        if (wr == 0) PG8_BAR;
        E(acc, cur, wr, wc, fr, fq);
        if (!has_next) break;
#pragma unroll
        for (int a = 0; a < 2; ++a)
#pragma unroll
            for (int b = 0; b < 2; ++b)
#pragma unroll
                for (int m = 0; m < 4; ++m)
#pragma unroll
                    for (int n = 0; n < 2; ++n) acc[a][b][m][n] = (f32x4){0.f, 0.f, 0.f, 0.f};
        cur = nxt; cA = nA; cB = nB; ++ui;
        if (wr == 1) PG8_BAR;
    }
    PG8_WAIT_V(0);
    PG8_BAR;
#undef PG8_SA
#undef PG8_SB
#undef PG8_STAGE
#undef PG8_LDA
#undef PG8_LDB
#undef PG8_MMA
#undef PG8_WAIT_V
#undef PG8_WAIT_L
#undef PG8_BAR
#undef PG8_SCHED
}

#define EPI_ARGS const f32x4 (&acc)[2][2][4][2], const Unit& u, int wr, int wc, int fr, int fq
__device__ __forceinline__ u32x4 pack8(f32x4 v0, f32x4 v1) { u32x4 w; w.x = cvt_pk_bf16(v0[0], v0[1]); w.y = cvt_pk_bf16(v0[2], v0[3]); w.z = cvt_pk_bf16(v1[0], v1[1]); w.w = cvt_pk_bf16(v1[2], v1[3]); return w; }

struct EpiStore {
    bf16_t* O; int ldc; int sig_pn;
    __device__ __forceinline__ void operator()(EPI_ARGS) const {
        const int row0 = u.pm * BM + wr * 64 + fr, col0 = u.pn * BM + wc * 32 + 8 * fq; const bool sig = u.pn >= sig_pn;
#pragma unroll
        for (int ai = 0; ai < 2; ++ai)
#pragma unroll
            for (int m = 0; m < 4; ++m) { bf16_t* rowp = O + (size_t)(row0 + ai * HALF + m * 16) * ldc + col0;
#pragma unroll
                for (int bj = 0; bj < 2; ++bj) { f32x4 v0 = acc[ai][bj][m][0], v1 = acc[ai][bj][m][1];
                    if (sig) {
#pragma unroll
                        for (int e = 0; e < 4; ++e) { v0[e] = sigmoidf_(v0[e]); v1[e] = sigmoidf_(v1[e]); } }
                    *(u32x4*)(rowp + bj * HALF) = pack8(v0, v1); } }
    }
};
struct EpiQ {
    bf16_t* Q; const float* rstd; const float* rope; int S, Sshift;
    __device__ __forceinline__ void operator()(EPI_ARGS) const {
        const int row0 = u.pm * BM + wr * 64 + fr;
#pragma unroll
        for (int ai = 0; ai < 2; ++ai)
#pragma unroll
            for (int m = 0; m < 4; ++m) { const int row = row0 + ai * HALF + m * 16; const int seq = row >> Sshift, pos = row & (S - 1);
                const float sc = rstd[2 * row] * QSCALE;
#pragma unroll
                for (int bj = 0; bj < 2; ++bj) { const int g32 = 8 * u.pn + 4 * bj + wc; const int head = g32 / 3, gl = g32 - 3 * head;
                    f32x4 v0 = acc[ai][bj][m][0] * sc, v1 = acc[ai][bj][m][1] * sc;
                    if (gl == 2) { const f32x4 cs = *(const f32x4*)(rope + (size_t)pos * 16 + 4 * fq), sn = *(const f32x4*)(rope + 131072 + (size_t)pos * 16 + 4 * fq);
                        f32x4 w0, w1;
                        w0[0] = v0[0] * cs[0] - v0[1] * sn[0]; w0[1] = v0[0] * sn[0] + v0[1] * cs[0];
                        w0[2] = v0[2] * cs[1] - v0[3] * sn[1]; w0[3] = v0[2] * sn[1] + v0[3] * cs[1];
                        w1[0] = v1[0] * cs[2] - v1[1] * sn[2]; w1[1] = v1[0] * sn[2] + v1[1] * cs[2];
                        w1[2] = v1[2] * cs[3] - v1[3] * sn[3]; w1[3] = v1[2] * sn[3] + v1[3] * cs[3];
                        v0 = w0; v1 = w1; }
                    *(u32x4*)(Q + ((size_t)((seq * 16 + head) << Sshift) + pos) * 96 + gl * 32 + 8 * fq) = pack8(v0, v1); }
                asm volatile("" ::: "memory"); }
    }
};
struct EpiKV {
    bf16_t* KF; bf16_t* V; const float* rstd; int S, Sshift;
    __device__ __forceinline__ void operator()(EPI_ARGS) const {
        const int row0 = u.pm * BM + wr * 64 + fr; const bool isv = u.pn >= 4;
#pragma unroll
        for (int ai = 0; ai < 2; ++ai)
#pragma unroll
            for (int m = 0; m < 4; ++m) { const int row = row0 + ai * HALF + m * 16; const int seq = row >> Sshift, pos = row & (S - 1);
                const float sc = rstd[2 * row + 1];
#pragma unroll
                for (int bj = 0; bj < 2; ++bj) { const int col = (u.pn & 3) * BM + bj * HALF + wc * 32 + 8 * fq; const int head = col >> 6, d = col & 63;
                    const f32x4 v0 = acc[ai][bj][m][0] * sc, v1 = acc[ai][bj][m][1] * sc; const size_t tok = (size_t)((seq * 16 + head) << Sshift) + pos;
                    bf16_t* p = isv ? V + tok * 64 + d : KF + tok * 96 + d;
                    *(u32x4*)p = pack8(v0, v1); }
                asm volatile("" ::: "memory"); }
    }
};
struct EpiGateA {
    float* T; const bf16_t* Z;
    __device__ __forceinline__ void operator()(EPI_ARGS) const {
        const int row0 = u.pm * BM + wr * 64 + fr, col0 = u.pn * BM + wc * 32 + 8 * fq;
#pragma unroll
        for (int ai = 0; ai < 2; ++ai)
#pragma unroll
            for (int m = 0; m < 4; ++m) { const int row = row0 + ai * HALF + m * 16;
#pragma unroll
                for (int bj = 0; bj < 2; ++bj) { const int col = col0 + bj * HALF; const u32x4 gw = *(const u32x4*)(Z + (size_t)row * ZLD + 3072 + col);
                    f32x4 v0 = acc[ai][bj][m][0], v1 = acc[ai][bj][m][1];
                    v0[0] *= bflo(gw.x); v0[1] *= bfhi(gw.x); v0[2] *= bflo(gw.y); v0[3] *= bfhi(gw.y); v1[0] *= bflo(gw.z); v1[1] *= bfhi(gw.z); v1[2] *= bflo(gw.w); v1[3] *= bfhi(gw.w);
                    float* tp = T + (size_t)row * D + col; *(f32x4*)tp = v0; *(f32x4*)(tp + 4) = v1; }
                asm volatile("" ::: "memory"); }
    }
};
struct EpiGateB {
    const float* T; const bf16_t* Z; bf16_t* O;
    __device__ __forceinline__ void operator()(EPI_ARGS) const {
        const int row0 = u.pm * BM + wr * 64 + fr, col0 = u.pn * BM + wc * 32 + 8 * fq;
#pragma unroll
        for (int ai = 0; ai < 2; ++ai)
#pragma unroll
            for (int m = 0; m < 4; ++m) { const int row = row0 + ai * HALF + m * 16;
#pragma unroll
                for (int bj = 0; bj < 2; ++bj) { const int col = col0 + bj * HALF; const u32x4 gw = *(const u32x4*)(Z + (size_t)row * ZLD + 4096 + col);
                    const float* tp = T + (size_t)row * D + col; f32x4 v0 = *(const f32x4*)tp, v1 = *(const f32x4*)(tp + 4);
                    const f32x4 a0 = acc[ai][bj][m][0], a1 = acc[ai][bj][m][1];
                    v0[0] += a0[0] * bflo(gw.x); v0[1] += a0[1] * bfhi(gw.x); v0[2] += a0[2] * bflo(gw.y); v0[3] += a0[3] * bfhi(gw.y);
                    v1[0] += a1[0] * bflo(gw.z); v1[1] += a1[1] * bfhi(gw.z); v1[2] += a1[2] * bflo(gw.w); v1[3] += a1[3] * bfhi(gw.w);
                    *(u32x4*)(O + (size_t)row * D + col) = pack8(v0, v1); }
                asm volatile("" ::: "memory"); }
    }
};
struct EpiResid {
    const float* base; float* out; const float* mod; int goff, Sshift, seqbase;
    __device__ __forceinline__ void operator()(EPI_ARGS) const {
        const int row0 = u.pm * BM + wr * 64 + fr, col0 = u.pn * BM + wc * 32 + 8 * fq;
        const float* gt = mod + (size_t)(seqbase + ((u.pm * BM) >> Sshift)) * 6144 + goff + col0;
        f32x4 g[2][2];
#pragma unroll
        for (int bj = 0; bj < 2; ++bj) { g[bj][0] = *(const f32x4*)(gt + bj * HALF); g[bj][1] = *(const f32x4*)(gt + bj * HALF + 4); }
#pragma unroll
        for (int ai = 0; ai < 2; ++ai)
#pragma unroll
            for (int m = 0; m < 4; ++m) { const size_t off = (size_t)(row0 + ai * HALF + m * 16) * D + col0;
#pragma unroll
                for (int bj = 0; bj < 2; ++bj) { const f32x4 b0 = *(const f32x4*)(base + off + bj * HALF), b1 = *(const f32x4*)(base + off + bj * HALF + 4);
                    *(f32x4*)(out + off + bj * HALF) = b0 + g[bj][0] * acc[ai][bj][m][0]; *(f32x4*)(out + off + bj * HALF + 4) = b1 + g[bj][1] * acc[ai][bj][m][1]; }
                if (m & 1) asm volatile("" ::: "memory"); }
    }
};

struct EpiAny {
    int kind;
    bf16_t* O; int ldc; int sig_pn;
    bf16_t* Q; bf16_t* KF; bf16_t* V; const float* rstd; const float* rope; int S, Sshift;
    float* T; const bf16_t* Z;
    const float* base; float* out; const float* mod; int goff, seqbase;
    __device__ __forceinline__ void operator()(EPI_ARGS) const {
        if (kind == 0) { EpiStore e{O, ldc, sig_pn}; e(acc, u, wr, wc, fr, fq); }
        else if (kind == 1) { EpiQ e{Q, rstd, rope, S, Sshift}; e(acc, u, wr, wc, fr, fq); }
        else if (kind == 2) { EpiKV e{KF, V, rstd, S, Sshift}; e(acc, u, wr, wc, fr, fq); }
        else if (kind == 3) { EpiGateA e{T, Z}; e(acc, u, wr, wc, fr, fq); }
        else if (kind == 4) { EpiGateB e{T, Z, O}; e(acc, u, wr, wc, fr, fq); }
        else { EpiResid e{base, out, mod, goff, Sshift, seqbase}; e(acc, u, wr, wc, fr, fq); }
    }
};
}

__device__ const float ROPE_INV[16] = {1.000000000e+00f, 5.623413324e-01f, 3.162277639e-01f, 1.778279394e-01f, 1.000000015e-01f, 5.623413250e-02f, 3.162277490e-02f, 1.778279431e-02f,
                                       9.999999776e-03f, 5.623413250e-03f, 3.162277630e-03f, 1.778279431e-03f, 1.000000047e-03f, 5.623413017e-04f, 3.162277571e-04f, 1.778279402e-04f};
__device__ __forceinline__ int perm_rope(int i) { return i < 16 ? 2 * i : 2 * (i - 16) + 1; }
__device__ __forceinline__ int rowmap(int kind, int n) {
    if (kind == 1) return n < 640 ? n : (n < 672 ? 640 + perm_rope(n - 640) : n + 96);
    if (kind == 2) { const int h = n / 96, c = n - h * 96; return c < 64 ? n : h * 96 + 64 + perm_rope(c - 64); }
    if (kind == 3) { const int h = n >> 7, c = n & 127; return c < 64 ? h * 64 + c : 1024 + h * 64 + (c - 64); }
    return n;
}
__device__ __forceinline__ void transpose_item(const float* W, int K, int N, bf16_t* WT, int kind, const float* ks, LAS float* scr, int item, int lane) {
    const int nblk = N / 32, kb = item / nblk, nb = item - kb * nblk, k0 = 64 * kb, n0 = 32 * nb;
#pragma unroll 8
    for (int i = 0; i < 32; ++i) { const int kk = 2 * i + (lane >> 5); float w = W[(size_t)(k0 + kk) * N + n0 + (lane & 31)]; if (ks) w *= ks[k0 + kk]; scr[kk * 33 + (lane & 31)] = w; }
    asm volatile("s_waitcnt lgkmcnt(0)" ::: "memory");
    const int c = lane & 7;
#pragma unroll
    for (int j = 0; j < 4; ++j) { const int n = (lane >> 3) + 8 * j; const LAS float* s = scr + (8 * c) * 33 + n;
        u32x4 o; o.x = cvt_pk_bf16(s[0 * 33], s[1 * 33]); o.y = cvt_pk_bf16(s[2 * 33], s[3 * 33]); o.z = cvt_pk_bf16(s[4 * 33], s[5 * 33]); o.w = cvt_pk_bf16(s[6 * 33], s[7 * 33]);
        *(u32x4*)(WT + (size_t)rowmap(kind, n0 + n) * K + k0 + 8 * c) = o; }
    asm volatile("s_waitcnt lgkmcnt(0)" ::: "memory");
}

__device__ __forceinline__ void norm_mod_row(const float* xrow, bf16_t* orow, const float* g, const float* sc, const float* sh, int lane) {
    const f32x4* xr = (const f32x4*)xrow + lane; f32x4 v[4]; float s = 0.f;
#pragma unroll
    for (int j = 0; j < 4; ++j) { v[j] = xr[64 * j]; s += (v[j].x * v[j].x + v[j].y * v[j].y) + (v[j].z * v[j].z + v[j].w * v[j].w); }
    const float rstd = 1.0f / sqrtf(wave_sum(s) * (1.f / D) + EPS);
    u32x2* o8 = (u32x2*)orow + lane;
#pragma unroll
    for (int j = 0; j < 4; ++j) { const f32x4 gg = ((const f32x4*)g)[lane + 64 * j], ss = ((const f32x4*)sc)[lane + 64 * j], hh = ((const f32x4*)sh)[lane + 64 * j];
        const f32x4 o = v[j] * rstd * gg * (ss + 1.0f) + hh; u32x2 w; w.x = cvt_pk_bf16(o.x, o.y); w.y = cvt_pk_bf16(o.z, o.w); o8[64 * j] = w; }
}
__device__ __forceinline__ void final_norm_row(float* xrow, const float* g, int lane) {
    f32x4* xr = (f32x4*)xrow + lane; f32x4 v[4]; float s = 0.f;
#pragma unroll
    for (int j = 0; j < 4; ++j) { v[j] = xr[64 * j]; s += (v[j].x * v[j].x + v[j].y * v[j].y) + (v[j].z * v[j].z + v[j].w * v[j].w); }
    const float rstd = 1.0f / sqrtf(wave_sum(s) * (1.f / D) + EPS);
#pragma unroll
    for (int j = 0; j < 4; ++j) xr[64 * j] = v[j] * rstd * ((const f32x4*)g)[lane + 64 * j];
}

__device__ __forceinline__ void dil_task(const bf16_t* Z, float* OG, float* LSE, int S, int task, LAS unsigned char* wl, int lane_in) {
    int lane = lane_in; asm volatile("" : "+v"(lane));
    const int r32 = lane & 31, hi = lane >> 5;
    const int bps = S >> 5, tps = 12 * bps;
    const int seq = task / tps; const int rem = task - seq * tps; const int hd = rem / bps; const int blk = rem - hd * bps;
    const int g = hd >> 2, sh = 2 * g, dl = 1 << sh; const int r = blk & (dl - 1), bi = blk >> sh;
    const int i0 = bi * 32, nsub = S >> sh;
    const size_t rowbase = (size_t)seq * S;
    const int tq = r + ((i0 + r32) << sh);
    const bf16_t* qp = Z + (rowbase + tq) * ZLD + 768 + hd * 64 + 8 * hi;
    bf16x8 qf[4];
#pragma unroll
    for (int s = 0; s < 4; ++s) qf[s] = *(const bf16x8*)(qp + 16 * s);
    f32x16 sc[5];
#pragma unroll
    for (int c = 0; c < 5; ++c) {
        int ik = i0 - 64 + 32 * c + r32; ik = ik < 0 ? 0 : (ik > nsub - 1 ? nsub - 1 : ik);
        const bf16_t* kp = Z + (rowbase + r + ((size_t)ik << sh)) * ZLD + 1536 + hd * 64 + 8 * hi;
        bf16x8 kf[4];
#pragma unroll
        for (int s = 0; s < 4; ++s) kf[s] = *(const bf16x8*)(kp + 16 * s);
        f32x16 a = {};
#pragma unroll
        for (int s = 0; s < 4; ++s) a = __builtin_amdgcn_mfma_f32_32x32x16_bf16(kf[s], qf[s], a, 0, 0, 0);
        sc[c] = a;
        asm volatile("" ::: "memory");
    }
    const float cb = __builtin_amdgcn_exp2f(-0.6666666667f * (float)(hd + 1)) * LOG2E * (float)dl;
    float mx = -INFINITY;
#pragma unroll
    for (int c = 0; c < 5; ++c)
#pragma unroll
        for (int e = 0; e < 16; ++e) {
            const int kvl = 32 * c + (e & 3) + 8 * (e >> 2) + 4 * hi; const int delta = kvl - 64 - r32; const int ik = i0 + r32 + delta;
            const int ad = delta < 0 ? -delta : delta; const bool valid = (ad <= 64) && (ik >= 0) && (ik < nsub);
            float v = sc[c][e] * DSCALE - cb * (float)ad; v = valid ? v : -INFINITY; sc[c][e] = v; mx = fmaxf(mx, v);
        }
    mx = swap_max(mx);
    float ls = 0.f;
#pragma unroll
    for (int c = 0; c < 5; ++c)
#pragma unroll
        for (int e = 0; e < 16; ++e) { const float p = __builtin_amdgcn_exp2f(sc[c][e] - mx); sc[c][e] = p; ls += p; }
    ls = swap_add(ls);
    f32x16 o0 = {}, o1 = {};
    const int vb = ((lane >> 4) & 1) * 32 + (lane & 3) * 8 + (4 * hi + ((lane & 15) >> 2)) * 64;
#pragma unroll
    for (int c = 0; c < 5; ++c) {
        u32x4 vv[4];
#pragma unroll
        for (int i = 0; i < 4; ++i) { const int row = (lane >> 3) + 8 * i; int ik = i0 - 64 + 32 * c + row; ik = ik < 0 ? 0 : (ik > nsub - 1 ? nsub - 1 : ik);
            vv[i] = *(const u32x4*)(Z + (rowbase + r + ((size_t)ik << sh)) * ZLD + 2304 + hd * 64 + (lane & 7) * 8); }
        asm volatile("s_waitcnt lgkmcnt(0)" ::: "memory");
#pragma unroll
        for (int i = 0; i < 4; ++i) { const int row = (lane >> 3) + 8 * i; *(LAS u32x4*)(wl + ((lane & 7) >> 2) * 2048 + row * 64 + (lane & 3) * 16) = vv[i]; }
        asm volatile("s_waitcnt lgkmcnt(0)" ::: "memory");
#pragma unroll
        for (int s = 0; s < 2; ++s) {
            u32x4 pw; pw.x = cvt_pk_bf16(sc[c][8 * s + 0], sc[c][8 * s + 1]); pw.y = cvt_pk_bf16(sc[c][8 * s + 2], sc[c][8 * s + 3]); pw.z = cvt_pk_bf16(sc[c][8 * s + 4], sc[c][8 * s + 5]); pw.w = cvt_pk_bf16(sc[c][8 * s + 6], sc[c][8 * s + 7]);
            const bf16x8 pf = __builtin_bit_cast(bf16x8, pw);
            { const s16x4 lo = vtr(wl + vb + s * 1024), hh = vtr(wl + vb + s * 1024 + 512); const bf16x8 vf = {lo[0], lo[1], lo[2], lo[3], hh[0], hh[1], hh[2], hh[3]};
              o0 = __builtin_amdgcn_mfma_f32_32x32x16_bf16(vf, pf, o0, 0, 0, 0); }
            { const s16x4 lo = vtr(wl + vb + 2048 + s * 1024), hh = vtr(wl + vb + 2048 + s * 1024 + 512); const bf16x8 vf = {lo[0], lo[1], lo[2], lo[3], hh[0], hh[1], hh[2], hh[3]};
              o1 = __builtin_amdgcn_mfma_f32_32x32x16_bf16(vf, pf, o1, 0, 0, 0); }
        }
    }
    const float inv = 1.0f / ls; const size_t rq = rowbase + tq;
    float* op = OG + (rq * 12 + hd) * 64 + 4 * hi;
#pragma unroll
    for (int i = 0; i < 4; ++i) {
        *(f32x4*)(op + 8 * i) = (f32x4){o0[4 * i] * inv, o0[4 * i + 1] * inv, o0[4 * i + 2] * inv, o0[4 * i + 3] * inv};
        *(f32x4*)(op + 32 + 8 * i) = (f32x4){o1[4 * i] * inv, o1[4 * i + 1] * inv, o1[4 * i + 2] * inv, o1[4 * i + 3] * inv};
    }
    if (hi == 0) LSE[rq * 12 + hd] = (mx + __builtin_amdgcn_logf(ls)) * LN2;
}

namespace mla {
constexpr int KPITCH = 208, KBYTES = 64 * KPITCH, VBYTES = 8192, BUF = KBYTES + VBYTES;
__device__ __forceinline__ void attn_unit(const bf16_t* Qh, const bf16_t* Kh, const bf16_t* Vh, bf16_t* Oh  , int S, int qb, LAS unsigned char* lds, int tid) {
    const int lane = tid & 63, r32 = lane & 31, hi = lane >> 5; const int wid = __builtin_amdgcn_readfirstlane(tid >> 6);
    const int qrow = qb * 256 + wid * 32 + r32;
    const bf16_t* Qw = Qh + (size_t)qrow * 96 + 8 * hi;
    bf16x8 qf[6];
#pragma unroll
    for (int s = 0; s < 6; ++s) qf[s] = *(const bf16x8*)(Qw + 16 * s);
    const int kc0 = tid, kc1 = tid + 512; const bool has1 = tid < 256;
    const unsigned kd0 = (unsigned)((kc0 / 12) * KPITCH + (kc0 % 12) * 16), kd1 = (unsigned)((kc1 / 12) * KPITCH + (kc1 % 12) * 16);
    const unsigned vd = (unsigned)(KBYTES + ((tid & 7) >> 2) * 4096 + (tid >> 3) * 64 + (tid & 3) * 16);
    const u32x4* Kg = (const u32x4*)Kh; const u32x4* Vg = (const u32x4*)Vh;
    const int NT = S >> 6;
    u32x4 ka = Kg[kc0], kb = has1 ? Kg[kc1] : (u32x4){0u, 0u, 0u, 0u}, va = Vg[tid];
    *(LAS u32x4*)(lds + kd0) = ka; if (has1) *(LAS u32x4*)(lds + kd1) = kb; *(LAS u32x4*)(lds + vd) = va;
    __syncthreads();
    f32x16 o0 = {}, o1 = {}; float mrun = -INFINITY, lrun = 0.f;
    const unsigned kfo = (unsigned)(r32 * KPITCH + hi * 16);
    const unsigned vb = (unsigned)(KBYTES + ((lane >> 4) & 1) * 32 + (lane & 3) * 8 + (4 * hi + ((lane & 15) >> 2)) * 64);
    for (int t = 0; t < NT; ++t) {
        const unsigned cur = (unsigned)(t & 1) * BUF, nxt = BUF - cur; const bool more = t + 1 < NT;
        if (more) { ka = Kg[(size_t)(t + 1) * 768 + kc0]; if (has1) kb = Kg[(size_t)(t + 1) * 768 + kc1]; va = Vg[(size_t)(t + 1) * 512 + tid]; }
        f32x16 p0 = {}, p1 = {};
#pragma unroll
        for (int s = 0; s < 6; ++s) {
            const bf16x8 a0 = *(const LAS bf16x8*)(lds + cur + kfo + s * 32), a1 = *(const LAS bf16x8*)(lds + cur + kfo + 32 * KPITCH + s * 32);
            p0 = __builtin_amdgcn_mfma_f32_32x32x16_bf16(a0, qf[s], p0, 0, 0, 0); p1 = __builtin_amdgcn_mfma_f32_32x32x16_bf16(a1, qf[s], p1, 0, 0, 0);
        }
        float rm = fmaxf(p0[0], p1[0]);
#pragma unroll
        for (int e = 1; e < 16; ++e) rm = fmaxf(rm, fmaxf(p0[e], p1[e]));
        rm = swap_max(rm);
        if (__any(rm > mrun)) { const float mn = fmaxf(mrun, rm); const float al = __builtin_amdgcn_exp2f(mrun - mn); mrun = mn; lrun *= al;
#pragma unroll
            for (int e = 0; e < 16; ++e) { o0[e] *= al; o1[e] *= al; } }
        float rs = 0.f;
#pragma unroll
        for (int e = 0; e < 16; ++e) { p0[e] = __builtin_amdgcn_exp2f(p0[e] - mrun); p1[e] = __builtin_amdgcn_exp2f(p1[e] - mrun); rs += p0[e] + p1[e]; }
        lrun += rs;
#pragma unroll
        for (int ks = 0; ks < 4; ++ks) {
            u32x4 pw;
            if (ks < 2) { const int b = 8 * ks; pw.x = cvt_pk_bf16(p0[b], p0[b + 1]); pw.y = cvt_pk_bf16(p0[b + 2], p0[b + 3]); pw.z = cvt_pk_bf16(p0[b + 4], p0[b + 5]); pw.w = cvt_pk_bf16(p0[b + 6], p0[b + 7]); }
            else { const int b = 8 * (ks - 2); pw.x = cvt_pk_bf16(p1[b], p1[b + 1]); pw.y = cvt_pk_bf16(p1[b + 2], p1[b + 3]); pw.z = cvt_pk_bf16(p1[b + 4], p1[b + 5]); pw.w = cvt_pk_bf16(p1[b + 6], p1[b + 7]); }
            const bf16x8 pf = __builtin_bit_cast(bf16x8, pw);
            { const s16x4 lo = vtr(lds + cur + vb + ks * 1024), hh = vtr(lds + cur + vb + ks * 1024 + 512); const bf16x8 vf = {lo[0], lo[1], lo[2], lo[3], hh[0], hh[1], hh[2], hh[3]};
              o0 = __builtin_amdgcn_mfma_f32_32x32x16_bf16(vf, pf, o0, 0, 0, 0); }
            { const s16x4 lo = vtr(lds + cur + vb + 4096 + ks * 1024), hh = vtr(lds + cur + vb + 4096 + ks * 1024 + 512); const bf16x8 vf = {lo[0], lo[1], lo[2], lo[3], hh[0], hh[1], hh[2], hh[3]};
              o1 = __builtin_amdgcn_mfma_f32_32x32x16_bf16(vf, pf, o1, 0, 0, 0); }
        }
        if (more) { *(LAS u32x4*)(lds + nxt + kd0) = ka; if (has1) *(LAS u32x4*)(lds + nxt + kd1) = kb; *(LAS u32x4*)(lds + nxt + vd) = va; }
        __syncthreads();
    }
    const float inv = 1.0f / swap_add(lrun);
    bf16_t* op = Oh + (size_t)qrow * D + 4 * hi;
#pragma unroll
    for (int i = 0; i < 4; ++i) {
        u32x2 w0; w0.x = cvt_pk_bf16(o0[4 * i] * inv, o0[4 * i + 1] * inv); w0.y = cvt_pk_bf16(o0[4 * i + 2] * inv, o0[4 * i + 3] * inv); *(u32x2*)(op + 8 * i) = w0;
        u32x2 w1; w1.x = cvt_pk_bf16(o1[4 * i] * inv, o1[4 * i + 1] * inv); w1.y = cvt_pk_bf16(o1[4 * i + 2] * inv, o1[4 * i + 3] * inv); *(u32x2*)(op + 32 + 8 * i) = w1;
    }
}
}

constexpr int SPC = 13, NSTEP = 1 + SPC * NCHUNK + 1;
struct Args { const float* in[21]; float* out; unsigned char* ws; int ph_lo, ph_hi; };

__global__ void __launch_bounds__(512, 2) fwd_kernel(Args args) {
    extern __shared__ __attribute__((aligned(16))) unsigned char lds_raw[];
    LAS unsigned char* lds = (LAS unsigned char*)lds_raw;
    const int wave0 = __builtin_amdgcn_readfirstlane(threadIdx.x >> 6);
    for (int ph = args.ph_lo; ph < args.ph_hi; ++ph) {
    int tid_l = wave0 * 64 + (int)__builtin_amdgcn_mbcnt_hi(~0u, __builtin_amdgcn_mbcnt_lo(~0u, 0u)); asm volatile("" : "+v"(tid_l));
    unsigned char* ws = args.ws; asm volatile("" : "+s"(ws));
    const int tid = tid_l, lane = tid & 63; const int wave = wave0;
    const int G = gridDim.x, bx = blockIdx.x; const int vcu = (G % 8 == 0) ? (bx % 8) * (G / 8) + bx / 8 : bx;
    const int gw = vcu * 8 + wave, NGW = G * 8;
    bf16_t* Win_t = (bf16_t*)(ws + WS_WIN); bf16_t* Wuq_t = (bf16_t*)(ws + WS_WUQ); bf16_t* Wukv_t = (bf16_t*)(ws + WS_WUKV); bf16_t* Pa_t = (bf16_t*)(ws + WS_PA);
    bf16_t* Pb_t = (bf16_t*)(ws + WS_PB); bf16_t* Wout_t = (bf16_t*)(ws + WS_WOUT); bf16_t* Wup_t = (bf16_t*)(ws + WS_WUP); bf16_t* Wdown_t = (bf16_t*)(ws + WS_WDOWN);
    float* MOD = (float*)(ws + WS_MOD); float* ROPE = (float*)(ws + WS_ROPE); float* RSTD = (float*)(ws + WS_RSTD);
    bf16_t* Hb = (bf16_t*)(ws + WS_H); bf16_t* Zb = (bf16_t*)(ws + WS_Z); bf16_t* Qb = (bf16_t*)(ws + WS_Q); bf16_t* KFb = (bf16_t*)(ws + WS_KF); bf16_t* Vb = (bf16_t*)(ws + WS_V);
    bf16_t* OAb = (bf16_t*)(ws + WS_OA); bf16_t* OBb = (bf16_t*)(ws + WS_OB); float* OGb = (float*)(ws + WS_OG); float* LSEb = (float*)(ws + WS_LSE);
    float* Tb = (float*)(ws + WS_T); bf16_t* MGb = (bf16_t*)(ws + WS_MERGED); bf16_t* UPb = (bf16_t*)(ws + WS_UP); bf16_t* ACTb = (bf16_t*)(ws + WS_ACT);
    bool sync_after = true;
        if (ph == 0) {
            if (bx < 96) {
                LAS float* sl = (LAS float*)lds;
                LAS float* part = (LAS float*)(lds + 49152);
                for (int idx = tid; idx < 12 * 1024; idx += 512) { const int b = idx >> 10, d = idx & 1023; const float c = b < 8 ? args.in[2][b * 1024 + d] : args.in[3][(b - 8) * 1024 + d];
                    sl[d * 12 + b] = c / (1.0f + __expf(-c)); }
                __syncthreads();
                const int e = bx * 64 + lane; float acc[12];
#pragma unroll
                for (int b = 0; b < 12; ++b) acc[b] = 0.f;
                const float* wp = args.in[4] + (size_t)(wave * 128) * 6144 + e;
#pragma unroll 8
                for (int d = 0; d < 128; ++d) { const float w = wp[(size_t)d * 6144]; const LAS f32x4* s4 = (const LAS f32x4*)(sl + (wave * 128 + d) * 12);
                    const f32x4 a = s4[0], b4 = s4[1], c4 = s4[2];
                    acc[0] += a.x * w; acc[1] += a.y * w; acc[2] += a.z * w; acc[3] += a.w * w; acc[4] += b4.x * w; acc[5] += b4.y * w; acc[6] += b4.z * w; acc[7] += b4.w * w;
                    acc[8] += c4.x * w; acc[9] += c4.y * w; acc[10] += c4.z * w; acc[11] += c4.w * w; }
#pragma unroll
                for (int b = 0; b < 12; ++b) part[(wave * 12 + b) * 64 + lane] = acc[b];
                __syncthreads();
                if (wave == 0) {
#pragma unroll
                    for (int b = 0; b < 12; ++b) { float s = args.in[5][e];
#pragma unroll
                        for (int w = 0; w < 8; ++w) s += part[(w * 12 + b) * 64 + lane];
                        MOD[b * 6144 + e] = s; } }
                __syncthreads();
            }
            for (int idx = bx * 512 + tid; idx < 8192 * 16; idx += G * 512) { const int pos = idx >> 4, i = idx & 15; const float ang = (float)pos * ROPE_INV[i];
                const double tt = (double)ang * 0.15915494309189535; const float fr_ = (float)(tt - floor(tt));
                ROPE[idx] = __builtin_amdgcn_cosf(fr_); ROPE[131072 + idx] = __builtin_amdgcn_sinf(fr_); }
            {
                LAS float* scr = (LAS float*)(lds + wave * 16384);
                constexpr int I_IN = 16 * 157, I_UQ = 6 * 48, I_UKV = 4 * 64, I_PA = 16 * 32, I_PB = 4 * 32, I_OUT = 16 * 32, I_UP = 16 * 176, I_DOWN = 44 * 32;
                constexpr int NITEMS = I_IN + I_UQ + I_UKV + I_PA + I_PB + I_OUT + I_UP + I_DOWN;
                for (int it = gw; it < NITEMS; it += NGW) {
                    int r = it; const float* W; int K, N, kind = 0; bf16_t* WT; const float* ks = nullptr;
                    if (r < I_IN) { W = args.in[7]; K = 1024; N = 5024; WT = Win_t; kind = 1; }
                    else if ((r -= I_IN) < I_UQ) { W = args.in[10]; K = 384; N = 1536; WT = Wuq_t; kind = 2; ks = args.in[8]; }
                    else if ((r -= I_UQ) < I_UKV) { W = args.in[11]; K = 256; N = 2048; WT = Wukv_t; kind = 3; ks = args.in[9]; }
                    else if ((r -= I_UKV) < I_PA) { W = args.in[12]; K = 1024; N = 1024; WT = Pa_t; }
                    else if ((r -= I_PA) < I_PB) { W = args.in[13]; K = 256; N = 1024; WT = Pb_t; }
                    else if ((r -= I_PB) < I_OUT) { W = args.in[14]; K = 1024; N = 1024; WT = Wout_t; }
                    else if ((r -= I_OUT) < I_UP) { W = args.in[16]; K = 1024; N = 5632; WT = Wup_t; }
                    else { r -= I_UP; W = args.in[19]; K = 2816; N = 1024; WT = Wdown_t; }
                    transpose_item(W, K, N, WT, kind, ks, scr, r, lane);
                }
                for (int idx = bx * 512 + tid; idx < 96 * 128; idx += G * 512) *(u32x4*)(Win_t + (size_t)672 * 1024 + (size_t)idx * 8) = (u32x4){0u, 0u, 0u, 0u};
            }
            __syncthreads();
        } else if (ph == NSTEP - 1) {
            float* o = args.out + (size_t)(NCHUNK - 1) * CH * D;
            for (int m = gw; m < CH; m += NGW) final_norm_row(o + (size_t)m * D, args.in[20], lane);
        } else {
            const int c = (ph - 1) / SPC, k = (ph - 1) - SPC * c;
            ChunkP P;
            if (c == 0) { P.x = args.in[0]; P.S = 2048; P.Sshift = 11; P.nseq = 8; P.seqbase = 0; }
            else { P.x = args.in[1] + (size_t)(c - 1) * CH * D; P.S = 8192; P.Sshift = 13; P.nseq = 2; P.seqbase = 8 + 2 * (c - 1); }
            P.out = args.out + (size_t)c * CH * D;
            sync_after = !(k == 3 || k == 6);
            pg8::Gemm g{}; pg8::EpiAny E{}; bool is_gemm = true;
            E.S = P.S; E.Sshift = P.Sshift; E.seqbase = P.seqbase; E.rstd = RSTD; E.rope = ROPE; E.Z = Zb; E.T = Tb; E.mod = MOD;
            if (k == 1) { g = pg8::Gemm{Hb, Win_t, CH, ZLD, 1024, 1024}; E.kind = 0; E.O = Zb; E.ldc = ZLD; E.sig_pn = 12; }
            else if (k == 3) { g = pg8::Gemm{Zb, Wuq_t, CH, 1536, 384, ZLD}; E.kind = 1; E.Q = Qb; }
            else if (k == 4) { g = pg8::Gemm{Zb + 384, Wukv_t, CH, 2048, 256, ZLD}; E.kind = 2; E.KF = KFb; E.V = Vb; }
            else if (k == 6) { g = pg8::Gemm{OAb, Pa_t, CH, 1024, 1024, 1024}; E.kind = 3; }
            else if (k == 7) { g = pg8::Gemm{OBb, Pb_t, CH, 1024, 256, 256}; E.kind = 4; E.O = MGb; }
            else if (k == 8) { g = pg8::Gemm{MGb, Wout_t, CH, 1024, 1024, 1024}; E.kind = 5; E.base = P.x; E.out = P.out; E.goff = 2048; }
            else if (k == 10) { g = pg8::Gemm{Hb, Wup_t, CH, NUP, 1024, 1024}; E.kind = 0; E.O = UPb; E.ldc = NUP; E.sig_pn = 1 << 30; }
            else if (k == 12) { g = pg8::Gemm{ACTb, Wdown_t, CH, 1024, DFF, DFF}; E.kind = 5; E.base = P.out; E.out = P.out; E.goff = 5120; }
            else is_gemm = false;
            if (is_gemm) { pg8::StaticOrder S; S.init(g.M, g.N, G, bx); pg8::gemm_phase(lds, g, S, E, tid); }
            else if (k == 0) {
                if (c > 0) { float* o = args.out + (size_t)(c - 1) * CH * D; for (int m = gw; m < CH; m += NGW) final_norm_row(o + (size_t)m * D, args.in[20], lane); }
                for (int m = gw; m < CH; m += NGW) { const float* md = MOD + (size_t)(P.seqbase + (m >> P.Sshift)) * 6144;
                    norm_mod_row(P.x + (size_t)m * D, Hb + (size_t)m * D, args.in[6], md + 1024, md, lane); }
            } else if (k == 2) {
                for (int m = gw; m < CH; m += NGW) {
                    const unsigned* zr = (const unsigned*)(Zb + (size_t)m * ZLD);
                    float sq = 0.f, skv = 0.f;
#pragma unroll
                    for (int j = 0; j < 3; ++j) { const unsigned w = zr[lane + 64 * j]; const float a = bflo(w), b = bfhi(w); sq += a * a + b * b; }
#pragma unroll
                    for (int j = 0; j < 2; ++j) { const unsigned w = zr[192 + lane + 64 * j]; const float a = bflo(w), b = bfhi(w); skv += a * a + b * b; }
                    sq = wave_sum(sq); skv = wave_sum(skv);
                    if (lane == 0) { RSTD[2 * m] = 1.0f / sqrtf(sq * (1.f / 384.f) + EPS); RSTD[2 * m + 1] = 1.0f / sqrtf(skv * (1.f / 256.f) + EPS); }
                    const int seq = m >> P.Sshift, pos = m & (P.S - 1);
                    unsigned pr = 0u;
                    { const int i = lane & 15; const unsigned w = zr[320 + i]; const float a = bflo(w), b = bfhi(w); const float cs = ROPE[pos * 16 + i], sn = ROPE[131072 + pos * 16 + i];
                      pr = cvt_pk_bf16(a * cs - b * sn, a * sn + b * cs); }
                    u32x4 o; const int b4 = 4 * (lane & 3);
                    o.x = __shfl(pr, b4); o.y = __shfl(pr, b4 + 1); o.z = __shfl(pr, b4 + 2); o.w = __shfl(pr, b4 + 3);
                    const int head = lane >> 2;
                    *(u32x4*)(KFb + ((size_t)((seq * 16 + head) << P.Sshift) + pos) * 96 + 64 + 8 * (lane & 3)) = o;
                }
                LAS unsigned char* wl = lds + wave * 4096;
                for (int task = gw; task < CH * 12 / 32; task += NGW) dil_task(Zb, OGb, LSEb, P.S, task, wl, lane);
            } else if (k == 5) {
                for (int it = bx * 512 + tid; it < CH * 32; it += G * 512) { const int row = it >> 5, j = (it >> 3) & 3, d8 = (it & 7) * 8;
                    const float l0 = LSEb[row * 12 + j], l1 = LSEb[row * 12 + 4 + j], l2 = LSEb[row * 12 + 8 + j]; const float mx = fmaxf(l0, fmaxf(l1, l2));
                    float w0 = __expf(l0 - mx), w1 = __expf(l1 - mx), w2 = __expf(l2 - mx); const float inv = 1.0f / (w0 + w1 + w2); w0 *= inv; w1 *= inv; w2 *= inv;
                    const float* p0 = OGb + ((size_t)row * 12 + j) * 64 + d8; const float* p1 = p0 + 4 * 64; const float* p2 = p0 + 8 * 64;
                    const f32x4 a0 = *(const f32x4*)p0 * w0 + *(const f32x4*)p1 * w1 + *(const f32x4*)p2 * w2;
                    const f32x4 a1 = *(const f32x4*)(p0 + 4) * w0 + *(const f32x4*)(p1 + 4) * w1 + *(const f32x4*)(p2 + 4) * w2;
                    *(u32x4*)(OBb + (size_t)row * 256 + j * 64 + d8) = pg8::pack8(a0, a1); }
                const int nqb = P.S >> 8, nunits = P.nseq * 16 * nqb;
                for (int uidx = vcu; uidx < nunits; uidx += G) { const int pair = uidx / nqb, qb = uidx - pair * nqb; const int seq = pair >> 4, head = pair & 15;
                    const size_t hb = (size_t)pair << P.Sshift;
                    mla::attn_unit(Qb + hb * 96, KFb + hb * 96, Vb + hb * 64, OAb + ((size_t)seq << P.Sshift) * D + head * 64, P.S, qb, lds, tid); }
            } else if (k == 9) {
                for (int m = gw; m < CH; m += NGW) { const float* md = MOD + (size_t)(P.seqbase + (m >> P.Sshift)) * 6144;
                    norm_mod_row(P.out + (size_t)m * D, Hb + (size_t)m * D, args.in[15], md + 4096, md + 3072, lane); }
            } else if (k == 11) {
                if (tid < 352) {
                    const int f0 = tid * 8; float w0[8], w1[8], w2[8], cb[8];
#pragma unroll
                    for (int e = 0; e < 8; ++e) { w0[e] = args.in[17][f0 + e]; w1[e] = args.in[17][DFF + f0 + e]; w2[e] = args.in[17][2 * DFF + f0 + e]; cb[e] = args.in[18][f0 + e]; }
                    for (int blk = vcu; blk < CH / 64; blk += G) {
                        const int r0 = blk * 64; const int pos0 = r0 & (P.S - 1);
                        const bf16_t* up = UPb + (size_t)r0 * NUP + f0;
                        u32x4 prev = (u32x4){0u, 0u, 0u, 0u}; if (pos0 > 0) prev = *(const u32x4*)(up - NUP);
                        u32x4 curv = *(const u32x4*)up;
#pragma unroll 4
                        for (int i = 0; i < 64; ++i) {
                            u32x4 nxt = (u32x4){0u, 0u, 0u, 0u}; if (pos0 + i + 1 < P.S) nxt = *(const u32x4*)(up + (size_t)(i + 1) * NUP);
                            const u32x4 gv = *(const u32x4*)(up + (size_t)i * NUP + DFF);
                            float r[8];
#pragma unroll
                            for (int q = 0; q < 4; ++q) {
                                const float pl = bflo(prev[q]), ph_ = bfhi(prev[q]), cl = bflo(curv[q]), chh = bfhi(curv[q]), nl = bflo(nxt[q]), nh = bfhi(nxt[q]);
                                const float xl = cb[2 * q] + w0[2 * q] * pl + w1[2 * q] * cl + w2[2 * q] * nl, xh = cb[2 * q + 1] + w0[2 * q + 1] * ph_ + w1[2 * q + 1] * chh + w2[2 * q + 1] * nh;
                                const float yl = 0.7978845608028654f * (xl + 0.044715f * xl * xl * xl), yh = 0.7978845608028654f * (xh + 0.044715f * xh * xh * xh);
                                r[2 * q] = xl * sigmoidf_(2.0f * yl) * bflo(gv[q]); r[2 * q + 1] = xh * sigmoidf_(2.0f * yh) * bfhi(gv[q]);
                            }
                            u32x4 o; o.x = cvt_pk_bf16(r[0], r[1]); o.y = cvt_pk_bf16(r[2], r[3]); o.z = cvt_pk_bf16(r[4], r[5]); o.w = cvt_pk_bf16(r[6], r[7]);
                            *(u32x4*)(ACTb + (size_t)(r0 + i) * DFF + f0) = o;
                            prev = curv; curv = nxt;
                        }
                    }
                }
            }
        }
#if MEGA
        if (sync_after && ph + 1 < args.ph_hi) cg::this_grid().sync();
#else
        (void)sync_after;
#endif
    }
}

extern "C" void kernel_launch(void* const* d_in, const int* in_sizes, int n_in, void* d_out, int out_size, void* d_ws, size_t ws_size, hipStream_t stream) {
    static int grid = 0;
    if (grid == 0) {
        if (n_in != 21 || ws_size < WS_END) { fprintf(stderr, "kernel_launch: unexpected n_in %d / ws_size %zu\n", n_in, ws_size); grid = -1; return; }
        int dev = 0, cus = 0, per_cu = 0;
        (void)hipGetDevice(&dev); (void)hipDeviceGetAttribute(&cus, hipDeviceAttributeMultiprocessorCount, dev);
        (void)hipFuncSetAttribute((const void*)fwd_kernel, hipFuncAttributeMaxDynamicSharedMemorySize, LDS_BYTES);
        (void)hipOccupancyMaxActiveBlocksPerMultiprocessor(&per_cu, (const void*)fwd_kernel, 512, LDS_BYTES);
        (void)hipGetLastError();
        if (per_cu < 1) fprintf(stderr, "kernel_launch: occupancy query says %d blocks/CU\n", per_cu);
        grid = cus;
    }
    if (grid < 0) return;
    Args a{};
    for (int i = 0; i < 21; ++i) a.in[i] = (const float*)d_in[i];
    a.out = (float*)d_out; a.ws = (unsigned char*)d_ws;
#if MEGA
    a.ph_lo = 0; a.ph_hi = NSTEP;
    void* kargs[] = {&a};
    hipError_t e = hipLaunchCooperativeKernel((const void*)fwd_kernel, dim3(grid), dim3(512), kargs, LDS_BYTES, stream);
    if (e != hipSuccess) fprintf(stderr, "cooperative launch failed: %s (grid %d)\n", hipGetErrorString(e), grid);
#else
    for (int ph = 0; ph < NSTEP; ++ph) { a.ph_lo = ph; a.ph_hi = ph + 1; hipLaunchKernelGGL(fwd_kernel, dim3(grid), dim3(512), LDS_BYTES, stream, a); }
#endif
}
```

```cpp
#include <hip/hip_runtime.h>
#include <hip/hip_cooperative_groups.h>
#include <cstdio>
#include <cstdint>
namespace cg = cooperative_groups;

#ifndef MEGA
#define MEGA 1
#endif

#define LAS __attribute__((address_space(3)))
typedef unsigned short bf16_t;
typedef short bf16x8 __attribute__((ext_vector_type(8)));
typedef short s16x4 __attribute__((ext_vector_type(4)));
typedef float f32x2 __attribute__((ext_vector_type(2)));
typedef float f32x4 __attribute__((ext_vector_type(4)));
typedef float f32x16 __attribute__((ext_vector_type(16)));
typedef unsigned u32x2 __attribute__((ext_vector_type(2)));
typedef unsigned u32x4 __attribute__((ext_vector_type(4)));

constexpr int D = 1024, CH = 16384, NCHUNK = 3, ZLD = 5120, NUP = 5632, DFF = 2816;

constexpr float EPS = 1e-6f, LOG2E = 1.4426950408889634f, LN2 = 0.6931471805599453f;
constexpr float QSCALE = 0.10206207261596577f * LOG2E;
constexpr float DSCALE = 0.125f * LOG2E;

constexpr size_t MiB = 1u << 20;
constexpr size_t WS_WIN = 2 * MiB, WS_WUQ = 12 * MiB, WS_WUKV = 14 * MiB, WS_PA = 15 * MiB, WS_PB = 17 * MiB, WS_WOUT = 18 * MiB,
                 WS_WUP = 20 * MiB, WS_WDOWN = 31 * MiB;
constexpr size_t WS_MOD = 37 * MiB, WS_ROPE = 38 * MiB  , WS_RSTD = 39 * MiB + 512 * 1024;
constexpr size_t WS_H = 40 * MiB, WS_Z = 72 * MiB, WS_Q = 232 * MiB, WS_KF = 280 * MiB, WS_V = 328 * MiB, WS_OA = 360 * MiB, WS_OB = 392 * MiB,
                 WS_OG = 400 * MiB, WS_LSE = 448 * MiB, WS_T = 232 * MiB, WS_MERGED = 296 * MiB, WS_UP = 72 * MiB, WS_ACT = 248 * MiB, WS_END = 449 * MiB;

constexpr int LDS_BYTES = 147456;

__device__ __forceinline__ unsigned cvt_pk_bf16(float lo, float hi) { unsigned r; asm volatile("v_cvt_pk_bf16_f32 %0, %1, %2" : "=v"(r) : "v"(lo), "v"(hi)); return r; }
__device__ __forceinline__ float bf2f(unsigned short b) { return __uint_as_float((unsigned)b << 16); }
__device__ __forceinline__ float bflo(unsigned w) { return __uint_as_float(w << 16); }
__device__ __forceinline__ float bfhi(unsigned w) { return __uint_as_float(w & 0xffff0000u); }
__device__ __forceinline__ float wave_sum(float v) {
#pragma unroll
    for (int o = 1; o < 64; o <<= 1) v += __shfl_xor(v, o);
    return v;
}
__device__ __forceinline__ float swap_max(float m) { auto rr = __builtin_amdgcn_permlane32_swap(__float_as_uint(m), __float_as_uint(m), false, false); return fmaxf(__uint_as_float(rr[0]), __uint_as_float(rr[1])); }
__device__ __forceinline__ float swap_add(float m) { auto rr = __builtin_amdgcn_permlane32_swap(__float_as_uint(m), __float_as_uint(m), false, false); return __uint_as_float(rr[0]) + __uint_as_float(rr[1]); }
__device__ __forceinline__ s16x4 vtr(LAS const unsigned char* p) { return __builtin_bit_cast(s16x4, __builtin_amdgcn_ds_read_tr16_b64_v4i16((LAS s16x4*)p)); }
__device__ __forceinline__ float sigmoidf_(float x) { return __builtin_amdgcn_rcpf(1.0f + __builtin_amdgcn_exp2f(-x * LOG2E)); }

struct ChunkP { const float* x; float* out; int S, Sshift, nseq, seqbase; };

namespace pg8 {
constexpr int BM = 256, BK = 64, HALF = 128, HTB = HALF * BK * 2, STAGE_BYTES = 8 * HTB, NXCD = 8, WGM = 8;
__host__ __device__ __forceinline__ int lds_byte(int r, int c) { const int st = (r >> 4) * 2 + (c >> 5), rr = r & 15, cc = c & 31, ob = rr * 64 + cc * 2; return st * 1024 + (ob ^ (((ob >> 9) & 1) << 5)); }
__host__ __device__ __forceinline__ void stage_rc(int b, int& R, int& C) { const int st = b / 1024, sb = b % 1024, swz = sb ^ (((sb >> 9) & 1) << 5); R = (st >> 1) * 16 + swz / 64; C = (st & 1) * 32 + (swz % 64) / 2; }
__host__ __device__ __forceinline__ int perm32(int rho) { const int n = rho >> 4, i = rho & 15; return 8 * (i >> 2) + 4 * n + (i & 3); }
struct Unit { int pm, pn; };
struct Gemm { const bf16_t* A; const bf16_t* Bt; int M, N, K, lda; };
struct StaticOrder {
    int nM, nN, nwg, G, c;
    __device__ void init(int M, int N, int G_, int c_) { nM = M / BM; nN = N / BM; nwg = nM * nN; G = G_; c = c_; }
    __device__ bool next(int i, Unit& u) const {
        const long L = (long)i * G + c; if (L >= nwg) return false;
        int wgid = (int)L; { const int q = nwg / NXCD, r = nwg % NXCD, xcd = wgid % NXCD, off = wgid / NXCD; wgid = (xcd < r ? xcd * (q + 1) : r * (q + 1) + (xcd - r) * q) + off; }
        const int nig = WGM * nN, gid = wgid / nig, fm = gid * WGM, gsz = (nM - fm) < WGM ? (nM - fm) : WGM;
        u.pm = fm + ((wgid % nig) % gsz); u.pn = (wgid % nig) / gsz; return true;
    }
};

template <class Epi, class Sched>
__device__ __forceinline__ void gemm_phase(LAS unsigned char* lds, const Gemm g, const Sched& S, const Epi& E, int tid_in) {
    int tid_ = tid_in; asm volatile("" : "+v"(tid_));
    const int tid = tid_, wid = __builtin_amdgcn_readfirstlane(tid >> 6), lane = tid & 63, wr = wid >> 2, wc = wid & 3, fr = lane & 15, fq = lane >> 4;
    const int K = g.K, nt = K / BK, lda = g.lda;
    unsigned voffA[2], voffB[2];
#pragma unroll
    for (int i = 0; i < 2; ++i) { int R, C; stage_rc(tid * 16 + i * 8192, R, C); const int Rb = (R & ~31) + perm32(R & 31);
        voffA[i] = (unsigned)(R * lda + C) * 2u; voffB[i] = (unsigned)(Rb * K + C) * 2u; }
    const size_t kstep = (size_t)(BK * 2);
    const size_t hstepA = (size_t)HALF * lda * 2, hstepB = (size_t)HALF * K * 2;
    const size_t tstepA = 2 * hstepA, tstepB = 2 * hstepB;
    const unsigned ldsw = (unsigned)wid * 1024u;
    const int aoff = lds_byte(wr * 64 + fr, fq * 8), boff = lds_byte(wc * 32 + fr, fq * 8);
#define PG8_SA(b, h) (((b) * 2 + (h)) * HTB)
#define PG8_SB(b, h) ((4 + (b) * 2 + (h)) * HTB)
#define PG8_STAGE(bufoff, gbase, voff) do { _Pragma("unroll") for (int _i = 0; _i < 2; ++_i) \
        __builtin_amdgcn_global_load_lds((const unsigned*)((const char*)(gbase) + (voff)[_i]), (LAS unsigned*)(lds + (bufoff) + ldsw + _i * 8192), 16, 0, 0); } while (0)
#define PG8_LDA(dst, b, h) do { _Pragma("unroll") for (int m = 0; m < 4; ++m) _Pragma("unroll") for (int k = 0; k < 2; ++k) dst[m][k] = *(const LAS bf16x8*)(lds + PG8_SA(b, h) + aoff + m * 2048 + k * 1024); } while (0)
#define PG8_LDB(dst, b, h) do { _Pragma("unroll") for (int n = 0; n < 2; ++n) _Pragma("unroll") for (int k = 0; k < 2; ++k) dst[n][k] = *(const LAS bf16x8*)(lds + PG8_SB(b, h) + boff + n * 2048 + k * 1024); } while (0)
#define PG8_MMA(ai, bj, At, Bt) do { __builtin_amdgcn_s_setprio(1); _Pragma("unroll") for (int m = 0; m < 4; ++m) _Pragma("unroll") for (int n = 0; n < 2; ++n) _Pragma("unroll") for (int k = 0; k < 2; ++k) \
        acc[ai][bj][m][n] = __builtin_amdgcn_mfma_f32_16x16x32_bf16(Bt[n][k], At[m][k], acc[ai][bj][m][n], 0, 0, 0); __builtin_amdgcn_s_setprio(0); } while (0)
#define PG8_WAIT_V(n) asm volatile("s_waitcnt vmcnt(" #n ")" ::: "memory")
#define PG8_WAIT_L(n) asm volatile("s_waitcnt lgkmcnt(" #n ")" ::: "memory")
#define PG8_BAR __builtin_amdgcn_s_barrier()
#define PG8_SCHED __builtin_amdgcn_sched_barrier(0)
    Unit cur, nxt; int ui = 0;
    if (!S.next(0, cur)) return;
    f32x4 acc[2][2][4][2];
#pragma unroll
    for (int a = 0; a < 2; ++a)
#pragma unroll
        for (int b = 0; b < 2; ++b)
#pragma unroll
            for (int m = 0; m < 4; ++m)
#pragma unroll
                for (int n = 0; n < 2; ++n) acc[a][b][m][n] = (f32x4){0.f, 0.f, 0.f, 0.f};
    bf16x8 At[4][2], B0[2][2], B1[2][2];
    const char* cA = (const char*)g.A + (size_t)cur.pm * tstepA; const char* cB = (const char*)g.Bt + (size_t)cur.pn * tstepB;
    PG8_STAGE(PG8_SB(0, 0), cB, voffB); PG8_STAGE(PG8_SB(0, 1), cB + hstepB, voffB); PG8_STAGE(PG8_SA(0, 0), cA, voffA); PG8_STAGE(PG8_SA(0, 1), cA + hstepA, voffA);
    if (wr == 1) PG8_BAR;
    PG8_WAIT_V(2); PG8_BAR;
    PG8_STAGE(PG8_SB(1, 0), cB + kstep, voffB); PG8_STAGE(PG8_SA(1, 0), cA + kstep, voffA); PG8_STAGE(PG8_SB(1, 1), cB + hstepB + kstep, voffB);
    PG8_WAIT_V(6); PG8_BAR;
    for (;;) {
        const bool has_next = S.next(ui + 1, nxt);
        const char* nA = has_next ? (const char*)g.A + (size_t)nxt.pm * tstepA : cA; const char* nB = has_next ? (const char*)g.Bt + (size_t)nxt.pn * tstepB : cB;
        for (int t = 0; t < nt; t += 2) {
            const bool last = (t == nt - 2);
            const char* a1 = cA + (size_t)(t + 1) * kstep;
            const char* a2 = last ? nA : cA + (size_t)(t + 2) * kstep; const char* b2 = last ? nB : cB + (size_t)(t + 2) * kstep;
            const char* a3 = a2 + kstep; const char* b3 = b2 + kstep;
            PG8_LDB(B0, 0, 0); PG8_LDB(B1, 0, 1); PG8_SCHED; PG8_LDA(At, 0, 0); PG8_STAGE(PG8_SA(1, 1), a1 + hstepA, voffA);
            PG8_WAIT_V(8); PG8_WAIT_L(0); PG8_BAR; PG8_MMA(0, 0, At, B0); PG8_MMA(0, 1, At, B1); PG8_BAR; PG8_SCHED;
            PG8_LDA(At, 0, 1); PG8_STAGE(PG8_SB(0, 0), b2, voffB); PG8_STAGE(PG8_SB(0, 1), b2 + hstepB, voffB); PG8_STAGE(PG8_SA(0, 0), a2, voffA);
            PG8_WAIT_V(8); PG8_WAIT_L(0); PG8_BAR; PG8_MMA(1, 0, At, B0); PG8_MMA(1, 1, At, B1); PG8_BAR; PG8_SCHED;
            PG8_LDB(B0, 1, 0); PG8_LDB(B1, 1, 1); PG8_SCHED; PG8_LDA(At, 1, 0); PG8_STAGE(PG8_SA(0, 1), a2 + hstepA, voffA);
            PG8_WAIT_V(8); PG8_WAIT_L(0); PG8_BAR; PG8_MMA(0, 0, At, B0); PG8_MMA(0, 1, At, B1); PG8_BAR; PG8_SCHED;
            PG8_LDA(At, 1, 1); PG8_STAGE(PG8_SB(1, 0), b3, voffB); PG8_STAGE(PG8_SB(1, 1), b3 + hstepB, voffB); PG8_STAGE(PG8_SA(1, 0), a3, voffA);
            PG8_WAIT_V(8); PG8_WAIT_L(0); PG8_BAR; PG8_MMA(1, 0, At, B0); PG8_MMA(1, 1, At, B1); PG8_BAR; PG8_SCHED;
        }
        if (wr == 0) PG8_BAR;
        E(acc, cur, wr, wc, fr, fq);
        if (!has_next) break;
#pragma unroll
        for (int a = 0; a < 2; ++a)
#pragma unroll
            for (int b = 0; b < 2; ++b)
#pragma unroll
                for (int m = 0; m < 4; ++m)
#pragma unroll
                    for (int n = 0; n < 2; ++n) acc[a][b][m][n] = (f32x4){0.f, 0.f, 0.f, 0.f};
        cur = nxt; cA = nA; cB = nB; ++ui;
        if (wr == 1) PG8_BAR;
    }
    PG8_WAIT_V(0);
    PG8_BAR;
#undef PG8_SA
#undef PG8_SB
#undef PG8_STAGE
#undef PG8_LDA
#undef PG8_LDB
#undef PG8_MMA
#undef PG8_WAIT_V
#undef PG8_WAIT_L
#undef PG8_BAR
#undef PG8_SCHED
}

#define EPI_ARGS const f32x4 (&acc)[2][2][4][2], const Unit& u, int wr, int wc, int fr, int fq
__device__ __forceinline__ u32x4 pack8(f32x4 v0, f32x4 v1) { u32x4 w; w.x = cvt_pk_bf16(v0[0], v0[1]); w.y = cvt_pk_bf16(v0[2], v0[3]); w.z = cvt_pk_bf16(v1[0], v1[1]); w.w = cvt_pk_bf16(v1[2], v1[3]); return w; }

struct EpiStore {
    bf16_t* O; int ldc; int sig_pn;
    __device__ __forceinline__ void operator()(EPI_ARGS) const {
        const int row0 = u.pm * BM + wr * 64 + fr, col0 = u.pn * BM + wc * 32 + 8 * fq; const bool sig = u.pn >= sig_pn;
#pragma unroll
        for (int ai = 0; ai < 2; ++ai)
#pragma unroll
            for (int m = 0; m < 4; ++m) { bf16_t* rowp = O + (size_t)(row0 + ai * HALF + m * 16) * ldc + col0;
#pragma unroll
                for (int bj = 0; bj < 2; ++bj) { f32x4 v0 = acc[ai][bj][m][0], v1 = acc[ai][bj][m][1];
                    if (sig) {
#pragma unroll
                        for (int e = 0; e < 4; ++e) { v0[e] = sigmoidf_(v0[e]); v1[e] = sigmoidf_(v1[e]); } }
                    *(u32x4*)(rowp + bj * HALF) = pack8(v0, v1); } }
    }
};
struct EpiQ {
    bf16_t* Q; const float* rstd; const float* rope; int S, Sshift;
    __device__ __forceinline__ void operator()(EPI_ARGS) const {
        const int row0 = u.pm * BM + wr * 64 + fr;
#pragma unroll
        for (int ai = 0; ai < 2; ++ai)
#pragma unroll
            for (int m = 0; m < 4; ++m) { const int row = row0 + ai * HALF + m * 16; const int seq = row >> Sshift, pos = row & (S - 1);
                const float sc = rstd[2 * row] * QSCALE;
#pragma unroll
                for (int bj = 0; bj < 2; ++bj) { const int g32 = 8 * u.pn + 4 * bj + wc; const int head = g32 / 3, gl = g32 - 3 * head;
                    f32x4 v0 = acc[ai][bj][m][0] * sc, v1 = acc[ai][bj][m][1] * sc;
                    if (gl == 2) { const f32x4 cs = *(const f32x4*)(rope + (size_t)pos * 16 + 4 * fq), sn = *(const f32x4*)(rope + 131072 + (size_t)pos * 16 + 4 * fq);
                        f32x4 w0, w1;
                        w0[0] = v0[0] * cs[0] - v0[1] * sn[0]; w0[1] = v0[0] * sn[0] + v0[1] * cs[0];
                        w0[2] = v0[2] * cs[1] - v0[3] * sn[1]; w0[3] = v0[2] * sn[1] + v0[3] * cs[1];
                        w1[0] = v1[0] * cs[2] - v1[1] * sn[2]; w1[1] = v1[0] * sn[2] + v1[1] * cs[2];
                        w1[2] = v1[2] * cs[3] - v1[3] * sn[3]; w1[3] = v1[2] * sn[3] + v1[3] * cs[3];
                        v0 = w0; v1 = w1; }
                    *(u32x4*)(Q + ((size_t)((seq * 16 + head) << Sshift) + pos) * 96 + gl * 32 + 8 * fq) = pack8(v0, v1); }
                asm volatile("" ::: "memory"); }
    }
};
struct EpiKV {
    bf16_t* KF; bf16_t* V; const float* rstd; int S, Sshift;
    __device__ __forceinline__ void operator()(EPI_ARGS) const {
        const int row0 = u.pm * BM + wr * 64 + fr; const bool isv = u.pn >= 4;
#pragma unroll
        for (int ai = 0; ai < 2; ++ai)
#pragma unroll
            for (int m = 0; m < 4; ++m) { const int row = row0 + ai * HALF + m * 16; const int seq = row >> Sshift, pos = row & (S - 1);
                const float sc = rstd[2 * row + 1];
#pragma unroll
                for (int bj = 0; bj < 2; ++bj) { const int col = (u.pn & 3) * BM + bj * HALF + wc * 32 + 8 * fq; const int head = col >> 6, d = col & 63;
                    const f32x4 v0 = acc[ai][bj][m][0] * sc, v1 = acc[ai][bj][m][1] * sc; const size_t tok = (size_t)((seq * 16 + head) << Sshift) + pos;
                    bf16_t* p = isv ? V + tok * 64 + d : KF + tok * 96 + d;
                    *(u32x4*)p = pack8(v0, v1); }
                asm volatile("" ::: "memory"); }
    }
};
struct EpiGateA {
    float* T; const bf16_t* Z;
    __device__ __forceinline__ void operator()(EPI_ARGS) const {
        const int row0 = u.pm * BM + wr * 64 + fr, col0 = u.pn * BM + wc * 32 + 8 * fq;
#pragma unroll
        for (int ai = 0; ai < 2; ++ai)
#pragma unroll
            for (int m = 0; m < 4; ++m) { const int row = row0 + ai * HALF + m * 16;
#pragma unroll
                for (int bj = 0; bj < 2; ++bj) { const int col = col0 + bj * HALF; const u32x4 gw = *(const u32x4*)(Z + (size_t)row * ZLD + 3072 + col);
                    f32x4 v0 = acc[ai][bj][m][0], v1 = acc[ai][bj][m][1];
                    v0[0] *= bflo(gw.x); v0[1] *= bfhi(gw.x); v0[2] *= bflo(gw.y); v0[3] *= bfhi(gw.y); v1[0] *= bflo(gw.z); v1[1] *= bfhi(gw.z); v1[2] *= bflo(gw.w); v1[3] *= bfhi(gw.w);
                    float* tp = T + (size_t)row * D + col; *(f32x4*)tp = v0; *(f32x4*)(tp + 4) = v1; }
                asm volatile("" ::: "memory"); }
    }
};
struct EpiGateB {
    const float* T; const bf16_t* Z; bf16_t* O;
    __device__ __forceinline__ void operator()(EPI_ARGS) const {
        const int row0 = u.pm * BM + wr * 64 + fr, col0 = u.pn * BM + wc * 32 + 8 * fq;
#pragma unroll
        for (int ai = 0; ai < 2; ++ai)
#pragma unroll
            for (int m = 0; m < 4; ++m) { const int row = row0 + ai * HALF + m * 16;
#pragma unroll
                for (int bj = 0; bj < 2; ++bj) { const int col = col0 + bj * HALF; const u32x4 gw = *(const u32x4*)(Z + (size_t)row * ZLD + 4096 + col);
                    const float* tp = T + (size_t)row * D + col; f32x4 v0 = *(const f32x4*)tp, v1 = *(const f32x4*)(tp + 4);
                    const f32x4 a0 = acc[ai][bj][m][0], a1 = acc[ai][bj][m][1];
                    v0[0] += a0[0] * bflo(gw.x); v0[1] += a0[1] * bfhi(gw.x); v0[2] += a0[2] * bflo(gw.y); v0[3] += a0[3] * bfhi(gw.y);
                    v1[0] += a1[0] * bflo(gw.z); v1[1] += a1[1] * bfhi(gw.z); v1[2] += a1[2] * bflo(gw.w); v1[3] += a1[3] * bfhi(gw.w);
                    *(u32x4*)(O + (size_t)row * D + col) = pack8(v0, v1); }
                asm volatile("" ::: "memory"); }
    }
};
struct EpiResid {
    const float* base; float* out; const float* mod; int goff, Sshift, seqbase;
    __device__ __forceinline__ void operator()(EPI_ARGS) const {
        const int row0 = u.pm * BM + wr * 64 + fr, col0 = u.pn * BM + wc * 32 + 8 * fq;
        const float* gt = mod + (size_t)(seqbase + ((u.pm * BM) >> Sshift)) * 6144 + goff + col0;
        f32x4 g[2][2];
#pragma unroll
        for (int bj = 0; bj < 2; ++bj) { g[bj][0] = *(const f32x4*)(gt + bj * HALF); g[bj][1] = *(const f32x4*)(gt + bj * HALF + 4); }
#pragma unroll
        for (int ai = 0; ai < 2; ++ai)
#pragma unroll
            for (int m = 0; m < 4; ++m) { const size_t off = (size_t)(row0 + ai * HALF + m * 16) * D + col0;
#pragma unroll
                for (int bj = 0; bj < 2; ++bj) { const f32x4 b0 = *(const f32x4*)(base + off + bj * HALF), b1 = *(const f32x4*)(base + off + bj * HALF + 4);
                    *(f32x4*)(out + off + bj * HALF) = b0 + g[bj][0] * acc[ai][bj][m][0]; *(f32x4*)(out + off + bj * HALF + 4) = b1 + g[bj][1] * acc[ai][bj][m][1]; }
                if (m & 1) asm volatile("" ::: "memory"); }
    }
};

struct EpiAny {
    int kind;
    bf16_t* O; int ldc; int sig_pn;
    bf16_t* Q; bf16_t* KF; bf16_t* V; const float* rstd; const float* rope; int S, Sshift;
    float* T; const bf16_t* Z;
    const float* base; float* out; const float* mod; int goff, seqbase;
    __device__ __forceinline__ void operator()(EPI_ARGS) const {
        if (kind == 0) { EpiStore e{O, ldc, sig_pn}; e(acc, u, wr, wc, fr, fq); }
        else if (kind == 1) { EpiQ e{Q, rstd, rope, S, Sshift}; e(acc, u, wr, wc, fr, fq); }
        else if (kind == 2) { EpiKV e{KF, V, rstd, S, Sshift}; e(acc, u, wr, wc, fr, fq); }
        else if (kind == 3) { EpiGateA e{T, Z}; e(acc, u, wr, wc, fr, fq); }
        else if (kind == 4) { EpiGateB e{T, Z, O}; e(acc, u, wr, wc, fr, fq); }
        else { EpiResid e{base, out, mod, goff, Sshift, seqbase}; e(acc, u, wr, wc, fr, fq); }
    }
};
}

__device__ const float ROPE_INV[16] = {1.000000000e+00f, 5.623413324e-01f, 3.162277639e-01f, 1.778279394e-01f, 1.000000015e-01f, 5.623413250e-02f, 3.162277490e-02f, 1.778279431e-02f,
                                       9.999999776e-03f, 5.623413250e-03f, 3.162277630e-03f, 1.778279431e-03f, 1.000000047e-03f, 5.623413017e-04f, 3.162277571e-04f, 1.778279402e-04f};
__device__ __forceinline__ int perm_rope(int i) { return i < 16 ? 2 * i : 2 * (i - 16) + 1; }
__device__ __forceinline__ int rowmap(int kind, int n) {
    if (kind == 1) return n < 640 ? n : (n < 672 ? 640 + perm_rope(n - 640) : n + 96);
    if (kind == 2) { const int h = n / 96, c = n - h * 96; return c < 64 ? n : h * 96 + 64 + perm_rope(c - 64); }
    if (kind == 3) { const int h = n >> 7, c = n & 127; return c < 64 ? h * 64 + c : 1024 + h * 64 + (c - 64); }
    return n;
}
__device__ __forceinline__ void transpose_item(const float* W, int K, int N, bf16_t* WT, int kind, const float* ks, LAS float* scr, int item, int lane) {
    const int nblk = N / 32, kb = item / nblk, nb = item - kb * nblk, k0 = 64 * kb, n0 = 32 * nb;
#pragma unroll 8
    for (int i = 0; i < 32; ++i) { const int kk = 2 * i + (lane >> 5); float w = W[(size_t)(k0 + kk) * N + n0 + (lane & 31)]; if (ks) w *= ks[k0 + kk]; scr[kk * 33 + (lane & 31)] = w; }
    asm volatile("s_waitcnt lgkmcnt(0)" ::: "memory");
    const int c = lane & 7;
#pragma unroll
    for (int j = 0; j < 4; ++j) { const int n = (lane >> 3) + 8 * j; const LAS float* s = scr + (8 * c) * 33 + n;
        u32x4 o; o.x = cvt_pk_bf16(s[0 * 33], s[1 * 33]); o.y = cvt_pk_bf16(s[2 * 33], s[3 * 33]); o.z = cvt_pk_bf16(s[4 * 33], s[5 * 33]); o.w = cvt_pk_bf16(s[6 * 33], s[7 * 33]);
        *(u32x4*)(WT + (size_t)rowmap(kind, n0 + n) * K + k0 + 8 * c) = o; }
    asm volatile("s_waitcnt lgkmcnt(0)" ::: "memory");
}

__device__ __forceinline__ void norm_mod_row(const float* xrow, bf16_t* orow, const float* g, const float* sc, const float* sh, int lane) {
    const f32x4* xr = (const f32x4*)xrow + lane; f32x4 v[4]; float s = 0.f;
#pragma unroll
    for (int j = 0; j < 4; ++j) { v[j] = xr[64 * j]; s += (v[j].x * v[j].x + v[j].y * v[j].y) + (v[j].z * v[j].z + v[j].w * v[j].w); }
    const float rstd = 1.0f / sqrtf(wave_sum(s) * (1.f / D) + EPS);
    u32x2* o8 = (u32x2*)orow + lane;
#pragma unroll
    for (int j = 0; j < 4; ++j) { const f32x4 gg = ((const f32x4*)g)[lane + 64 * j], ss = ((const f32x4*)sc)[lane + 64 * j], hh = ((const f32x4*)sh)[lane + 64 * j];
        const f32x4 o = v[j] * rstd * gg * (ss + 1.0f) + hh; u32x2 w; w.x = cvt_pk_bf16(o.x, o.y); w.y = cvt_pk_bf16(o.z, o.w); o8[64 * j] = w; }
}
__device__ __forceinline__ void final_norm_row(float* xrow, const float* g, int lane) {
    f32x4* xr = (f32x4*)xrow + lane; f32x4 v[4]; float s = 0.f;
#pragma unroll
    for (int j = 0; j < 4; ++j) { v[j] = xr[64 * j]; s += (v[j].x * v[j].x + v[j].y * v[j].y) + (v[j].z * v[j].z + v[j].w * v[j].w); }
    const float rstd = 1.0f / sqrtf(wave_sum(s) * (1.f / D) + EPS);
#pragma unroll
    for (int j = 0; j < 4; ++j) xr[64 * j] = v[j] * rstd * ((const f32x4*)g)[lane + 64 * j];
}

__device__ __forceinline__ void dil_task(const bf16_t* Z, float* OG, float* LSE, int S, int task, LAS unsigned char* wl, int lane_in) {
    int lane = lane_in; asm volatile("" : "+v"(lane));
    const int r32 = lane & 31, hi = lane >> 5;
    const int bps = S >> 5, tps = 12 * bps;
    const int seq = task / tps; const int rem = task - seq * tps; const int hd = rem / bps; const int blk = rem - hd * bps;
    const int g = hd >> 2, sh = 2 * g, dl = 1 << sh; const int r = blk & (dl - 1), bi = blk >> sh;
    const int i0 = bi * 32, nsub = S >> sh;
    const size_t rowbase = (size_t)seq * S;
    const int tq = r + ((i0 + r32) << sh);
    const bf16_t* qp = Z + (rowbase + tq) * ZLD + 768 + hd * 64 + 8 * hi;
    bf16x8 qf[4];
#pragma unroll
    for (int s = 0; s < 4; ++s) qf[s] = *(const bf16x8*)(qp + 16 * s);
    f32x16 sc[5];
#pragma unroll
    for (int c = 0; c < 5; ++c) {
        int ik = i0 - 64 + 32 * c + r32; ik = ik < 0 ? 0 : (ik > nsub - 1 ? nsub - 1 : ik);
        const bf16_t* kp = Z + (rowbase + r + ((size_t)ik << sh)) * ZLD + 1536 + hd * 64 + 8 * hi;
        bf16x8 kf[4];
#pragma unroll
        for (int s = 0; s < 4; ++s) kf[s] = *(const bf16x8*)(kp + 16 * s);
        f32x16 a = {};
#pragma unroll
        for (int s = 0; s < 4; ++s) a = __builtin_amdgcn_mfma_f32_32x32x16_bf16(kf[s], qf[s], a, 0, 0, 0);
        sc[c] = a;
        asm volatile("" ::: "memory");
    }
    const float cb = __builtin_amdgcn_exp2f(-0.6666666667f * (float)(hd + 1)) * LOG2E * (float)dl;
    float mx = -INFINITY;
#pragma unroll
    for (int c = 0; c < 5; ++c)
#pragma unroll
        for (int e = 0; e < 16; ++e) {
            const int kvl = 32 * c + (e & 3) + 8 * (e >> 2) + 4 * hi; const int delta = kvl - 64 - r32; const int ik = i0 + r32 + delta;
            const int ad = delta < 0 ? -delta : delta; const bool valid = (ad <= 64) && (ik >= 0) && (ik < nsub);
            float v = sc[c][e] * DSCALE - cb * (float)ad; v = valid ? v : -INFINITY; sc[c][e] = v; mx = fmaxf(mx, v);
        }
    mx = swap_max(mx);
    float ls = 0.f;
#pragma unroll
    for (int c = 0; c < 5; ++c)
#pragma unroll
        for (int e = 0; e < 16; ++e) { const float p = __builtin_amdgcn_exp2f(sc[c][e] - mx); sc[c][e] = p; ls += p; }
    ls = swap_add(ls);
    f32x16 o0 = {}, o1 = {};
    const int vb = ((lane >> 4) & 1) * 32 + (lane & 3) * 8 + (4 * hi + ((lane & 15) >> 2)) * 64;
#pragma unroll
    for (int c = 0; c < 5; ++c) {
        u32x4 vv[4];
#pragma unroll
        for (int i = 0; i < 4; ++i) { const int row = (lane >> 3) + 8 * i; int ik = i0 - 64 + 32 * c + row; ik = ik < 0 ? 0 : (ik > nsub - 1 ? nsub - 1 : ik);
            vv[i] = *(const u32x4*)(Z + (rowbase + r + ((size_t)ik << sh)) * ZLD + 2304 + hd * 64 + (lane & 7) * 8); }
        asm volatile("s_waitcnt lgkmcnt(0)" ::: "memory");
#pragma unroll
        for (int i = 0; i < 4; ++i) { const int row = (lane >> 3) + 8 * i; *(LAS u32x4*)(wl + ((lane & 7) >> 2) * 2048 + row * 64 + (lane & 3) * 16) = vv[i]; }
        asm volatile("s_waitcnt lgkmcnt(0)" ::: "memory");
#pragma unroll
        for (int s = 0; s < 2; ++s) {
            u32x4 pw; pw.x = cvt_pk_bf16(sc[c][8 * s + 0], sc[c][8 * s + 1]); pw.y = cvt_pk_bf16(sc[c][8 * s + 2], sc[c][8 * s + 3]); pw.z = cvt_pk_bf16(sc[c][8 * s + 4], sc[c][8 * s + 5]); pw.w = cvt_pk_bf16(sc[c][8 * s + 6], sc[c][8 * s + 7]);
            const bf16x8 pf = __builtin_bit_cast(bf16x8, pw);
            { const s16x4 lo = vtr(wl + vb + s * 1024), hh = vtr(wl + vb + s * 1024 + 512); const bf16x8 vf = {lo[0], lo[1], lo[2], lo[3], hh[0], hh[1], hh[2], hh[3]};
              o0 = __builtin_amdgcn_mfma_f32_32x32x16_bf16(vf, pf, o0, 0, 0, 0); }
            { const s16x4 lo = vtr(wl + vb + 2048 + s * 1024), hh = vtr(wl + vb + 2048 + s * 1024 + 512); const bf16x8 vf = {lo[0], lo[1], lo[2], lo[3], hh[0], hh[1], hh[2], hh[3]};
              o1 = __builtin_amdgcn_mfma_f32_32x32x16_bf16(vf, pf, o1, 0, 0, 0); }
        }
    }
    const float inv = 1.0f / ls; const size_t rq = rowbase + tq;
    float* op = OG + (rq * 12 + hd) * 64 + 4 * hi;
#pragma unroll
    for (int i = 0; i < 4; ++i) {
        *(f32x4*)(op + 8 * i) = (f32x4){o0[4 * i] * inv, o0[4 * i + 1] * inv, o0[4 * i + 2] * inv, o0[4 * i + 3] * inv};
        *(f32x4*)(op + 32 + 8 * i) = (f32x4){o1[4 * i] * inv, o1[4 * i + 1] * inv, o1[4 * i + 2] * inv, o1[4 * i + 3] * inv};
    }
    if (hi == 0) LSE[rq * 12 + hd] = (mx + __builtin_amdgcn_logf(ls)) * LN2;
}

namespace mla {
constexpr int KPITCH = 208, KBYTES = 64 * KPITCH, VBYTES = 8192, BUF = KBYTES + VBYTES;
__device__ __forceinline__ void attn_unit(const bf16_t* Qh, const bf16_t* Kh, const bf16_t* Vh, bf16_t* Oh  , int S, int qb, LAS unsigned char* lds, int tid) {
    const int lane = tid & 63, r32 = lane & 31, hi = lane >> 5; const int wid = __builtin_amdgcn_readfirstlane(tid >> 6);
    const int qrow = qb * 256 + wid * 32 + r32;
    const bf16_t* Qw = Qh + (size_t)qrow * 96 + 8 * hi;
    bf16x8 qf[6];
#pragma unroll
    for (int s = 0; s < 6; ++s) qf[s] = *(const bf16x8*)(Qw + 16 * s);
    const int kc0 = tid, kc1 = tid + 512; const bool has1 = tid < 256;
    const unsigned kd0 = (unsigned)((kc0 / 12) * KPITCH + (kc0 % 12) * 16), kd1 = (unsigned)((kc1 / 12) * KPITCH + (kc1 % 12) * 16);
    const unsigned vd = (unsigned)(KBYTES + ((tid & 7) >> 2) * 4096 + (tid >> 3) * 64 + (tid & 3) * 16);
    const u32x4* Kg = (const u32x4*)Kh; const u32x4* Vg = (const u32x4*)Vh;
    const int NT = S >> 6;
    u32x4 ka = Kg[kc0], kb = has1 ? Kg[kc1] : (u32x4){0u, 0u, 0u, 0u}, va = Vg[tid];
    *(LAS u32x4*)(lds + kd0) = ka; if (has1) *(LAS u32x4*)(lds + kd1) = kb; *(LAS u32x4*)(lds + vd) = va;
    __syncthreads();
    f32x16 o0 = {}, o1 = {}; float mrun = -INFINITY, lrun = 0.f;
    const unsigned kfo = (unsigned)(r32 * KPITCH + hi * 16);
    const unsigned vb = (unsigned)(KBYTES + ((lane >> 4) & 1) * 32 + (lane & 3) * 8 + (4 * hi + ((lane & 15) >> 2)) * 64);
    for (int t = 0; t < NT; ++t) {
        const unsigned cur = (unsigned)(t & 1) * BUF, nxt = BUF - cur; const bool more = t + 1 < NT;
        if (more) { ka = Kg[(size_t)(t + 1) * 768 + kc0]; if (has1) kb = Kg[(size_t)(t + 1) * 768 + kc1]; va = Vg[(size_t)(t + 1) * 512 + tid]; }
        f32x16 p0 = {}, p1 = {};
#pragma unroll
        for (int s = 0; s < 6; ++s) {
            const bf16x8 a0 = *(const LAS bf16x8*)(lds + cur + kfo + s * 32), a1 = *(const LAS bf16x8*)(lds + cur + kfo + 32 * KPITCH + s * 32);
            p0 = __builtin_amdgcn_mfma_f32_32x32x16_bf16(a0, qf[s], p0, 0, 0, 0); p1 = __builtin_amdgcn_mfma_f32_32x32x16_bf16(a1, qf[s], p1, 0, 0, 0);
        }
        float rm = fmaxf(p0[0], p1[0]);
#pragma unroll
        for (int e = 1; e < 16; ++e) rm = fmaxf(rm, fmaxf(p0[e], p1[e]));
        rm = swap_max(rm);
        if (__any(rm > mrun)) { const float mn = fmaxf(mrun, rm); const float al = __builtin_amdgcn_exp2f(mrun - mn); mrun = mn; lrun *= al;
#pragma unroll
            for (int e = 0; e < 16; ++e) { o0[e] *= al; o1[e] *= al; } }
        float rs = 0.f;
#pragma unroll
        for (int e = 0; e < 16; ++e) { p0[e] = __builtin_amdgcn_exp2f(p0[e] - mrun); p1[e] = __builtin_amdgcn_exp2f(p1[e] - mrun); rs += p0[e] + p1[e]; }
        lrun += rs;
#pragma unroll
        for (int ks = 0; ks < 4; ++ks) {
            u32x4 pw;
            if (ks < 2) { const int b = 8 * ks; pw.x = cvt_pk_bf16(p0[b], p0[b + 1]); pw.y = cvt_pk_bf16(p0[b + 2], p0[b + 3]); pw.z = cvt_pk_bf16(p0[b + 4], p0[b + 5]); pw.w = cvt_pk_bf16(p0[b + 6], p0[b + 7]); }
            else { const int b = 8 * (ks - 2); pw.x = cvt_pk_bf16(p1[b], p1[b + 1]); pw.y = cvt_pk_bf16(p1[b + 2], p1[b + 3]); pw.z = cvt_pk_bf16(p1[b + 4], p1[b + 5]); pw.w = cvt_pk_bf16(p1[b + 6], p1[b + 7]); }
            const bf16x8 pf = __builtin_bit_cast(bf16x8, pw);
            { const s16x4 lo = vtr(lds + cur + vb + ks * 1024), hh = vtr(lds + cur + vb + ks * 1024 + 512); const bf16x8 vf = {lo[0], lo[1], lo[2], lo[3], hh[0], hh[1], hh[2], hh[3]};
              o0 = __builtin_amdgcn_mfma_f32_32x32x16_bf16(vf, pf, o0, 0, 0, 0); }
            { const s16x4 lo = vtr(lds + cur + vb + 4096 + ks * 1024), hh = vtr(lds + cur + vb + 4096 + ks * 1024 + 512); const bf16x8 vf = {lo[0], lo[1], lo[2], lo[3], hh[0], hh[1], hh[2], hh[3]};
              o1 = __builtin_amdgcn_mfma_f32_32x32x16_bf16(vf, pf, o1, 0, 0, 0); }
        }
        if (more) { *(LAS u32x4*)(lds + nxt + kd0) = ka; if (has1) *(LAS u32x4*)(lds + nxt + kd1) = kb; *(LAS u32x4*)(lds + nxt + vd) = va; }
        __syncthreads();
    }
    const float inv = 1.0f / swap_add(lrun);
    bf16_t* op = Oh + (size_t)qrow * D + 4 * hi;
#pragma unroll
    for (int i = 0; i < 4; ++i) {
        u32x2 w0; w0.x = cvt_pk_bf16(o0[4 * i] * inv, o0[4 * i + 1] * inv); w0.y = cvt_pk_bf16(o0[4 * i + 2] * inv, o0[4 * i + 3] * inv); *(u32x2*)(op + 8 * i) = w0;
        u32x2 w1; w1.x = cvt_pk_bf16(o1[4 * i] * inv, o1[4 * i + 1] * inv); w1.y = cvt_pk_bf16(o1[4 * i + 2] * inv, o1[4 * i + 3] * inv); *(u32x2*)(op + 32 + 8 * i) = w1;
    }
}
}

constexpr int SPC = 13, NSTEP = 1 + SPC * NCHUNK + 1;
struct Args { const float* in[21]; float* out; unsigned char* ws; int ph_lo, ph_hi; };

__global__ void __launch_bounds__(512, 2) fwd_kernel(Args args) {
    extern __shared__ __attribute__((aligned(16))) unsigned char lds_raw[];
    LAS unsigned char* lds = (LAS unsigned char*)lds_raw;
    const int wave0 = __builtin_amdgcn_readfirstlane(threadIdx.x >> 6);
    for (int ph = args.ph_lo; ph < args.ph_hi; ++ph) {
    int tid_l = wave0 * 64 + (int)__builtin_amdgcn_mbcnt_hi(~0u, __builtin_amdgcn_mbcnt_lo(~0u, 0u)); asm volatile("" : "+v"(tid_l));
    unsigned char* ws = args.ws; asm volatile("" : "+s"(ws));
    const int tid = tid_l, lane = tid & 63; const int wave = wave0;
    const int G = gridDim.x, bx = blockIdx.x; const int vcu = (G % 8 == 0) ? (bx % 8) * (G / 8) + bx / 8 : bx;
    const int gw = vcu * 8 + wave, NGW = G * 8;
    bf16_t* Win_t = (bf16_t*)(ws + WS_WIN); bf16_t* Wuq_t = (bf16_t*)(ws + WS_WUQ); bf16_t* Wukv_t = (bf16_t*)(ws + WS_WUKV); bf16_t* Pa_t = (bf16_t*)(ws + WS_PA);
    bf16_t* Pb_t = (bf16_t*)(ws + WS_PB); bf16_t* Wout_t = (bf16_t*)(ws + WS_WOUT); bf16_t* Wup_t = (bf16_t*)(ws + WS_WUP); bf16_t* Wdown_t = (bf16_t*)(ws + WS_WDOWN);
    float* MOD = (float*)(ws + WS_MOD); float* ROPE = (float*)(ws + WS_ROPE); float* RSTD = (float*)(ws + WS_RSTD);
    bf16_t* Hb = (bf16_t*)(ws + WS_H); bf16_t* Zb = (bf16_t*)(ws + WS_Z); bf16_t* Qb = (bf16_t*)(ws + WS_Q); bf16_t* KFb = (bf16_t*)(ws + WS_KF); bf16_t* Vb = (bf16_t*)(ws + WS_V);
    bf16_t* OAb = (bf16_t*)(ws + WS_OA); bf16_t* OBb = (bf16_t*)(ws + WS_OB); float* OGb = (float*)(ws + WS_OG); float* LSEb = (float*)(ws + WS_LSE);
    float* Tb = (float*)(ws + WS_T); bf16_t* MGb = (bf16_t*)(ws + WS_MERGED); bf16_t* UPb = (bf16_t*)(ws + WS_UP); bf16_t* ACTb = (bf16_t*)(ws + WS_ACT);
    bool sync_after = true;
        if (ph == 0) {
            if (bx < 96) {
                LAS float* sl = (LAS float*)lds;
                LAS float* part = (LAS float*)(lds + 49152);
                for (int idx = tid; idx < 12 * 1024; idx += 512) { const int b = idx >> 10, d = idx & 1023; const float c = b < 8 ? args.in[2][b * 1024 + d] : args.in[3][(b - 8) * 1024 + d];
                    sl[d * 12 + b] = c / (1.0f + __expf(-c)); }
                __syncthreads();
                const int e = bx * 64 + lane; float acc[12];
#pragma unroll
                for (int b = 0; b < 12; ++b) acc[b] = 0.f;
                const float* wp = args.in[4] + (size_t)(wave * 128) * 6144 + e;
#pragma unroll 8
                for (int d = 0; d < 128; ++d) { const float w = wp[(size_t)d * 6144]; const LAS f32x4* s4 = (const LAS f32x4*)(sl + (wave * 128 + d) * 12);
                    const f32x4 a = s4[0], b4 = s4[1], c4 = s4[2];
                    acc[0] += a.x * w; acc[1] += a.y * w; acc[2] += a.z * w; acc[3] += a.w * w; acc[4] += b4.x * w; acc[5] += b4.y * w; acc[6] += b4.z * w; acc[7] += b4.w * w;
                    acc[8] += c4.x * w; acc[9] += c4.y * w; acc[10] += c4.z * w; acc[11] += c4.w * w; }
#pragma unroll
                for (int b = 0; b < 12; ++b) part[(wave * 12 + b) * 64 + lane] = acc[b];
                __syncthreads();
                if (wave == 0) {
#pragma unroll
                    for (int b = 0; b < 12; ++b) { float s = args.in[5][e];
#pragma unroll
                        for (int w = 0; w < 8; ++w) s += part[(w * 12 + b) * 64 + lane];
                        MOD[b * 6144 + e] = s; } }
                __syncthreads();
            }
            for (int idx = bx * 512 + tid; idx < 8192 * 16; idx += G * 512) { const int pos = idx >> 4, i = idx & 15; const float ang = (float)pos * ROPE_INV[i];
                const double tt = (double)ang * 0.15915494309189535; const float fr_ = (float)(tt - floor(tt));
                ROPE[idx] = __builtin_amdgcn_cosf(fr_); ROPE[131072 + idx] = __builtin_amdgcn_sinf(fr_); }
            {
                LAS float* scr = (LAS float*)(lds + wave * 16384);
                constexpr int I_IN = 16 * 157, I_UQ = 6 * 48, I_UKV = 4 * 64, I_PA = 16 * 32, I_PB = 4 * 32, I_OUT = 16 * 32, I_UP = 16 * 176, I_DOWN = 44 * 32;
                constexpr int NITEMS = I_IN + I_UQ + I_UKV + I_PA + I_PB + I_OUT + I_UP + I_DOWN;
                for (int it = gw; it < NITEMS; it += NGW) {
                    int r = it; const float* W; int K, N, kind = 0; bf16_t* WT; const float* ks = nullptr;
                    if (r < I_IN) { W = args.in[7]; K = 1024; N = 5024; WT = Win_t; kind = 1; }
                    else if ((r -= I_IN) < I_UQ) { W = args.in[10]; K = 384; N = 1536; WT = Wuq_t; kind = 2; ks = args.in[8]; }
                    else if ((r -= I_UQ) < I_UKV) { W = args.in[11]; K = 256; N = 2048; WT = Wukv_t; kind = 3; ks = args.in[9]; }
                    else if ((r -= I_UKV) < I_PA) { W = args.in[12]; K = 1024; N = 1024; WT = Pa_t; }
                    else if ((r -= I_PA) < I_PB) { W = args.in[13]; K = 256; N = 1024; WT = Pb_t; }
                    else if ((r -= I_PB) < I_OUT) { W = args.in[14]; K = 1024; N = 1024; WT = Wout_t; }
                    else if ((r -= I_OUT) < I_UP) { W = args.in[16]; K = 1024; N = 5632; WT = Wup_t; }
                    else { r -= I_UP; W = args.in[19]; K = 2816; N = 1024; WT = Wdown_t; }
                    transpose_item(W, K, N, WT, kind, ks, scr, r, lane);
                }
                for (int idx = bx * 512 + tid; idx < 96 * 128; idx += G * 512) *(u32x4*)(Win_t + (size_t)672 * 1024 + (size_t)idx * 8) = (u32x4){0u, 0u, 0u, 0u};
            }
            __syncthreads();
        } else if (ph == NSTEP - 1) {
            float* o = args.out + (size_t)(NCHUNK - 1) * CH * D;
            for (int m = gw; m < CH; m += NGW) final_norm_row(o + (size_t)m * D, args.in[20], lane);
        } else {
            const int c = (ph - 1) / SPC, k = (ph - 1) - SPC * c;
            ChunkP P;
            if (c == 0) { P.x = args.in[0]; P.S = 2048; P.Sshift = 11; P.nseq = 8; P.seqbase = 0; }
            else { P.x = args.in[1] + (size_t)(c - 1) * CH * D; P.S = 8192; P.Sshift = 13; P.nseq = 2; P.seqbase = 8 + 2 * (c - 1); }
            P.out = args.out + (size_t)c * CH * D;
            sync_after = !(k == 3 || k == 6);
            pg8::Gemm g{}; pg8::EpiAny E{}; bool is_gemm = true;
            E.S = P.S; E.Sshift = P.Sshift; E.seqbase = P.seqbase; E.rstd = RSTD; E.rope = ROPE; E.Z = Zb; E.T = Tb; E.mod = MOD;
            if (k == 1) { g = pg8::Gemm{Hb, Win_t, CH, ZLD, 1024, 1024}; E.kind = 0; E.O = Zb; E.ldc = ZLD; E.sig_pn = 12; }
            else if (k == 3) { g = pg8::Gemm{Zb, Wuq_t, CH, 1536, 384, ZLD}; E.kind = 1; E.Q = Qb; }
            else if (k == 4) { g = pg8::Gemm{Zb + 384, Wukv_t, CH, 2048, 256, ZLD}; E.kind = 2; E.KF = KFb; E.V = Vb; }
            else if (k == 6) { g = pg8::Gemm{OAb, Pa_t, CH, 1024, 1024, 1024}; E.kind = 3; }
            else if (k == 7) { g = pg8::Gemm{OBb, Pb_t, CH, 1024, 256, 256}; E.kind = 4; E.O = MGb; }
            else if (k == 8) { g = pg8::Gemm{MGb, Wout_t, CH, 1024, 1024, 1024}; E.kind = 5; E.base = P.x; E.out = P.out; E.goff = 2048; }
            else if (k == 10) { g = pg8::Gemm{Hb, Wup_t, CH, NUP, 1024, 1024}; E.kind = 0; E.O = UPb; E.ldc = NUP; E.sig_pn = 1 << 30; }
            else if (k == 12) { g = pg8::Gemm{ACTb, Wdown_t, CH, 1024, DFF, DFF}; E.kind = 5; E.base = P.out; E.out = P.out; E.goff = 5120; }
            else is_gemm = false;
            if (is_gemm) { pg8::StaticOrder S; S.init(g.M, g.N, G, bx); pg8::gemm_phase(lds, g, S, E, tid); }
            else if (k == 0) {
                if (c > 0) { float* o = args.out + (size_t)(c - 1) * CH * D; for (int m = gw; m < CH; m += NGW) final_norm_row(o + (size_t)m * D, args.in[20], lane); }
                for (int m = gw; m < CH; m += NGW) { const float* md = MOD + (size_t)(P.seqbase + (m >> P.Sshift)) * 6144;
                    norm_mod_row(P.x + (size_t)m * D, Hb + (size_t)m * D, args.in[6], md + 1024, md, lane); }
            } else if (k == 2) {
                for (int m = gw; m < CH; m += NGW) {
                    const unsigned* zr = (const unsigned*)(Zb + (size_t)m * ZLD);
                    float sq = 0.f, skv = 0.f;
#pragma unroll
                    for (int j = 0; j < 3; ++j) { const unsigned w = zr[lane + 64 * j]; const float a = bflo(w), b = bfhi(w); sq += a * a + b * b; }
#pragma unroll
                    for (int j = 0; j < 2; ++j) { const unsigned w = zr[192 + lane + 64 * j]; const float a = bflo(w), b = bfhi(w); skv += a * a + b * b; }
                    sq = wave_sum(sq); skv = wave_sum(skv);
                    if (lane == 0) { RSTD[2 * m] = 1.0f / sqrtf(sq * (1.f / 384.f) + EPS); RSTD[2 * m + 1] = 1.0f / sqrtf(skv * (1.f / 256.f) + EPS); }
                    const int seq = m >> P.Sshift, pos = m & (P.S - 1);
                    unsigned pr = 0u;
                    { const int i = lane & 15; const unsigned w = zr[320 + i]; const float a = bflo(w), b = bfhi(w); const float cs = ROPE[pos * 16 + i], sn = ROPE[131072 + pos * 16 + i];
                      pr = cvt_pk_bf16(a * cs - b * sn, a * sn + b * cs); }
                    u32x4 o; const int b4 = 4 * (lane & 3);
                    o.x = __shfl(pr, b4); o.y = __shfl(pr, b4 + 1); o.z = __shfl(pr, b4 + 2); o.w = __shfl(pr, b4 + 3);
                    const int head = lane >> 2;
                    *(u32x4*)(KFb + ((size_t)((seq * 16 + head) << P.Sshift) + pos) * 96 + 64 + 8 * (lane & 3)) = o;
                }
                LAS unsigned char* wl = lds + wave * 4096;
                for (int task = gw; task < CH * 12 / 32; task += NGW) dil_task(Zb, OGb, LSEb, P.S, task, wl, lane);
            } else if (k == 5) {
                for (int it = bx * 512 + tid; it < CH * 32; it += G * 512) { const int row = it >> 5, j = (it >> 3) & 3, d8 = (it & 7) * 8;
                    const float l0 = LSEb[row * 12 + j], l1 = LSEb[row * 12 + 4 + j], l2 = LSEb[row * 12 + 8 + j]; const float mx = fmaxf(l0, fmaxf(l1, l2));
                    float w0 = __expf(l0 - mx), w1 = __expf(l1 - mx), w2 = __expf(l2 - mx); const float inv = 1.0f / (w0 + w1 + w2); w0 *= inv; w1 *= inv; w2 *= inv;
                    const float* p0 = OGb + ((size_t)row * 12 + j) * 64 + d8; const float* p1 = p0 + 4 * 64; const float* p2 = p0 + 8 * 64;
                    const f32x4 a0 = *(const f32x4*)p0 * w0 + *(const f32x4*)p1 * w1 + *(const f32x4*)p2 * w2;
                    const f32x4 a1 = *(const f32x4*)(p0 + 4) * w0 + *(const f32x4*)(p1 + 4) * w1 + *(const f32x4*)(p2 + 4) * w2;
                    *(u32x4*)(OBb + (size_t)row * 256 + j * 64 + d8) = pg8::pack8(a0, a1); }
                const int nqb = P.S >> 8, nunits = P.nseq * 16 * nqb;
                for (int uidx = vcu; uidx < nunits; uidx += G) { const int pair = uidx / nqb, qb = uidx - pair * nqb; const int seq = pair >> 4, head = pair & 15;
                    const size_t hb = (size_t)pair << P.Sshift;
                    mla::attn_unit(Qb + hb * 96, KFb + hb * 96, Vb + hb * 64, OAb + ((size_t)seq << P.Sshift) * D + head * 64, P.S, qb, lds, tid); }
            } else if (k == 9) {
                for (int m = gw; m < CH; m += NGW) { const float* md = MOD + (size_t)(P.seqbase + (m >> P.Sshift)) * 6144;
                    norm_mod_row(P.out + (size_t)m * D, Hb + (size_t)m * D, args.in[15], md + 4096, md + 3072, lane); }
            } else if (k == 11) {
                if (tid < 352) {
                    const int f0 = tid * 8; float w0[8], w1[8], w2[8], cb[8];
#pragma unroll
                    for (int e = 0; e < 8; ++e) { w0[e] = args.in[17][f0 + e]; w1[e] = args.in[17][DFF + f0 + e]; w2[e] = args.in[17][2 * DFF + f0 + e]; cb[e] = args.in[18][f0 + e]; }
                    for (int blk = vcu; blk < CH / 64; blk += G) {
                        const int r0 = blk * 64; const int pos0 = r0 & (P.S - 1);
                        const bf16_t* up = UPb + (size_t)r0 * NUP + f0;
                        u32x4 prev = (u32x4){0u, 0u, 0u, 0u}; if (pos0 > 0) prev = *(const u32x4*)(up - NUP);
                        u32x4 curv = *(const u32x4*)up;
#pragma unroll 4
                        for (int i = 0; i < 64; ++i) {
                            u32x4 nxt = (u32x4){0u, 0u, 0u, 0u}; if (pos0 + i + 1 < P.S) nxt = *(const u32x4*)(up + (size_t)(i + 1) * NUP);
                            const u32x4 gv = *(const u32x4*)(up + (size_t)i * NUP + DFF);
                            float r[8];
#pragma unroll
                            for (int q = 0; q < 4; ++q) {
                                const float pl = bflo(prev[q]), ph_ = bfhi(prev[q]), cl = bflo(curv[q]), chh = bfhi(curv[q]), nl = bflo(nxt[q]), nh = bfhi(nxt[q]);
                                const float xl = cb[2 * q] + w0[2 * q] * pl + w1[2 * q] * cl + w2[2 * q] * nl, xh = cb[2 * q + 1] + w0[2 * q + 1] * ph_ + w1[2 * q + 1] * chh + w2[2 * q + 1] * nh;
                                const float yl = 0.7978845608028654f * (xl + 0.044715f * xl * xl * xl), yh = 0.7978845608028654f * (xh + 0.044715f * xh * xh * xh);
                                r[2 * q] = xl * sigmoidf_(2.0f * yl) * bflo(gv[q]); r[2 * q + 1] = xh * sigmoidf_(2.0f * yh) * bfhi(gv[q]);
                            }
                            u32x4 o; o.x = cvt_pk_bf16(r[0], r[1]); o.y = cvt_pk_bf16(r[2], r[3]); o.z = cvt_pk_bf16(r[4], r[5]); o.w = cvt_pk_bf16(r[6], r[7]);
                            *(u32x4*)(ACTb + (size_t)(r0 + i) * DFF + f0) = o;
                            prev = curv; curv = nxt;
                        }
                    }
                }
            }
        }
#if MEGA
        if (sync_after && ph + 1 < args.ph_hi) cg::this_grid().sync();
#else
        (void)sync_after;
#endif
    }
}

extern "C" void kernel_launch(void* const* d_in, const int* in_sizes, int n_in, void* d_out, int out_size, void* d_ws, size_t ws_size, hipStream_t stream) {
    static int grid = 0;
    if (grid == 0) {
        if (n_in != 21 || ws_size < WS_END) { fprintf(stderr, "kernel_launch: unexpected n_in %d / ws_size %zu\n", n_in, ws_size); grid = -1; return; }
        int dev = 0, cus = 0, per_cu = 0;
        (void)hipGetDevice(&dev); (void)hipDeviceGetAttribute(&cus, hipDeviceAttributeMultiprocessorCount, dev);
        (void)hipFuncSetAttribute((const void*)fwd_kernel, hipFuncAttributeMaxDynamicSharedMemorySize, LDS_BYTES);
        (void)hipOccupancyMaxActiveBlocksPerMultiprocessor(&per_cu, (const void*)fwd_kernel, 512, LDS_BYTES);
        (void)hipGetLastError();
        if (per_cu < 1) fprintf(stderr, "kernel_launch: occupancy query says %d blocks/CU\n", per_cu);
        grid = cus;
    }
    if (grid < 0) return;
    Args a{};
    for (int i = 0; i < 21; ++i) a.in[i] = (const float*)d_in[i];
    a.out = (float*)d_out; a.ws = (unsigned char*)d_ws;
#if MEGA
    a.ph_lo = 0; a.ph_hi = NSTEP;
    void* kargs[] = {&a};
    hipError_t e = hipLaunchCooperativeKernel((const void*)fwd_kernel, dim3(grid), dim3(512), kargs, LDS_BYTES, stream);
    if (e != hipSuccess) fprintf(stderr, "cooperative launch failed: %s (grid %d)\n", hipGetErrorString(e), grid);
#else
    for (int ph = 0; ph < NSTEP; ++ph) { a.ph_lo = ph; a.ph_hi = ph + 1; hipLaunchKernelGGL(fwd_kernel, dim3(grid), dim3(512), LDS_BYTES, stream, a); }
#endif
}
```

```cpp
#include <hip/hip_runtime.h>
#include <hip/hip_cooperative_groups.h>
#include <cstdio>
#include <cstdint>
namespace cg = cooperative_groups;

#ifndef MEGA
#define MEGA 1
#endif

#define LAS __attribute__((address_space(3)))
typedef unsigned short bf16_t;
typedef short bf16x8 __attribute__((ext_vector_type(8)));
typedef short s16x4 __attribute__((ext_vector_type(4)));
typedef float f32x2 __attribute__((ext_vector_type(2)));
typedef float f32x4 __attribute__((ext_vector_type(4)));
typedef float f32x16 __attribute__((ext_vector_type(16)));
typedef unsigned u32x2 __attribute__((ext_vector_type(2)));
typedef unsigned u32x4 __attribute__((ext_vector_type(4)));

constexpr int D = 1024, CH = 16384, NCHUNK = 3, ZLD = 5120, NUP = 5632, DFF = 2816;

constexpr float EPS = 1e-6f, LOG2E = 1.4426950408889634f, LN2 = 0.6931471805599453f;
constexpr float QSCALE = 0.10206207261596577f * LOG2E;
constexpr float DSCALE = 0.125f * LOG2E;

constexpr size_t MiB = 1u << 20;
constexpr size_t WS_WIN = 2 * MiB, WS_WUQ = 12 * MiB, WS_WUKV = 14 * MiB, WS_PA = 15 * MiB, WS_PB = 17 * MiB, WS_WOUT = 18 * MiB,
                 WS_WUP = 20 * MiB, WS_WDOWN = 31 * MiB;
constexpr size_t WS_MOD = 37 * MiB, WS_ROPE = 38 * MiB  , WS_RSTD = 39 * MiB + 512 * 1024;
constexpr size_t WS_H = 40 * MiB, WS_Z = 72 * MiB, WS_Q = 232 * MiB, WS_KF = 280 * MiB, WS_V = 328 * MiB, WS_OA = 360 * MiB, WS_OB = 392 * MiB,
                 WS_OG = 400 * MiB, WS_LSE = 448 * MiB, WS_T = 232 * MiB, WS_MERGED = 296 * MiB, WS_UP = 72 * MiB, WS_ACT = 248 * MiB, WS_END = 449 * MiB;

constexpr int LDS_BYTES = 147456;

__device__ __forceinline__ unsigned cvt_pk_bf16(float lo, float hi) { unsigned r; asm volatile("v_cvt_pk_bf16_f32 %0, %1, %2" : "=v"(r) : "v"(lo), "v"(hi)); return r; }
__device__ __forceinline__ float bf2f(unsigned short b) { return __uint_as_float((unsigned)b << 16); }
__device__ __forceinline__ float bflo(unsigned w) { return __uint_as_float(w << 16); }
__device__ __forceinline__ float bfhi(unsigned w) { return __uint_as_float(w & 0xffff0000u); }
__device__ __forceinline__ float wave_sum(float v) {
#pragma unroll
    for (int o = 1; o < 64; o <<= 1) v += __shfl_xor(v, o);
    return v;
}
__device__ __forceinline__ float swap_max(float m) { auto rr = __builtin_amdgcn_permlane32_swap(__float_as_uint(m), __float_as_uint(m), false, false); return fmaxf(__uint_as_float(rr[0]), __uint_as_float(rr[1])); }
__device__ __forceinline__ float swap_add(float m) { auto rr = __builtin_amdgcn_permlane32_swap(__float_as_uint(m), __float_as_uint(m), false, false); return __uint_as_float(rr[0]) + __uint_as_float(rr[1]); }
__device__ __forceinline__ s16x4 vtr(LAS const unsigned char* p) { return __builtin_bit_cast(s16x4, __builtin_amdgcn_ds_read_tr16_b64_v4i16((LAS s16x4*)p)); }
__device__ __forceinline__ float sigmoidf_(float x) { return __builtin_amdgcn_rcpf(1.0f + __builtin_amdgcn_exp2f(-x * LOG2E)); }

struct ChunkP { const float* x; float* out; int S, Sshift, nseq, seqbase; };

namespace pg8 {
constexpr int BM = 256, BK = 64, HALF = 128, HTB = HALF * BK * 2, STAGE_BYTES = 8 * HTB, NXCD = 8, WGM = 8;
__host__ __device__ __forceinline__ int lds_byte(int r, int c) { const int st = (r >> 4) * 2 + (c >> 5), rr = r & 15, cc = c & 31, ob = rr * 64 + cc * 2; return st * 1024 + (ob ^ (((ob >> 9) & 1) << 5)); }
__host__ __device__ __forceinline__ void stage_rc(int b, int& R, int& C) { const int st = b / 1024, sb = b % 1024, swz = sb ^ (((sb >> 9) & 1) << 5); R = (st >> 1) * 16 + swz / 64; C = (st & 1) * 32 + (swz % 64) / 2; }
__host__ __device__ __forceinline__ int perm32(int rho) { const int n = rho >> 4, i = rho & 15; return 8 * (i >> 2) + 4 * n + (i & 3); }
struct Unit { int pm, pn; };
struct Gemm { const bf16_t* A; const bf16_t* Bt; int M, N, K, lda; };
struct StaticOrder {
    int nM, nN, nwg, G, c;
    __device__ void init(int M, int N, int G_, int c_) { nM = M / BM; nN = N / BM; nwg = nM * nN; G = G_; c = c_; }
    __device__ bool next(int i, Unit& u) const {
        const long L = (long)i * G + c; if (L >= nwg) return false;
        int wgid = (int)L; { const int q = nwg / NXCD, r = nwg % NXCD, xcd = wgid % NXCD, off = wgid / NXCD; wgid = (xcd < r ? xcd * (q + 1) : r * (q + 1) + (xcd - r) * q) + off; }
        const int nig = WGM * nN, gid = wgid / nig, fm = gid * WGM, gsz = (nM - fm) < WGM ? (nM - fm) : WGM;
        u.pm = fm + ((wgid % nig) % gsz); u.pn = (wgid % nig) / gsz; return true;
    }
};

template <class Epi, class Sched>
__device__ __forceinline__ void gemm_phase(LAS unsigned char* lds, const Gemm g, const Sched& S, const Epi& E, int tid_in) {
    int tid_ = tid_in; asm volatile("" : "+v"(tid_));
    const int tid = tid_, wid = __builtin_amdgcn_readfirstlane(tid >> 6), lane = tid & 63, wr = wid >> 2, wc = wid & 3, fr = lane & 15, fq = lane >> 4;
    const int K = g.K, nt = K / BK, lda = g.lda;
    unsigned voffA[2], voffB[2];
#pragma unroll
    for (int i = 0; i < 2; ++i) { int R, C; stage_rc(tid * 16 + i * 8192, R, C); const int Rb = (R & ~31) + perm32(R & 31);
        voffA[i] = (unsigned)(R * lda + C) * 2u; voffB[i] = (unsigned)(Rb * K + C) * 2u; }
    const size_t kstep = (size_t)(BK * 2);
    const size_t hstepA = (size_t)HALF * lda * 2, hstepB = (size_t)HALF * K * 2;
    const size_t tstepA = 2 * hstepA, tstepB = 2 * hstepB;
    const unsigned ldsw = (unsigned)wid * 1024u;
    const int aoff = lds_byte(wr * 64 + fr, fq * 8), boff = lds_byte(wc * 32 + fr, fq * 8);
#define PG8_SA(b, h) (((b) * 2 + (h)) * HTB)
#define PG8_SB(b, h) ((4 + (b) * 2 + (h)) * HTB)
#define PG8_STAGE(bufoff, gbase, voff) do { _Pragma("unroll") for (int _i = 0; _i < 2; ++_i) \
        __builtin_amdgcn_global_load_lds((const unsigned*)((const char*)(gbase) + (voff)[_i]), (LAS unsigned*)(lds + (bufoff) + ldsw + _i * 8192), 16, 0, 0); } while (0)
#define PG8_LDA(dst, b, h) do { _Pragma("unroll") for (int m = 0; m < 4; ++m) _Pragma("unroll") for (int k = 0; k < 2; ++k) dst[m][k] = *(const LAS bf16x8*)(lds + PG8_SA(b, h) + aoff + m * 2048 + k * 1024); } while (0)
#define PG8_LDB(dst, b, h) do { _Pragma("unroll") for (int n = 0; n < 2; ++n) _Pragma("unroll") for (int k = 0; k < 2; ++k) dst[n][k] = *(const LAS bf16x8*)(lds + PG8_SB(b, h) + boff + n * 2048 + k * 1024); } while (0)
#define PG8_MMA(ai, bj, At, Bt) do { __builtin_amdgcn_s_setprio(1); _Pragma("unroll") for (int m = 0; m < 4; ++m) _Pragma("unroll") for (int n = 0; n < 2; ++n) _Pragma("unroll") for (int k = 0; k < 2; ++k) \
        acc[ai][bj][m][n] = __builtin_amdgcn_mfma_f32_16x16x32_bf16(Bt[n][k], At[m][k], acc[ai][bj][m][n], 0, 0, 0); __builtin_amdgcn_s_setprio(0); } while (0)
#define PG8_WAIT_V(n) asm volatile("s_waitcnt vmcnt(" #n ")" ::: "memory")
#define PG8_WAIT_L(n) asm volatile("s_waitcnt lgkmcnt(" #n ")" ::: "memory")
#define PG8_BAR __builtin_amdgcn_s_barrier()
#define PG8_SCHED __builtin_amdgcn_sched_barrier(0)
    Unit cur, nxt; int ui = 0;
    if (!S.next(0, cur)) return;
    f32x4 acc[2][2][4][2];
#pragma unroll
    for (int a = 0; a < 2; ++a)
#pragma unroll
        for (int b = 0; b < 2; ++b)
#pragma unroll
            for (int m = 0; m < 4; ++m)
#pragma unroll
                for (int n = 0; n < 2; ++n) acc[a][b][m][n] = (f32x4){0.f, 0.f, 0.f, 0.f};
    bf16x8 At[4][2], B0[2][2], B1[2][2];
    const char* cA = (const char*)g.A + (size_t)cur.pm * tstepA; const char* cB = (const char*)g.Bt + (size_t)cur.pn * tstepB;
    PG8_STAGE(PG8_SB(0, 0), cB, voffB); PG8_STAGE(PG8_SB(0, 1), cB + hstepB, voffB); PG8_STAGE(PG8_SA(0, 0), cA, voffA); PG8_STAGE(PG8_SA(0, 1), cA + hstepA, voffA);
    if (wr == 1) PG8_BAR;
    PG8_WAIT_V(2); PG8_BAR;
    PG8_STAGE(PG8_SB(1, 0), cB + kstep, voffB); PG8_STAGE(PG8_SA(1, 0), cA + kstep, voffA); PG8_STAGE(PG8_SB(1, 1), cB + hstepB + kstep, voffB);
    PG8_WAIT_V(6); PG8_BAR;
    for (;;) {
        const bool has_next = S.next(ui + 1, nxt);
        const char* nA = has_next ? (const char*)g.A + (size_t)nxt.pm * tstepA : cA; const char* nB = has_next ? (const char*)g.Bt + (size_t)nxt.pn * tstepB : cB;
        for (int t = 0; t < nt; t += 2) {
            const bool last = (t == nt - 2);
            const char* a1 = cA + (size_t)(t + 1) * kstep;
            const char* a2 = last ? nA : cA + (size_t)(t + 2) * kstep; const char* b2 = last ? nB : cB + (size_t)(t + 2) * kstep;
            const char* a3 = a2 + kstep; const char* b3 = b2 + kstep;
            PG8_LDB(B0, 0, 0); PG8_LDB(B1, 0, 1); PG8_SCHED; PG8_LDA(At, 0, 0); PG8_STAGE(PG8_SA(1, 1), a1 + hstepA, voffA);
            PG8_WAIT_V(8); PG8_WAIT_L(0); PG8_BAR; PG8_MMA(0, 0, At, B0); PG8_MMA(0, 1, At, B1); PG8_BAR; PG8_SCHED;
            PG8_LDA(At, 0, 1); PG8_STAGE(PG8_SB(0, 0), b2, voffB); PG8_STAGE(PG8_SB(0, 1), b2 + hstepB, voffB); PG8_STAGE(PG8_SA(0, 0), a2, voffA);
            PG8_WAIT_V(8); PG8_WAIT_L(0); PG8_BAR; PG8_MMA(1, 0, At, B0); PG8_MMA(1, 1, At, B1); PG8_BAR; PG8_SCHED;
            PG8_LDB(B0, 1, 0); PG8_LDB(B1, 1, 1); PG8_SCHED; PG8_LDA(At, 1, 0); PG8_STAGE(PG8_SA(0, 1), a2 + hstepA, voffA);
            PG8_WAIT_V(8); PG8_WAIT_L(0); PG8_BAR; PG8_MMA(0, 0, At, B0); PG8_MMA(0, 1, At, B1); PG8_BAR; PG8_SCHED;
            PG8_LDA(At, 1, 1); PG8_STAGE(PG8_SB(1, 0), b3, voffB); PG8_STAGE(PG8_SB(1, 1), b3 + hstepB, voffB); PG8_STAGE(PG8_SA(1, 0), a3, voffA);
            PG8_WAIT_V(8); PG8_WAIT_L(0); PG8_BAR; PG8_MMA(1, 0, At, B0); PG8_MMA(1, 1, At, B1); PG8_BAR; PG8_SCHED;
        }
        if (wr == 0) PG8_BAR;
        E(acc, cur, wr, wc, fr, fq);
        if (!has_next) break;
#pragma unroll
        for (int a = 0; a < 2; ++a)
#pragma unroll
            for (int b = 0; b < 2; ++b)
#pragma unroll
                for (int m = 0; m < 4; ++m)
#pragma unroll
                    for (int n = 0; n < 2; ++n) acc[a][b][m][n] = (f32x4){0.f, 0.f, 0.f, 0.f};
        cur = nxt; cA = nA; cB = nB; ++ui;
        if (wr == 1) PG8_BAR;
    }
    PG8_WAIT_V(0);
    PG8_BAR;
#undef PG8_SA
#undef PG8_SB
#undef PG8_STAGE
#undef PG8_LDA
#undef PG8_LDB
#undef PG8_MMA
#undef PG8_WAIT_V
#undef PG8_WAIT_L
#undef PG8_BAR
#undef PG8_SCHED
}

#define EPI_ARGS const f32x4 (&acc)[2][2][4][2], const Unit& u, int wr, int wc, int fr, int fq
__device__ __forceinline__ u32x4 pack8(f32x4 v0, f32x4 v1) { u32x4 w; w.x = cvt_pk_bf16(v0[0], v0[1]); w.y = cvt_pk_bf16(v0[2], v0[3]); w.z = cvt_pk_bf16(v1[0], v1[1]); w.w = cvt_pk_bf16(v1[2], v1[3]); return w; }

struct EpiStore {
    bf16_t* O; int ldc; int sig_pn;
    __device__ __forceinline__ void operator()(EPI_ARGS) const {
        const int row0 = u.pm * BM + wr * 64 + fr, col0 = u.pn * BM + wc * 32 + 8 * fq; const bool sig = u.pn >= sig_pn;
#pragma unroll
        for (int ai = 0; ai < 2; ++ai)
#pragma unroll
            for (int m = 0; m < 4; ++m) { bf16_t* rowp = O + (size_t)(row0 + ai * HALF + m * 16) * ldc + col0;
#pragma unroll
                for (int bj = 0; bj < 2; ++bj) { f32x4 v0 = acc[ai][bj][m][0], v1 = acc[ai][bj][m][1];
                    if (sig) {
#pragma unroll
                        for (int e = 0; e < 4; ++e) { v0[e] = sigmoidf_(v0[e]); v1[e] = sigmoidf_(v1[e]); } }
                    *(u32x4*)(rowp + bj * HALF) = pack8(v0, v1); } }
    }
};
struct EpiQ {
    bf16_t* Q; const float* rstd; const float* rope; int S, Sshift;
    __device__ __forceinline__ void operator()(EPI_ARGS) const {
        const int row0 = u.pm * BM + wr * 64 + fr;
#pragma unroll
        for (int ai = 0; ai < 2; ++ai)
#pragma unroll
            for (int m = 0; m < 4; ++m) { const int row = row0 + ai * HALF + m * 16; const int seq = row >> Sshift, pos = row & (S - 1);
                const float sc = rstd[2 * row] * QSCALE;
#pragma unroll
                for (int bj = 0; bj < 2; ++bj) { const int g32 = 8 * u.pn + 4 * bj + wc; const int head = g32 / 3, gl = g32 - 3 * head;
                    f32x4 v0 = acc[ai][bj][m][0] * sc, v1 = acc[ai][bj][m][1] * sc;
                    if (gl == 2) { const f32x4 cs = *(const f32x4*)(rope + (size_t)pos * 16 + 4 * fq), sn = *(const f32x4*)(rope + 131072 + (size_t)pos * 16 + 4 * fq);
                        f32x4 w0, w1;
                        w0[0] = v0[0] * cs[0] - v0[1] * sn[0]; w0[1] = v0[0] * sn[0] + v0[1] * cs[0];
                        w0[2] = v0[2] * cs[1] - v0[3] * sn[1]; w0[3] = v0[2] * sn[1] + v0[3] * cs[1];
                        w1[0] = v1[0] * cs[2] - v1[1] * sn[2]; w1[1] = v1[0] * sn[2] + v1[1] * cs[2];
                        w1[2] = v1[2] * cs[3] - v1[3] * sn[3]; w1[3] = v1[2] * sn[3] + v1[3] * cs[3];
                        v0 = w0; v1 = w1; }
                    *(u32x4*)(Q + ((size_t)((seq * 16 + head) << Sshift) + pos) * 96 + gl * 32 + 8 * fq) = pack8(v0, v1); }
                asm volatile("" ::: "memory"); }
    }
};
struct EpiKV {
    bf16_t* KF; bf16_t* V; const float* rstd; int S, Sshift;
    __device__ __forceinline__ void operator()(EPI_ARGS) const {
        const int row0 = u.pm * BM + wr * 64 + fr; const bool isv = u.pn >= 4;
#pragma unroll
        for (int ai = 0; ai < 2; ++ai)
#pragma unroll
            for (int m = 0; m < 4; ++m) { const int row = row0 + ai * HALF + m * 16; const int seq = row >> Sshift, pos = row & (S - 1);
                const float sc = rstd[2 * row + 1];
#pragma unroll
                for (int bj = 0; bj < 2; ++bj) { const int col = (u.pn & 3) * BM + bj * HALF + wc * 32 + 8 * fq; const int head = col >> 6, d = col & 63;
                    const f32x4 v0 = acc[ai][bj][m][0] * sc, v1 = acc[ai][bj][m][1] * sc; const size_t tok = (size_t)((seq * 16 + head) << Sshift) + pos;
                    bf16_t* p = isv ? V + tok * 64 + d : KF + tok * 96 + d;
                    *(u32x4*)p = pack8(v0, v1); }
                asm volatile("" ::: "memory"); }
    }
};
struct EpiGateA {
    float* T; const bf16_t* Z;
    __device__ __forceinline__ void operator()(EPI_ARGS) const {
        const int row0 = u.pm * BM + wr * 64 + fr, col0 = u.pn * BM + wc * 32 + 8 * fq;
#pragma unroll
        for (int ai = 0; ai < 2; ++ai)
#pragma unroll
            for (int m = 0; m < 4; ++m) { const int row = row0 + ai * HALF + m * 16;
#pragma unroll
                for (int bj = 0; bj < 2; ++bj) { const int col = col0 + bj * HALF; const u32x4 gw = *(const u32x4*)(Z + (size_t)row * ZLD + 3072 + col);
                    f32x4 v0 = acc[ai][bj][m][0], v1 = acc[ai][bj][m][1];
                    v0[0] *= bflo(gw.x); v0[1] *= bfhi(gw.x); v0[2] *= bflo(gw.y); v0[3] *= bfhi(gw.y); v1[0] *= bflo(gw.z); v1[1] *= bfhi(gw.z); v1[2] *= bflo(gw.w); v1[3] *= bfhi(gw.w);
                    float* tp = T + (size_t)row * D + col; *(f32x4*)tp = v0; *(f32x4*)(tp + 4) = v1; }
                asm volatile("" ::: "memory"); }
    }
};
struct EpiGateB {
    const float* T; const bf16_t* Z; bf16_t* O;
    __device__ __forceinline__ void operator()(EPI_ARGS) const {
        const int row0 = u.pm * BM + wr * 64 + fr, col0 = u.pn * BM + wc * 32 + 8 * fq;
#pragma unroll
        for (int ai = 0; ai < 2; ++ai)
#pragma unroll
            for (int m = 0; m < 4; ++m) { const int row = row0 + ai * HALF + m * 16;
#pragma unroll
                for (int bj = 0; bj < 2; ++bj) { const int col = col0 + bj * HALF; const u32x4 gw = *(const u32x4*)(Z + (size_t)row * ZLD + 4096 + col);
                    const float* tp = T + (size_t)row * D + col; f32x4 v0 = *(const f32x4*)tp, v1 = *(const f32x4*)(tp + 4);
                    const f32x4 a0 = acc[ai][bj][m][0], a1 = acc[ai][bj][m][1];
                    v0[0] += a0[0] * bflo(gw.x); v0[1] += a0[1] * bfhi(gw.x); v0[2] += a0[2] * bflo(gw.y); v0[3] += a0[3] * bfhi(gw.y);
                    v1[0] += a1[0] * bflo(gw.z); v1[1] += a1[1] * bfhi(gw.z); v1[2] += a1[2] * bflo(gw.w); v1[3] += a1[3] * bfhi(gw.w);
                    *(u32x4*)(O + (size_t)row * D + col) = pack8(v0, v1); }
                asm volatile("" ::: "memory"); }
    }
};
struct EpiResid {
    const float* base; float* out; const float* mod; int goff, Sshift, seqbase;
    __device__ __forceinline__ void operator()(EPI_ARGS) const {
        const int row0 = u.pm * BM + wr * 64 + fr, col0 = u.pn * BM + wc * 32 + 8 * fq;
        const float* gt = mod + (size_t)(seqbase + ((u.pm * BM) >> Sshift)) * 6144 + goff + col0;
        f32x4 g[2][2];
#pragma unroll
        for (int bj = 0; bj < 2; ++bj) { g[bj][0] = *(const f32x4*)(gt + bj * HALF); g[bj][1] = *(const f32x4*)(gt + bj * HALF + 4); }
#pragma unroll
        for (int ai = 0; ai < 2; ++ai)
#pragma unroll
            for (int m = 0; m < 4; ++m) { const size_t off = (size_t)(row0 + ai * HALF + m * 16) * D + col0;
#pragma unroll
                for (int bj = 0; bj < 2; ++bj) { const f32x4 b0 = *(const f32x4*)(base + off + bj * HALF), b1 = *(const f32x4*)(base + off + bj * HALF + 4);
                    *(f32x4*)(out + off + bj * HALF) = b0 + g[bj][0] * acc[ai][bj][m][0]; *(f32x4*)(out + off + bj * HALF + 4) = b1 + g[bj][1] * acc[ai][bj][m][1]; }
                if (m & 1) asm volatile("" ::: "memory"); }
    }
};

struct EpiAny {
    int kind;
    bf16_t* O; int ldc; int sig_pn;
    bf16_t* Q; bf16_t* KF; bf16_t* V; const float* rstd; const float* rope; int S, Sshift;
    float* T; const bf16_t* Z;
    const float* base; float* out; const float* mod; int goff, seqbase;
    __device__ __forceinline__ void operator()(EPI_ARGS) const {
        if (kind == 0) { EpiStore e{O, ldc, sig_pn}; e(acc, u, wr, wc, fr, fq); }
        else if (kind == 1) { EpiQ e{Q, rstd, rope, S, Sshift}; e(acc, u, wr, wc, fr, fq); }
        else if (kind == 2) { EpiKV e{KF, V, rstd, S, Sshift}; e(acc, u, wr, wc, fr, fq); }
        else if (kind == 3) { EpiGateA e{T, Z}; e(acc, u, wr, wc, fr, fq); }
        else if (kind == 4) { EpiGateB e{T, Z, O}; e(acc, u, wr, wc, fr, fq); }
        else { EpiResid e{base, out, mod, goff, Sshift, seqbase}; e(acc, u, wr, wc, fr, fq); }
    }
};
}

__device__ const float ROPE_INV[16] = {1.000000000e+00f, 5.623413324e-01f, 3.162277639e-01f, 1.778279394e-01f, 1.000000015e-01f, 5.623413250e-02f, 3.162277490e-02f, 1.778279431e-02f,
                                       9.999999776e-03f, 5.623413250e-03f, 3.162277630e-03f, 1.778279431e-03f, 1.000000047e-03f, 5.623413017e-04f, 3.162277571e-04f, 1.778279402e-04f};
__device__ __forceinline__ int perm_rope(int i) { return i < 16 ? 2 * i : 2 * (i - 16) + 1; }
__device__ __forceinline__ int rowmap(int kind, int n) {
    if (kind == 1) return n < 640 ? n : (n < 672 ? 640 + perm_rope(n - 640) : n + 96);
    if (kind == 2) { const int h = n / 96, c = n - h * 96; return c < 64 ? n : h * 96 + 64 + perm_rope(c - 64); }
    if (kind == 3) { const int h = n >> 7, c = n & 127; return c < 64 ? h * 64 + c : 1024 + h * 64 + (c - 64); }
    return n;
}
__device__ __forceinline__ void transpose_item(const float* W, int K, int N, bf16_t* WT, int kind, const float* ks, LAS float* scr, int item, int lane) {
    const int nblk = N / 32, kb = item / nblk, nb = item - kb * nblk, k0 = 64 * kb, n0 = 32 * nb;
#pragma unroll 8
    for (int i = 0; i < 32; ++i) { const int kk = 2 * i + (lane >> 5); float w = W[(size_t)(k0 + kk) * N + n0 + (lane & 31)]; if (ks) w *= ks[k0 + kk]; scr[kk * 33 + (lane & 31)] = w; }
    asm volatile("s_waitcnt lgkmcnt(0)" ::: "memory");
    const int c = lane & 7;
#pragma unroll
    for (int j = 0; j < 4; ++j) { const int n = (lane >> 3) + 8 * j; const LAS float* s = scr + (8 * c) * 33 + n;
        u32x4 o; o.x = cvt_pk_bf16(s[0 * 33], s[1 * 33]); o.y = cvt_pk_bf16(s[2 * 33], s[3 * 33]); o.z = cvt_pk_bf16(s[4 * 33], s[5 * 33]); o.w = cvt_pk_bf16(s[6 * 33], s[7 * 33]);
        *(u32x4*)(WT + (size_t)rowmap(kind, n0 + n) * K + k0 + 8 * c) = o; }
    asm volatile("s_waitcnt lgkmcnt(0)" ::: "memory");
}

__device__ __forceinline__ void norm_mod_row(const float* xrow, bf16_t* orow, const float* g, const float* sc, const float* sh, int lane) {
    const f32x4* xr = (const f32x4*)xrow + lane; f32x4 v[4]; float s = 0.f;
#pragma unroll
    for (int j = 0; j < 4; ++j) { v[j] = xr[64 * j]; s += (v[j].x * v[j].x + v[j].y * v[j].y) + (v[j].z * v[j].z + v[j].w * v[j].w); }
    const float rstd = 1.0f / sqrtf(wave_sum(s) * (1.f / D) + EPS);
    u32x2* o8 = (u32x2*)orow + lane;
#pragma unroll
    for (int j = 0; j < 4; ++j) { const f32x4 gg = ((const f32x4*)g)[lane + 64 * j], ss = ((const f32x4*)sc)[lane + 64 * j], hh = ((const f32x4*)sh)[lane + 64 * j];
        const f32x4 o = v[j] * rstd * gg * (ss + 1.0f) + hh; u32x2 w; w.x = cvt_pk_bf16(o.x, o.y); w.y = cvt_pk_bf16(o.z, o.w); o8[64 * j] = w; }
}
__device__ __forceinline__ void final_norm_row(float* xrow, const float* g, int lane) {
    f32x4* xr = (f32x4*)xrow + lane; f32x4 v[4]; float s = 0.f;
#pragma unroll
    for (int j = 0; j < 4; ++j) { v[j] = xr[64 * j]; s += (v[j].x * v[j].x + v[j].y * v[j].y) + (v[j].z * v[j].z + v[j].w * v[j].w); }
    const float rstd = 1.0f / sqrtf(wave_sum(s) * (1.f / D) + EPS);
#pragma unroll
    for (int j = 0; j < 4; ++j) xr[64 * j] = v[j] * rstd * ((const f32x4*)g)[lane + 64 * j];
}

__device__ __forceinline__ void dil_task(const bf16_t* Z, float* OG, float* LSE, int S, int task, LAS unsigned char* wl, int lane_in) {
    int lane = lane_in; asm volatile("" : "+v"(lane));
    const int r32 = lane & 31, hi = lane >> 5;
    const int bps = S >> 5, tps = 12 * bps;
    const int seq = task / tps; const int rem = task - seq * tps; const int hd = rem / bps; const int blk = rem - hd * bps;
    const int g = hd >> 2, sh = 2 * g, dl = 1 << sh; const int r = blk & (dl - 1), bi = blk >> sh;
    const int i0 = bi * 32, nsub = S >> sh;
    const size_t rowbase = (size_t)seq * S;
    const int tq = r + ((i0 + r32) << sh);
    const bf16_t* qp = Z + (rowbase + tq) * ZLD + 768 + hd * 64 + 8 * hi;
    bf16x8 qf[4];
#pragma unroll
    for (int s = 0; s < 4; ++s) qf[s] = *(const bf16x8*)(qp + 16 * s);
    f32x16 sc[5];
#pragma unroll
    for (int c = 0; c < 5; ++c) {
        int ik = i0 - 64 + 32 * c + r32; ik = ik < 0 ? 0 : (ik > nsub - 1 ? nsub - 1 : ik);
        const bf16_t* kp = Z + (rowbase + r + ((size_t)ik << sh)) * ZLD + 1536 + hd * 64 + 8 * hi;
        bf16x8 kf[4];
#pragma unroll
        for (int s = 0; s < 4; ++s) kf[s] = *(const bf16x8*)(kp + 16 * s);
        f32x16 a = {};
#pragma unroll
        for (int s = 0; s < 4; ++s) a = __builtin_amdgcn_mfma_f32_32x32x16_bf16(kf[s], qf[s], a, 0, 0, 0);
        sc[c] = a;
        asm volatile("" ::: "memory");
    }
    const float cb = __builtin_amdgcn_exp2f(-0.6666666667f * (float)(hd + 1)) * LOG2E * (float)dl;
    float mx = -INFINITY;
#pragma unroll
    for (int c = 0; c < 5; ++c)
#pragma unroll
        for (int e = 0; e < 16; ++e) {
            const int kvl = 32 * c + (e & 3) + 8 * (e >> 2) + 4 * hi; const int delta = kvl - 64 - r32; const int ik = i0 + r32 + delta;
            const int ad = delta < 0 ? -delta : delta; const bool valid = (ad <= 64) && (ik >= 0) && (ik < nsub);
            float v = sc[c][e] * DSCALE - cb * (float)ad; v = valid ? v : -INFINITY; sc[c][e] = v; mx = fmaxf(mx, v);
        }
    mx = swap_max(mx);
    float ls = 0.f;
#pragma unroll
    for (int c = 0; c < 5; ++c)
#pragma unroll
        for (int e = 0; e < 16; ++e) { const float p = __builtin_amdgcn_exp2f(sc[c][e] - mx); sc[c][e] = p; ls += p; }
    ls = swap_add(ls);
    f32x16 o0 = {}, o1 = {};
    const int vb = ((lane >> 4) & 1) * 32 + (lane & 3) * 8 + (4 * hi + ((lane & 15) >> 2)) * 64;
#pragma unroll
    for (int c = 0; c < 5; ++c) {
        u32x4 vv[4];
#pragma unroll
        for (int i = 0; i < 4; ++i) { const int row = (lane >> 3) + 8 * i; int ik = i0 - 64 + 32 * c + row; ik = ik < 0 ? 0 : (ik > nsub - 1 ? nsub - 1 : ik);
            vv[i] = *(const u32x4*)(Z + (rowbase + r + ((size_t)ik << sh)) * ZLD + 2304 + hd * 64 + (lane & 7) * 8); }
        asm volatile("s_waitcnt lgkmcnt(0)" ::: "memory");
#pragma unroll
        for (int i = 0; i < 4; ++i) { const int row = (lane >> 3) + 8 * i; *(LAS u32x4*)(wl + ((lane & 7) >> 2) * 2048 + row * 64 + (lane & 3) * 16) = vv[i]; }
        asm volatile("s_waitcnt lgkmcnt(0)" ::: "memory");
#pragma unroll
        for (int s = 0; s < 2; ++s) {
            u32x4 pw; pw.x = cvt_pk_bf16(sc[c][8 * s + 0], sc[c][8 * s + 1]); pw.y = cvt_pk_bf16(sc[c][8 * s + 2], sc[c][8 * s + 3]); pw.z = cvt_pk_bf16(sc[c][8 * s + 4], sc[c][8 * s + 5]); pw.w = cvt_pk_bf16(sc[c][8 * s + 6], sc[c][8 * s + 7]);
            const bf16x8 pf = __builtin_bit_cast(bf16x8, pw);
            { const s16x4 lo = vtr(wl + vb + s * 1024), hh = vtr(wl + vb + s * 1024 + 512); const bf16x8 vf = {lo[0], lo[1], lo[2], lo[3], hh[0], hh[1], hh[2], hh[3]};
              o0 = __builtin_amdgcn_mfma_f32_32x32x16_bf16(vf, pf, o0, 0, 0, 0); }
            { const s16x4 lo = vtr(wl + vb + 2048 + s * 1024), hh = vtr(wl + vb + 2048 + s * 1024 + 512); const bf16x8 vf = {lo[0], lo[1], lo[2], lo[3], hh[0], hh[1], hh[2], hh[3]};
              o1 = __builtin_amdgcn_mfma_f32_32x32x16_bf16(vf, pf, o1, 0, 0, 0); }
        }
    }
    const float inv = 1.0f / ls; const size_t rq = rowbase + tq;
    float* op = OG + (rq * 12 + hd) * 64 + 4 * hi;
#pragma unroll
    for (int i = 0; i < 4; ++i) {
        *(f32x4*)(op + 8 * i) = (f32x4){o0[4 * i] * inv, o0[4 * i + 1] * inv, o0[4 * i + 2] * inv, o0[4 * i + 3] * inv};
        *(f32x4*)(op + 32 + 8 * i) = (f32x4){o1[4 * i] * inv, o1[4 * i + 1] * inv, o1[4 * i + 2] * inv, o1[4 * i + 3] * inv};
    }
    if (hi == 0) LSE[rq * 12 + hd] = (mx + __builtin_amdgcn_logf(ls)) * LN2;
}

namespace mla {
constexpr int KPITCH = 208, KBYTES = 64 * KPITCH, VBYTES = 8192, BUF = KBYTES + VBYTES;
__device__ __forceinline__ void attn_unit(const bf16_t* Qh, const bf16_t* Kh, const bf16_t* Vh, bf16_t* Oh  , int S, int qb, LAS unsigned char* lds, int tid) {
    const int lane = tid & 63, r32 = lane & 31, hi = lane >> 5; const int wid = __builtin_amdgcn_readfirstlane(tid >> 6);
    const int qrow = qb * 256 + wid * 32 + r32;
    const bf16_t* Qw = Qh + (size_t)qrow * 96 + 8 * hi;
    bf16x8 qf[6];
#pragma unroll
    for (int s = 0; s < 6; ++s) qf[s] = *(const bf16x8*)(Qw + 16 * s);
    const int kc0 = tid, kc1 = tid + 512; const bool has1 = tid < 256;
    const unsigned kd0 = (unsigned)((kc0 / 12) * KPITCH + (kc0 % 12) * 16), kd1 = (unsigned)((kc1 / 12) * KPITCH + (kc1 % 12) * 16);
    const unsigned vd = (unsigned)(KBYTES + ((tid & 7) >> 2) * 4096 + (tid >> 3) * 64 + (tid & 3) * 16);
    const u32x4* Kg = (const u32x4*)Kh; const u32x4* Vg = (const u32x4*)Vh;
    const int NT = S >> 6;
    u32x4 ka = Kg[kc0], kb = has1 ? Kg[kc1] : (u32x4){0u, 0u, 0u, 0u}, va = Vg[tid];
    *(LAS u32x4*)(lds + kd0) = ka; if (has1) *(LAS u32x4*)(lds + kd1) = kb; *(LAS u32x4*)(lds + vd) = va;
    __syncthreads();
    f32x16 o0 = {}, o1 = {}; float mrun = -INFINITY, lrun = 0.f;
    const unsigned kfo = (unsigned)(r32 * KPITCH + hi * 16);
    const unsigned vb = (unsigned)(KBYTES + ((lane >> 4) & 1) * 32 + (lane & 3) * 8 + (4 * hi + ((lane & 15) >> 2)) * 64);
    for (int t = 0; t < NT; ++t) {
        const unsigned cur = (unsigned)(t & 1) * BUF, nxt = BUF - cur; const bool more = t + 1 < NT;
        if (more) { ka = Kg[(size_t)(t + 1) * 768 + kc0]; if (has1) kb = Kg[(size_t)(t + 1) * 768 + kc1]; va = Vg[(size_t)(t + 1) * 512 + tid]; }
        f32x16 p0 = {}, p1 = {};
#pragma unroll
        for (int s = 0; s < 6; ++s) {
            const bf16x8 a0 = *(const LAS bf16x8*)(lds + cur + kfo + s * 32), a1 = *(const LAS bf16x8*)(lds + cur + kfo + 32 * KPITCH + s * 32);
            p0 = __builtin_amdgcn_mfma_f32_32x32x16_bf16(a0, qf[s], p0, 0, 0, 0); p1 = __builtin_amdgcn_mfma_f32_32x32x16_bf16(a1, qf[s], p1, 0, 0, 0);
        }
        float rm = fmaxf(p0[0], p1[0]);
#pragma unroll
        for (int e = 1; e < 16; ++e) rm = fmaxf(rm, fmaxf(p0[e], p1[e]));
        rm = swap_max(rm);
        if (__any(rm > mrun)) { const float mn = fmaxf(mrun, rm); const float al = __builtin_amdgcn_exp2f(mrun - mn); mrun = mn; lrun *= al;
#pragma unroll
            for (int e = 0; e < 16; ++e) { o0[e] *= al; o1[e] *= al; } }
        float rs = 0.f;
#pragma unroll
        for (int e = 0; e < 16; ++e) { p0[e] = __builtin_amdgcn_exp2f(p0[e] - mrun); p1[e] = __builtin_amdgcn_exp2f(p1[e] - mrun); rs += p0[e] + p1[e]; }
        lrun += rs;
#pragma unroll
        for (int ks = 0; ks < 4; ++ks) {
            u32x4 pw;
            if (ks < 2) { const int b = 8 * ks; pw.x = cvt_pk_bf16(p0[b], p0[b + 1]); pw.y = cvt_pk_bf16(p0[b + 2], p0[b + 3]); pw.z = cvt_pk_bf16(p0[b + 4], p0[b + 5]); pw.w = cvt_pk_bf16(p0[b + 6], p0[b + 7]); }
            else { const int b = 8 * (ks - 2); pw.x = cvt_pk_bf16(p1[b], p1[b + 1]); pw.y = cvt_pk_bf16(p1[b + 2], p1[b + 3]); pw.z = cvt_pk_bf16(p1[b + 4], p1[b + 5]); pw.w = cvt_pk_bf16(p1[b + 6], p1[b + 7]); }
            const bf16x8 pf = __builtin_bit_cast(bf16x8, pw);
            { const s16x4 lo = vtr(lds + cur + vb + ks * 1024), hh = vtr(lds + cur + vb + ks * 1024 + 512); const bf16x8 vf = {lo[0], lo[1], lo[2], lo[3], hh[0], hh[1], hh[2], hh[3]};
              o0 = __builtin_amdgcn_mfma_f32_32x32x16_bf16(vf, pf, o0, 0, 0, 0); }
            { const s16x4 lo = vtr(lds + cur + vb + 4096 + ks * 1024), hh = vtr(lds + cur + vb + 4096 + ks * 1024 + 512); const bf16x8 vf = {lo[0], lo[1], lo[2], lo[3], hh[0], hh[1], hh[2], hh[3]};
              o1 = __builtin_amdgcn_mfma_f32_32x32x16_bf16(vf, pf, o1, 0, 0, 0); }
        }
        if (more) { *(LAS u32x4*)(lds + nxt + kd0) = ka; if (has1) *(LAS u32x4*)(lds + nxt + kd1) = kb; *(LAS u32x4*)(lds + nxt + vd) = va; }
        __syncthreads();
    }
    const float inv = 1.0f / swap_add(lrun);
    bf16_t* op = Oh + (size_t)qrow * D + 4 * hi;
#pragma unroll
    for (int i = 0; i < 4; ++i) {
        u32x2 w0; w0.x = cvt_pk_bf16(o0[4 * i] * inv, o0[4 * i + 1] * inv); w0.y = cvt_pk_bf16(o0[4 * i + 2] * inv, o0[4 * i + 3] * inv); *(u32x2*)(op + 8 * i) = w0;
        u32x2 w1; w1.x = cvt_pk_bf16(o1[4 * i] * inv, o1[4 * i + 1] * inv); w1.y = cvt_pk_bf16(o1[4 * i + 2] * inv, o1[4 * i + 3] * inv); *(u32x2*)(op + 32 + 8 * i) = w1;
    }
}
}

#define XB_TMO      128
#define XB_XCNT(j)  (256  + 64 * (j))
#define XB_XSUB(j)  (1280 + 64 * (j))
#define XB_XGEN(j)  (2304 + 64 * (j))
#define XB_TOP      3328
#define XB_TOPGEN   3392
#define XCD_BAR_WORDS 3456
#define XB_SPIN_CAP (1u << 20)
__device__ __forceinline__ unsigned xb_ld(unsigned* p)              { return __hip_atomic_load(p, __ATOMIC_RELAXED, __HIP_MEMORY_SCOPE_AGENT); }
__device__ __forceinline__ unsigned xb_add(unsigned* p, unsigned v) { return __hip_atomic_fetch_add(p, v, __ATOMIC_RELAXED, __HIP_MEMORY_SCOPE_AGENT); }
__device__ __forceinline__ unsigned xb_xcc_id() { return (unsigned)__builtin_amdgcn_s_getreg((3 << 11) | 20) & 0xFu; }
#define XB_SPIN(cond, bar) do { unsigned _sp = 0; while (cond) { __builtin_amdgcn_s_sleep(1); \
    if ((++_sp & 255u) == 0u) { if (xb_ld(&(bar)[XB_TMO])) break; if (_sp > XB_SPIN_CAP) { atomicAdd(&(bar)[XB_TMO], 1u); break; } } } } while (0)
struct XcdBarrier { unsigned* bar; unsigned x; volatile LAS unsigned* st; };
__device__ __forceinline__ XcdBarrier xcd_barrier_post(unsigned* bar, volatile LAS unsigned* st, int tid) {
    XcdBarrier b; b.bar = bar; b.x = xb_xcc_id(); b.st = st;
    if (tid == 0) (void)xb_add(&bar[XB_XCNT(b.x)], 1u);
    return b;
}
__device__ __forceinline__ void xcd_barrier_complete(unsigned* bar, unsigned x, unsigned& nloc, unsigned& nx) {
    const unsigned G = gridDim.x * gridDim.y * gridDim.z;
    unsigned sum, cnt, mine, sp = 0u;
    for (;;) {
        sum = 0u; cnt = 0u; mine = 0u;
#pragma unroll
        for (unsigned j = 0; j < 16; ++j) { const unsigned c = xb_ld(&bar[XB_XCNT(j)]); sum += c; cnt += (c > 0u) ? 1u : 0u; mine = (j == x) ? c : mine; }
        if (sum == G) break;
        __builtin_amdgcn_s_sleep(1);
        if ((++sp & 255u) == 0u) { if (xb_ld(&bar[XB_TMO])) break; if (sp > XB_SPIN_CAP) { atomicAdd(&bar[XB_TMO], 1u); break; } }
    }
    nloc = mine > 0u ? mine : 1u; nx = cnt > 0u ? cnt : 1u;
}
__device__ __forceinline__ void xcd_barrier(const XcdBarrier& b, int tid) {
    asm volatile("s_waitcnt vmcnt(0)" ::: "memory");
    __syncthreads();
    if (tid == 0) {
        unsigned* bar = b.bar;
        __builtin_amdgcn_s_waitcnt(0);
        unsigned nloc = b.st[0], nx = b.st[1];
        if (nloc == 0u) { xcd_barrier_complete(bar, b.x, nloc, nx); b.st[0] = nloc; b.st[1] = nx; }
        const unsigned old = xb_add(&bar[XB_XSUB(b.x)], 1u);
        const unsigned gen = old / nloc;
        if (old + 1u == (gen + 1u) * nloc) {
            __builtin_amdgcn_fence(__ATOMIC_RELEASE, "agent");
            asm volatile("s_waitcnt vmcnt(0)" ::: "memory");
            const unsigned og = xb_add(&bar[XB_TOP], 1u);
            const unsigned tg = og / nx;
            if (og + 1u == (tg + 1u) * nx) xb_add(&bar[XB_TOPGEN], 1u);
            else XB_SPIN(xb_ld(&bar[XB_TOPGEN]) == tg, bar);
            __builtin_amdgcn_fence(__ATOMIC_ACQUIRE, "agent");
            xb_add(&bar[XB_XGEN(b.x)], 1u);
            asm volatile("s_waitcnt vmcnt(0)" ::: "memory");
        } else {
            XB_SPIN(xb_ld(&bar[XB_XGEN(b.x)]) == gen, bar);
            __builtin_amdgcn_fence(__ATOMIC_ACQUIRE, "agent");
            asm volatile("s_waitcnt vmcnt(0)" ::: "memory");
        }
    }
    __syncthreads();
}

constexpr int SPC = 13, NSTEP = 1 + SPC * NCHUNK + 1;
struct Args { const float* in[21]; float* out; unsigned char* ws; int ph_lo, ph_hi; };

__global__ void __launch_bounds__(512, 2) fwd_kernel(Args args) {
    extern __shared__ __attribute__((aligned(16))) unsigned char lds_raw[];
    LAS unsigned char* lds = (LAS unsigned char*)lds_raw;
    const int wave0 = __builtin_amdgcn_readfirstlane(threadIdx.x >> 6);
#if MEGA
    volatile LAS unsigned* bst = (volatile LAS unsigned*)(lds + 131072 + 352);
    if (threadIdx.x < 2) bst[threadIdx.x] = 0u;
    __syncthreads();
    XcdBarrier xbar = xcd_barrier_post((unsigned*)args.ws + 4096, bst, (int)threadIdx.x);
#endif
    for (int ph = args.ph_lo; ph < args.ph_hi; ++ph) {
    int tid_l = wave0 * 64 + (int)__builtin_amdgcn_mbcnt_hi(~0u, __builtin_amdgcn_mbcnt_lo(~0u, 0u)); asm volatile("" : "+v"(tid_l));
    unsigned char* ws = args.ws; asm volatile("" : "+s"(ws));
    const int tid = tid_l, lane = tid & 63; const int wave = wave0;
    const int G = gridDim.x, bx = blockIdx.x; const int vcu = (G % 8 == 0) ? (bx % 8) * (G / 8) + bx / 8 : bx;
    const int gw = vcu * 8 + wave, NGW = G * 8;
    bf16_t* Win_t = (bf16_t*)(ws + WS_WIN); bf16_t* Wuq_t = (bf16_t*)(ws + WS_WUQ); bf16_t* Wukv_t = (bf16_t*)(ws + WS_WUKV); bf16_t* Pa_t = (bf16_t*)(ws + WS_PA);
    bf16_t* Pb_t = (bf16_t*)(ws + WS_PB); bf16_t* Wout_t = (bf16_t*)(ws + WS_WOUT); bf16_t* Wup_t = (bf16_t*)(ws + WS_WUP); bf16_t* Wdown_t = (bf16_t*)(ws + WS_WDOWN);
    float* MOD = (float*)(ws + WS_MOD); float* ROPE = (float*)(ws + WS_ROPE); float* RSTD = (float*)(ws + WS_RSTD);
    bf16_t* Hb = (bf16_t*)(ws + WS_H); bf16_t* Zb = (bf16_t*)(ws + WS_Z); bf16_t* Qb = (bf16_t*)(ws + WS_Q); bf16_t* KFb = (bf16_t*)(ws + WS_KF); bf16_t* Vb = (bf16_t*)(ws + WS_V);
    bf16_t* OAb = (bf16_t*)(ws + WS_OA); bf16_t* OBb = (bf16_t*)(ws + WS_OB); float* OGb = (float*)(ws + WS_OG); float* LSEb = (float*)(ws + WS_LSE);
    float* Tb = (float*)(ws + WS_T); bf16_t* MGb = (bf16_t*)(ws + WS_MERGED); bf16_t* UPb = (bf16_t*)(ws + WS_UP); bf16_t* ACTb = (bf16_t*)(ws + WS_ACT);
    bool sync_after = true;
        if (ph == 0) {
            if (bx < 96) {
                LAS float* sl = (LAS float*)lds;
                LAS float* part = (LAS float*)(lds + 49152);
                for (int idx = tid; idx < 12 * 1024; idx += 512) { const int b = idx >> 10, d = idx & 1023; const float c = b < 8 ? args.in[2][b * 1024 + d] : args.in[3][(b - 8) * 1024 + d];
                    sl[d * 12 + b] = c / (1.0f + __expf(-c)); }
                __syncthreads();
                const int e = bx * 64 + lane; float acc[12];
#pragma unroll
                for (int b = 0; b < 12; ++b) acc[b] = 0.f;
                const float* wp = args.in[4] + (size_t)(wave * 128) * 6144 + e;
#pragma unroll 8
                for (int d = 0; d < 128; ++d) { const float w = wp[(size_t)d * 6144]; const LAS f32x4* s4 = (const LAS f32x4*)(sl + (wave * 128 + d) * 12);
                    const f32x4 a = s4[0], b4 = s4[1], c4 = s4[2];
                    acc[0] += a.x * w; acc[1] += a.y * w; acc[2] += a.z * w; acc[3] += a.w * w; acc[4] += b4.x * w; acc[5] += b4.y * w; acc[6] += b4.z * w; acc[7] += b4.w * w;
                    acc[8] += c4.x * w; acc[9] += c4.y * w; acc[10] += c4.z * w; acc[11] += c4.w * w; }
#pragma unroll
                for (int b = 0; b < 12; ++b) part[(wave * 12 + b) * 64 + lane] = acc[b];
                __syncthreads();
                if (wave == 0) {
#pragma unroll
                    for (int b = 0; b < 12; ++b) { float s = args.in[5][e];
#pragma unroll
                        for (int w = 0; w < 8; ++w) s += part[(w * 12 + b) * 64 + lane];
                        MOD[b * 6144 + e] = s; } }
                __syncthreads();
            }
            for (int idx = bx * 512 + tid; idx < 8192 * 16; idx += G * 512) { const int pos = idx >> 4, i = idx & 15; const float ang = (float)pos * ROPE_INV[i];
                const double tt = (double)ang * 0.15915494309189535; const float fr_ = (float)(tt - floor(tt));
                ROPE[idx] = __builtin_amdgcn_cosf(fr_); ROPE[131072 + idx] = __builtin_amdgcn_sinf(fr_); }
            {
                LAS float* scr = (LAS float*)(lds + wave * 16384);
                constexpr int I_IN = 16 * 157, I_UQ = 6 * 48, I_UKV = 4 * 64, I_PA = 16 * 32, I_PB = 4 * 32, I_OUT = 16 * 32, I_UP = 16 * 176, I_DOWN = 44 * 32;
                constexpr int NITEMS = I_IN + I_UQ + I_UKV + I_PA + I_PB + I_OUT + I_UP + I_DOWN;
                for (int it = gw; it < NITEMS; it += NGW) {
                    int r = it; const float* W; int K, N, kind = 0; bf16_t* WT; const float* ks = nullptr;
                    if (r < I_IN) { W = args.in[7]; K = 1024; N = 5024; WT = Win_t; kind = 1; }
                    else if ((r -= I_IN) < I_UQ) { W = args.in[10]; K = 384; N = 1536; WT = Wuq_t; kind = 2; ks = args.in[8]; }
                    else if ((r -= I_UQ) < I_UKV) { W = args.in[11]; K = 256; N = 2048; WT = Wukv_t; kind = 3; ks = args.in[9]; }
                    else if ((r -= I_UKV) < I_PA) { W = args.in[12]; K = 1024; N = 1024; WT = Pa_t; }
                    else if ((r -= I_PA) < I_PB) { W = args.in[13]; K = 256; N = 1024; WT = Pb_t; }
                    else if ((r -= I_PB) < I_OUT) { W = args.in[14]; K = 1024; N = 1024; WT = Wout_t; }
                    else if ((r -= I_OUT) < I_UP) { W = args.in[16]; K = 1024; N = 5632; WT = Wup_t; }
                    else { r -= I_UP; W = args.in[19]; K = 2816; N = 1024; WT = Wdown_t; }
                    transpose_item(W, K, N, WT, kind, ks, scr, r, lane);
                }
                for (int idx = bx * 512 + tid; idx < 96 * 128; idx += G * 512) *(u32x4*)(Win_t + (size_t)672 * 1024 + (size_t)idx * 8) = (u32x4){0u, 0u, 0u, 0u};
            }
            __syncthreads();
        } else if (ph == NSTEP - 1) {
            float* o = args.out + (size_t)(NCHUNK - 1) * CH * D;
            for (int m = gw; m < CH; m += NGW) final_norm_row(o + (size_t)m * D, args.in[20], lane);
        } else {
            const int c = (ph - 1) / SPC, k = (ph - 1) - SPC * c;
            ChunkP P;
            if (c == 0) { P.x = args.in[0]; P.S = 2048; P.Sshift = 11; P.nseq = 8; P.seqbase = 0; }
            else { P.x = args.in[1] + (size_t)(c - 1) * CH * D; P.S = 8192; P.Sshift = 13; P.nseq = 2; P.seqbase = 8 + 2 * (c - 1); }
            P.out = args.out + (size_t)c * CH * D;
            sync_after = !(k == 3 || k == 6);
            pg8::Gemm g{}; pg8::EpiAny E{}; bool is_gemm = true;
            E.S = P.S; E.Sshift = P.Sshift; E.seqbase = P.seqbase; E.rstd = RSTD; E.rope = ROPE; E.Z = Zb; E.T = Tb; E.mod = MOD;
            if (k == 1) { g = pg8::Gemm{Hb, Win_t, CH, ZLD, 1024, 1024}; E.kind = 0; E.O = Zb; E.ldc = ZLD; E.sig_pn = 12; }
            else if (k == 3) { g = pg8::Gemm{Zb, Wuq_t, CH, 1536, 384, ZLD}; E.kind = 1; E.Q = Qb; }
            else if (k == 4) { g = pg8::Gemm{Zb + 384, Wukv_t, CH, 2048, 256, ZLD}; E.kind = 2; E.KF = KFb; E.V = Vb; }
            else if (k == 6) { g = pg8::Gemm{OAb, Pa_t, CH, 1024, 1024, 1024}; E.kind = 3; }
            else if (k == 7) { g = pg8::Gemm{OBb, Pb_t, CH, 1024, 256, 256}; E.kind = 4; E.O = MGb; }
            else if (k == 8) { g = pg8::Gemm{MGb, Wout_t, CH, 1024, 1024, 1024}; E.kind = 5; E.base = P.x; E.out = P.out; E.goff = 2048; }
            else if (k == 10) { g = pg8::Gemm{Hb, Wup_t, CH, NUP, 1024, 1024}; E.kind = 0; E.O = UPb; E.ldc = NUP; E.sig_pn = 1 << 30; }
            else if (k == 12) { g = pg8::Gemm{ACTb, Wdown_t, CH, 1024, DFF, DFF}; E.kind = 5; E.base = P.out; E.out = P.out; E.goff = 5120; }
            else is_gemm = false;
            if (is_gemm) { pg8::StaticOrder S; S.init(g.M, g.N, G, bx); pg8::gemm_phase(lds, g, S, E, tid); }
            else if (k == 0) {
                if (c > 0) { float* o = args.out + (size_t)(c - 1) * CH * D; for (int m = gw; m < CH; m += NGW) final_norm_row(o + (size_t)m * D, args.in[20], lane); }
                for (int m = gw; m < CH; m += NGW) { const float* md = MOD + (size_t)(P.seqbase + (m >> P.Sshift)) * 6144;
                    norm_mod_row(P.x + (size_t)m * D, Hb + (size_t)m * D, args.in[6], md + 1024, md, lane); }
            } else if (k == 2) {
                for (int m = gw; m < CH; m += NGW) {
                    const unsigned* zr = (const unsigned*)(Zb + (size_t)m * ZLD);
                    float sq = 0.f, skv = 0.f;
#pragma unroll
                    for (int j = 0; j < 3; ++j) { const unsigned w = zr[lane + 64 * j]; const float a = bflo(w), b = bfhi(w); sq += a * a + b * b; }
#pragma unroll
                    for (int j = 0; j < 2; ++j) { const unsigned w = zr[192 + lane + 64 * j]; const float a = bflo(w), b = bfhi(w); skv += a * a + b * b; }
                    sq = wave_sum(sq); skv = wave_sum(skv);
                    if (lane == 0) { RSTD[2 * m] = 1.0f / sqrtf(sq * (1.f / 384.f) + EPS); RSTD[2 * m + 1] = 1.0f / sqrtf(skv * (1.f / 256.f) + EPS); }
                    const int seq = m >> P.Sshift, pos = m & (P.S - 1);
                    unsigned pr = 0u;
                    { const int i = lane & 15; const unsigned w = zr[320 + i]; const float a = bflo(w), b = bfhi(w); const float cs = ROPE[pos * 16 + i], sn = ROPE[131072 + pos * 16 + i];
                      pr = cvt_pk_bf16(a * cs - b * sn, a * sn + b * cs); }
                    u32x4 o; const int b4 = 4 * (lane & 3);
                    o.x = __shfl(pr, b4); o.y = __shfl(pr, b4 + 1); o.z = __shfl(pr, b4 + 2); o.w = __shfl(pr, b4 + 3);
                    const int head = lane >> 2;
                    *(u32x4*)(KFb + ((size_t)((seq * 16 + head) << P.Sshift) + pos) * 96 + 64 + 8 * (lane & 3)) = o;
                }
                LAS unsigned char* wl = lds + wave * 4096;
                for (int task = gw; task < CH * 12 / 32; task += NGW) dil_task(Zb, OGb, LSEb, P.S, task, wl, lane);
            } else if (k == 5) {
                for (int it = bx * 512 + tid; it < CH * 32; it += G * 512) { const int row = it >> 5, j = (it >> 3) & 3, d8 = (it & 7) * 8;
                    const float l0 = LSEb[row * 12 + j], l1 = LSEb[row * 12 + 4 + j], l2 = LSEb[row * 12 + 8 + j]; const float mx = fmaxf(l0, fmaxf(l1, l2));
                    float w0 = __expf(l0 - mx), w1 = __expf(l1 - mx), w2 = __expf(l2 - mx); const float inv = 1.0f / (w0 + w1 + w2); w0 *= inv; w1 *= inv; w2 *= inv;
                    const float* p0 = OGb + ((size_t)row * 12 + j) * 64 + d8; const float* p1 = p0 + 4 * 64; const float* p2 = p0 + 8 * 64;
                    const f32x4 a0 = *(const f32x4*)p0 * w0 + *(const f32x4*)p1 * w1 + *(const f32x4*)p2 * w2;
                    const f32x4 a1 = *(const f32x4*)(p0 + 4) * w0 + *(const f32x4*)(p1 + 4) * w1 + *(const f32x4*)(p2 + 4) * w2;
                    *(u32x4*)(OBb + (size_t)row * 256 + j * 64 + d8) = pg8::pack8(a0, a1); }
                const int nqb = P.S >> 8, nunits = P.nseq * 16 * nqb;
                for (int uidx = vcu; uidx < nunits; uidx += G) { const int pair = uidx / nqb, qb = uidx - pair * nqb; const int seq = pair >> 4, head = pair & 15;
                    const size_t hb = (size_t)pair << P.Sshift;
                    mla::attn_unit(Qb + hb * 96, KFb + hb * 96, Vb + hb * 64, OAb + ((size_t)seq << P.Sshift) * D + head * 64, P.S, qb, lds, tid); }
            } else if (k == 9) {
                for (int m = gw; m < CH; m += NGW) { const float* md = MOD + (size_t)(P.seqbase + (m >> P.Sshift)) * 6144;
                    norm_mod_row(P.out + (size_t)m * D, Hb + (size_t)m * D, args.in[15], md + 4096, md + 3072, lane); }
            } else if (k == 11) {
                if (tid < 352) {
                    const int f0 = tid * 8; float w0[8], w1[8], w2[8], cb[8];
#pragma unroll
                    for (int e = 0; e < 8; ++e) { w0[e] = args.in[17][f0 + e]; w1[e] = args.in[17][DFF + f0 + e]; w2[e] = args.in[17][2 * DFF + f0 + e]; cb[e] = args.in[18][f0 + e]; }
                    for (int blk = vcu; blk < CH / 64; blk += G) {
                        const int r0 = blk * 64; const int pos0 = r0 & (P.S - 1);
                        const bf16_t* up = UPb + (size_t)r0 * NUP + f0;
                        u32x4 prev = (u32x4){0u, 0u, 0u, 0u}; if (pos0 > 0) prev = *(const u32x4*)(up - NUP);
                        u32x4 curv = *(const u32x4*)up;
#pragma unroll 4
                        for (int i = 0; i < 64; ++i) {
                            u32x4 nxt = (u32x4){0u, 0u, 0u, 0u}; if (pos0 + i + 1 < P.S) nxt = *(const u32x4*)(up + (size_t)(i + 1) * NUP);
                            const u32x4 gv = *(const u32x4*)(up + (size_t)i * NUP + DFF);
                            float r[8];
#pragma unroll
                            for (int q = 0; q < 4; ++q) {
                                const float pl = bflo(prev[q]), ph_ = bfhi(prev[q]), cl = bflo(curv[q]), chh = bfhi(curv[q]), nl = bflo(nxt[q]), nh = bfhi(nxt[q]);
                                const float xl = cb[2 * q] + w0[2 * q] * pl + w1[2 * q] * cl + w2[2 * q] * nl, xh = cb[2 * q + 1] + w0[2 * q + 1] * ph_ + w1[2 * q + 1] * chh + w2[2 * q + 1] * nh;
                                const float yl = 0.7978845608028654f * (xl + 0.044715f * xl * xl * xl), yh = 0.7978845608028654f * (xh + 0.044715f * xh * xh * xh);
                                r[2 * q] = xl * sigmoidf_(2.0f * yl) * bflo(gv[q]); r[2 * q + 1] = xh * sigmoidf_(2.0f * yh) * bfhi(gv[q]);
                            }
                            u32x4 o; o.x = cvt_pk_bf16(r[0], r[1]); o.y = cvt_pk_bf16(r[2], r[3]); o.z = cvt_pk_bf16(r[4], r[5]); o.w = cvt_pk_bf16(r[6], r[7]);
                            *(u32x4*)(ACTb + (size_t)(r0 + i) * DFF + f0) = o;
                            prev = curv; curv = nxt;
                        }
                    }
                }
            }
        }
#if MEGA
        if (sync_after && ph + 1 < args.ph_hi) { if (ph == 0) cg::this_grid().sync(); else xcd_barrier(xbar, tid); }
#else
        (void)sync_after;
#endif
    }
}

extern "C" void kernel_launch(void* const* d_in, const int* in_sizes, int n_in, void* d_out, int out_size, void* d_ws, size_t ws_size, hipStream_t stream) {
    static int grid = 0;
    if (grid == 0) {
        if (n_in != 21 || ws_size < WS_END) { fprintf(stderr, "kernel_launch: unexpected n_in %d / ws_size %zu\n", n_in, ws_size); grid = -1; return; }
        int dev = 0, cus = 0, per_cu = 0;
        (void)hipGetDevice(&dev); (void)hipDeviceGetAttribute(&cus, hipDeviceAttributeMultiprocessorCount, dev);
        (void)hipFuncSetAttribute((const void*)fwd_kernel, hipFuncAttributeMaxDynamicSharedMemorySize, LDS_BYTES);
        (void)hipOccupancyMaxActiveBlocksPerMultiprocessor(&per_cu, (const void*)fwd_kernel, 512, LDS_BYTES);
        (void)hipGetLastError();
        if (per_cu < 1) fprintf(stderr, "kernel_launch: occupancy query says %d blocks/CU\n", per_cu);
        grid = cus;
    }
    if (grid < 0) return;
    Args a{};
    for (int i = 0; i < 21; ++i) a.in[i] = (const float*)d_in[i];
    a.out = (float*)d_out; a.ws = (unsigned char*)d_ws;
#if MEGA
    (void)hipMemsetAsync(d_ws, 0, 65536, stream);
    a.ph_lo = 0; a.ph_hi = NSTEP;
    void* kargs[] = {&a};
    hipError_t e = hipLaunchCooperativeKernel((const void*)fwd_kernel, dim3(grid), dim3(512), kargs, LDS_BYTES, stream);
    if (e != hipSuccess) fprintf(stderr, "cooperative launch failed: %s (grid %d)\n", hipGetErrorString(e), grid);
#else
    for (int ph = 0; ph < NSTEP; ++ph) { a.ph_lo = ph; a.ph_hi = ph + 1; hipLaunchKernelGGL(fwd_kernel, dim3(grid), dim3(512), LDS_BYTES, stream, a);
#ifdef PROBE_DUP
        if (ph > 0 && ph < NSTEP - 1 && ((PROBE_DUP >> ((ph - 1) % SPC)) & 1)) hipLaunchKernelGGL(fwd_kernel, dim3(grid), dim3(512), LDS_BYTES, stream, a);
#endif
    }
#endif
}
```

```cpp
#include <hip/hip_runtime.h>
#include <hip/hip_cooperative_groups.h>
#include <cstdio>
#include <cstdint>
namespace cg = cooperative_groups;

#ifndef MEGA
#define MEGA 1
#endif

#define LAS __attribute__((address_space(3)))
typedef unsigned short bf16_t;
typedef short bf16x8 __attribute__((ext_vector_type(8)));
typedef short s16x4 __attribute__((ext_vector_type(4)));
typedef float f32x2 __attribute__((ext_vector_type(2)));
typedef float f32x4 __attribute__((ext_vector_type(4)));
typedef float f32x16 __attribute__((ext_vector_type(16)));
typedef unsigned u32x2 __attribute__((ext_vector_type(2)));
typedef unsigned u32x4 __attribute__((ext_vector_type(4)));

constexpr int D = 1024, CH = 16384, NCHUNK = 3, ZLD = 5120, NUP = 5632, DFF = 2816;

constexpr float EPS = 1e-6f, LOG2E = 1.4426950408889634f, LN2 = 0.6931471805599453f;
constexpr float QSCALE = 0.10206207261596577f * LOG2E;
constexpr float DSCALE = 0.125f * LOG2E;

constexpr size_t MiB = 1u << 20;
constexpr size_t WS_WIN = 2 * MiB, WS_WUQ = 12 * MiB, WS_WUKV = 14 * MiB, WS_PA = 15 * MiB, WS_PB = 17 * MiB, WS_WOUT = 18 * MiB,
                 WS_WUP = 20 * MiB, WS_WDOWN = 31 * MiB;
constexpr size_t WS_MOD = 37 * MiB, WS_ROPE = 38 * MiB  , WS_RSTD = 39 * MiB + 512 * 1024;
constexpr size_t WS_H = 40 * MiB, WS_Z = 72 * MiB, WS_Q = 232 * MiB, WS_KF = 280 * MiB, WS_V = 328 * MiB, WS_OA = 360 * MiB, WS_OB = 392 * MiB,
                 WS_OG = 400 * MiB, WS_LSE = 448 * MiB, WS_T = 232 * MiB, WS_MERGED = 296 * MiB, WS_UP = 72 * MiB, WS_ACT = 248 * MiB, WS_END = 449 * MiB;

constexpr int LDS_BYTES = 147456;

__device__ __forceinline__ unsigned cvt_pk_bf16(float lo, float hi) { unsigned r; asm volatile("v_cvt_pk_bf16_f32 %0, %1, %2" : "=v"(r) : "v"(lo), "v"(hi)); return r; }
__device__ __forceinline__ float bf2f(unsigned short b) { return __uint_as_float((unsigned)b << 16); }
__device__ __forceinline__ float bflo(unsigned w) { return __uint_as_float(w << 16); }
__device__ __forceinline__ float bfhi(unsigned w) { return __uint_as_float(w & 0xffff0000u); }
__device__ __forceinline__ float wave_sum(float v) {
#pragma unroll
    for (int o = 1; o < 64; o <<= 1) v += __shfl_xor(v, o);
    return v;
}
__device__ __forceinline__ float swap_max(float m) { auto rr = __builtin_amdgcn_permlane32_swap(__float_as_uint(m), __float_as_uint(m), false, false); return fmaxf(__uint_as_float(rr[0]), __uint_as_float(rr[1])); }
__device__ __forceinline__ float swap_add(float m) { auto rr = __builtin_amdgcn_permlane32_swap(__float_as_uint(m), __float_as_uint(m), false, false); return __uint_as_float(rr[0]) + __uint_as_float(rr[1]); }
__device__ __forceinline__ s16x4 vtr(LAS const unsigned char* p) { return __builtin_bit_cast(s16x4, __builtin_amdgcn_ds_read_tr16_b64_v4i16((LAS s16x4*)p)); }
__device__ __forceinline__ float sigmoidf_(float x) { return __builtin_amdgcn_rcpf(1.0f + __builtin_amdgcn_exp2f(-x * LOG2E)); }

struct ChunkP { const float* x; float* out; int S, Sshift, nseq, seqbase; };

namespace pg8 {
constexpr int BM = 256, BK = 64, HALF = 128, HTB = HALF * BK * 2, STAGE_BYTES = 8 * HTB, NXCD = 8, WGM = 8;
__host__ __device__ __forceinline__ int lds_byte(int r, int c) { const int st = (r >> 4) * 2 + (c >> 5), rr = r & 15, cc = c & 31, ob = rr * 64 + cc * 2; return st * 1024 + (ob ^ (((ob >> 9) & 1) << 5)); }
__host__ __device__ __forceinline__ void stage_rc(int b, int& R, int& C) { const int st = b / 1024, sb = b % 1024, swz = sb ^ (((sb >> 9) & 1) << 5); R = (st >> 1) * 16 + swz / 64; C = (st & 1) * 32 + (swz % 64) / 2; }
__host__ __device__ __forceinline__ int perm32(int rho) { const int n = rho >> 4, i = rho & 15; return 8 * (i >> 2) + 4 * n + (i & 3); }
struct Unit { int pm, pn; };
struct Gemm { const bf16_t* A; const bf16_t* Bt; int M, N, K, lda; };
struct StaticOrder {
    int nM, nN, nwg, G, c;
    __device__ void init(int M, int N, int G_, int c_) { nM = M / BM; nN = N / BM; nwg = nM * nN; G = G_; c = c_; }
    __device__ bool next(int i, Unit& u) const {
        const long L = (long)i * G + c; if (L >= nwg) return false;
        int wgid = (int)L; { const int q = nwg / NXCD, r = nwg % NXCD, xcd = wgid % NXCD, off = wgid / NXCD; wgid = (xcd < r ? xcd * (q + 1) : r * (q + 1) + (xcd - r) * q) + off; }
        const int nig = WGM * nN, gid = wgid / nig, fm = gid * WGM, gsz = (nM - fm) < WGM ? (nM - fm) : WGM;
        u.pm = fm + ((wgid % nig) % gsz); u.pn = (wgid % nig) / gsz; return true;
    }
};

template <class Epi, class Sched>
__device__ __forceinline__ void gemm_phase(LAS unsigned char* lds, const Gemm g, const Sched& S, const Epi& E, int tid_in) {
    int tid_ = tid_in; asm volatile("" : "+v"(tid_));
    const int tid = tid_, wid = __builtin_amdgcn_readfirstlane(tid >> 6), lane = tid & 63, wr = wid >> 2, wc = wid & 3, fr = lane & 15, fq = lane >> 4;
    const int K = g.K, nt = K / BK, lda = g.lda;
    unsigned voffA[2], voffB[2];
#pragma unroll
    for (int i = 0; i < 2; ++i) { int R, C; stage_rc(tid * 16 + i * 8192, R, C); const int Rb = (R & ~31) + perm32(R & 31);
        voffA[i] = (unsigned)(R * lda + C) * 2u; voffB[i] = (unsigned)(Rb * K + C) * 2u; }
    const size_t kstep = (size_t)(BK * 2);
    const size_t hstepA = (size_t)HALF * lda * 2, hstepB = (size_t)HALF * K * 2;
    const size_t tstepA = 2 * hstepA, tstepB = 2 * hstepB;
    const unsigned ldsw = (unsigned)wid * 1024u;
    const int aoff = lds_byte(wr * 64 + fr, fq * 8), boff = lds_byte(wc * 32 + fr, fq * 8);
#define PG8_SA(b, h) (((b) * 2 + (h)) * HTB)
#define PG8_SB(b, h) ((4 + (b) * 2 + (h)) * HTB)
#define PG8_STAGE(bufoff, gbase, voff) do { _Pragma("unroll") for (int _i = 0; _i < 2; ++_i) \
        __builtin_amdgcn_global_load_lds((const unsigned*)((const char*)(gbase) + (voff)[_i]), (LAS unsigned*)(lds + (bufoff) + ldsw + _i * 8192), 16, 0, 0); } while (0)
#define PG8_LDA(dst, b, h) do { _Pragma("unroll") for (int m = 0; m < 4; ++m) _Pragma("unroll") for (int k = 0; k < 2; ++k) dst[m][k] = *(const LAS bf16x8*)(lds + PG8_SA(b, h) + aoff + m * 2048 + k * 1024); } while (0)
#define PG8_LDB(dst, b, h) do { _Pragma("unroll") for (int n = 0; n < 2; ++n) _Pragma("unroll") for (int k = 0; k < 2; ++k) dst[n][k] = *(const LAS bf16x8*)(lds + PG8_SB(b, h) + boff + n * 2048 + k * 1024); } while (0)
#define PG8_MMA(ai, bj, At, Bt) do { __builtin_amdgcn_s_setprio(1); _Pragma("unroll") for (int m = 0; m < 4; ++m) _Pragma("unroll") for (int n = 0; n < 2; ++n) _Pragma("unroll") for (int k = 0; k < 2; ++k) \
        acc[ai][bj][m][n] = __builtin_amdgcn_mfma_f32_16x16x32_bf16(Bt[n][k], At[m][k], acc[ai][bj][m][n], 0, 0, 0); __builtin_amdgcn_s_setprio(0); } while (0)
#define PG8_WAIT_V(n) asm volatile("s_waitcnt vmcnt(" #n ")" ::: "memory")
#define PG8_WAIT_L(n) asm volatile("s_waitcnt lgkmcnt(" #n ")" ::: "memory")
#define PG8_BAR __builtin_amdgcn_s_barrier()
#define PG8_SCHED __builtin_amdgcn_sched_barrier(0)
    Unit cur, nxt; int ui = 0;
    if (!S.next(0, cur)) return;
    f32x4 acc[2][2][4][2];
#pragma unroll
    for (int a = 0; a < 2; ++a)
#pragma unroll
        for (int b = 0; b < 2; ++b)
#pragma unroll
            for (int m = 0; m < 4; ++m)
#pragma unroll
                for (int n = 0; n < 2; ++n) acc[a][b][m][n] = (f32x4){0.f, 0.f, 0.f, 0.f};
    bf16x8 At[4][2], B0[2][2], B1[2][2];
    const char* cA = (const char*)g.A + (size_t)cur.pm * tstepA; const char* cB = (const char*)g.Bt + (size_t)cur.pn * tstepB;
    PG8_STAGE(PG8_SB(0, 0), cB, voffB); PG8_STAGE(PG8_SB(0, 1), cB + hstepB, voffB); PG8_STAGE(PG8_SA(0, 0), cA, voffA); PG8_STAGE(PG8_SA(0, 1), cA + hstepA, voffA);
    if (wr == 1) PG8_BAR;
    PG8_WAIT_V(2); PG8_BAR;
    PG8_STAGE(PG8_SB(1, 0), cB + kstep, voffB); PG8_STAGE(PG8_SA(1, 0), cA + kstep, voffA); PG8_STAGE(PG8_SB(1, 1), cB + hstepB + kstep, voffB);
    PG8_WAIT_V(6); PG8_BAR;
    for (;;) {
        const bool has_next = S.next(ui + 1, nxt);
        const char* nA = has_next ? (const char*)g.A + (size_t)nxt.pm * tstepA : cA; const char* nB = has_next ? (const char*)g.Bt + (size_t)nxt.pn * tstepB : cB;
        for (int t = 0; t < nt; t += 2) {
            const bool last = (t == nt - 2);
            const char* a1 = cA + (size_t)(t + 1) * kstep;
            const char* a2 = last ? nA : cA + (size_t)(t + 2) * kstep; const char* b2 = last ? nB : cB + (size_t)(t + 2) * kstep;
            const char* a3 = a2 + kstep; const char* b3 = b2 + kstep;
            PG8_LDB(B0, 0, 0); PG8_LDB(B1, 0, 1); PG8_SCHED; PG8_LDA(At, 0, 0); PG8_STAGE(PG8_SA(1, 1), a1 + hstepA, voffA);
            PG8_WAIT_V(8); PG8_WAIT_L(0); PG8_BAR; PG8_MMA(0, 0, At, B0); PG8_MMA(0, 1, At, B1); PG8_BAR; PG8_SCHED;
            PG8_LDA(At, 0, 1); PG8_STAGE(PG8_SB(0, 0), b2, voffB); PG8_STAGE(PG8_SB(0, 1), b2 + hstepB, voffB); PG8_STAGE(PG8_SA(0, 0), a2, voffA);
            PG8_WAIT_V(8); PG8_WAIT_L(0); PG8_BAR; PG8_MMA(1, 0, At, B0); PG8_MMA(1, 1, At, B1); PG8_BAR; PG8_SCHED;
            PG8_LDB(B0, 1, 0); PG8_LDB(B1, 1, 1); PG8_SCHED; PG8_LDA(At, 1, 0); PG8_STAGE(PG8_SA(0, 1), a2 + hstepA, voffA);
            PG8_WAIT_V(8); PG8_WAIT_L(0); PG8_BAR; PG8_MMA(0, 0, At, B0); PG8_MMA(0, 1, At, B1); PG8_BAR; PG8_SCHED;
            PG8_LDA(At, 1, 1); PG8_STAGE(PG8_SB(1, 0), b3, voffB); PG8_STAGE(PG8_SB(1, 1), b3 + hstepB, voffB); PG8_STAGE(PG8_SA(1, 0), a3, voffA);
            PG8_WAIT_V(8); PG8_WAIT_L(0); PG8_BAR; PG8_MMA(1, 0, At, B0); PG8_MMA(1, 1, At, B1); PG8_BAR; PG8_SCHED;
        }
        if (wr == 0) PG8_BAR;
        E(acc, cur, wr, wc, fr, fq);
        if (!has_next) break;
#pragma unroll
        for (int a = 0; a < 2; ++a)
#pragma unroll
            for (int b = 0; b < 2; ++b)
#pragma unroll
                for (int m = 0; m < 4; ++m)
#pragma unroll
                    for (int n = 0; n < 2; ++n) acc[a][b][m][n] = (f32x4){0.f, 0.f, 0.f, 0.f};
        cur = nxt; cA = nA; cB = nB; ++ui;
        if (wr == 1) PG8_BAR;
    }
    PG8_WAIT_V(0);
    PG8_BAR;
#undef PG8_SA
#undef PG8_SB
#undef PG8_STAGE
#undef PG8_LDA
#undef PG8_LDB
#undef PG8_MMA
#undef PG8_WAIT_V
#undef PG8_WAIT_L
#undef PG8_BAR
#undef PG8_SCHED
}

#define EPI_ARGS const f32x4 (&acc)[2][2][4][2], const Unit& u, int wr, int wc, int fr, int fq
__device__ __forceinline__ u32x4 pack8(f32x4 v0, f32x4 v1) { u32x4 w; w.x = cvt_pk_bf16(v0[0], v0[1]); w.y = cvt_pk_bf16(v0[2], v0[3]); w.z = cvt_pk_bf16(v1[0], v1[1]); w.w = cvt_pk_bf16(v1[2], v1[3]); return w; }

struct EpiStore {
    bf16_t* O; int ldc; int sig_pn;
    __device__ __forceinline__ void operator()(EPI_ARGS) const {
        const int row0 = u.pm * BM + wr * 64 + fr, col0 = u.pn * BM + wc * 32 + 8 * fq; const bool sig = u.pn >= sig_pn;
#pragma unroll
        for (int ai = 0; ai < 2; ++ai)
#pragma unroll
            for (int m = 0; m < 4; ++m) { bf16_t* rowp = O + (size_t)(row0 + ai * HALF + m * 16) * ldc + col0;
#pragma unroll
                for (int bj = 0; bj < 2; ++bj) { f32x4 v0 = acc[ai][bj][m][0], v1 = acc[ai][bj][m][1];
                    if (sig) {
#pragma unroll
                        for (int e = 0; e < 4; ++e) { v0[e] = sigmoidf_(v0[e]); v1[e] = sigmoidf_(v1[e]); } }
                    *(u32x4*)(rowp + bj * HALF) = pack8(v0, v1); } }
    }
};
struct EpiQ {
    bf16_t* Q; const float* rstd; const float* rope; int S, Sshift;
    __device__ __forceinline__ void operator()(EPI_ARGS) const {
        const int row0 = u.pm * BM + wr * 64 + fr;
#pragma unroll
        for (int ai = 0; ai < 2; ++ai)
#pragma unroll
            for (int m = 0; m < 4; ++m) { const int row = row0 + ai * HALF + m * 16; const int seq = row >> Sshift, pos = row & (S - 1);
                const float sc = rstd[2 * row] * QSCALE;
#pragma unroll
                for (int bj = 0; bj < 2; ++bj) { const int g32 = 8 * u.pn + 4 * bj + wc; const int head = g32 / 3, gl = g32 - 3 * head;
                    f32x4 v0 = acc[ai][bj][m][0] * sc, v1 = acc[ai][bj][m][1] * sc;
                    if (gl == 2) { const f32x4 cs = *(const f32x4*)(rope + (size_t)pos * 16 + 4 * fq), sn = *(const f32x4*)(rope + 131072 + (size_t)pos * 16 + 4 * fq);
                        f32x4 w0, w1;
                        w0[0] = v0[0] * cs[0] - v0[1] * sn[0]; w0[1] = v0[0] * sn[0] + v0[1] * cs[0];
                        w0[2] = v0[2] * cs[1] - v0[3] * sn[1]; w0[3] = v0[2] * sn[1] + v0[3] * cs[1];
                        w1[0] = v1[0] * cs[2] - v1[1] * sn[2]; w1[1] = v1[0] * sn[2] + v1[1] * cs[2];
                        w1[2] = v1[2] * cs[3] - v1[3] * sn[3]; w1[3] = v1[2] * sn[3] + v1[3] * cs[3];
                        v0 = w0; v1 = w1; }
                    *(u32x4*)(Q + ((size_t)((seq * 16 + head) << Sshift) + pos) * 96 + gl * 32 + 8 * fq) = pack8(v0, v1); }
                asm volatile("" ::: "memory"); }
    }
};
struct EpiKV {
    bf16_t* KF; bf16_t* V; const float* rstd; int S, Sshift;
    __device__ __forceinline__ void operator()(EPI_ARGS) const {
        const int row0 = u.pm * BM + wr * 64 + fr; const bool isv = u.pn >= 4;
#pragma unroll
        for (int ai = 0; ai < 2; ++ai)
#pragma unroll
            for (int m = 0; m < 4; ++m) { const int row = row0 + ai * HALF + m * 16; const int seq = row >> Sshift, pos = row & (S - 1);
                const float sc = rstd[2 * row + 1];
#pragma unroll
                for (int bj = 0; bj < 2; ++bj) { const int col = (u.pn & 3) * BM + bj * HALF + wc * 32 + 8 * fq; const int head = col >> 6, d = col & 63;
                    const f32x4 v0 = acc[ai][bj][m][0] * sc, v1 = acc[ai][bj][m][1] * sc; const size_t tok = (size_t)((seq * 16 + head) << Sshift) + pos;
                    bf16_t* p = isv ? V + tok * 64 + d : KF + tok * 96 + d;
                    *(u32x4*)p = pack8(v0, v1); }
                asm volatile("" ::: "memory"); }
    }
};
struct EpiGateA {
    bf16_t* T; const bf16_t* Z;
    __device__ __forceinline__ void operator()(EPI_ARGS) const {
        const int row0 = u.pm * BM + wr * 64 + fr, col0 = u.pn * BM + wc * 32 + 8 * fq;
#pragma unroll
        for (int ai = 0; ai < 2; ++ai)
#pragma unroll
            for (int m = 0; m < 4; ++m) { const int row = row0 + ai * HALF + m * 16;
#pragma unroll
                for (int bj = 0; bj < 2; ++bj) { const int col = col0 + bj * HALF; const u32x4 gw = *(const u32x4*)(Z + (size_t)row * ZLD + 3072 + col);
                    f32x4 v0 = acc[ai][bj][m][0], v1 = acc[ai][bj][m][1];
                    v0[0] *= bflo(gw.x); v0[1] *= bfhi(gw.x); v0[2] *= bflo(gw.y); v0[3] *= bfhi(gw.y); v1[0] *= bflo(gw.z); v1[1] *= bfhi(gw.z); v1[2] *= bflo(gw.w); v1[3] *= bfhi(gw.w);
                    *(u32x4*)(T + (size_t)row * D + col) = pack8(v0, v1); }
                asm volatile("" ::: "memory"); }
    }
};
struct EpiGateB {
    const bf16_t* T; const bf16_t* Z; bf16_t* O;
    __device__ __forceinline__ void operator()(EPI_ARGS) const {
        const int row0 = u.pm * BM + wr * 64 + fr, col0 = u.pn * BM + wc * 32 + 8 * fq;
#pragma unroll
        for (int ai = 0; ai < 2; ++ai)
#pragma unroll
            for (int m = 0; m < 4; ++m) { const int row = row0 + ai * HALF + m * 16;
#pragma unroll
                for (int bj = 0; bj < 2; ++bj) { const int col = col0 + bj * HALF; const u32x4 gw = *(const u32x4*)(Z + (size_t)row * ZLD + 4096 + col);
                    const u32x4 tw = *(const u32x4*)(T + (size_t)row * D + col); f32x4 v0 = {bflo(tw.x), bfhi(tw.x), bflo(tw.y), bfhi(tw.y)}, v1 = {bflo(tw.z), bfhi(tw.z), bflo(tw.w), bfhi(tw.w)};
                    const f32x4 a0 = acc[ai][bj][m][0], a1 = acc[ai][bj][m][1];
                    v0[0] += a0[0] * bflo(gw.x); v0[1] += a0[1] * bfhi(gw.x); v0[2] += a0[2] * bflo(gw.y); v0[3] += a0[3] * bfhi(gw.y);
                    v1[0] += a1[0] * bflo(gw.z); v1[1] += a1[1] * bfhi(gw.z); v1[2] += a1[2] * bflo(gw.w); v1[3] += a1[3] * bfhi(gw.w);
                    *(u32x4*)(O + (size_t)row * D + col) = pack8(v0, v1); }
                asm volatile("" ::: "memory"); }
    }
};
struct EpiResid {
    const float* base; float* out; const float* mod; int goff, Sshift, seqbase; int mode; bf16_t* x1;
    __device__ __forceinline__ void operator()(EPI_ARGS) const {
        const int row0 = u.pm * BM + wr * 64 + fr, col0 = u.pn * BM + wc * 32 + 8 * fq;
        const float* gt = mod + (size_t)(seqbase + ((u.pm * BM) >> Sshift)) * 6144 + goff + col0;
        f32x4 g[2][2];
#pragma unroll
        for (int bj = 0; bj < 2; ++bj) { g[bj][0] = *(const f32x4*)(gt + bj * HALF); g[bj][1] = *(const f32x4*)(gt + bj * HALF + 4); }
#pragma unroll
        for (int ai = 0; ai < 2; ++ai)
#pragma unroll
            for (int m = 0; m < 4; ++m) { const size_t off = (size_t)(row0 + ai * HALF + m * 16) * D + col0;
#pragma unroll
                for (int bj = 0; bj < 2; ++bj) {
                    if (mode == 0) { const f32x4 b0 = *(const f32x4*)(base + off + bj * HALF), b1 = *(const f32x4*)(base + off + bj * HALF + 4);
                        *(u32x4*)(x1 + off + bj * HALF) = pack8(b0 + g[bj][0] * acc[ai][bj][m][0], b1 + g[bj][1] * acc[ai][bj][m][1]); }
                    else { const u32x4 w = *(const u32x4*)(x1 + off + bj * HALF); const f32x4 b0 = {bflo(w.x), bfhi(w.x), bflo(w.y), bfhi(w.y)}, b1 = {bflo(w.z), bfhi(w.z), bflo(w.w), bfhi(w.w)};
                        *(f32x4*)(out + off + bj * HALF) = b0 + g[bj][0] * acc[ai][bj][m][0]; *(f32x4*)(out + off + bj * HALF + 4) = b1 + g[bj][1] * acc[ai][bj][m][1]; } }
                if (m & 1) asm volatile("" ::: "memory"); }
    }
};

struct EpiAny {
    int kind;
    bf16_t* O; int ldc; int sig_pn;
    bf16_t* Q; bf16_t* KF; bf16_t* V; const float* rstd; const float* rope; int S, Sshift;
    bf16_t* T; const bf16_t* Z;
    const float* base; float* out; const float* mod; int goff, seqbase; int rmode; bf16_t* x1;
    __device__ __forceinline__ void operator()(EPI_ARGS) const {
        if (kind == 0) { EpiStore e{O, ldc, sig_pn}; e(acc, u, wr, wc, fr, fq); }
        else if (kind == 1) { EpiQ e{Q, rstd, rope, S, Sshift}; e(acc, u, wr, wc, fr, fq); }
        else if (kind == 2) { EpiKV e{KF, V, rstd, S, Sshift}; e(acc, u, wr, wc, fr, fq); }
        else if (kind == 3) { EpiGateA e{T, Z}; e(acc, u, wr, wc, fr, fq); }
        else if (kind == 4) { EpiGateB e{T, Z, O}; e(acc, u, wr, wc, fr, fq); }
        else { EpiResid e{base, out, mod, goff, Sshift, seqbase, rmode, x1}; e(acc, u, wr, wc, fr, fq); }
    }
};
}

__device__ const float ROPE_INV[16] = {1.000000000e+00f, 5.623413324e-01f, 3.162277639e-01f, 1.778279394e-01f, 1.000000015e-01f, 5.623413250e-02f, 3.162277490e-02f, 1.778279431e-02f,
                                       9.999999776e-03f, 5.623413250e-03f, 3.162277630e-03f, 1.778279431e-03f, 1.000000047e-03f, 5.623413017e-04f, 3.162277571e-04f, 1.778279402e-04f};
__device__ __forceinline__ int perm_rope(int i) { return i < 16 ? 2 * i : 2 * (i - 16) + 1; }
__device__ __forceinline__ int rowmap(int kind, int n) {
    if (kind == 1) return n < 640 ? n : (n < 672 ? 640 + perm_rope(n - 640) : n + 96);
    if (kind == 2) { const int h = n / 96, c = n - h * 96; return c < 64 ? n : h * 96 + 64 + perm_rope(c - 64); }
    if (kind == 3) { const int h = n >> 7, c = n & 127; return c < 64 ? h * 64 + c : 1024 + h * 64 + (c - 64); }
    return n;
}
__device__ __forceinline__ void transpose_item(const float* W, int K, int N, bf16_t* WT, int kind, const float* ks, LAS float* scr, int item, int lane) {
    const int nblk = N / 32, kb = item / nblk, nb = item - kb * nblk, k0 = 64 * kb, n0 = 32 * nb;
#pragma unroll 8
    for (int i = 0; i < 32; ++i) { const int kk = 2 * i + (lane >> 5); float w = W[(size_t)(k0 + kk) * N + n0 + (lane & 31)]; if (ks) w *= ks[k0 + kk]; scr[kk * 33 + (lane & 31)] = w; }
    asm volatile("s_waitcnt lgkmcnt(0)" ::: "memory");
    const int c = lane & 7;
#pragma unroll
    for (int j = 0; j < 4; ++j) { const int n = (lane >> 3) + 8 * j; const LAS float* s = scr + (8 * c) * 33 + n;
        u32x4 o; o.x = cvt_pk_bf16(s[0 * 33], s[1 * 33]); o.y = cvt_pk_bf16(s[2 * 33], s[3 * 33]); o.z = cvt_pk_bf16(s[4 * 33], s[5 * 33]); o.w = cvt_pk_bf16(s[6 * 33], s[7 * 33]);
        *(u32x4*)(WT + (size_t)rowmap(kind, n0 + n) * K + k0 + 8 * c) = o; }
    asm volatile("s_waitcnt lgkmcnt(0)" ::: "memory");
}

__device__ __forceinline__ void norm_mod_row(const float* xrow, bf16_t* orow, const float* g, const float* sc, const float* sh, int lane) {
    const f32x4* xr = (const f32x4*)xrow + lane; f32x4 v[4]; float s = 0.f;
#pragma unroll
    for (int j = 0; j < 4; ++j) { v[j] = xr[64 * j]; s += (v[j].x * v[j].x + v[j].y * v[j].y) + (v[j].z * v[j].z + v[j].w * v[j].w); }
    const float rstd = 1.0f / sqrtf(wave_sum(s) * (1.f / D) + EPS);
    u32x2* o8 = (u32x2*)orow + lane;
#pragma unroll
    for (int j = 0; j < 4; ++j) { const f32x4 gg = ((const f32x4*)g)[lane + 64 * j], ss = ((const f32x4*)sc)[lane + 64 * j], hh = ((const f32x4*)sh)[lane + 64 * j];
        const f32x4 o = v[j] * rstd * gg * (ss + 1.0f) + hh; u32x2 w; w.x = cvt_pk_bf16(o.x, o.y); w.y = cvt_pk_bf16(o.z, o.w); o8[64 * j] = w; }
}
__device__ __forceinline__ void norm_mod_row16(const bf16_t* xrow, bf16_t* orow, const float* g, const float* sc, const float* sh, int lane) {
    const u32x2* xr = (const u32x2*)xrow + lane; f32x4 v[4]; float s = 0.f;
#pragma unroll
    for (int j = 0; j < 4; ++j) { const u32x2 w = xr[64 * j]; v[j] = (f32x4){bflo(w.x), bfhi(w.x), bflo(w.y), bfhi(w.y)}; s += (v[j].x * v[j].x + v[j].y * v[j].y) + (v[j].z * v[j].z + v[j].w * v[j].w); }
    const float rstd = 1.0f / sqrtf(wave_sum(s) * (1.f / D) + EPS);
    u32x2* o8 = (u32x2*)orow + lane;
#pragma unroll
    for (int j = 0; j < 4; ++j) { const f32x4 gg = ((const f32x4*)g)[lane + 64 * j], ss = ((const f32x4*)sc)[lane + 64 * j], hh = ((const f32x4*)sh)[lane + 64 * j];
        const f32x4 o = v[j] * rstd * gg * (ss + 1.0f) + hh; u32x2 w; w.x = cvt_pk_bf16(o.x, o.y); w.y = cvt_pk_bf16(o.z, o.w); o8[64 * j] = w; }
}
__device__ __forceinline__ void final_norm_row(float* xrow, const float* g, int lane) {
    f32x4* xr = (f32x4*)xrow + lane; f32x4 v[4]; float s = 0.f;
#pragma unroll
    for (int j = 0; j < 4; ++j) { v[j] = xr[64 * j]; s += (v[j].x * v[j].x + v[j].y * v[j].y) + (v[j].z * v[j].z + v[j].w * v[j].w); }
    const float rstd = 1.0f / sqrtf(wave_sum(s) * (1.f / D) + EPS);
#pragma unroll
    for (int j = 0; j < 4; ++j) xr[64 * j] = v[j] * rstd * ((const f32x4*)g)[lane + 64 * j];
}

__device__ __forceinline__ void dil_task(const bf16_t* Z, float* OG, float* LSE, int S, int task, LAS unsigned char* wl, int lane_in) {
    int lane = lane_in; asm volatile("" : "+v"(lane));
    const int r32 = lane & 31, hi = lane >> 5;
    const int bps = S >> 5, tps = 12 * bps;
    const int seq = task / tps; const int rem = task - seq * tps; const int hd = rem / bps; const int blk = rem - hd * bps;
    const int g = hd >> 2, sh = 2 * g, dl = 1 << sh; const int r = blk & (dl - 1), bi = blk >> sh;
    const int i0 = bi * 32, nsub = S >> sh;
    const size_t rowbase = (size_t)seq * S;
    const int tq = r + ((i0 + r32) << sh);
    const bf16_t* qp = Z + (rowbase + tq) * ZLD + 768 + hd * 64 + 8 * hi;
    bf16x8 qf[4];
#pragma unroll
    for (int s = 0; s < 4; ++s) qf[s] = *(const bf16x8*)(qp + 16 * s);
    f32x16 sc[5];
#pragma unroll
    for (int c = 0; c < 5; ++c) {
        int ik = i0 - 64 + 32 * c + r32; ik = ik < 0 ? 0 : (ik > nsub - 1 ? nsub - 1 : ik);
        const bf16_t* kp = Z + (rowbase + r + ((size_t)ik << sh)) * ZLD + 1536 + hd * 64 + 8 * hi;
        bf16x8 kf[4];
#pragma unroll
        for (int s = 0; s < 4; ++s) kf[s] = *(const bf16x8*)(kp + 16 * s);
        f32x16 a = {};
#pragma unroll
        for (int s = 0; s < 4; ++s) a = __builtin_amdgcn_mfma_f32_32x32x16_bf16(kf[s], qf[s], a, 0, 0, 0);
        sc[c] = a;
        asm volatile("" ::: "memory");
    }
    const float cb = __builtin_amdgcn_exp2f(-0.6666666667f * (float)(hd + 1)) * LOG2E * (float)dl;
    float mx = -INFINITY;
#pragma unroll
    for (int c = 0; c < 5; ++c)
#pragma unroll
        for (int e = 0; e < 16; ++e) {
            const int kvl = 32 * c + (e & 3) + 8 * (e >> 2) + 4 * hi; const int delta = kvl - 64 - r32; const int ik = i0 + r32 + delta;
            const int ad = delta < 0 ? -delta : delta; const bool valid = (ad <= 64) && (ik >= 0) && (ik < nsub);
            float v = sc[c][e] * DSCALE - cb * (float)ad; v = valid ? v : -INFINITY; sc[c][e] = v; mx = fmaxf(mx, v);
        }
    mx = swap_max(mx);
    float ls = 0.f;
#pragma unroll
    for (int c = 0; c < 5; ++c)
#pragma unroll
        for (int e = 0; e < 16; ++e) { const float p = __builtin_amdgcn_exp2f(sc[c][e] - mx); sc[c][e] = p; ls += p; }
    ls = swap_add(ls);
    f32x16 o0 = {}, o1 = {};
    const int vb = ((lane >> 4) & 1) * 32 + (lane & 3) * 8 + (4 * hi + ((lane & 15) >> 2)) * 64;
#pragma unroll
    for (int c = 0; c < 5; ++c) {
        u32x4 vv[4];
#pragma unroll
        for (int i = 0; i < 4; ++i) { const int row = (lane >> 3) + 8 * i; int ik = i0 - 64 + 32 * c + row; ik = ik < 0 ? 0 : (ik > nsub - 1 ? nsub - 1 : ik);
            vv[i] = *(const u32x4*)(Z + (rowbase + r + ((size_t)ik << sh)) * ZLD + 2304 + hd * 64 + (lane & 7) * 8); }
        asm volatile("s_waitcnt lgkmcnt(0)" ::: "memory");
#pragma unroll
        for (int i = 0; i < 4; ++i) { const int row = (lane >> 3) + 8 * i; *(LAS u32x4*)(wl + ((lane & 7) >> 2) * 2048 + row * 64 + (lane & 3) * 16) = vv[i]; }
        asm volatile("s_waitcnt lgkmcnt(0)" ::: "memory");
#pragma unroll
        for (int s = 0; s < 2; ++s) {
            u32x4 pw; pw.x = cvt_pk_bf16(sc[c][8 * s + 0], sc[c][8 * s + 1]); pw.y = cvt_pk_bf16(sc[c][8 * s + 2], sc[c][8 * s + 3]); pw.z = cvt_pk_bf16(sc[c][8 * s + 4], sc[c][8 * s + 5]); pw.w = cvt_pk_bf16(sc[c][8 * s + 6], sc[c][8 * s + 7]);
            const bf16x8 pf = __builtin_bit_cast(bf16x8, pw);
            { const s16x4 lo = vtr(wl + vb + s * 1024), hh = vtr(wl + vb + s * 1024 + 512); const bf16x8 vf = {lo[0], lo[1], lo[2], lo[3], hh[0], hh[1], hh[2], hh[3]};
              o0 = __builtin_amdgcn_mfma_f32_32x32x16_bf16(vf, pf, o0, 0, 0, 0); }
            { const s16x4 lo = vtr(wl + vb + 2048 + s * 1024), hh = vtr(wl + vb + 2048 + s * 1024 + 512); const bf16x8 vf = {lo[0], lo[1], lo[2], lo[3], hh[0], hh[1], hh[2], hh[3]};
              o1 = __builtin_amdgcn_mfma_f32_32x32x16_bf16(vf, pf, o1, 0, 0, 0); }
        }
    }
    const float inv = 1.0f / ls; const size_t rq = rowbase + tq;
    float* op = OG + (rq * 12 + hd) * 64 + 4 * hi;
#pragma unroll
    for (int i = 0; i < 4; ++i) {
        *(f32x4*)(op + 8 * i) = (f32x4){o0[4 * i] * inv, o0[4 * i + 1] * inv, o0[4 * i + 2] * inv, o0[4 * i + 3] * inv};
        *(f32x4*)(op + 32 + 8 * i) = (f32x4){o1[4 * i] * inv, o1[4 * i + 1] * inv, o1[4 * i + 2] * inv, o1[4 * i + 3] * inv};
    }
    if (hi == 0) LSE[rq * 12 + hd] = (mx + __builtin_amdgcn_logf(ls)) * LN2;
}

namespace mla {
constexpr int KPITCH = 208, KBYTES = 64 * KPITCH, VBYTES = 8192, BUF = KBYTES + VBYTES, QOFF = 2 * BUF, DUMMY = QOFF + 8 * 12288;
#define MLA_PACK(P, b) (u32x4){cvt_pk_bf16(P[b], P[b + 1]), cvt_pk_bf16(P[b + 2], P[b + 3]), cvt_pk_bf16(P[b + 4], P[b + 5]), cvt_pk_bf16(P[b + 6], P[b + 7])}
#define SGB(mask, n) __builtin_amdgcn_sched_group_barrier(mask, n, 0)
__device__ __forceinline__ float max2_(float a, float b) { return __builtin_amdgcn_fmed3f(a, b, INFINITY); }
constexpr float THR = 8.0f;
__device__ __forceinline__ void softmax_blk(f32x16& p0, f32x16& p1, f32x16& o0, f32x16& o1, float& mhat, float& lrun, u32x4 (&pf)[4], bool first) {
    float r0 = max2_(p0[0], p0[1]), r1 = max2_(p1[0], p1[1]);
#pragma unroll
    for (int e = 2; e < 16; ++e) { r0 = max2_(r0, p0[e]); r1 = max2_(r1, p1[e]); }
    const float rm = swap_max(max2_(r0, r1));
    if (first || __any(rm - mhat > THR)) {
        const float mn = first ? rm : fmaxf(rm, mhat); const float f = first ? 0.f : __builtin_amdgcn_exp2f(mhat - mn); mhat = mn; lrun *= f;
#pragma unroll
        for (int e = 0; e < 16; ++e) { o0[e] *= f; o1[e] *= f; }
    }
    float s0 = 0.f, s1 = 0.f;
#pragma unroll
    for (int e = 0; e < 16; ++e) { p0[e] = __builtin_amdgcn_exp2f(p0[e] - mhat); p1[e] = __builtin_amdgcn_exp2f(p1[e] - mhat); s0 += p0[e]; s1 += p1[e]; }
    lrun += s0 + s1;
    pf[0] = MLA_PACK(p0, 0); pf[1] = MLA_PACK(p0, 8); pf[2] = MLA_PACK(p1, 0); pf[3] = MLA_PACK(p1, 8);
}
__device__ __forceinline__ void pv_blk(const u32x4 (&pf)[4], f32x16& o0, f32x16& o1, LAS const unsigned char* vbase) {
#pragma unroll
    for (int ks = 0; ks < 4; ++ks) {
        const bf16x8 p = __builtin_bit_cast(bf16x8, pf[ks]);
        { const s16x4 lo = vtr(vbase + ks * 1024), hh = vtr(vbase + ks * 1024 + 512); const bf16x8 vf = {lo[0], lo[1], lo[2], lo[3], hh[0], hh[1], hh[2], hh[3]};
          o0 = __builtin_amdgcn_mfma_f32_32x32x16_bf16(vf, p, o0, 0, 0, 0); }
        { const s16x4 lo = vtr(vbase + 4096 + ks * 1024), hh = vtr(vbase + 4096 + ks * 1024 + 512); const bf16x8 vf = {lo[0], lo[1], lo[2], lo[3], hh[0], hh[1], hh[2], hh[3]};
          o1 = __builtin_amdgcn_mfma_f32_32x32x16_bf16(vf, p, o1, 0, 0, 0); }
    }
}
__device__ __forceinline__ void store_o(bf16_t* op, const f32x16& o0, const f32x16& o1, float inv) {
#pragma unroll
    for (int i = 0; i < 4; ++i) {
        u32x2 w0; w0.x = cvt_pk_bf16(o0[4 * i] * inv, o0[4 * i + 1] * inv); w0.y = cvt_pk_bf16(o0[4 * i + 2] * inv, o0[4 * i + 3] * inv); *(u32x2*)(op + 8 * i) = w0;
        u32x2 w1; w1.x = cvt_pk_bf16(o1[4 * i] * inv, o1[4 * i + 1] * inv); w1.y = cvt_pk_bf16(o1[4 * i + 2] * inv, o1[4 * i + 3] * inv); *(u32x2*)(op + 32 + 8 * i) = w1;
    }
}
__device__ __forceinline__ void attn_unit(const bf16_t* Qh, const bf16_t* Kh, const bf16_t* Vh, bf16_t* Oh  , int S, int qb, LAS unsigned char* lds, int tid) {
    const int lane = tid & 63, r32 = lane & 31, hi = lane >> 5; const int wid = __builtin_amdgcn_readfirstlane(tid >> 6);
    const int qrow = qb * 512 + wid * 64 + r32;
    const bf16_t* Qw = Qh + (size_t)qrow * 96 + 8 * hi;
    LAS unsigned char* ql = lds + QOFF + wid * 12288 + lane * 16;
#pragma unroll
    for (int s = 0; s < 6; ++s) { *(LAS bf16x8*)(ql + s * 1024) = *(const bf16x8*)(Qw + 16 * s); *(LAS bf16x8*)(ql + (6 + s) * 1024) = *(const bf16x8*)(Qw + 32 * 96 + 16 * s); }
    const bool has1 = tid < 256; const int kc0 = tid, kc1 = has1 ? tid + 512 : tid;
    const unsigned kd0 = (unsigned)((kc0 / 12) * KPITCH + (kc0 % 12) * 16);
    const unsigned kd1 = has1 ? (unsigned)((kc1 / 12) * KPITCH + (kc1 % 12) * 16) : (unsigned)(DUMMY + (tid - 256) * 16);
    const unsigned kd1n = has1 ? BUF : 0u;
    const unsigned vd = (unsigned)(KBYTES + ((tid & 7) >> 2) * 4096 + (tid >> 3) * 64 + (tid & 3) * 16);
    const u32x4* Kg = (const u32x4*)Kh; const u32x4* Vg = (const u32x4*)Vh;
    const int NT = S >> 6;
    u32x4 ka = Kg[kc0], kb = Kg[kc1], va = Vg[tid];
    *(LAS u32x4*)(lds + kd0) = ka; *(LAS u32x4*)(lds + kd1) = kb; *(LAS u32x4*)(lds + vd) = va;
    __syncthreads();
    f32x16 oa0 = {}, oa1 = {}, ob0 = {}, ob1 = {}; float ma = 0.f, la = 0.f, mb = 0.f, lb = 0.f;
    const unsigned kfo = (unsigned)(r32 * KPITCH + hi * 16);
    const unsigned vb = (unsigned)(KBYTES + ((lane >> 4) & 1) * 32 + (lane & 3) * 8 + (4 * hi + ((lane & 15) >> 2)) * 64);
    for (int t = 0; t < NT; ++t) {
        const unsigned cur = (unsigned)(t & 1) * BUF, nxt = BUF - cur;
        const int tn = t + 1 < NT ? t + 1 : t;
        ka = Kg[(size_t)tn * 768 + kc0]; kb = Kg[(size_t)tn * 768 + kc1]; va = Vg[(size_t)tn * 512 + tid];
        u32x4 pf[4];
        {
            f32x16 p0 = {}, p1 = {};
#pragma unroll
            for (int s = 0; s < 6; ++s) {
                const bf16x8 a0 = *(const LAS bf16x8*)(lds + cur + kfo + s * 32), a1 = *(const LAS bf16x8*)(lds + cur + kfo + 32 * KPITCH + s * 32);
                const bf16x8 q = *(const LAS bf16x8*)(ql + s * 1024);
                p0 = __builtin_amdgcn_mfma_f32_32x32x16_bf16(a0, q, p0, 0, 0, 0); p1 = __builtin_amdgcn_mfma_f32_32x32x16_bf16(a1, q, p1, 0, 0, 0);
            }
            softmax_blk(p0, p1, oa0, oa1, ma, la, pf, t == 0);
            pv_blk(pf, oa0, oa1, lds + cur + vb);
        }
        __builtin_amdgcn_sched_barrier(0);
        {
            f32x16 p0 = {}, p1 = {};
#pragma unroll
            for (int s = 0; s < 6; ++s) {
                const bf16x8 a0 = *(const LAS bf16x8*)(lds + cur + kfo + s * 32), a1 = *(const LAS bf16x8*)(lds + cur + kfo + 32 * KPITCH + s * 32);
                const bf16x8 q = *(const LAS bf16x8*)(ql + (6 + s) * 1024);
                p0 = __builtin_amdgcn_mfma_f32_32x32x16_bf16(a0, q, p0, 0, 0, 0); p1 = __builtin_amdgcn_mfma_f32_32x32x16_bf16(a1, q, p1, 0, 0, 0);
            }
            softmax_blk(p0, p1, ob0, ob1, mb, lb, pf, t == 0);
            pv_blk(pf, ob0, ob1, lds + cur + vb);
        }
        *(LAS u32x4*)(lds + nxt + kd0) = ka; *(LAS u32x4*)(lds + (has1 ? nxt : 0u) + kd1) = kb; *(LAS u32x4*)(lds + nxt + vd) = va;
        __syncthreads();
    }
    bf16_t* op = Oh + (size_t)qrow * D + 4 * hi;
    store_o(op, oa0, oa1, 1.0f / swap_add(la));
    store_o(op + 32 * D, ob0, ob1, 1.0f / swap_add(lb));
}
#undef SGB
}

#define XB_TMO      128
#define XB_XCNT(j)  (256  + 64 * (j))
#define XB_XSUB(j)  (1280 + 64 * (j))
#define XB_XGEN(j)  (2304 + 64 * (j))
#define XB_TOP      3328
#define XB_TOPGEN   3392
#define XCD_BAR_WORDS 3456
#define XB_SPIN_CAP (1u << 20)
__device__ __forceinline__ unsigned xb_ld(unsigned* p)              { return __hip_atomic_load(p, __ATOMIC_RELAXED, __HIP_MEMORY_SCOPE_AGENT); }
__device__ __forceinline__ unsigned xb_add(unsigned* p, unsigned v) { return __hip_atomic_fetch_add(p, v, __ATOMIC_RELAXED, __HIP_MEMORY_SCOPE_AGENT); }
__device__ __forceinline__ unsigned xb_xcc_id() { return (unsigned)__builtin_amdgcn_s_getreg((3 << 11) | 20) & 0xFu; }
#define XB_SPIN(cond, bar) do { unsigned _sp = 0; while (cond) { __builtin_amdgcn_s_sleep(1); \
    if ((++_sp & 255u) == 0u) { if (xb_ld(&(bar)[XB_TMO])) break; if (_sp > XB_SPIN_CAP) { atomicAdd(&(bar)[XB_TMO], 1u); break; } } } } while (0)
struct XcdBarrier { unsigned* bar; unsigned x; volatile LAS unsigned* st; };
__device__ __forceinline__ XcdBarrier xcd_barrier_post(unsigned* bar, volatile LAS unsigned* st, int tid) {
    XcdBarrier b; b.bar = bar; b.x = xb_xcc_id(); b.st = st;
    if (tid == 0) (void)xb_add(&bar[XB_XCNT(b.x)], 1u);
    return b;
}
__device__ __forceinline__ void xcd_barrier_complete(unsigned* bar, unsigned x, unsigned& nloc, unsigned& nx) {
    const unsigned G = gridDim.x * gridDim.y * gridDim.z;
    unsigned sum, cnt, mine, sp = 0u;
    for (;;) {
        sum = 0u; cnt = 0u; mine = 0u;
#pragma unroll
        for (unsigned j = 0; j < 16; ++j) { const unsigned c = xb_ld(&bar[XB_XCNT(j)]); sum += c; cnt += (c > 0u) ? 1u : 0u; mine = (j == x) ? c : mine; }
        if (sum == G) break;
        __builtin_amdgcn_s_sleep(1);
        if ((++sp & 255u) == 0u) { if (xb_ld(&bar[XB_TMO])) break; if (sp > XB_SPIN_CAP) { atomicAdd(&bar[XB_TMO], 1u); break; } }
    }
    nloc = mine > 0u ? mine : 1u; nx = cnt > 0u ? cnt : 1u;
}
__device__ __forceinline__ void xcd_barrier(const XcdBarrier& b, int tid) {
    asm volatile("s_waitcnt vmcnt(0)" ::: "memory");
    __syncthreads();
    if (tid == 0) {
        unsigned* bar = b.bar;
        __builtin_amdgcn_s_waitcnt(0);
        unsigned nloc = b.st[0], nx = b.st[1];
        if (nloc == 0u) { xcd_barrier_complete(bar, b.x, nloc, nx); b.st[0] = nloc; b.st[1] = nx; }
        const unsigned old = xb_add(&bar[XB_XSUB(b.x)], 1u);
        const unsigned gen = old / nloc;
        if (old + 1u == (gen + 1u) * nloc) {
            __builtin_amdgcn_fence(__ATOMIC_RELEASE, "agent");
            asm volatile("s_waitcnt vmcnt(0)" ::: "memory");
            const unsigned og = xb_add(&bar[XB_TOP], 1u);
            const unsigned tg = og / nx;
            if (og + 1u == (tg + 1u) * nx) xb_add(&bar[XB_TOPGEN], 1u);
            else XB_SPIN(xb_ld(&bar[XB_TOPGEN]) == tg, bar);
            __builtin_amdgcn_fence(__ATOMIC_ACQUIRE, "agent");
            xb_add(&bar[XB_XGEN(b.x)], 1u);
            asm volatile("s_waitcnt vmcnt(0)" ::: "memory");
        } else {
            XB_SPIN(xb_ld(&bar[XB_XGEN(b.x)]) == gen, bar);
            __builtin_amdgcn_fence(__ATOMIC_ACQUIRE, "agent");
            asm volatile("s_waitcnt vmcnt(0)" ::: "memory");
        }
    }
    __syncthreads();
}

constexpr int SPC = 13, NSTEP = 1 + SPC * NCHUNK + 1;
struct Args { const float* in[21]; float* out; unsigned char* ws; int ph_lo, ph_hi; };

__global__ void __launch_bounds__(512, 2) fwd_kernel(Args args) {
    extern __shared__ __attribute__((aligned(16))) unsigned char lds_raw[];
    LAS unsigned char* lds = (LAS unsigned char*)lds_raw;
    const int wave0 = __builtin_amdgcn_readfirstlane(threadIdx.x >> 6);
#if MEGA
    volatile LAS unsigned* bst = (volatile LAS unsigned*)(lds + LDS_BYTES - 16);
    if (threadIdx.x < 2) bst[threadIdx.x] = 0u;
    __syncthreads();
    XcdBarrier xbar = xcd_barrier_post((unsigned*)args.ws + 4096, bst, (int)threadIdx.x);
#endif
    for (int ph = args.ph_lo; ph < args.ph_hi; ++ph) {
    int tid_l = wave0 * 64 + (int)__builtin_amdgcn_mbcnt_hi(~0u, __builtin_amdgcn_mbcnt_lo(~0u, 0u)); asm volatile("" : "+v"(tid_l));
    unsigned char* ws = args.ws; asm volatile("" : "+s"(ws));
    const int tid = tid_l, lane = tid & 63; const int wave = wave0;
    const int G = gridDim.x, bx = blockIdx.x; const int vcu = (G % 8 == 0) ? (bx % 8) * (G / 8) + bx / 8 : bx;
    const int gw = vcu * 8 + wave, NGW = G * 8;
    bf16_t* Win_t = (bf16_t*)(ws + WS_WIN); bf16_t* Wuq_t = (bf16_t*)(ws + WS_WUQ); bf16_t* Wukv_t = (bf16_t*)(ws + WS_WUKV); bf16_t* Pa_t = (bf16_t*)(ws + WS_PA);
    bf16_t* Pb_t = (bf16_t*)(ws + WS_PB); bf16_t* Wout_t = (bf16_t*)(ws + WS_WOUT); bf16_t* Wup_t = (bf16_t*)(ws + WS_WUP); bf16_t* Wdown_t = (bf16_t*)(ws + WS_WDOWN);
    float* MOD = (float*)(ws + WS_MOD); float* ROPE = (float*)(ws + WS_ROPE); float* RSTD = (float*)(ws + WS_RSTD);
    bf16_t* Hb = (bf16_t*)(ws + WS_H); bf16_t* Zb = (bf16_t*)(ws + WS_Z); bf16_t* Qb = (bf16_t*)(ws + WS_Q); bf16_t* KFb = (bf16_t*)(ws + WS_KF); bf16_t* Vb = (bf16_t*)(ws + WS_V);
    bf16_t* OAb = (bf16_t*)(ws + WS_OA); bf16_t* OBb = (bf16_t*)(ws + WS_OB); float* OGb = (float*)(ws + WS_OG); float* LSEb = (float*)(ws + WS_LSE);
    bf16_t* Tb = (bf16_t*)(ws + WS_T); bf16_t* MGb = (bf16_t*)(ws + WS_MERGED); bf16_t* X1b = (bf16_t*)(ws + WS_OA); bf16_t* UPb = (bf16_t*)(ws + WS_UP); bf16_t* ACTb = (bf16_t*)(ws + WS_ACT);
    bool sync_after = true;
        if (ph == 0) {
            if (bx < 96) {
                LAS float* sl = (LAS float*)lds;
                LAS float* part = (LAS float*)(lds + 49152);
                for (int idx = tid; idx < 12 * 1024; idx += 512) { const int b = idx >> 10, d = idx & 1023; const float c = b < 8 ? args.in[2][b * 1024 + d] : args.in[3][(b - 8) * 1024 + d];
                    sl[d * 12 + b] = c / (1.0f + __expf(-c)); }
                __syncthreads();
                const int e = bx * 64 + lane; float acc[12];
#pragma unroll
                for (int b = 0; b < 12; ++b) acc[b] = 0.f;
                const float* wp = args.in[4] + (size_t)(wave * 128) * 6144 + e;
#pragma unroll 8
                for (int d = 0; d < 128; ++d) { const float w = wp[(size_t)d * 6144]; const LAS f32x4* s4 = (const LAS f32x4*)(sl + (wave * 128 + d) * 12);
                    const f32x4 a = s4[0], b4 = s4[1], c4 = s4[2];
                    acc[0] += a.x * w; acc[1] += a.y * w; acc[2] += a.z * w; acc[3] += a.w * w; acc[4] += b4.x * w; acc[5] += b4.y * w; acc[6] += b4.z * w; acc[7] += b4.w * w;
                    acc[8] += c4.x * w; acc[9] += c4.y * w; acc[10] += c4.z * w; acc[11] += c4.w * w; }
#pragma unroll
                for (int b = 0; b < 12; ++b) part[(wave * 12 + b) * 64 + lane] = acc[b];
                __syncthreads();
                if (wave == 0) {
#pragma unroll
                    for (int b = 0; b < 12; ++b) { float s = args.in[5][e];
#pragma unroll
                        for (int w = 0; w < 8; ++w) s += part[(w * 12 + b) * 64 + lane];
                        MOD[b * 6144 + e] = s; } }
                __syncthreads();
            }
            for (int idx = bx * 512 + tid; idx < 8192 * 16; idx += G * 512) { const int pos = idx >> 4, i = idx & 15; const float ang = (float)pos * ROPE_INV[i];
                const double tt = (double)ang * 0.15915494309189535; const float fr_ = (float)(tt - floor(tt));
                ROPE[idx] = __builtin_amdgcn_cosf(fr_); ROPE[131072 + idx] = __builtin_amdgcn_sinf(fr_); }
            {
                LAS float* scr = (LAS float*)(lds + wave * 16384);
                constexpr int I_IN = 16 * 157, I_UQ = 6 * 48, I_UKV = 4 * 64, I_PA = 16 * 32, I_PB = 4 * 32, I_OUT = 16 * 32, I_UP = 16 * 176, I_DOWN = 44 * 32;
                constexpr int NITEMS = I_IN + I_UQ + I_UKV + I_PA + I_PB + I_OUT + I_UP + I_DOWN;
                for (int it = gw; it < NITEMS; it += NGW) {
                    int r = it; const float* W; int K, N, kind = 0; bf16_t* WT; const float* ks = nullptr;
                    if (r < I_IN) { W = args.in[7]; K = 1024; N = 5024; WT = Win_t; kind = 1; }
                    else if ((r -= I_IN) < I_UQ) { W = args.in[10]; K = 384; N = 1536; WT = Wuq_t; kind = 2; ks = args.in[8]; }
                    else if ((r -= I_UQ) < I_UKV) { W = args.in[11]; K = 256; N = 2048; WT = Wukv_t; kind = 3; ks = args.in[9]; }
                    else if ((r -= I_UKV) < I_PA) { W = args.in[12]; K = 1024; N = 1024; WT = Pa_t; }
                    else if ((r -= I_PA) < I_PB) { W = args.in[13]; K = 256; N = 1024; WT = Pb_t; }
                    else if ((r -= I_PB) < I_OUT) { W = args.in[14]; K = 1024; N = 1024; WT = Wout_t; }
                    else if ((r -= I_OUT) < I_UP) { W = args.in[16]; K = 1024; N = 5632; WT = Wup_t; }
                    else { r -= I_UP; W = args.in[19]; K = 2816; N = 1024; WT = Wdown_t; }
                    transpose_item(W, K, N, WT, kind, ks, scr, r, lane);
                }
                for (int idx = bx * 512 + tid; idx < 96 * 128; idx += G * 512) *(u32x4*)(Win_t + (size_t)672 * 1024 + (size_t)idx * 8) = (u32x4){0u, 0u, 0u, 0u};
            }
            __syncthreads();
        } else if (ph == NSTEP - 1) {
            float* o = args.out + (size_t)(NCHUNK - 1) * CH * D;
            for (int m = gw; m < CH; m += NGW) final_norm_row(o + (size_t)m * D, args.in[20], lane);
        } else {
            const int c = (ph - 1) / SPC, k = (ph - 1) - SPC * c;
            ChunkP P;
            if (c == 0) { P.x = args.in[0]; P.S = 2048; P.Sshift = 11; P.nseq = 8; P.seqbase = 0; }
            else { P.x = args.in[1] + (size_t)(c - 1) * CH * D; P.S = 8192; P.Sshift = 13; P.nseq = 2; P.seqbase = 8 + 2 * (c - 1); }
            P.out = args.out + (size_t)c * CH * D;
            sync_after = !(k == 3 || k == 6);
            pg8::Gemm g{}; pg8::EpiAny E{}; bool is_gemm = true;
            E.S = P.S; E.Sshift = P.Sshift; E.seqbase = P.seqbase; E.rstd = RSTD; E.rope = ROPE; E.Z = Zb; E.T = Tb; E.mod = MOD;
            if (k == 1) { g = pg8::Gemm{Hb, Win_t, CH, ZLD, 1024, 1024}; E.kind = 0; E.O = Zb; E.ldc = ZLD; E.sig_pn = 12; }
            else if (k == 3) { g = pg8::Gemm{Zb, Wuq_t, CH, 1536, 384, ZLD}; E.kind = 1; E.Q = Qb; }
            else if (k == 4) { g = pg8::Gemm{Zb + 384, Wukv_t, CH, 2048, 256, ZLD}; E.kind = 2; E.KF = KFb; E.V = Vb; }
            else if (k == 6) { g = pg8::Gemm{OAb, Pa_t, CH, 1024, 1024, 1024}; E.kind = 3; }
            else if (k == 7) { g = pg8::Gemm{OBb, Pb_t, CH, 1024, 256, 256}; E.kind = 4; E.O = MGb; }
            else if (k == 8) { g = pg8::Gemm{MGb, Wout_t, CH, 1024, 1024, 1024}; E.kind = 5; E.base = P.x; E.out = P.out; E.goff = 2048; E.rmode = 0; E.x1 = X1b; }
            else if (k == 10) { g = pg8::Gemm{Hb, Wup_t, CH, NUP, 1024, 1024}; E.kind = 0; E.O = UPb; E.ldc = NUP; E.sig_pn = 1 << 30; }
            else if (k == 12) { g = pg8::Gemm{ACTb, Wdown_t, CH, 1024, DFF, DFF}; E.kind = 5; E.base = P.out; E.out = P.out; E.goff = 5120; E.rmode = 1; E.x1 = X1b; }
            else is_gemm = false;
            if (is_gemm) { pg8::StaticOrder S; S.init(g.M, g.N, G, bx); pg8::gemm_phase(lds, g, S, E, tid); }
            else if (k == 0) {
                if (c > 0) { float* o = args.out + (size_t)(c - 1) * CH * D; for (int m = gw; m < CH; m += NGW) final_norm_row(o + (size_t)m * D, args.in[20], lane); }
                for (int m = gw; m < CH; m += NGW) { const float* md = MOD + (size_t)(P.seqbase + (m >> P.Sshift)) * 6144;
                    norm_mod_row(P.x + (size_t)m * D, Hb + (size_t)m * D, args.in[6], md + 1024, md, lane); }
            } else if (k == 2) {
                for (int m = gw; m < CH; m += NGW) {
                    const unsigned* zr = (const unsigned*)(Zb + (size_t)m * ZLD);
                    float sq = 0.f, skv = 0.f;
#pragma unroll
                    for (int j = 0; j < 3; ++j) { const unsigned w = zr[lane + 64 * j]; const float a = bflo(w), b = bfhi(w); sq += a * a + b * b; }
#pragma unroll
                    for (int j = 0; j < 2; ++j) { const unsigned w = zr[192 + lane + 64 * j]; const float a = bflo(w), b = bfhi(w); skv += a * a + b * b; }
                    sq = wave_sum(sq); skv = wave_sum(skv);
                    if (lane == 0) { RSTD[2 * m] = 1.0f / sqrtf(sq * (1.f / 384.f) + EPS); RSTD[2 * m + 1] = 1.0f / sqrtf(skv * (1.f / 256.f) + EPS); }
                    const int seq = m >> P.Sshift, pos = m & (P.S - 1);
                    unsigned pr = 0u;
                    { const int i = lane & 15; const unsigned w = zr[320 + i]; const float a = bflo(w), b = bfhi(w); const float cs = ROPE[pos * 16 + i], sn = ROPE[131072 + pos * 16 + i];
                      pr = cvt_pk_bf16(a * cs - b * sn, a * sn + b * cs); }
                    u32x4 o; const int b4 = 4 * (lane & 3);
                    o.x = __shfl(pr, b4); o.y = __shfl(pr, b4 + 1); o.z = __shfl(pr, b4 + 2); o.w = __shfl(pr, b4 + 3);
                    const int head = lane >> 2;
                    *(u32x4*)(KFb + ((size_t)((seq * 16 + head) << P.Sshift) + pos) * 96 + 64 + 8 * (lane & 3)) = o;
                }
                LAS unsigned char* wl = lds + wave * 4096;
                for (int task = gw; task < CH * 12 / 32; task += NGW) dil_task(Zb, OGb, LSEb, P.S, task, wl, lane);
            } else if (k == 5) {
                for (int it = bx * 512 + tid; it < CH * 32; it += G * 512) { const int row = it >> 5, j = (it >> 3) & 3, d8 = (it & 7) * 8;
                    const float l0 = LSEb[row * 12 + j], l1 = LSEb[row * 12 + 4 + j], l2 = LSEb[row * 12 + 8 + j]; const float mx = fmaxf(l0, fmaxf(l1, l2));
                    float w0 = __expf(l0 - mx), w1 = __expf(l1 - mx), w2 = __expf(l2 - mx); const float inv = 1.0f / (w0 + w1 + w2); w0 *= inv; w1 *= inv; w2 *= inv;
                    const float* p0 = OGb + ((size_t)row * 12 + j) * 64 + d8; const float* p1 = p0 + 4 * 64; const float* p2 = p0 + 8 * 64;
                    const f32x4 a0 = *(const f32x4*)p0 * w0 + *(const f32x4*)p1 * w1 + *(const f32x4*)p2 * w2;
                    const f32x4 a1 = *(const f32x4*)(p0 + 4) * w0 + *(const f32x4*)(p1 + 4) * w1 + *(const f32x4*)(p2 + 4) * w2;
                    *(u32x4*)(OBb + (size_t)row * 256 + j * 64 + d8) = pg8::pack8(a0, a1); }
                const int nqb = P.S >> 9, nunits = P.nseq * 16 * nqb;
                for (int uidx = vcu; uidx < nunits; uidx += G) { const int pair = uidx / nqb, qb = uidx - pair * nqb; const int seq = pair >> 4, head = pair & 15;
                    const size_t hb = (size_t)pair << P.Sshift;
                    mla::attn_unit(Qb + hb * 96, KFb + hb * 96, Vb + hb * 64, OAb + ((size_t)seq << P.Sshift) * D + head * 64, P.S, qb, lds, tid); }
            } else if (k == 9) {
                for (int m = gw; m < CH; m += NGW) { const float* md = MOD + (size_t)(P.seqbase + (m >> P.Sshift)) * 6144;
                    norm_mod_row16(X1b + (size_t)m * D, Hb + (size_t)m * D, args.in[15], md + 4096, md + 3072, lane); }
            } else if (k == 11) {
                for (int it = bx * 512 + tid; it < (CH / 16) * 352; it += G * 512) {
                    const int rb = it / 352, f0 = (it - rb * 352) * 8; const int r0 = rb * 16, pos0 = r0 & (P.S - 1);
                    float w0[8], w1[8], w2[8], cb[8];
                    { const f32x4* wp = (const f32x4*)(args.in[17] + f0); const f32x4 a0 = wp[0], a1 = wp[1], b0 = wp[DFF / 4], b1 = wp[DFF / 4 + 1], c0 = wp[2 * DFF / 4], c1 = wp[2 * DFF / 4 + 1];
                      const f32x4* bp = (const f32x4*)(args.in[18] + f0); const f32x4 d0 = bp[0], d1 = bp[1];
#pragma unroll
                      for (int e = 0; e < 4; ++e) { w0[e] = a0[e]; w0[4 + e] = a1[e]; w1[e] = b0[e]; w1[4 + e] = b1[e]; w2[e] = c0[e]; w2[4 + e] = c1[e]; cb[e] = d0[e]; cb[4 + e] = d1[e]; } }
                    const bf16_t* up = UPb + (size_t)r0 * NUP + f0;
                    u32x4 uu[18], gg[16];
                    uu[0] = (u32x4){0u, 0u, 0u, 0u}; if (pos0 > 0) uu[0] = *(const u32x4*)(up - NUP);
#pragma unroll
                    for (int i = 0; i < 16; ++i) { uu[i + 1] = *(const u32x4*)(up + (size_t)i * NUP); gg[i] = *(const u32x4*)(up + (size_t)i * NUP + DFF); }
                    uu[17] = (u32x4){0u, 0u, 0u, 0u}; if (pos0 + 16 < P.S) uu[17] = *(const u32x4*)(up + (size_t)16 * NUP);
#pragma unroll
                    for (int i = 0; i < 16; ++i) {
                        float r[8];
#pragma unroll
                        for (int q = 0; q < 4; ++q) {
                            const float pl = bflo(uu[i][q]), ph_ = bfhi(uu[i][q]), cl = bflo(uu[i + 1][q]), chh = bfhi(uu[i + 1][q]), nl = bflo(uu[i + 2][q]), nh = bfhi(uu[i + 2][q]);
                            const float xl = cb[2 * q] + w0[2 * q] * pl + w1[2 * q] * cl + w2[2 * q] * nl, xh = cb[2 * q + 1] + w0[2 * q + 1] * ph_ + w1[2 * q + 1] * chh + w2[2 * q + 1] * nh;
                            const float yl = 0.7978845608028654f * (xl + 0.044715f * xl * xl * xl), yh = 0.7978845608028654f * (xh + 0.044715f * xh * xh * xh);
                            r[2 * q] = xl * sigmoidf_(2.0f * yl) * bflo(gg[i][q]); r[2 * q + 1] = xh * sigmoidf_(2.0f * yh) * bfhi(gg[i][q]);
                        }
                        u32x4 o; o.x = cvt_pk_bf16(r[0], r[1]); o.y = cvt_pk_bf16(r[2], r[3]); o.z = cvt_pk_bf16(r[4], r[5]); o.w = cvt_pk_bf16(r[6], r[7]);
                        *(u32x4*)(ACTb + (size_t)(r0 + i) * DFF + f0) = o;
                    }
                }
            }
        }
#if MEGA
        if (sync_after && ph + 1 < args.ph_hi) { if (ph == 0) cg::this_grid().sync(); else xcd_barrier(xbar, wave0 * 64 + (int)__builtin_amdgcn_mbcnt_hi(~0u, __builtin_amdgcn_mbcnt_lo(~0u, 0u))); }
#else
        (void)sync_after;
#endif
    }
}

extern "C" void kernel_launch(void* const* d_in, const int* in_sizes, int n_in, void* d_out, int out_size, void* d_ws, size_t ws_size, hipStream_t stream) {
    static int grid = 0;
    if (grid == 0) {
        if (n_in != 21 || ws_size < WS_END) { fprintf(stderr, "kernel_launch: unexpected n_in %d / ws_size %zu\n", n_in, ws_size); grid = -1; return; }
        int dev = 0, cus = 0, per_cu = 0;
        (void)hipGetDevice(&dev); (void)hipDeviceGetAttribute(&cus, hipDeviceAttributeMultiprocessorCount, dev);
        (void)hipFuncSetAttribute((const void*)fwd_kernel, hipFuncAttributeMaxDynamicSharedMemorySize, LDS_BYTES);
        (void)hipOccupancyMaxActiveBlocksPerMultiprocessor(&per_cu, (const void*)fwd_kernel, 512, LDS_BYTES);
        (void)hipGetLastError();
        if (per_cu < 1) fprintf(stderr, "kernel_launch: occupancy query says %d blocks/CU\n", per_cu);
        grid = cus;
    }
    if (grid < 0) return;
    Args a{};
    for (int i = 0; i < 21; ++i) a.in[i] = (const float*)d_in[i];
    a.out = (float*)d_out; a.ws = (unsigned char*)d_ws;
#if MEGA
    (void)hipMemsetAsync(d_ws, 0, 65536, stream);
    a.ph_lo = 0; a.ph_hi = NSTEP;
    void* kargs[] = {&a};
    hipError_t e = hipLaunchCooperativeKernel((const void*)fwd_kernel, dim3(grid), dim3(512), kargs, LDS_BYTES, stream);
    if (e != hipSuccess) fprintf(stderr, "cooperative launch failed: %s (grid %d)\n", hipGetErrorString(e), grid);
#else
    for (int ph = 0; ph < NSTEP; ++ph) { a.ph_lo = ph; a.ph_hi = ph + 1; hipLaunchKernelGGL(fwd_kernel, dim3(grid), dim3(512), LDS_BYTES, stream, a);
#ifdef PROBE_DUP
        if (ph > 0 && ph < NSTEP - 1 && ((PROBE_DUP >> ((ph - 1) % SPC)) & 1)) hipLaunchKernelGGL(fwd_kernel, dim3(grid), dim3(512), LDS_BYTES, stream, a);
#endif
    }
#endif
}
```

```cpp
#include <hip/hip_runtime.h>
#include <hip/hip_cooperative_groups.h>
#include <cstdio>
#include <cstdint>
namespace cg = cooperative_groups;

#ifndef MEGA
#define MEGA 1
#endif

#define LAS __attribute__((address_space(3)))
typedef unsigned short bf16_t;
typedef short bf16x8 __attribute__((ext_vector_type(8)));
typedef short s16x4 __attribute__((ext_vector_type(4)));
typedef float f32x2 __attribute__((ext_vector_type(2)));
typedef float f32x4 __attribute__((ext_vector_type(4)));
typedef float f32x16 __attribute__((ext_vector_type(16)));
typedef unsigned u32x2 __attribute__((ext_vector_type(2)));
typedef unsigned u32x4 __attribute__((ext_vector_type(4)));

constexpr int D = 1024, CH = 16384, NCHUNK = 3, ZLD = 5120, NUP = 5632, DFF = 2816;

constexpr float EPS = 1e-6f, LOG2E = 1.4426950408889634f, LN2 = 0.6931471805599453f;
constexpr float QSCALE = 0.10206207261596577f * LOG2E;
constexpr float DSCALE = 0.125f * LOG2E;

constexpr size_t MiB = 1u << 20;
constexpr size_t WS_WIN = 2 * MiB, WS_WUQ = 12 * MiB, WS_WUKV = 14 * MiB, WS_PA = 15 * MiB, WS_PB = 17 * MiB, WS_WOUT = 18 * MiB,
                 WS_WUP = 20 * MiB, WS_WDOWN = 31 * MiB;
constexpr size_t WS_MOD = 37 * MiB, WS_ROPE = 38 * MiB  , WS_RSTD = 39 * MiB + 512 * 1024;
constexpr size_t WS_H = 40 * MiB, WS_Z = 72 * MiB, WS_Q = 232 * MiB, WS_KF = 280 * MiB, WS_V = 328 * MiB, WS_OA = 360 * MiB, WS_OB = 392 * MiB,
                 WS_OG = 400 * MiB, WS_LSE = 448 * MiB, WS_T = 232 * MiB, WS_MERGED = 296 * MiB, WS_UP = 72 * MiB, WS_ACT = 248 * MiB, WS_END = 449 * MiB;

constexpr int LDS_BYTES = 147456;

__device__ __forceinline__ unsigned cvt_pk_bf16(float lo, float hi) { unsigned r; asm volatile("v_cvt_pk_bf16_f32 %0, %1, %2" : "=v"(r) : "v"(lo), "v"(hi)); return r; }
__device__ __forceinline__ float bf2f(unsigned short b) { return __uint_as_float((unsigned)b << 16); }
__device__ __forceinline__ float bflo(unsigned w) { return __uint_as_float(w << 16); }
__device__ __forceinline__ float bfhi(unsigned w) { return __uint_as_float(w & 0xffff0000u); }
__device__ __forceinline__ float wave_sum(float v) {
#pragma unroll
    for (int o = 1; o < 64; o <<= 1) v += __shfl_xor(v, o);
    return v;
}
__device__ __forceinline__ float swap_max(float m) { auto rr = __builtin_amdgcn_permlane32_swap(__float_as_uint(m), __float_as_uint(m), false, false); return fmaxf(__uint_as_float(rr[0]), __uint_as_float(rr[1])); }
__device__ __forceinline__ float swap_add(float m) { auto rr = __builtin_amdgcn_permlane32_swap(__float_as_uint(m), __float_as_uint(m), false, false); return __uint_as_float(rr[0]) + __uint_as_float(rr[1]); }
__device__ __forceinline__ s16x4 vtr(LAS const unsigned char* p) { return __builtin_bit_cast(s16x4, __builtin_amdgcn_ds_read_tr16_b64_v4i16((LAS s16x4*)p)); }
__device__ __forceinline__ float sigmoidf_(float x) { return __builtin_amdgcn_rcpf(1.0f + __builtin_amdgcn_exp2f(-x * LOG2E)); }

struct ChunkP { const float* x; float* out; int S, Sshift, nseq, seqbase; };

namespace pg8 {
constexpr int BM = 256, BK = 64, HALF = 128, HTB = HALF * BK * 2, STAGE_BYTES = 8 * HTB, NXCD = 8, WGM = 8;
__host__ __device__ __forceinline__ int lds_byte(int r, int c) { const int st = (r >> 4) * 2 + (c >> 5), rr = r & 15, cc = c & 31, ob = rr * 64 + cc * 2; return st * 1024 + (ob ^ (((ob >> 9) & 1) << 5)); }
__host__ __device__ __forceinline__ void stage_rc(int b, int& R, int& C) { const int st = b / 1024, sb = b % 1024, swz = sb ^ (((sb >> 9) & 1) << 5); R = (st >> 1) * 16 + swz / 64; C = (st & 1) * 32 + (swz % 64) / 2; }
__host__ __device__ __forceinline__ int perm32(int rho) { const int n = rho >> 4, i = rho & 15; return 8 * (i >> 2) + 4 * n + (i & 3); }
struct Unit { int pm, pn; };
struct Gemm { const bf16_t* A; const bf16_t* Bt; int M, N, K, lda; };
struct StaticOrder {
    int nM, nN, nwg, G, c;
    __device__ void init(int M, int N, int G_, int c_) { nM = M / BM; nN = N / BM; nwg = nM * nN; G = G_; c = c_; }
    __device__ bool next(int i, Unit& u) const {
        const long L = (long)i * G + c; if (L >= nwg) return false;
        int wgid = (int)L; { const int q = nwg / NXCD, r = nwg % NXCD, xcd = wgid % NXCD, off = wgid / NXCD; wgid = (xcd < r ? xcd * (q + 1) : r * (q + 1) + (xcd - r) * q) + off; }
        const int nig = WGM * nN, gid = wgid / nig, fm = gid * WGM, gsz = (nM - fm) < WGM ? (nM - fm) : WGM;
        u.pm = fm + ((wgid % nig) % gsz); u.pn = (wgid % nig) / gsz; return true;
    }
};

template <class Epi, class Sched>
__device__ __forceinline__ void gemm_phase(LAS unsigned char* lds, const Gemm g, const Sched& S, const Epi& E, int tid_in) {
    int tid_ = tid_in; asm volatile("" : "+v"(tid_));
    const int tid = tid_, wid = __builtin_amdgcn_readfirstlane(tid >> 6), lane = tid & 63, wr = wid >> 2, wc = wid & 3, fr = lane & 15, fq = lane >> 4;
    const int K = g.K, nt = K / BK, lda = g.lda;
    unsigned voffA[2], voffB[2];
#pragma unroll
    for (int i = 0; i < 2; ++i) { int R, C; stage_rc(tid * 16 + i * 8192, R, C); const int Rb = (R & ~31) + perm32(R & 31);
        voffA[i] = (unsigned)(R * lda + C) * 2u; voffB[i] = (unsigned)(Rb * K + C) * 2u; }
    const size_t kstep = (size_t)(BK * 2);
    const size_t hstepA = (size_t)HALF * lda * 2, hstepB = (size_t)HALF * K * 2;
    const size_t tstepA = 2 * hstepA, tstepB = 2 * hstepB;
    const unsigned ldsw = (unsigned)wid * 1024u;
    const int aoff = lds_byte(wr * 64 + fr, fq * 8), boff = lds_byte(wc * 32 + fr, fq * 8);
#define PG8_SA(b, h) (((b) * 2 + (h)) * HTB)
#define PG8_SB(b, h) ((4 + (b) * 2 + (h)) * HTB)
#define PG8_STAGE(bufoff, gbase, voff) do { _Pragma("unroll") for (int _i = 0; _i < 2; ++_i) \
        __builtin_amdgcn_global_load_lds((const unsigned*)((const char*)(gbase) + (voff)[_i]), (LAS unsigned*)(lds + (bufoff) + ldsw + _i * 8192), 16, 0, 0); } while (0)
#define PG8_LDA(dst, b, h) do { _Pragma("unroll") for (int m = 0; m < 4; ++m) _Pragma("unroll") for (int k = 0; k < 2; ++k) dst[m][k] = *(const LAS bf16x8*)(lds + PG8_SA(b, h) + aoff + m * 2048 + k * 1024); } while (0)
#define PG8_LDB(dst, b, h) do { _Pragma("unroll") for (int n = 0; n < 2; ++n) _Pragma("unroll") for (int k = 0; k < 2; ++k) dst[n][k] = *(const LAS bf16x8*)(lds + PG8_SB(b, h) + boff + n * 2048 + k * 1024); } while (0)
#define PG8_MMA(ai, bj, At, Bt) do { __builtin_amdgcn_s_setprio(1); _Pragma("unroll") for (int m = 0; m < 4; ++m) _Pragma("unroll") for (int n = 0; n < 2; ++n) _Pragma("unroll") for (int k = 0; k < 2; ++k) \
        acc[ai][bj][m][n] = __builtin_amdgcn_mfma_f32_16x16x32_bf16(Bt[n][k], At[m][k], acc[ai][bj][m][n], 0, 0, 0); __builtin_amdgcn_s_setprio(0); } while (0)
#define PG8_WAIT_V(n) asm volatile("s_waitcnt vmcnt(" #n ")" ::: "memory")
#define PG8_WAIT_L(n) asm volatile("s_waitcnt lgkmcnt(" #n ")" ::: "memory")
#define PG8_BAR __builtin_amdgcn_s_barrier()
#define PG8_SCHED __builtin_amdgcn_sched_barrier(0)
    Unit cur, nxt; int ui = 0;
    if (!S.next(0, cur)) return;
    f32x4 acc[2][2][4][2];
#pragma unroll
    for (int a = 0; a < 2; ++a)
#pragma unroll
        for (int b = 0; b < 2; ++b)
#pragma unroll
            for (int m = 0; m < 4; ++m)
#pragma unroll
                for (int n = 0; n < 2; ++n) acc[a][b][m][n] = (f32x4){0.f, 0.f, 0.f, 0.f};
    bf16x8 At[4][2], B0[2][2], B1[2][2];
    const char* cA = (const char*)g.A + (size_t)cur.pm * tstepA; const char* cB = (const char*)g.Bt + (size_t)cur.pn * tstepB;
    PG8_STAGE(PG8_SB(0, 0), cB, voffB); PG8_STAGE(PG8_SB(0, 1), cB + hstepB, voffB); PG8_STAGE(PG8_SA(0, 0), cA, voffA); PG8_STAGE(PG8_SA(0, 1), cA + hstepA, voffA);
    if (wr == 1) PG8_BAR;
    PG8_WAIT_V(2); PG8_BAR;
    PG8_STAGE(PG8_SB(1, 0), cB + kstep, voffB); PG8_STAGE(PG8_SA(1, 0), cA + kstep, voffA); PG8_STAGE(PG8_SB(1, 1), cB + hstepB + kstep, voffB);
    PG8_WAIT_V(6); PG8_BAR;
    for (;;) {
        const bool has_next = S.next(ui + 1, nxt);
        const char* nA = has_next ? (const char*)g.A + (size_t)nxt.pm * tstepA : cA; const char* nB = has_next ? (const char*)g.Bt + (size_t)nxt.pn * tstepB : cB;
        for (int t = 0; t < nt; t += 2) {
            const bool last = (t == nt - 2);
            const char* a1 = cA + (size_t)(t + 1) * kstep;
            const char* a2 = last ? nA : cA + (size_t)(t + 2) * kstep; const char* b2 = last ? nB : cB + (size_t)(t + 2) * kstep;
            const char* a3 = a2 + kstep; const char* b3 = b2 + kstep;
            PG8_LDB(B0, 0, 0); PG8_LDB(B1, 0, 1); PG8_SCHED; PG8_LDA(At, 0, 0); PG8_STAGE(PG8_SA(1, 1), a1 + hstepA, voffA);
            PG8_WAIT_V(8); PG8_WAIT_L(0); PG8_BAR; PG8_MMA(0, 0, At, B0); PG8_MMA(0, 1, At, B1); PG8_BAR; PG8_SCHED;
            PG8_LDA(At, 0, 1); PG8_STAGE(PG8_SB(0, 0), b2, voffB); PG8_STAGE(PG8_SB(0, 1), b2 + hstepB, voffB); PG8_STAGE(PG8_SA(0, 0), a2, voffA);
            PG8_WAIT_V(8); PG8_WAIT_L(0); PG8_BAR; PG8_MMA(1, 0, At, B0); PG8_MMA(1, 1, At, B1); PG8_BAR; PG8_SCHED;
            PG8_LDB(B0, 1, 0); PG8_LDB(B1, 1, 1); PG8_SCHED; PG8_LDA(At, 1, 0); PG8_STAGE(PG8_SA(0, 1), a2 + hstepA, voffA);
            PG8_WAIT_V(8); PG8_WAIT_L(0); PG8_BAR; PG8_MMA(0, 0, At, B0); PG8_MMA(0, 1, At, B1); PG8_BAR; PG8_SCHED;
            PG8_LDA(At, 1, 1); PG8_STAGE(PG8_SB(1, 0), b3, voffB); PG8_STAGE(PG8_SB(1, 1), b3 + hstepB, voffB); PG8_STAGE(PG8_SA(1, 0), a3, voffA);
            PG8_WAIT_V(8); PG8_WAIT_L(0); PG8_BAR; PG8_MMA(1, 0, At, B0); PG8_MMA(1, 1, At, B1); PG8_BAR; PG8_SCHED;
        }
        if (wr == 0) PG8_BAR;
        E(acc, cur, wr, wc, fr, fq);
        if (!has_next) break;
#pragma unroll
        for (int a = 0; a < 2; ++a)
#pragma unroll
            for (int b = 0; b < 2; ++b)
#pragma unroll
                for (int m = 0; m < 4; ++m)
#pragma unroll
                    for (int n = 0; n < 2; ++n) acc[a][b][m][n] = (f32x4){0.f, 0.f, 0.f, 0.f};
        cur = nxt; cA = nA; cB = nB; ++ui;
        if (wr == 1) PG8_BAR;
    }
    PG8_WAIT_V(0);
    PG8_BAR;
#undef PG8_SA
#undef PG8_SB
#undef PG8_STAGE
#undef PG8_LDA
#undef PG8_LDB
#undef PG8_MMA
#undef PG8_WAIT_V
#undef PG8_WAIT_L
#undef PG8_BAR
#undef PG8_SCHED
}

#define EPI_ARGS const f32x4 (&acc)[2][2][4][2], const Unit& u, int wr, int wc, int fr, int fq
__device__ __forceinline__ u32x4 pack8(f32x4 v0, f32x4 v1) { u32x4 w; w.x = cvt_pk_bf16(v0[0], v0[1]); w.y = cvt_pk_bf16(v0[2], v0[3]); w.z = cvt_pk_bf16(v1[0], v1[1]); w.w = cvt_pk_bf16(v1[2], v1[3]); return w; }

struct EpiStore {
    bf16_t* O; int ldc; int sig_pn;
    __device__ __forceinline__ void operator()(EPI_ARGS) const {
        const int row0 = u.pm * BM + wr * 64 + fr, col0 = u.pn * BM + wc * 32 + 8 * fq; const bool sig = u.pn >= sig_pn;
#pragma unroll
        for (int ai = 0; ai < 2; ++ai)
#pragma unroll
            for (int m = 0; m < 4; ++m) { bf16_t* rowp = O + (size_t)(row0 + ai * HALF + m * 16) * ldc + col0;
#pragma unroll
                for (int bj = 0; bj < 2; ++bj) { f32x4 v0 = acc[ai][bj][m][0], v1 = acc[ai][bj][m][1];
                    if (sig) {
#pragma unroll
                        for (int e = 0; e < 4; ++e) { v0[e] = sigmoidf_(v0[e]); v1[e] = sigmoidf_(v1[e]); } }
                    *(u32x4*)(rowp + bj * HALF) = pack8(v0, v1); } }
    }
};
struct EpiQ {
    bf16_t* Q; const float* rstd; const float* rope; int S, Sshift;
    __device__ __forceinline__ void operator()(EPI_ARGS) const {
        const int row0 = u.pm * BM + wr * 64 + fr;
#pragma unroll
        for (int ai = 0; ai < 2; ++ai)
#pragma unroll
            for (int m = 0; m < 4; ++m) { const int row = row0 + ai * HALF + m * 16; const int seq = row >> Sshift, pos = row & (S - 1);
                const float sc = rstd[2 * row] * QSCALE;
#pragma unroll
                for (int bj = 0; bj < 2; ++bj) { const int g32 = 8 * u.pn + 4 * bj + wc; const int head = g32 / 3, gl = g32 - 3 * head;
                    f32x4 v0 = acc[ai][bj][m][0] * sc, v1 = acc[ai][bj][m][1] * sc;
                    if (gl == 2) { const f32x4 cs = *(const f32x4*)(rope + (size_t)pos * 16 + 4 * fq), sn = *(const f32x4*)(rope + 131072 + (size_t)pos * 16 + 4 * fq);
                        f32x4 w0, w1;
                        w0[0] = v0[0] * cs[0] - v0[1] * sn[0]; w0[1] = v0[0] * sn[0] + v0[1] * cs[0];
                        w0[2] = v0[2] * cs[1] - v0[3] * sn[1]; w0[3] = v0[2] * sn[1] + v0[3] * cs[1];
                        w1[0] = v1[0] * cs[2] - v1[1] * sn[2]; w1[1] = v1[0] * sn[2] + v1[1] * cs[2];
                        w1[2] = v1[2] * cs[3] - v1[3] * sn[3]; w1[3] = v1[2] * sn[3] + v1[3] * cs[3];
                        v0 = w0; v1 = w1; }
                    *(u32x4*)(Q + ((size_t)((seq * 16 + head) << Sshift) + pos) * 96 + gl * 32 + 8 * fq) = pack8(v0, v1); }
                asm volatile("" ::: "memory"); }
    }
};
struct EpiKV {
    bf16_t* KF; bf16_t* V; const float* rstd; int S, Sshift;
    __device__ __forceinline__ void operator()(EPI_ARGS) const {
        const int row0 = u.pm * BM + wr * 64 + fr; const bool isv = u.pn >= 4;
#pragma unroll
        for (int ai = 0; ai < 2; ++ai)
#pragma unroll
            for (int m = 0; m < 4; ++m) { const int row = row0 + ai * HALF + m * 16; const int seq = row >> Sshift, pos = row & (S - 1);
                const float sc = rstd[2 * row + 1];
#pragma unroll
                for (int bj = 0; bj < 2; ++bj) { const int col = (u.pn & 3) * BM + bj * HALF + wc * 32 + 8 * fq; const int head = col >> 6, d = col & 63;
                    const f32x4 v0 = acc[ai][bj][m][0] * sc, v1 = acc[ai][bj][m][1] * sc; const size_t tok = (size_t)((seq * 16 + head) << Sshift) + pos;
                    bf16_t* p = isv ? V + tok * 64 + d : KF + tok * 96 + d;
                    *(u32x4*)p = pack8(v0, v1); }
                asm volatile("" ::: "memory"); }
    }
};
struct EpiGateA {
    bf16_t* T; const bf16_t* Z;
    __device__ __forceinline__ void operator()(EPI_ARGS) const {
        const int row0 = u.pm * BM + wr * 64 + fr, col0 = u.pn * BM + wc * 32 + 8 * fq;
#pragma unroll
        for (int ai = 0; ai < 2; ++ai)
#pragma unroll
            for (int m = 0; m < 4; ++m) { const int row = row0 + ai * HALF + m * 16;
#pragma unroll
                for (int bj = 0; bj < 2; ++bj) { const int col = col0 + bj * HALF; const u32x4 gw = *(const u32x4*)(Z + (size_t)row * ZLD + 3072 + col);
                    f32x4 v0 = acc[ai][bj][m][0], v1 = acc[ai][bj][m][1];
                    v0[0] *= bflo(gw.x); v0[1] *= bfhi(gw.x); v0[2] *= bflo(gw.y); v0[3] *= bfhi(gw.y); v1[0] *= bflo(gw.z); v1[1] *= bfhi(gw.z); v1[2] *= bflo(gw.w); v1[3] *= bfhi(gw.w);
                    *(u32x4*)(T + (size_t)row * D + col) = pack8(v0, v1); }
                asm volatile("" ::: "memory"); }
    }
};
struct EpiGateB {
    const bf16_t* T; const bf16_t* Z; bf16_t* O;
    __device__ __forceinline__ void operator()(EPI_ARGS) const {
        const int row0 = u.pm * BM + wr * 64 + fr, col0 = u.pn * BM + wc * 32 + 8 * fq;
#pragma unroll
        for (int ai = 0; ai < 2; ++ai)
#pragma unroll
            for (int m = 0; m < 4; ++m) { const int row = row0 + ai * HALF + m * 16;
#pragma unroll
                for (int bj = 0; bj < 2; ++bj) { const int col = col0 + bj * HALF; const u32x4 gw = *(const u32x4*)(Z + (size_t)row * ZLD + 4096 + col);
                    const u32x4 tw = *(const u32x4*)(T + (size_t)row * D + col); f32x4 v0 = {bflo(tw.x), bfhi(tw.x), bflo(tw.y), bfhi(tw.y)}, v1 = {bflo(tw.z), bfhi(tw.z), bflo(tw.w), bfhi(tw.w)};
                    const f32x4 a0 = acc[ai][bj][m][0], a1 = acc[ai][bj][m][1];
                    v0[0] += a0[0] * bflo(gw.x); v0[1] += a0[1] * bfhi(gw.x); v0[2] += a0[2] * bflo(gw.y); v0[3] += a0[3] * bfhi(gw.y);
                    v1[0] += a1[0] * bflo(gw.z); v1[1] += a1[1] * bfhi(gw.z); v1[2] += a1[2] * bflo(gw.w); v1[3] += a1[3] * bfhi(gw.w);
                    *(u32x4*)(O + (size_t)row * D + col) = pack8(v0, v1); }
                asm volatile("" ::: "memory"); }
    }
};
struct EpiResid {
    const float* base; float* out; const float* mod; int goff, Sshift, seqbase; int mode; bf16_t* x1;
    __device__ __forceinline__ void operator()(EPI_ARGS) const {
        const int row0 = u.pm * BM + wr * 64 + fr, col0 = u.pn * BM + wc * 32 + 8 * fq;
        const float* gt = mod + (size_t)(seqbase + ((u.pm * BM) >> Sshift)) * 6144 + goff + col0;
        f32x4 g[2][2];
#pragma unroll
        for (int bj = 0; bj < 2; ++bj) { g[bj][0] = *(const f32x4*)(gt + bj * HALF); g[bj][1] = *(const f32x4*)(gt + bj * HALF + 4); }
#pragma unroll
        for (int ai = 0; ai < 2; ++ai)
#pragma unroll
            for (int m = 0; m < 4; ++m) { const size_t off = (size_t)(row0 + ai * HALF + m * 16) * D + col0;
#pragma unroll
                for (int bj = 0; bj < 2; ++bj) {
                    if (mode == 0) { const f32x4 b0 = *(const f32x4*)(base + off + bj * HALF), b1 = *(const f32x4*)(base + off + bj * HALF + 4);
                        *(u32x4*)(x1 + off + bj * HALF) = pack8(b0 + g[bj][0] * acc[ai][bj][m][0], b1 + g[bj][1] * acc[ai][bj][m][1]); }
                    else { const u32x4 w = *(const u32x4*)(x1 + off + bj * HALF); const f32x4 b0 = {bflo(w.x), bfhi(w.x), bflo(w.y), bfhi(w.y)}, b1 = {bflo(w.z), bfhi(w.z), bflo(w.w), bfhi(w.w)};
                        *(u32x4*)(x1 + off + bj * HALF) = pack8(b0 + g[bj][0] * acc[ai][bj][m][0], b1 + g[bj][1] * acc[ai][bj][m][1]); } }
                if (m & 1) asm volatile("" ::: "memory"); }
    }
};

struct EpiAny {
    int kind;
    bf16_t* O; int ldc; int sig_pn;
    bf16_t* Q; bf16_t* KF; bf16_t* V; const float* rstd; const float* rope; int S, Sshift;
    bf16_t* T; const bf16_t* Z;
    const float* base; float* out; const float* mod; int goff, seqbase; int rmode; bf16_t* x1;
    __device__ __forceinline__ void operator()(EPI_ARGS) const {
        if (kind == 0) { EpiStore e{O, ldc, sig_pn}; e(acc, u, wr, wc, fr, fq); }
        else if (kind == 1) { EpiQ e{Q, rstd, rope, S, Sshift}; e(acc, u, wr, wc, fr, fq); }
        else if (kind == 2) { EpiKV e{KF, V, rstd, S, Sshift}; e(acc, u, wr, wc, fr, fq); }
        else if (kind == 3) { EpiGateA e{T, Z}; e(acc, u, wr, wc, fr, fq); }
        else if (kind == 4) { EpiGateB e{T, Z, O}; e(acc, u, wr, wc, fr, fq); }
        else { EpiResid e{base, out, mod, goff, Sshift, seqbase, rmode, x1}; e(acc, u, wr, wc, fr, fq); }
    }
};
}

__device__ const float ROPE_INV[16] = {1.000000000e+00f, 5.623413324e-01f, 3.162277639e-01f, 1.778279394e-01f, 1.000000015e-01f, 5.623413250e-02f, 3.162277490e-02f, 1.778279431e-02f,
                                       9.999999776e-03f, 5.623413250e-03f, 3.162277630e-03f, 1.778279431e-03f, 1.000000047e-03f, 5.623413017e-04f, 3.162277571e-04f, 1.778279402e-04f};
__device__ __forceinline__ int perm_rope(int i) { return i < 16 ? 2 * i : 2 * (i - 16) + 1; }
__device__ __forceinline__ int rowmap(int kind, int n) {
    if (kind == 1) return n < 640 ? n : (n < 672 ? 640 + perm_rope(n - 640) : n + 96);
    if (kind == 2) { const int h = n / 96, c = n - h * 96; return c < 64 ? n : h * 96 + 64 + perm_rope(c - 64); }
    if (kind == 3) { const int h = n >> 7, c = n & 127; return c < 64 ? h * 64 + c : 1024 + h * 64 + (c - 64); }
    return n;
}
__device__ __forceinline__ void transpose_item(const float* W, int K, int N, bf16_t* WT, int kind, const float* ks, LAS float* scr, int item, int lane) {
    const int nblk = N / 32, kb = item / nblk, nb = item - kb * nblk, k0 = 64 * kb, n0 = 32 * nb;
#pragma unroll 8
    for (int i = 0; i < 32; ++i) { const int kk = 2 * i + (lane >> 5); float w = W[(size_t)(k0 + kk) * N + n0 + (lane & 31)]; if (ks) w *= ks[k0 + kk]; scr[kk * 33 + (lane & 31)] = w; }
    asm volatile("s_waitcnt lgkmcnt(0)" ::: "memory");
    const int c = lane & 7;
#pragma unroll
    for (int j = 0; j < 4; ++j) { const int n = (lane >> 3) + 8 * j; const LAS float* s = scr + (8 * c) * 33 + n;
        u32x4 o; o.x = cvt_pk_bf16(s[0 * 33], s[1 * 33]); o.y = cvt_pk_bf16(s[2 * 33], s[3 * 33]); o.z = cvt_pk_bf16(s[4 * 33], s[5 * 33]); o.w = cvt_pk_bf16(s[6 * 33], s[7 * 33]);
        *(u32x4*)(WT + (size_t)rowmap(kind, n0 + n) * K + k0 + 8 * c) = o; }
    asm volatile("s_waitcnt lgkmcnt(0)" ::: "memory");
}

__device__ __forceinline__ void norm_mod_row(const float* xrow, bf16_t* orow, const float* g, const float* sc, const float* sh, int lane) {
    const f32x4* xr = (const f32x4*)xrow + lane; f32x4 v[4]; float s = 0.f;
#pragma unroll
    for (int j = 0; j < 4; ++j) { v[j] = xr[64 * j]; s += (v[j].x * v[j].x + v[j].y * v[j].y) + (v[j].z * v[j].z + v[j].w * v[j].w); }
    const float rstd = 1.0f / sqrtf(wave_sum(s) * (1.f / D) + EPS);
    u32x2* o8 = (u32x2*)orow + lane;
#pragma unroll
    for (int j = 0; j < 4; ++j) { const f32x4 gg = ((const f32x4*)g)[lane + 64 * j], ss = ((const f32x4*)sc)[lane + 64 * j], hh = ((const f32x4*)sh)[lane + 64 * j];
        const f32x4 o = v[j] * rstd * gg * (ss + 1.0f) + hh; u32x2 w; w.x = cvt_pk_bf16(o.x, o.y); w.y = cvt_pk_bf16(o.z, o.w); o8[64 * j] = w; }
}
__device__ __forceinline__ void norm_mod_row16(const bf16_t* xrow, bf16_t* orow, const float* g, const float* sc, const float* sh, int lane) {
    const u32x2* xr = (const u32x2*)xrow + lane; f32x4 v[4]; float s = 0.f;
#pragma unroll
    for (int j = 0; j < 4; ++j) { const u32x2 w = xr[64 * j]; v[j] = (f32x4){bflo(w.x), bfhi(w.x), bflo(w.y), bfhi(w.y)}; s += (v[j].x * v[j].x + v[j].y * v[j].y) + (v[j].z * v[j].z + v[j].w * v[j].w); }
    const float rstd = 1.0f / sqrtf(wave_sum(s) * (1.f / D) + EPS);
    u32x2* o8 = (u32x2*)orow + lane;
#pragma unroll
    for (int j = 0; j < 4; ++j) { const f32x4 gg = ((const f32x4*)g)[lane + 64 * j], ss = ((const f32x4*)sc)[lane + 64 * j], hh = ((const f32x4*)sh)[lane + 64 * j];
        const f32x4 o = v[j] * rstd * gg * (ss + 1.0f) + hh; u32x2 w; w.x = cvt_pk_bf16(o.x, o.y); w.y = cvt_pk_bf16(o.z, o.w); o8[64 * j] = w; }
}
__device__ __forceinline__ void final_norm_row(const bf16_t* xin, float* xrow, const float* g, int lane) {
    f32x4* xr = (f32x4*)xrow + lane; const u32x2* xi = (const u32x2*)xin + lane; f32x4 v[4]; float s = 0.f;
#pragma unroll
    for (int j = 0; j < 4; ++j) { const u32x2 w = xi[64 * j]; v[j] = (f32x4){bflo(w.x), bfhi(w.x), bflo(w.y), bfhi(w.y)}; s += (v[j].x * v[j].x + v[j].y * v[j].y) + (v[j].z * v[j].z + v[j].w * v[j].w); }
    const float rstd = 1.0f / sqrtf(wave_sum(s) * (1.f / D) + EPS);
#pragma unroll
    for (int j = 0; j < 4; ++j) xr[64 * j] = v[j] * rstd * ((const f32x4*)g)[lane + 64 * j];
}

__device__ __forceinline__ void dil_task(const bf16_t* Z, float* OG, float* LSE, int S, int task, LAS unsigned char* wl, int lane_in) {
    int lane = lane_in; asm volatile("" : "+v"(lane));
    const int r32 = lane & 31, hi = lane >> 5;
    const int bps = S >> 5, tps = 12 * bps;
    const int seq = task / tps; const int rem = task - seq * tps; const int hd = rem / bps; const int blk = rem - hd * bps;
    const int g = hd >> 2, sh = 2 * g, dl = 1 << sh; const int r = blk & (dl - 1), bi = blk >> sh;
    const int i0 = bi * 32, nsub = S >> sh;
    const size_t rowbase = (size_t)seq * S;
    const int tq = r + ((i0 + r32) << sh);
    const bf16_t* qp = Z + (rowbase + tq) * ZLD + 768 + hd * 64 + 8 * hi;
    bf16x8 qf[4];
#pragma unroll
    for (int s = 0; s < 4; ++s) qf[s] = *(const bf16x8*)(qp + 16 * s);
    f32x16 sc[5];
#pragma unroll
    for (int c = 0; c < 5; ++c) {
        int ik = i0 - 64 + 32 * c + r32; ik = ik < 0 ? 0 : (ik > nsub - 1 ? nsub - 1 : ik);
        const bf16_t* kp = Z + (rowbase + r + ((size_t)ik << sh)) * ZLD + 1536 + hd * 64 + 8 * hi;
        bf16x8 kf[4];
#pragma unroll
        for (int s = 0; s < 4; ++s) kf[s] = *(const bf16x8*)(kp + 16 * s);
        f32x16 a = {};
#pragma unroll
        for (int s = 0; s < 4; ++s) a = __builtin_amdgcn_mfma_f32_32x32x16_bf16(kf[s], qf[s], a, 0, 0, 0);
        sc[c] = a;
        asm volatile("" ::: "memory");
    }
    const float cb = __builtin_amdgcn_exp2f(-0.6666666667f * (float)(hd + 1)) * LOG2E * (float)dl;
    float mx = -INFINITY;
#pragma unroll
    for (int c = 0; c < 5; ++c)
#pragma unroll
        for (int e = 0; e < 16; ++e) {
            const int kvl = 32 * c + (e & 3) + 8 * (e >> 2) + 4 * hi; const int delta = kvl - 64 - r32; const int ik = i0 + r32 + delta;
            const int ad = delta < 0 ? -delta : delta; const bool valid = (ad <= 64) && (ik >= 0) && (ik < nsub);
            float v = sc[c][e] * DSCALE - cb * (float)ad; v = valid ? v : -INFINITY; sc[c][e] = v; mx = fmaxf(mx, v);
        }
    mx = swap_max(mx);
    float ls = 0.f;
#pragma unroll
    for (int c = 0; c < 5; ++c)
#pragma unroll
        for (int e = 0; e < 16; ++e) { const float p = __builtin_amdgcn_exp2f(sc[c][e] - mx); sc[c][e] = p; ls += p; }
    ls = swap_add(ls);
    f32x16 o0 = {}, o1 = {};
    const int vb = ((lane >> 4) & 1) * 32 + (lane & 3) * 8 + (4 * hi + ((lane & 15) >> 2)) * 64;
#pragma unroll
    for (int c = 0; c < 5; ++c) {
        u32x4 vv[4];
#pragma unroll
        for (int i = 0; i < 4; ++i) { const int row = (lane >> 3) + 8 * i; int ik = i0 - 64 + 32 * c + row; ik = ik < 0 ? 0 : (ik > nsub - 1 ? nsub - 1 : ik);
            vv[i] = *(const u32x4*)(Z + (rowbase + r + ((size_t)ik << sh)) * ZLD + 2304 + hd * 64 + (lane & 7) * 8); }
        asm volatile("s_waitcnt lgkmcnt(0)" ::: "memory");
#pragma unroll
        for (int i = 0; i < 4; ++i) { const int row = (lane >> 3) + 8 * i; *(LAS u32x4*)(wl + ((lane & 7) >> 2) * 2048 + row * 64 + (lane & 3) * 16) = vv[i]; }
        asm volatile("s_waitcnt lgkmcnt(0)" ::: "memory");
#pragma unroll
        for (int s = 0; s < 2; ++s) {
            u32x4 pw; pw.x = cvt_pk_bf16(sc[c][8 * s + 0], sc[c][8 * s + 1]); pw.y = cvt_pk_bf16(sc[c][8 * s + 2], sc[c][8 * s + 3]); pw.z = cvt_pk_bf16(sc[c][8 * s + 4], sc[c][8 * s + 5]); pw.w = cvt_pk_bf16(sc[c][8 * s + 6], sc[c][8 * s + 7]);
            const bf16x8 pf = __builtin_bit_cast(bf16x8, pw);
            { const s16x4 lo = vtr(wl + vb + s * 1024), hh = vtr(wl + vb + s * 1024 + 512); const bf16x8 vf = {lo[0], lo[1], lo[2], lo[3], hh[0], hh[1], hh[2], hh[3]};
              o0 = __builtin_amdgcn_mfma_f32_32x32x16_bf16(vf, pf, o0, 0, 0, 0); }
            { const s16x4 lo = vtr(wl + vb + 2048 + s * 1024), hh = vtr(wl + vb + 2048 + s * 1024 + 512); const bf16x8 vf = {lo[0], lo[1], lo[2], lo[3], hh[0], hh[1], hh[2], hh[3]};
              o1 = __builtin_amdgcn_mfma_f32_32x32x16_bf16(vf, pf, o1, 0, 0, 0); }
        }
    }
    const float inv = 1.0f / ls; const size_t rq = rowbase + tq;
    float* op = OG + (rq * 12 + hd) * 64 + 4 * hi;
#pragma unroll
    for (int i = 0; i < 4; ++i) {
        *(f32x4*)(op + 8 * i) = (f32x4){o0[4 * i] * inv, o0[4 * i + 1] * inv, o0[4 * i + 2] * inv, o0[4 * i + 3] * inv};
        *(f32x4*)(op + 32 + 8 * i) = (f32x4){o1[4 * i] * inv, o1[4 * i + 1] * inv, o1[4 * i + 2] * inv, o1[4 * i + 3] * inv};
    }
    if (hi == 0) LSE[rq * 12 + hd] = (mx + __builtin_amdgcn_logf(ls)) * LN2;
}

namespace mla {
constexpr int KPITCH = 208, KBYTES = 64 * KPITCH, VBYTES = 8192, BUF = KBYTES + VBYTES, QOFF = 2 * BUF, DUMMY = QOFF + 8 * 12288;
#define MLA_PACK(P, b) (u32x4){cvt_pk_bf16(P[b], P[b + 1]), cvt_pk_bf16(P[b + 2], P[b + 3]), cvt_pk_bf16(P[b + 4], P[b + 5]), cvt_pk_bf16(P[b + 6], P[b + 7])}
#define SGB(mask, n) __builtin_amdgcn_sched_group_barrier(mask, n, 0)
__device__ __forceinline__ float max2_(float a, float b) { return __builtin_amdgcn_fmed3f(a, b, INFINITY); }
constexpr float THR = 8.0f;
__device__ __forceinline__ void softmax_blk(f32x16& p0, f32x16& p1, f32x16& o0, f32x16& o1, float& mhat, float& lrun, u32x4 (&pf)[4], bool first) {
    float r0 = max2_(p0[0], p0[1]), r1 = max2_(p1[0], p1[1]);
#pragma unroll
    for (int e = 2; e < 16; ++e) { r0 = max2_(r0, p0[e]); r1 = max2_(r1, p1[e]); }
    const float rm = swap_max(max2_(r0, r1));
    if (first || __any(rm - mhat > THR)) {
        const float mn = first ? rm : fmaxf(rm, mhat); const float f = first ? 0.f : __builtin_amdgcn_exp2f(mhat - mn); mhat = mn; lrun *= f;
#pragma unroll
        for (int e = 0; e < 16; ++e) { o0[e] *= f; o1[e] *= f; }
    }
    float s0 = 0.f, s1 = 0.f;
#pragma unroll
    for (int e = 0; e < 16; ++e) { p0[e] = __builtin_amdgcn_exp2f(p0[e] - mhat); p1[e] = __builtin_amdgcn_exp2f(p1[e] - mhat); s0 += p0[e]; s1 += p1[e]; }
    lrun += s0 + s1;
    pf[0] = MLA_PACK(p0, 0); pf[1] = MLA_PACK(p0, 8); pf[2] = MLA_PACK(p1, 0); pf[3] = MLA_PACK(p1, 8);
}
__device__ __forceinline__ void pv_blk(const u32x4 (&pf)[4], f32x16& o0, f32x16& o1, LAS const unsigned char* vbase) {
#pragma unroll
    for (int ks = 0; ks < 4; ++ks) {
        const bf16x8 p = __builtin_bit_cast(bf16x8, pf[ks]);
        { const s16x4 lo = vtr(vbase + ks * 1024), hh = vtr(vbase + ks * 1024 + 512); const bf16x8 vf = {lo[0], lo[1], lo[2], lo[3], hh[0], hh[1], hh[2], hh[3]};
          o0 = __builtin_amdgcn_mfma_f32_32x32x16_bf16(vf, p, o0, 0, 0, 0); }
        { const s16x4 lo = vtr(vbase + 4096 + ks * 1024), hh = vtr(vbase + 4096 + ks * 1024 + 512); const bf16x8 vf = {lo[0], lo[1], lo[2], lo[3], hh[0], hh[1], hh[2], hh[3]};
          o1 = __builtin_amdgcn_mfma_f32_32x32x16_bf16(vf, p, o1, 0, 0, 0); }
    }
}
__device__ __forceinline__ void store_o(bf16_t* op, const f32x16& o0, const f32x16& o1, float inv) {
#pragma unroll
    for (int i = 0; i < 4; ++i) {
        u32x2 w0; w0.x = cvt_pk_bf16(o0[4 * i] * inv, o0[4 * i + 1] * inv); w0.y = cvt_pk_bf16(o0[4 * i + 2] * inv, o0[4 * i + 3] * inv); *(u32x2*)(op + 8 * i) = w0;
        u32x2 w1; w1.x = cvt_pk_bf16(o1[4 * i] * inv, o1[4 * i + 1] * inv); w1.y = cvt_pk_bf16(o1[4 * i + 2] * inv, o1[4 * i + 3] * inv); *(u32x2*)(op + 32 + 8 * i) = w1;
    }
}
__device__ __forceinline__ void attn_unit(const bf16_t* Qh, const bf16_t* Kh, const bf16_t* Vh, bf16_t* Oh  , int S, int qb, LAS unsigned char* lds, int tid) {
    const int lane = tid & 63, r32 = lane & 31, hi = lane >> 5; const int wid = __builtin_amdgcn_readfirstlane(tid >> 6);
    const int qrow = qb * 512 + wid * 64 + r32;
    const bf16_t* Qw = Qh + (size_t)qrow * 96 + 8 * hi;
    LAS unsigned char* ql = lds + QOFF + wid * 12288 + lane * 16;
#pragma unroll
    for (int s = 0; s < 6; ++s) { *(LAS bf16x8*)(ql + s * 1024) = *(const bf16x8*)(Qw + 16 * s); *(LAS bf16x8*)(ql + (6 + s) * 1024) = *(const bf16x8*)(Qw + 32 * 96 + 16 * s); }
    const bool has1 = tid < 256; const int kc0 = tid, kc1 = has1 ? tid + 512 : tid;
    const unsigned kd0 = (unsigned)((kc0 / 12) * KPITCH + (kc0 % 12) * 16);
    const unsigned kd1 = has1 ? (unsigned)((kc1 / 12) * KPITCH + (kc1 % 12) * 16) : (unsigned)(DUMMY + (tid - 256) * 16);
    const unsigned kd1n = has1 ? BUF : 0u;
    const unsigned vd = (unsigned)(KBYTES + ((tid & 7) >> 2) * 4096 + (tid >> 3) * 64 + (tid & 3) * 16);
    const u32x4* Kg = (const u32x4*)Kh; const u32x4* Vg = (const u32x4*)Vh;
    const int NT = S >> 6;
    u32x4 ka = Kg[kc0], kb = Kg[kc1], va = Vg[tid];
    *(LAS u32x4*)(lds + kd0) = ka; *(LAS u32x4*)(lds + kd1) = kb; *(LAS u32x4*)(lds + vd) = va;
    __syncthreads();
    f32x16 oa0 = {}, oa1 = {}, ob0 = {}, ob1 = {}; float ma = 0.f, la = 0.f, mb = 0.f, lb = 0.f;
    const unsigned kfo = (unsigned)(r32 * KPITCH + hi * 16);
    const unsigned vb = (unsigned)(KBYTES + ((lane >> 4) & 1) * 32 + (lane & 3) * 8 + (4 * hi + ((lane & 15) >> 2)) * 64);
    for (int t = 0; t < NT; ++t) {
        const unsigned cur = (unsigned)(t & 1) * BUF, nxt = BUF - cur;
        const int tn = t + 1 < NT ? t + 1 : t;
        ka = Kg[(size_t)tn * 768 + kc0]; kb = Kg[(size_t)tn * 768 + kc1]; va = Vg[(size_t)tn * 512 + tid];
        u32x4 pf[4];
        {
            f32x16 p0 = {}, p1 = {};
#pragma unroll
            for (int s = 0; s < 6; ++s) {
                const bf16x8 a0 = *(const LAS bf16x8*)(lds + cur + kfo + s * 32), a1 = *(const LAS bf16x8*)(lds + cur + kfo + 32 * KPITCH + s * 32);
                const bf16x8 q = *(const LAS bf16x8*)(ql + s * 1024);
                p0 = __builtin_amdgcn_mfma_f32_32x32x16_bf16(a0, q, p0, 0, 0, 0); p1 = __builtin_amdgcn_mfma_f32_32x32x16_bf16(a1, q, p1, 0, 0, 0);
            }
            softmax_blk(p0, p1, oa0, oa1, ma, la, pf, t == 0);
            pv_blk(pf, oa0, oa1, lds + cur + vb);
        }
        __builtin_amdgcn_sched_barrier(0);
        {
            f32x16 p0 = {}, p1 = {};
#pragma unroll
            for (int s = 0; s < 6; ++s) {
                const bf16x8 a0 = *(const LAS bf16x8*)(lds + cur + kfo + s * 32), a1 = *(const LAS bf16x8*)(lds + cur + kfo + 32 * KPITCH + s * 32);
                const bf16x8 q = *(const LAS bf16x8*)(ql + (6 + s) * 1024);
                p0 = __builtin_amdgcn_mfma_f32_32x32x16_bf16(a0, q, p0, 0, 0, 0); p1 = __builtin_amdgcn_mfma_f32_32x32x16_bf16(a1, q, p1, 0, 0, 0);
            }
            softmax_blk(p0, p1, ob0, ob1, mb, lb, pf, t == 0);
            pv_blk(pf, ob0, ob1, lds + cur + vb);
        }
        *(LAS u32x4*)(lds + nxt + kd0) = ka; *(LAS u32x4*)(lds + (has1 ? nxt : 0u) + kd1) = kb; *(LAS u32x4*)(lds + nxt + vd) = va;
        __syncthreads();
    }
    bf16_t* op = Oh + (size_t)qrow * D + 4 * hi;
    store_o(op, oa0, oa1, 1.0f / swap_add(la));
    store_o(op + 32 * D, ob0, ob1, 1.0f / swap_add(lb));
}
#undef SGB
}

#define XB_TMO      128
#define XB_XCNT(j)  (256  + 64 * (j))
#define XB_XSUB(j)  (1280 + 64 * (j))
#define XB_XGEN(j)  (2304 + 64 * (j))
#define XB_TOP      3328
#define XB_TOPGEN   3392
#define XCD_BAR_WORDS 3456
#define XB_SPIN_CAP (1u << 20)
__device__ __forceinline__ unsigned xb_ld(unsigned* p)              { return __hip_atomic_load(p, __ATOMIC_RELAXED, __HIP_MEMORY_SCOPE_AGENT); }
__device__ __forceinline__ unsigned xb_add(unsigned* p, unsigned v) { return __hip_atomic_fetch_add(p, v, __ATOMIC_RELAXED, __HIP_MEMORY_SCOPE_AGENT); }
__device__ __forceinline__ unsigned xb_xcc_id() { return (unsigned)__builtin_amdgcn_s_getreg((3 << 11) | 20) & 0xFu; }
#define XB_SPIN(cond, bar) do { unsigned _sp = 0; while (cond) { __builtin_amdgcn_s_sleep(1); \
    if ((++_sp & 255u) == 0u) { if (xb_ld(&(bar)[XB_TMO])) break; if (_sp > XB_SPIN_CAP) { atomicAdd(&(bar)[XB_TMO], 1u); break; } } } } while (0)
struct XcdBarrier { unsigned* bar; unsigned x; volatile LAS unsigned* st; };
__device__ __forceinline__ XcdBarrier xcd_barrier_post(unsigned* bar, volatile LAS unsigned* st, int tid) {
    XcdBarrier b; b.bar = bar; b.x = xb_xcc_id(); b.st = st;
    if (tid == 0) (void)xb_add(&bar[XB_XCNT(b.x)], 1u);
    return b;
}
__device__ __forceinline__ void xcd_barrier_complete(unsigned* bar, unsigned x, unsigned& nloc, unsigned& nx) {
    const unsigned G = gridDim.x * gridDim.y * gridDim.z;
    unsigned sum, cnt, mine, sp = 0u;
    for (;;) {
        sum = 0u; cnt = 0u; mine = 0u;
#pragma unroll
        for (unsigned j = 0; j < 16; ++j) { const unsigned c = xb_ld(&bar[XB_XCNT(j)]); sum += c; cnt += (c > 0u) ? 1u : 0u; mine = (j == x) ? c : mine; }
        if (sum == G) break;
        __builtin_amdgcn_s_sleep(1);
        if ((++sp & 255u) == 0u) { if (xb_ld(&bar[XB_TMO])) break; if (sp > XB_SPIN_CAP) { atomicAdd(&bar[XB_TMO], 1u); break; } }
    }
    nloc = mine > 0u ? mine : 1u; nx = cnt > 0u ? cnt : 1u;
}
__device__ __forceinline__ void xcd_barrier(const XcdBarrier& b, int tid) {
    asm volatile("s_waitcnt vmcnt(0)" ::: "memory");
    __syncthreads();
    if (tid == 0) {
        unsigned* bar = b.bar;
        __builtin_amdgcn_s_waitcnt(0);
        unsigned nloc = b.st[0], nx = b.st[1];
        if (nloc == 0u) { xcd_barrier_complete(bar, b.x, nloc, nx); b.st[0] = nloc; b.st[1] = nx; }
        const unsigned old = xb_add(&bar[XB_XSUB(b.x)], 1u);
        const unsigned gen = old / nloc;
        if (old + 1u == (gen + 1u) * nloc) {
            __builtin_amdgcn_fence(__ATOMIC_RELEASE, "agent");
            asm volatile("s_waitcnt vmcnt(0)" ::: "memory");
            const unsigned og = xb_add(&bar[XB_TOP], 1u);
            const unsigned tg = og / nx;
            if (og + 1u == (tg + 1u) * nx) xb_add(&bar[XB_TOPGEN], 1u);
            else XB_SPIN(xb_ld(&bar[XB_TOPGEN]) == tg, bar);
            __builtin_amdgcn_fence(__ATOMIC_ACQUIRE, "agent");
            xb_add(&bar[XB_XGEN(b.x)], 1u);
            asm volatile("s_waitcnt vmcnt(0)" ::: "memory");
        } else {
            XB_SPIN(xb_ld(&bar[XB_XGEN(b.x)]) == gen, bar);
            __builtin_amdgcn_fence(__ATOMIC_ACQUIRE, "agent");
            asm volatile("s_waitcnt vmcnt(0)" ::: "memory");
        }
    }
    __syncthreads();
}

constexpr int SPC = 13, NSTEP = 1 + SPC * NCHUNK + 1;
struct Args { const float* in[21]; float* out; unsigned char* ws; int ph_lo, ph_hi; };

__global__ void __launch_bounds__(512, 2) fwd_kernel(Args args) {
    extern __shared__ __attribute__((aligned(16))) unsigned char lds_raw[];
    LAS unsigned char* lds = (LAS unsigned char*)lds_raw;
    const int wave0 = __builtin_amdgcn_readfirstlane(threadIdx.x >> 6);
#if MEGA
    volatile LAS unsigned* bst = (volatile LAS unsigned*)(lds + LDS_BYTES - 16);
    if (threadIdx.x < 2) bst[threadIdx.x] = 0u;
    __syncthreads();
    XcdBarrier xbar = xcd_barrier_post((unsigned*)args.ws + 4096, bst, (int)threadIdx.x);
#endif
    for (int ph = args.ph_lo; ph < args.ph_hi; ++ph) {
    int tid_l = wave0 * 64 + (int)__builtin_amdgcn_mbcnt_hi(~0u, __builtin_amdgcn_mbcnt_lo(~0u, 0u)); asm volatile("" : "+v"(tid_l));
    unsigned char* ws = args.ws; asm volatile("" : "+s"(ws));
    const int tid = tid_l, lane = tid & 63; const int wave = wave0;
    const int G = gridDim.x, bx = blockIdx.x; const int vcu = (G % 8 == 0) ? (bx % 8) * (G / 8) + bx / 8 : bx;
    const int gw = vcu * 8 + wave, NGW = G * 8;
    bf16_t* Win_t = (bf16_t*)(ws + WS_WIN); bf16_t* Wuq_t = (bf16_t*)(ws + WS_WUQ); bf16_t* Wukv_t = (bf16_t*)(ws + WS_WUKV); bf16_t* Pa_t = (bf16_t*)(ws + WS_PA);
    bf16_t* Pb_t = (bf16_t*)(ws + WS_PB); bf16_t* Wout_t = (bf16_t*)(ws + WS_WOUT); bf16_t* Wup_t = (bf16_t*)(ws + WS_WUP); bf16_t* Wdown_t = (bf16_t*)(ws + WS_WDOWN);
    float* MOD = (float*)(ws + WS_MOD); float* ROPE = (float*)(ws + WS_ROPE); float* RSTD = (float*)(ws + WS_RSTD);
    bf16_t* Hb = (bf16_t*)(ws + WS_H); bf16_t* Zb = (bf16_t*)(ws + WS_Z); bf16_t* Qb = (bf16_t*)(ws + WS_Q); bf16_t* KFb = (bf16_t*)(ws + WS_KF); bf16_t* Vb = (bf16_t*)(ws + WS_V);
    bf16_t* OAb = (bf16_t*)(ws + WS_OA); bf16_t* OBb = (bf16_t*)(ws + WS_OB); float* OGb = (float*)(ws + WS_OG); float* LSEb = (float*)(ws + WS_LSE);
    bf16_t* Tb = (bf16_t*)(ws + WS_T); bf16_t* MGb = (bf16_t*)(ws + WS_MERGED); bf16_t* X1b = (bf16_t*)(ws + WS_OA); bf16_t* UPb = (bf16_t*)(ws + WS_UP); bf16_t* ACTb = (bf16_t*)(ws + WS_ACT);
    bool sync_after = true;
        if (ph == 0) {
            if (bx < 96) {
                LAS float* sl = (LAS float*)lds;
                LAS float* part = (LAS float*)(lds + 49152);
                for (int idx = tid; idx < 12 * 1024; idx += 512) { const int b = idx >> 10, d = idx & 1023; const float c = b < 8 ? args.in[2][b * 1024 + d] : args.in[3][(b - 8) * 1024 + d];
                    sl[d * 12 + b] = c / (1.0f + __expf(-c)); }
                __syncthreads();
                const int e = bx * 64 + lane; float acc[12];
#pragma unroll
                for (int b = 0; b < 12; ++b) acc[b] = 0.f;
                const float* wp = args.in[4] + (size_t)(wave * 128) * 6144 + e;
#pragma unroll 8
                for (int d = 0; d < 128; ++d) { const float w = wp[(size_t)d * 6144]; const LAS f32x4* s4 = (const LAS f32x4*)(sl + (wave * 128 + d) * 12);
                    const f32x4 a = s4[0], b4 = s4[1], c4 = s4[2];
                    acc[0] += a.x * w; acc[1] += a.y * w; acc[2] += a.z * w; acc[3] += a.w * w; acc[4] += b4.x * w; acc[5] += b4.y * w; acc[6] += b4.z * w; acc[7] += b4.w * w;
                    acc[8] += c4.x * w; acc[9] += c4.y * w; acc[10] += c4.z * w; acc[11] += c4.w * w; }
#pragma unroll
                for (int b = 0; b < 12; ++b) part[(wave * 12 + b) * 64 + lane] = acc[b];
                __syncthreads();
                if (wave == 0) {
#pragma unroll
                    for (int b = 0; b < 12; ++b) { float s = args.in[5][e];
#pragma unroll
                        for (int w = 0; w < 8; ++w) s += part[(w * 12 + b) * 64 + lane];
                        MOD[b * 6144 + e] = s; } }
                __syncthreads();
            }
            for (int idx = bx * 512 + tid; idx < 8192 * 16; idx += G * 512) { const int pos = idx >> 4, i = idx & 15; const float ang = (float)pos * ROPE_INV[i];
                const double tt = (double)ang * 0.15915494309189535; const float fr_ = (float)(tt - floor(tt));
                ROPE[idx] = __builtin_amdgcn_cosf(fr_); ROPE[131072 + idx] = __builtin_amdgcn_sinf(fr_); }
            {
                LAS float* scr = (LAS float*)(lds + wave * 16384);
                constexpr int I_IN = 16 * 157, I_UQ = 6 * 48, I_UKV = 4 * 64, I_PA = 16 * 32, I_PB = 4 * 32, I_OUT = 16 * 32, I_UP = 16 * 176, I_DOWN = 44 * 32;
                constexpr int NITEMS = I_IN + I_UQ + I_UKV + I_PA + I_PB + I_OUT + I_UP + I_DOWN;
                for (int it = gw; it < NITEMS; it += NGW) {
                    int r = it; const float* W; int K, N, kind = 0; bf16_t* WT; const float* ks = nullptr;
                    if (r < I_IN) { W = args.in[7]; K = 1024; N = 5024; WT = Win_t; kind = 1; }
                    else if ((r -= I_IN) < I_UQ) { W = args.in[10]; K = 384; N = 1536; WT = Wuq_t; kind = 2; ks = args.in[8]; }
                    else if ((r -= I_UQ) < I_UKV) { W = args.in[11]; K = 256; N = 2048; WT = Wukv_t; kind = 3; ks = args.in[9]; }
                    else if ((r -= I_UKV) < I_PA) { W = args.in[12]; K = 1024; N = 1024; WT = Pa_t; }
                    else if ((r -= I_PA) < I_PB) { W = args.in[13]; K = 256; N = 1024; WT = Pb_t; }
                    else if ((r -= I_PB) < I_OUT) { W = args.in[14]; K = 1024; N = 1024; WT = Wout_t; }
                    else if ((r -= I_OUT) < I_UP) { W = args.in[16]; K = 1024; N = 5632; WT = Wup_t; }
                    else { r -= I_UP; W = args.in[19]; K = 2816; N = 1024; WT = Wdown_t; }
                    transpose_item(W, K, N, WT, kind, ks, scr, r, lane);
                }
                for (int idx = bx * 512 + tid; idx < 96 * 128; idx += G * 512) *(u32x4*)(Win_t + (size_t)672 * 1024 + (size_t)idx * 8) = (u32x4){0u, 0u, 0u, 0u};
            }
            __syncthreads();
        } else if (ph == NSTEP - 1) {
            float* o = args.out + (size_t)(NCHUNK - 1) * CH * D;
            for (int m = gw; m < CH; m += NGW) final_norm_row(X1b + (size_t)m * D, o + (size_t)m * D, args.in[20], lane);
        } else {
            const int c = (ph - 1) / SPC, k = (ph - 1) - SPC * c;
            ChunkP P;
            if (c == 0) { P.x = args.in[0]; P.S = 2048; P.Sshift = 11; P.nseq = 8; P.seqbase = 0; }
            else { P.x = args.in[1] + (size_t)(c - 1) * CH * D; P.S = 8192; P.Sshift = 13; P.nseq = 2; P.seqbase = 8 + 2 * (c - 1); }
            P.out = args.out + (size_t)c * CH * D;
            sync_after = !(k == 3 || k == 6);
            pg8::Gemm g{}; pg8::EpiAny E{}; bool is_gemm = true;
            E.S = P.S; E.Sshift = P.Sshift; E.seqbase = P.seqbase; E.rstd = RSTD; E.rope = ROPE; E.Z = Zb; E.T = Tb; E.mod = MOD;
            if (k == 1) { g = pg8::Gemm{Hb, Win_t, CH, ZLD, 1024, 1024}; E.kind = 0; E.O = Zb; E.ldc = ZLD; E.sig_pn = 12; }
            else if (k == 3) { g = pg8::Gemm{Zb, Wuq_t, CH, 1536, 384, ZLD}; E.kind = 1; E.Q = Qb; }
            else if (k == 4) { g = pg8::Gemm{Zb + 384, Wukv_t, CH, 2048, 256, ZLD}; E.kind = 2; E.KF = KFb; E.V = Vb; }
            else if (k == 6) { g = pg8::Gemm{OAb, Pa_t, CH, 1024, 1024, 1024}; E.kind = 3; }
            else if (k == 7) { g = pg8::Gemm{OBb, Pb_t, CH, 1024, 256, 256}; E.kind = 4; E.O = MGb; }
            else if (k == 8) { g = pg8::Gemm{MGb, Wout_t, CH, 1024, 1024, 1024}; E.kind = 5; E.base = P.x; E.out = P.out; E.goff = 2048; E.rmode = 0; E.x1 = X1b; }
            else if (k == 10) { g = pg8::Gemm{Hb, Wup_t, CH, NUP, 1024, 1024}; E.kind = 0; E.O = UPb; E.ldc = NUP; E.sig_pn = 1 << 30; }
            else if (k == 12) { g = pg8::Gemm{ACTb, Wdown_t, CH, 1024, DFF, DFF}; E.kind = 5; E.base = P.out; E.out = P.out; E.goff = 5120; E.rmode = 1; E.x1 = X1b; }
            else is_gemm = false;
            if (is_gemm) { pg8::StaticOrder S; S.init(g.M, g.N, G, bx); pg8::gemm_phase(lds, g, S, E, tid); }
            else if (k == 0) {
                if (c > 0) { float* o = args.out + (size_t)(c - 1) * CH * D; for (int m = gw; m < CH; m += NGW) final_norm_row(X1b + (size_t)m * D, o + (size_t)m * D, args.in[20], lane); }
                for (int m = gw; m < CH; m += NGW) { const float* md = MOD + (size_t)(P.seqbase + (m >> P.Sshift)) * 6144;
                    norm_mod_row(P.x + (size_t)m * D, Hb + (size_t)m * D, args.in[6], md + 1024, md, lane); }
            } else if (k == 2) {
                for (int m = gw; m < CH; m += NGW) {
                    const unsigned* zr = (const unsigned*)(Zb + (size_t)m * ZLD);
                    float sq = 0.f, skv = 0.f;
#pragma unroll
                    for (int j = 0; j < 3; ++j) { const unsigned w = zr[lane + 64 * j]; const float a = bflo(w), b = bfhi(w); sq += a * a + b * b; }
#pragma unroll
                    for (int j = 0; j < 2; ++j) { const unsigned w = zr[192 + lane + 64 * j]; const float a = bflo(w), b = bfhi(w); skv += a * a + b * b; }
                    sq = wave_sum(sq); skv = wave_sum(skv);
                    if (lane == 0) { RSTD[2 * m] = 1.0f / sqrtf(sq * (1.f / 384.f) + EPS); RSTD[2 * m + 1] = 1.0f / sqrtf(skv * (1.f / 256.f) + EPS); }
                    const int seq = m >> P.Sshift, pos = m & (P.S - 1);
                    unsigned pr = 0u;
                    { const int i = lane & 15; const unsigned w = zr[320 + i]; const float a = bflo(w), b = bfhi(w); const float cs = ROPE[pos * 16 + i], sn = ROPE[131072 + pos * 16 + i];
                      pr = cvt_pk_bf16(a * cs - b * sn, a * sn + b * cs); }
                    u32x4 o; const int b4 = 4 * (lane & 3);
                    o.x = __shfl(pr, b4); o.y = __shfl(pr, b4 + 1); o.z = __shfl(pr, b4 + 2); o.w = __shfl(pr, b4 + 3);
                    const int head = lane >> 2;
                    *(u32x4*)(KFb + ((size_t)((seq * 16 + head) << P.Sshift) + pos) * 96 + 64 + 8 * (lane & 3)) = o;
                }
                LAS unsigned char* wl = lds + wave * 4096;
                for (int task = gw; task < CH * 12 / 32; task += NGW) dil_task(Zb, OGb, LSEb, P.S, task, wl, lane);
            } else if (k == 5) {
                for (int it = bx * 512 + tid; it < CH * 32; it += G * 512) { const int row = it >> 5, j = (it >> 3) & 3, d8 = (it & 7) * 8;
                    const float l0 = LSEb[row * 12 + j], l1 = LSEb[row * 12 + 4 + j], l2 = LSEb[row * 12 + 8 + j]; const float mx = fmaxf(l0, fmaxf(l1, l2));
                    float w0 = __expf(l0 - mx), w1 = __expf(l1 - mx), w2 = __expf(l2 - mx); const float inv = 1.0f / (w0 + w1 + w2); w0 *= inv; w1 *= inv; w2 *= inv;
                    const float* p0 = OGb + ((size_t)row * 12 + j) * 64 + d8; const float* p1 = p0 + 4 * 64; const float* p2 = p0 + 8 * 64;
                    const f32x4 a0 = *(const f32x4*)p0 * w0 + *(const f32x4*)p1 * w1 + *(const f32x4*)p2 * w2;
                    const f32x4 a1 = *(const f32x4*)(p0 + 4) * w0 + *(const f32x4*)(p1 + 4) * w1 + *(const f32x4*)(p2 + 4) * w2;
                    *(u32x4*)(OBb + (size_t)row * 256 + j * 64 + d8) = pg8::pack8(a0, a1); }
                const int nqb = P.S >> 9, nunits = P.nseq * 16 * nqb;
                for (int uidx = vcu; uidx < nunits; uidx += G) { const int pair = uidx / nqb, qb = uidx - pair * nqb; const int seq = pair >> 4, head = pair & 15;
                    const size_t hb = (size_t)pair << P.Sshift;
                    mla::attn_unit(Qb + hb * 96, KFb + hb * 96, Vb + hb * 64, OAb + ((size_t)seq << P.Sshift) * D + head * 64, P.S, qb, lds, tid); }
            } else if (k == 9) {
                for (int m = gw; m < CH; m += NGW) { const float* md = MOD + (size_t)(P.seqbase + (m >> P.Sshift)) * 6144;
                    norm_mod_row16(X1b + (size_t)m * D, Hb + (size_t)m * D, args.in[15], md + 4096, md + 3072, lane); }
            } else if (k == 11) {
                for (int it = bx * 512 + tid; it < (CH / 16) * 352; it += G * 512) {
                    const int rb = it / 352, f0 = (it - rb * 352) * 8; const int r0 = rb * 16, pos0 = r0 & (P.S - 1);
                    float w0[8], w1[8], w2[8], cb[8];
                    { const f32x4* wp = (const f32x4*)(args.in[17] + f0); const f32x4 a0 = wp[0], a1 = wp[1], b0 = wp[DFF / 4], b1 = wp[DFF / 4 + 1], c0 = wp[2 * DFF / 4], c1 = wp[2 * DFF / 4 + 1];
                      const f32x4* bp = (const f32x4*)(args.in[18] + f0); const f32x4 d0 = bp[0], d1 = bp[1];
#pragma unroll
                      for (int e = 0; e < 4; ++e) { w0[e] = a0[e]; w0[4 + e] = a1[e]; w1[e] = b0[e]; w1[4 + e] = b1[e]; w2[e] = c0[e]; w2[4 + e] = c1[e]; cb[e] = d0[e]; cb[4 + e] = d1[e]; } }
                    const bf16_t* up = UPb + (size_t)r0 * NUP + f0;
                    u32x4 uu[18], gg[16];
                    uu[0] = (u32x4){0u, 0u, 0u, 0u}; if (pos0 > 0) uu[0] = *(const u32x4*)(up - NUP);
#pragma unroll
                    for (int i = 0; i < 16; ++i) { uu[i + 1] = *(const u32x4*)(up + (size_t)i * NUP); gg[i] = *(const u32x4*)(up + (size_t)i * NUP + DFF); }
                    uu[17] = (u32x4){0u, 0u, 0u, 0u}; if (pos0 + 16 < P.S) uu[17] = *(const u32x4*)(up + (size_t)16 * NUP);
#pragma unroll
                    for (int i = 0; i < 16; ++i) {
                        float r[8];
#pragma unroll
                        for (int q = 0; q < 4; ++q) {
                            const float pl = bflo(uu[i][q]), ph_ = bfhi(uu[i][q]), cl = bflo(uu[i + 1][q]), chh = bfhi(uu[i + 1][q]), nl = bflo(uu[i + 2][q]), nh = bfhi(uu[i + 2][q]);
                            const float xl = cb[2 * q] + w0[2 * q] * pl + w1[2 * q] * cl + w2[2 * q] * nl, xh = cb[2 * q + 1] + w0[2 * q + 1] * ph_ + w1[2 * q + 1] * chh + w2[2 * q + 1] * nh;
                            const float yl = 0.7978845608028654f * (xl + 0.044715f * xl * xl * xl), yh = 0.7978845608028654f * (xh + 0.044715f * xh * xh * xh);
                            r[2 * q] = xl * sigmoidf_(2.0f * yl) * bflo(gg[i][q]); r[2 * q + 1] = xh * sigmoidf_(2.0f * yh) * bfhi(gg[i][q]);
                        }
                        u32x4 o; o.x = cvt_pk_bf16(r[0], r[1]); o.y = cvt_pk_bf16(r[2], r[3]); o.z = cvt_pk_bf16(r[4], r[5]); o.w = cvt_pk_bf16(r[6], r[7]);
                        *(u32x4*)(ACTb + (size_t)(r0 + i) * DFF + f0) = o;
                    }
                }
            }
        }
#if MEGA
        if (sync_after && ph + 1 < args.ph_hi) { if (ph == 0) cg::this_grid().sync(); else xcd_barrier(xbar, wave0 * 64 + (int)__builtin_amdgcn_mbcnt_hi(~0u, __builtin_amdgcn_mbcnt_lo(~0u, 0u))); }
#else
        (void)sync_after;
#endif
    }
}

extern "C" void kernel_launch(void* const* d_in, const int* in_sizes, int n_in, void* d_out, int out_size, void* d_ws, size_t ws_size, hipStream_t stream) {
    static int grid = 0;
    if (grid == 0) {
        if (n_in != 21 || ws_size < WS_END) { fprintf(stderr, "kernel_launch: unexpected n_in %d / ws_size %zu\n", n_in, ws_size); grid = -1; return; }
        int dev = 0, cus = 0, per_cu = 0;
        (void)hipGetDevice(&dev); (void)hipDeviceGetAttribute(&cus, hipDeviceAttributeMultiprocessorCount, dev);
        (void)hipFuncSetAttribute((const void*)fwd_kernel, hipFuncAttributeMaxDynamicSharedMemorySize, LDS_BYTES);
        (void)hipOccupancyMaxActiveBlocksPerMultiprocessor(&per_cu, (const void*)fwd_kernel, 512, LDS_BYTES);
        (void)hipGetLastError();
        if (per_cu < 1) fprintf(stderr, "kernel_launch: occupancy query says %d blocks/CU\n", per_cu);
        grid = cus;
    }
    if (grid < 0) return;
    Args a{};
    for (int i = 0; i < 21; ++i) a.in[i] = (const float*)d_in[i];
    a.out = (float*)d_out; a.ws = (unsigned char*)d_ws;
#if MEGA
    (void)hipMemsetAsync(d_ws, 0, 65536, stream);
    a.ph_lo = 0; a.ph_hi = NSTEP;
    void* kargs[] = {&a};
    hipError_t e = hipLaunchCooperativeKernel((const void*)fwd_kernel, dim3(grid), dim3(512), kargs, LDS_BYTES, stream);
    if (e != hipSuccess) fprintf(stderr, "cooperative launch failed: %s (grid %d)\n", hipGetErrorString(e), grid);
#else
    for (int ph = 0; ph < NSTEP; ++ph) { a.ph_lo = ph; a.ph_hi = ph + 1; hipLaunchKernelGGL(fwd_kernel, dim3(grid), dim3(512), LDS_BYTES, stream, a);
#ifdef PROBE_DUP
        if (ph > 0 && ph < NSTEP - 1 && ((PROBE_DUP >> ((ph - 1) % SPC)) & 1)) hipLaunchKernelGGL(fwd_kernel, dim3(grid), dim3(512), LDS_BYTES, stream, a);
#endif
    }
#endif
}
```

```cpp
#include <hip/hip_runtime.h>
#include <hip/hip_cooperative_groups.h>
#include <cstdio>
#include <cstdint>
namespace cg = cooperative_groups;

#ifndef MEGA
#define MEGA 1
#endif

#define LAS __attribute__((address_space(3)))
typedef unsigned short bf16_t;
typedef short bf16x8 __attribute__((ext_vector_type(8)));
typedef short s16x4 __attribute__((ext_vector_type(4)));
typedef float f32x2 __attribute__((ext_vector_type(2)));
typedef float f32x4 __attribute__((ext_vector_type(4)));
typedef float f32x16 __attribute__((ext_vector_type(16)));
typedef unsigned u32x2 __attribute__((ext_vector_type(2)));
typedef unsigned u32x4 __attribute__((ext_vector_type(4)));

constexpr int D = 1024, CH = 16384, NCHUNK = 3, ZLD = 5120, NUP = 5632, DFF = 2816;

constexpr float EPS = 1e-6f, LOG2E = 1.4426950408889634f, LN2 = 0.6931471805599453f;
constexpr float QSCALE = 0.10206207261596577f * LOG2E;
constexpr float DSCALE = 0.125f * LOG2E;

constexpr size_t MiB = 1u << 20;
constexpr size_t WS_WIN = 2 * MiB, WS_WUQ = 12 * MiB, WS_WUKV = 14 * MiB, WS_PA = 15 * MiB, WS_PB = 17 * MiB, WS_WOUT = 18 * MiB,
                 WS_WUP = 20 * MiB, WS_WDOWN = 31 * MiB;
constexpr size_t WS_MOD = 37 * MiB, WS_ROPE = 38 * MiB  , WS_RSTD = 39 * MiB + 512 * 1024;
constexpr size_t WS_H = 40 * MiB, WS_Z = 72 * MiB, WS_Q = 232 * MiB, WS_KF = 280 * MiB, WS_V = 328 * MiB, WS_OA = 360 * MiB, WS_OB = 392 * MiB,
                 WS_OG = 400 * MiB, WS_LSE = 448 * MiB, WS_T = 232 * MiB, WS_MERGED = 296 * MiB, WS_UP = 72 * MiB, WS_ACT = 248 * MiB, WS_EDGE = 449 * MiB  , WS_END = 454 * MiB;

constexpr int LDS_BYTES = 147456;

__device__ __forceinline__ unsigned cvt_pk_bf16(float lo, float hi) { unsigned r; asm volatile("v_cvt_pk_bf16_f32 %0, %1, %2" : "=v"(r) : "v"(lo), "v"(hi)); return r; }
__device__ __forceinline__ float bf2f(unsigned short b) { return __uint_as_float((unsigned)b << 16); }
__device__ __forceinline__ float bflo(unsigned w) { return __uint_as_float(w << 16); }
__device__ __forceinline__ float bfhi(unsigned w) { return __uint_as_float(w & 0xffff0000u); }
__device__ __forceinline__ float wave_sum(float v) {
#pragma unroll
    for (int o = 1; o < 64; o <<= 1) v += __shfl_xor(v, o);
    return v;
}
__device__ __forceinline__ float swap_max(float m) { auto rr = __builtin_amdgcn_permlane32_swap(__float_as_uint(m), __float_as_uint(m), false, false); return fmaxf(__uint_as_float(rr[0]), __uint_as_float(rr[1])); }
__device__ __forceinline__ float swap_add(float m) { auto rr = __builtin_amdgcn_permlane32_swap(__float_as_uint(m), __float_as_uint(m), false, false); return __uint_as_float(rr[0]) + __uint_as_float(rr[1]); }
__device__ __forceinline__ s16x4 vtr(LAS const unsigned char* p) { return __builtin_bit_cast(s16x4, __builtin_amdgcn_ds_read_tr16_b64_v4i16((LAS s16x4*)p)); }
__device__ __forceinline__ float sigmoidf_(float x) { return __builtin_amdgcn_rcpf(1.0f + __builtin_amdgcn_exp2f(-x * LOG2E)); }

struct ChunkP { const float* x; float* out; int S, Sshift, nseq, seqbase; };

namespace pg8 {
constexpr int BM = 256, BK = 64, HALF = 128, HTB = HALF * BK * 2, STAGE_BYTES = 8 * HTB, NXCD = 8, WGM = 8;
__host__ __device__ __forceinline__ int lds_byte(int r, int c) { const int st = (r >> 4) * 2 + (c >> 5), rr = r & 15, cc = c & 31, ob = rr * 64 + cc * 2; return st * 1024 + (ob ^ (((ob >> 9) & 1) << 5)); }
__host__ __device__ __forceinline__ void stage_rc(int b, int& R, int& C) { const int st = b / 1024, sb = b % 1024, swz = sb ^ (((sb >> 9) & 1) << 5); R = (st >> 1) * 16 + swz / 64; C = (st & 1) * 32 + (swz % 64) / 2; }
__host__ __device__ __forceinline__ int perm32(int rho) { const int n = rho >> 4, i = rho & 15; return 8 * (i >> 2) + 4 * n + (i & 3); }
struct Unit { int pm, pn; };
struct Gemm { const bf16_t* A; const bf16_t* Bt; int M, N, K, lda; };
struct StaticOrder {
    int nM, nN, nwg, G, c;
    __device__ void init(int M, int N, int G_, int c_) { nM = M / BM; nN = N / BM; nwg = nM * nN; G = G_; c = c_; }
    __device__ bool next(int i, Unit& u) const {
        const long L = (long)i * G + c; if (L >= nwg) return false;
        int wgid = (int)L; { const int q = nwg / NXCD, r = nwg % NXCD, xcd = wgid % NXCD, off = wgid / NXCD; wgid = (xcd < r ? xcd * (q + 1) : r * (q + 1) + (xcd - r) * q) + off; }
        const int nig = WGM * nN, gid = wgid / nig, fm = gid * WGM, gsz = (nM - fm) < WGM ? (nM - fm) : WGM;
        u.pm = fm + ((wgid % nig) % gsz); u.pn = (wgid % nig) / gsz; return true;
    }
};

template <class Epi, class Sched>
__device__ __forceinline__ void gemm_phase(LAS unsigned char* lds, const Gemm g, const Sched& S, const Epi& E, int tid_in) {
    int tid_ = tid_in; asm volatile("" : "+v"(tid_));
    const int tid = tid_, wid = __builtin_amdgcn_readfirstlane(tid >> 6), lane = tid & 63, wr = wid >> 2, wc = wid & 3, fr = lane & 15, fq = lane >> 4;
    const int K = g.K, nt = K / BK, lda = g.lda;
    unsigned voffA[2], voffB[2];
#pragma unroll
    for (int i = 0; i < 2; ++i) { int R, C; stage_rc(tid * 16 + i * 8192, R, C); const int Rb = (R & ~31) + perm32(R & 31);
        voffA[i] = (unsigned)(R * lda + C) * 2u; voffB[i] = (unsigned)(Rb * K + C) * 2u; }
    const size_t kstep = (size_t)(BK * 2);
    const size_t hstepA = (size_t)HALF * lda * 2, hstepB = (size_t)HALF * K * 2;
    const size_t tstepA = 2 * hstepA, tstepB = 2 * hstepB;
    const unsigned ldsw = (unsigned)wid * 1024u;
    const int aoff = lds_byte(wr * 64 + fr, fq * 8), boff = lds_byte(wc * 32 + fr, fq * 8);
#define PG8_SA(b, h) (((b) * 2 + (h)) * HTB)
#define PG8_SB(b, h) ((4 + (b) * 2 + (h)) * HTB)
#define PG8_STAGE(bufoff, gbase, voff) do { _Pragma("unroll") for (int _i = 0; _i < 2; ++_i) \
        __builtin_amdgcn_global_load_lds((const unsigned*)((const char*)(gbase) + (voff)[_i]), (LAS unsigned*)(lds + (bufoff) + ldsw + _i * 8192), 16, 0, 0); } while (0)
#define PG8_LDA(dst, b, h) do { _Pragma("unroll") for (int m = 0; m < 4; ++m) _Pragma("unroll") for (int k = 0; k < 2; ++k) dst[m][k] = *(const LAS bf16x8*)(lds + PG8_SA(b, h) + aoff + m * 2048 + k * 1024); } while (0)
#define PG8_LDB(dst, b, h) do { _Pragma("unroll") for (int n = 0; n < 2; ++n) _Pragma("unroll") for (int k = 0; k < 2; ++k) dst[n][k] = *(const LAS bf16x8*)(lds + PG8_SB(b, h) + boff + n * 2048 + k * 1024); } while (0)
#define PG8_MMA(ai, bj, At, Bt) do { __builtin_amdgcn_s_setprio(1); _Pragma("unroll") for (int m = 0; m < 4; ++m) _Pragma("unroll") for (int n = 0; n < 2; ++n) _Pragma("unroll") for (int k = 0; k < 2; ++k) \
        acc[ai][bj][m][n] = __builtin_amdgcn_mfma_f32_16x16x32_bf16(Bt[n][k], At[m][k], acc[ai][bj][m][n], 0, 0, 0); __builtin_amdgcn_s_setprio(0); } while (0)
#define PG8_WAIT_V(n) asm volatile("s_waitcnt vmcnt(" #n ")" ::: "memory")
#define PG8_WAIT_L(n) asm volatile("s_waitcnt lgkmcnt(" #n ")" ::: "memory")
#define PG8_BAR __builtin_amdgcn_s_barrier()
#define PG8_SCHED __builtin_amdgcn_sched_barrier(0)
    Unit cur, nxt; int ui = 0;
    if (!S.next(0, cur)) return;
    f32x4 acc[2][2][4][2];
#pragma unroll
    for (int a = 0; a < 2; ++a)
#pragma unroll
        for (int b = 0; b < 2; ++b)
#pragma unroll
            for (int m = 0; m < 4; ++m)
#pragma unroll
                for (int n = 0; n < 2; ++n) acc[a][b][m][n] = (f32x4){0.f, 0.f, 0.f, 0.f};
    bf16x8 At[4][2], B0[2][2], B1[2][2];
    const char* cA = (const char*)g.A + (size_t)cur.pm * tstepA; const char* cB = (const char*)g.Bt + (size_t)cur.pn * tstepB;
    PG8_STAGE(PG8_SB(0, 0), cB, voffB); PG8_STAGE(PG8_SB(0, 1), cB + hstepB, voffB); PG8_STAGE(PG8_SA(0, 0), cA, voffA); PG8_STAGE(PG8_SA(0, 1), cA + hstepA, voffA);
    if (wr == 1) PG8_BAR;
    PG8_WAIT_V(2); PG8_BAR;
    PG8_STAGE(PG8_SB(1, 0), cB + kstep, voffB); PG8_STAGE(PG8_SA(1, 0), cA + kstep, voffA); PG8_STAGE(PG8_SB(1, 1), cB + hstepB + kstep, voffB);
    PG8_WAIT_V(6); PG8_BAR;
    for (;;) {
        const bool has_next = S.next(ui + 1, nxt);
        const char* nA = has_next ? (const char*)g.A + (size_t)nxt.pm * tstepA : cA; const char* nB = has_next ? (const char*)g.Bt + (size_t)nxt.pn * tstepB : cB;
        for (int t = 0; t < nt; t += 2) {
            const bool last = (t == nt - 2);
            const char* a1 = cA + (size_t)(t + 1) * kstep;
            const char* a2 = last ? nA : cA + (size_t)(t + 2) * kstep; const char* b2 = last ? nB : cB + (size_t)(t + 2) * kstep;
            const char* a3 = a2 + kstep; const char* b3 = b2 + kstep;
            PG8_LDB(B0, 0, 0); PG8_LDB(B1, 0, 1); PG8_SCHED; PG8_LDA(At, 0, 0); PG8_STAGE(PG8_SA(1, 1), a1 + hstepA, voffA);
            PG8_WAIT_V(8); PG8_WAIT_L(0); PG8_BAR; PG8_MMA(0, 0, At, B0); PG8_MMA(0, 1, At, B1); PG8_BAR; PG8_SCHED;
            PG8_LDA(At, 0, 1); PG8_STAGE(PG8_SB(0, 0), b2, voffB); PG8_STAGE(PG8_SB(0, 1), b2 + hstepB, voffB); PG8_STAGE(PG8_SA(0, 0), a2, voffA);
            PG8_WAIT_V(8); PG8_WAIT_L(0); PG8_BAR; PG8_MMA(1, 0, At, B0); PG8_MMA(1, 1, At, B1); PG8_BAR; PG8_SCHED;
            PG8_LDB(B0, 1, 0); PG8_LDB(B1, 1, 1); PG8_SCHED; PG8_LDA(At, 1, 0); PG8_STAGE(PG8_SA(0, 1), a2 + hstepA, voffA);
            PG8_WAIT_V(8); PG8_WAIT_L(0); PG8_BAR; PG8_MMA(0, 0, At, B0); PG8_MMA(0, 1, At, B1); PG8_BAR; PG8_SCHED;
            PG8_LDA(At, 1, 1); PG8_STAGE(PG8_SB(1, 0), b3, voffB); PG8_STAGE(PG8_SB(1, 1), b3 + hstepB, voffB); PG8_STAGE(PG8_SA(1, 0), a3, voffA);
            PG8_WAIT_V(8); PG8_WAIT_L(0); PG8_BAR; PG8_MMA(1, 0, At, B0); PG8_MMA(1, 1, At, B1); PG8_BAR; PG8_SCHED;
        }
        if (wr == 0) PG8_BAR;
        E(acc, cur, wr, wc, fr, fq);
        if (!has_next) break;
#pragma unroll
        for (int a = 0; a < 2; ++a)
#pragma unroll
            for (int b = 0; b < 2; ++b)
#pragma unroll
                for (int m = 0; m < 4; ++m)
#pragma unroll
                    for (int n = 0; n < 2; ++n) acc[a][b][m][n] = (f32x4){0.f, 0.f, 0.f, 0.f};
        cur = nxt; cA = nA; cB = nB; ++ui;
        if (wr == 1) PG8_BAR;
    }
    PG8_WAIT_V(0);
    PG8_BAR;
#undef PG8_SA
#undef PG8_SB
#undef PG8_STAGE
#undef PG8_LDA
#undef PG8_LDB
#undef PG8_MMA
#undef PG8_WAIT_V
#undef PG8_WAIT_L
#undef PG8_BAR
#undef PG8_SCHED
}

#define EPI_ARGS const f32x4 (&acc)[2][2][4][2], const Unit& u, int wr, int wc, int fr, int fq
__device__ __forceinline__ u32x4 pack8(f32x4 v0, f32x4 v1) { u32x4 w; w.x = cvt_pk_bf16(v0[0], v0[1]); w.y = cvt_pk_bf16(v0[2], v0[3]); w.z = cvt_pk_bf16(v1[0], v1[1]); w.w = cvt_pk_bf16(v1[2], v1[3]); return w; }

struct EpiStore {
    bf16_t* O; int ldc; int sig_pn;
    __device__ __forceinline__ void operator()(EPI_ARGS) const {
        const int row0 = u.pm * BM + wr * 64 + fr, col0 = u.pn * BM + wc * 32 + 8 * fq; const bool sig = u.pn >= sig_pn;
#pragma unroll
        for (int ai = 0; ai < 2; ++ai)
#pragma unroll
            for (int m = 0; m < 4; ++m) { bf16_t* rowp = O + (size_t)(row0 + ai * HALF + m * 16) * ldc + col0;
#pragma unroll
                for (int bj = 0; bj < 2; ++bj) { f32x4 v0 = acc[ai][bj][m][0], v1 = acc[ai][bj][m][1];
                    if (sig) {
#pragma unroll
                        for (int e = 0; e < 4; ++e) { v0[e] = sigmoidf_(v0[e]); v1[e] = sigmoidf_(v1[e]); } }
                    *(u32x4*)(rowp + bj * HALF) = pack8(v0, v1); } }
    }
};
struct EpiQ {
    bf16_t* Q; const float* rstd; const float* rope; int S, Sshift;
    __device__ __forceinline__ void operator()(EPI_ARGS) const {
        const int row0 = u.pm * BM + wr * 64 + fr;
#pragma unroll
        for (int ai = 0; ai < 2; ++ai)
#pragma unroll
            for (int m = 0; m < 4; ++m) { const int row = row0 + ai * HALF + m * 16; const int seq = row >> Sshift, pos = row & (S - 1);
                const float sc = rstd[2 * row] * QSCALE;
#pragma unroll
                for (int bj = 0; bj < 2; ++bj) { const int g32 = 8 * u.pn + 4 * bj + wc; const int head = g32 / 3, gl = g32 - 3 * head;
                    f32x4 v0 = acc[ai][bj][m][0] * sc, v1 = acc[ai][bj][m][1] * sc;
                    if (gl == 2) { const f32x4 cs = *(const f32x4*)(rope + (size_t)pos * 16 + 4 * fq), sn = *(const f32x4*)(rope + 131072 + (size_t)pos * 16 + 4 * fq);
                        f32x4 w0, w1;
                        w0[0] = v0[0] * cs[0] - v0[1] * sn[0]; w0[1] = v0[0] * sn[0] + v0[1] * cs[0];
                        w0[2] = v0[2] * cs[1] - v0[3] * sn[1]; w0[3] = v0[2] * sn[1] + v0[3] * cs[1];
                        w1[0] = v1[0] * cs[2] - v1[1] * sn[2]; w1[1] = v1[0] * sn[2] + v1[1] * cs[2];
                        w1[2] = v1[2] * cs[3] - v1[3] * sn[3]; w1[3] = v1[2] * sn[3] + v1[3] * cs[3];
                        v0 = w0; v1 = w1; }
                    *(u32x4*)(Q + ((size_t)((seq * 16 + head) << Sshift) + pos) * 96 + gl * 32 + 8 * fq) = pack8(v0, v1); }
                asm volatile("" ::: "memory"); }
    }
};
struct EpiKV {
    bf16_t* KF; bf16_t* V; const float* rstd; int S, Sshift;
    __device__ __forceinline__ void operator()(EPI_ARGS) const {
        const int row0 = u.pm * BM + wr * 64 + fr; const bool isv = u.pn >= 4;
#pragma unroll
        for (int ai = 0; ai < 2; ++ai)
#pragma unroll
            for (int m = 0; m < 4; ++m) { const int row = row0 + ai * HALF + m * 16; const int seq = row >> Sshift, pos = row & (S - 1);
                const float sc = rstd[2 * row + 1];
#pragma unroll
                for (int bj = 0; bj < 2; ++bj) { const int col = (u.pn & 3) * BM + bj * HALF + wc * 32 + 8 * fq; const int head = col >> 6, d = col & 63;
                    const f32x4 v0 = acc[ai][bj][m][0] * sc, v1 = acc[ai][bj][m][1] * sc; const size_t tok = (size_t)((seq * 16 + head) << Sshift) + pos;
                    bf16_t* p = isv ? V + tok * 64 + d : KF + tok * 96 + d;
                    *(u32x4*)p = pack8(v0, v1); }
                asm volatile("" ::: "memory"); }
    }
};
struct EpiGateA {
    bf16_t* T; const bf16_t* Z;
    __device__ __forceinline__ void operator()(EPI_ARGS) const {
        const int row0 = u.pm * BM + wr * 64 + fr, col0 = u.pn * BM + wc * 32 + 8 * fq;
#pragma unroll
        for (int ai = 0; ai < 2; ++ai)
#pragma unroll
            for (int m = 0; m < 4; ++m) { const int row = row0 + ai * HALF + m * 16;
#pragma unroll
                for (int bj = 0; bj < 2; ++bj) { const int col = col0 + bj * HALF; const u32x4 gw = *(const u32x4*)(Z + (size_t)row * ZLD + 3072 + col);
                    f32x4 v0 = acc[ai][bj][m][0], v1 = acc[ai][bj][m][1];
                    v0[0] *= bflo(gw.x); v0[1] *= bfhi(gw.x); v0[2] *= bflo(gw.y); v0[3] *= bfhi(gw.y); v1[0] *= bflo(gw.z); v1[1] *= bfhi(gw.z); v1[2] *= bflo(gw.w); v1[3] *= bfhi(gw.w);
                    *(u32x4*)(T + (size_t)row * D + col) = pack8(v0, v1); }
                asm volatile("" ::: "memory"); }
    }
};
struct EpiGateB {
    const bf16_t* T; const bf16_t* Z; bf16_t* O;
    __device__ __forceinline__ void operator()(EPI_ARGS) const {
        const int row0 = u.pm * BM + wr * 64 + fr, col0 = u.pn * BM + wc * 32 + 8 * fq;
#pragma unroll
        for (int ai = 0; ai < 2; ++ai)
#pragma unroll
            for (int m = 0; m < 4; ++m) { const int row = row0 + ai * HALF + m * 16;
#pragma unroll
                for (int bj = 0; bj < 2; ++bj) { const int col = col0 + bj * HALF; const u32x4 gw = *(const u32x4*)(Z + (size_t)row * ZLD + 4096 + col);
                    const u32x4 tw = *(const u32x4*)(T + (size_t)row * D + col); f32x4 v0 = {bflo(tw.x), bfhi(tw.x), bflo(tw.y), bfhi(tw.y)}, v1 = {bflo(tw.z), bfhi(tw.z), bflo(tw.w), bfhi(tw.w)};
                    const f32x4 a0 = acc[ai][bj][m][0], a1 = acc[ai][bj][m][1];
                    v0[0] += a0[0] * bflo(gw.x); v0[1] += a0[1] * bfhi(gw.x); v0[2] += a0[2] * bflo(gw.y); v0[3] += a0[3] * bfhi(gw.y);
                    v1[0] += a1[0] * bflo(gw.z); v1[1] += a1[1] * bfhi(gw.z); v1[2] += a1[2] * bflo(gw.w); v1[3] += a1[3] * bfhi(gw.w);
                    *(u32x4*)(O + (size_t)row * D + col) = pack8(v0, v1); }
                asm volatile("" ::: "memory"); }
    }
};
struct EpiResid {
    const float* base; float* out; const float* mod; int goff, Sshift, seqbase; int mode; bf16_t* x1;
    __device__ __forceinline__ void operator()(EPI_ARGS) const {
        const int row0 = u.pm * BM + wr * 64 + fr, col0 = u.pn * BM + wc * 32 + 8 * fq;
        const float* gt = mod + (size_t)(seqbase + ((u.pm * BM) >> Sshift)) * 6144 + goff + col0;
        f32x4 g[2][2];
#pragma unroll
        for (int bj = 0; bj < 2; ++bj) { g[bj][0] = *(const f32x4*)(gt + bj * HALF); g[bj][1] = *(const f32x4*)(gt + bj * HALF + 4); }
#pragma unroll
        for (int ai = 0; ai < 2; ++ai)
#pragma unroll
            for (int m = 0; m < 4; ++m) { const size_t off = (size_t)(row0 + ai * HALF + m * 16) * D + col0;
#pragma unroll
                for (int bj = 0; bj < 2; ++bj) {
                    if (mode == 0) { const f32x4 b0 = *(const f32x4*)(base + off + bj * HALF), b1 = *(const f32x4*)(base + off + bj * HALF + 4);
                        *(u32x4*)(x1 + off + bj * HALF) = pack8(b0 + g[bj][0] * acc[ai][bj][m][0], b1 + g[bj][1] * acc[ai][bj][m][1]); }
                    else { const u32x4 w = *(const u32x4*)(x1 + off + bj * HALF); const f32x4 b0 = {bflo(w.x), bfhi(w.x), bflo(w.y), bfhi(w.y)}, b1 = {bflo(w.z), bfhi(w.z), bflo(w.w), bfhi(w.w)};
                        *(u32x4*)(x1 + off + bj * HALF) = pack8(b0 + g[bj][0] * acc[ai][bj][m][0], b1 + g[bj][1] * acc[ai][bj][m][1]); } }
                if (m & 1) asm volatile("" ::: "memory"); }
    }
};

__device__ __forceinline__ float dpp_prev(float oldv, float v) { return __int_as_float(__builtin_amdgcn_update_dpp(__float_as_int(oldv), __float_as_int(v), 0x111, 0xf, 0xf, false)); }
__device__ __forceinline__ float dpp_next(float oldv, float v) { return __int_as_float(__builtin_amdgcn_update_dpp(__float_as_int(oldv), __float_as_int(v), 0x101, 0xf, 0xf, false)); }
__device__ __forceinline__ float dpp_ror1(float v)  { return __int_as_float(__builtin_amdgcn_update_dpp(0, __float_as_int(v), 0x121, 0xf, 0xf, false)); }
__device__ __forceinline__ float dpp_ror15(float v) { return __int_as_float(__builtin_amdgcn_update_dpp(0, __float_as_int(v), 0x12F, 0xf, 0xf, false)); }
__device__ __forceinline__ float gelu_tanh_(float x) { const float y = 0.7978845608028654f * (x + 0.044715f * x * x * x); return x * sigmoidf_(2.0f * y); }
struct EpiConv {
    bf16_t* ACT; const float* cw; const float* cbias; float* EDGEU; float* PARTP; float* PARTG; LAS unsigned char* xl;
    __device__ __forceinline__ void operator()(EPI_ARGS) const {
#define UU(ai, m, e) acc[ai][0][m][(e) >> 2][(e) & 3]
#define GG(ai, m, e) acc[ai][1][m][(e) >> 2][(e) & 3]
        const int c0 = u.pn * 128 + wc * 32 + 8 * fq;
        float w0[8], w1[8], w2[8], cb[8];
        { const f32x4* wp = (const f32x4*)(cw + c0); const f32x4 a0 = wp[0], a1 = wp[1], b0 = wp[DFF / 4], b1 = wp[DFF / 4 + 1], d0 = wp[2 * DFF / 4], d1 = wp[2 * DFF / 4 + 1];
          const f32x4* bp = (const f32x4*)(cbias + c0); const f32x4 e0 = bp[0], e1 = bp[1];
#pragma unroll
          for (int e = 0; e < 4; ++e) { w0[e] = a0[e]; w0[4 + e] = a1[e]; w1[e] = b0[e]; w1[4 + e] = b1[e]; w2[e] = d0[e]; w2[4 + e] = d1[e]; cb[e] = e0[e]; cb[4 + e] = e1[e]; } }
        LAS float* XE = (LAS float*)xl;
#pragma unroll
        for (int ai = 0; ai < 2; ++ai) { const int blk = 2 * ai + wr;
            if (fr == 0) {
#pragma unroll
                for (int e = 0; e < 8; ++e) XE[((blk * 2 + 0) * 4 + wc) * 32 + fq * 8 + e] = UU(ai, 0, e); }
            if (fr == 15) {
#pragma unroll
                for (int e = 0; e < 8; ++e) XE[((blk * 2 + 1) * 4 + wc) * 32 + fq * 8 + e] = UU(ai, 3, e); } }
        if (wr == 0 && fr == 0) { float* ep = EDGEU + (size_t)(u.pm * 2 + 0) * DFF + c0; *(f32x4*)ep = acc[0][0][0][0]; *(f32x4*)(ep + 4) = acc[0][0][0][1]; }
        if (wr == 1 && fr == 15) { float* ep = EDGEU + (size_t)(u.pm * 2 + 1) * DFF + c0; *(f32x4*)ep = acc[1][0][3][0]; *(f32x4*)(ep + 4) = acc[1][0][3][1]; }
        asm volatile("s_waitcnt lgkmcnt(0)" ::: "memory"); __builtin_amdgcn_s_barrier(); asm volatile("" ::: "memory");
#pragma unroll
        for (int ai = 0; ai < 2; ++ai) { const int blk = 2 * ai + wr;
#pragma unroll
            for (int m = 0; m < 4; ++m) { const int row = u.pm * BM + ai * HALF + wr * 64 + m * 16 + fr;
                float pre[8], r[8], ex[8];
#pragma unroll
                for (int e = 0; e < 8; ++e) ex[e] = 0.f;
                if (m == 0 && blk > 0 && fr == 0) {
#pragma unroll
                    for (int e = 0; e < 8; ++e) ex[e] = XE[(((blk - 1) * 2 + 1) * 4 + wc) * 32 + fq * 8 + e]; }
                if (m == 3 && blk < 3 && fr == 15) {
#pragma unroll
                    for (int e = 0; e < 8; ++e) ex[e] = XE[(((blk + 1) * 2 + 0) * 4 + wc) * 32 + fq * 8 + e]; }
#pragma unroll
                for (int e = 0; e < 8; ++e) { const float uc = UU(ai, m, e);
                    const float oldp = (m == 0) ? ex[e] : dpp_ror1(UU(ai, m == 0 ? 0 : m - 1, e));
                    const float oldn = (m == 3) ? ex[e] : dpp_ror15(UU(ai, m == 3 ? 3 : m + 1, e));
                    const float up_ = dpp_prev(oldp, uc), un_ = dpp_next(oldn, uc);
                    pre[e] = cb[e] + w0[e] * up_ + w1[e] * uc + w2[e] * un_; r[e] = gelu_tanh_(pre[e]) * GG(ai, m, e); }
                const bool edge0 = (blk == 0 && m == 0 && fr == 0), edge1 = (blk == 3 && m == 3 && fr == 15);
                if (edge0 || edge1) { const size_t o = (size_t)(u.pm * 2 + (edge1 ? 1 : 0)) * DFF + c0;
                    *(f32x4*)(PARTP + o) = (f32x4){pre[0], pre[1], pre[2], pre[3]}; *(f32x4*)(PARTP + o + 4) = (f32x4){pre[4], pre[5], pre[6], pre[7]};
                    *(f32x4*)(PARTG + o) = acc[ai][1][m][0]; *(f32x4*)(PARTG + o + 4) = acc[ai][1][m][1]; }
                else { u32x4 w; w.x = cvt_pk_bf16(r[0], r[1]); w.y = cvt_pk_bf16(r[2], r[3]); w.z = cvt_pk_bf16(r[4], r[5]); w.w = cvt_pk_bf16(r[6], r[7]);
                    *(u32x4*)(ACT + (size_t)row * DFF + c0) = w; }
                asm volatile("" ::: "memory"); }
        }
#undef UU
#undef GG
    }
};

struct EpiAny {
    int kind;
    unsigned char* ws;
    int S, Sshift, seqbase, goff, rmode; const float* base; const float* cw; const float* cbias; LAS unsigned char* xl;
    __device__ __forceinline__ void operator()(EPI_ARGS) const {
        if (kind == 0) { EpiStore e{(bf16_t*)(ws + WS_Z), ZLD, 12}; e(acc, u, wr, wc, fr, fq); }
        else if (kind == 1) { EpiQ e{(bf16_t*)(ws + WS_Q), (const float*)(ws + WS_RSTD), (const float*)(ws + WS_ROPE), S, Sshift}; e(acc, u, wr, wc, fr, fq); }
        else if (kind == 2) { EpiKV e{(bf16_t*)(ws + WS_KF), (bf16_t*)(ws + WS_V), (const float*)(ws + WS_RSTD), S, Sshift}; e(acc, u, wr, wc, fr, fq); }
        else if (kind == 3) { EpiGateA e{(bf16_t*)(ws + WS_T), (const bf16_t*)(ws + WS_Z)}; e(acc, u, wr, wc, fr, fq); }
        else if (kind == 4) { EpiGateB e{(const bf16_t*)(ws + WS_T), (const bf16_t*)(ws + WS_Z), (bf16_t*)(ws + WS_MERGED)}; e(acc, u, wr, wc, fr, fq); }
        else if (kind == 5) { EpiResid e{base, nullptr, (const float*)(ws + WS_MOD), goff, Sshift, seqbase, rmode, (bf16_t*)(ws + WS_OA)}; e(acc, u, wr, wc, fr, fq); }
        else { float* ed = (float*)(ws + WS_EDGE); EpiConv e{(bf16_t*)(ws + WS_ACT), cw, cbias, ed, ed + 128 * DFF, ed + 256 * DFF, xl}; e(acc, u, wr, wc, fr, fq); }
    }
};
}

__device__ const float ROPE_INV[16] = {1.000000000e+00f, 5.623413324e-01f, 3.162277639e-01f, 1.778279394e-01f, 1.000000015e-01f, 5.623413250e-02f, 3.162277490e-02f, 1.778279431e-02f,
                                       9.999999776e-03f, 5.623413250e-03f, 3.162277630e-03f, 1.778279431e-03f, 1.000000047e-03f, 5.623413017e-04f, 3.162277571e-04f, 1.778279402e-04f};
__device__ __forceinline__ int perm_rope(int i) { return i < 16 ? 2 * i : 2 * (i - 16) + 1; }
__device__ __forceinline__ int rowmap(int kind, int n) {
    if (kind == 1) return n < 640 ? n : (n < 672 ? 640 + perm_rope(n - 640) : n + 96);
    if (kind == 2) { const int h = n / 96, c = n - h * 96; return c < 64 ? n : h * 96 + 64 + perm_rope(c - 64); }
    if (kind == 3) { const int h = n >> 7, c = n & 127; return c < 64 ? h * 64 + c : 1024 + h * 64 + (c - 64); }
    if (kind == 4) { const int f = n < DFF ? n : n - DFF; return (f >> 7) * 256 + (n < DFF ? 0 : 128) + (f & 127); }
    return n;
}
__device__ __forceinline__ void transpose_item(const float* W, int K, int N, bf16_t* WT, int kind, const float* ks, LAS float* scr, int item, int lane) {
    const int nblk = N / 32, kb = item / nblk, nb = item - kb * nblk, k0 = 64 * kb, n0 = 32 * nb;
#pragma unroll 8
    for (int i = 0; i < 32; ++i) { const int kk = 2 * i + (lane >> 5); float w = W[(size_t)(k0 + kk) * N + n0 + (lane & 31)]; if (ks) w *= ks[k0 + kk]; scr[kk * 33 + (lane & 31)] = w; }
    asm volatile("s_waitcnt lgkmcnt(0)" ::: "memory");
    const int c = lane & 7;
#pragma unroll
    for (int j = 0; j < 4; ++j) { const int n = (lane >> 3) + 8 * j; const LAS float* s = scr + (8 * c) * 33 + n;
        u32x4 o; o.x = cvt_pk_bf16(s[0 * 33], s[1 * 33]); o.y = cvt_pk_bf16(s[2 * 33], s[3 * 33]); o.z = cvt_pk_bf16(s[4 * 33], s[5 * 33]); o.w = cvt_pk_bf16(s[6 * 33], s[7 * 33]);
        *(u32x4*)(WT + (size_t)rowmap(kind, n0 + n) * K + k0 + 8 * c) = o; }
    asm volatile("s_waitcnt lgkmcnt(0)" ::: "memory");
}

__device__ __forceinline__ void norm_mod_row(const float* xrow, bf16_t* orow, const float* g, const float* sc, const float* sh, int lane) {
    const f32x4* xr = (const f32x4*)xrow + lane; f32x4 v[4]; float s = 0.f;
#pragma unroll
    for (int j = 0; j < 4; ++j) { v[j] = xr[64 * j]; s += (v[j].x * v[j].x + v[j].y * v[j].y) + (v[j].z * v[j].z + v[j].w * v[j].w); }
    const float rstd = 1.0f / sqrtf(wave_sum(s) * (1.f / D) + EPS);
    u32x2* o8 = (u32x2*)orow + lane;
#pragma unroll
    for (int j = 0; j < 4; ++j) { const f32x4 gg = ((const f32x4*)g)[lane + 64 * j], ss = ((const f32x4*)sc)[lane + 64 * j], hh = ((const f32x4*)sh)[lane + 64 * j];
        const f32x4 o = v[j] * rstd * gg * (ss + 1.0f) + hh; u32x2 w; w.x = cvt_pk_bf16(o.x, o.y); w.y = cvt_pk_bf16(o.z, o.w); o8[64 * j] = w; }
}
__device__ __forceinline__ void norm_mod_row16(const bf16_t* xrow, bf16_t* orow, const float* g, const float* sc, const float* sh, int lane) {
    const u32x2* xr = (const u32x2*)xrow + lane; f32x4 v[4]; float s = 0.f;
#pragma unroll
    for (int j = 0; j < 4; ++j) { const u32x2 w = xr[64 * j]; v[j] = (f32x4){bflo(w.x), bfhi(w.x), bflo(w.y), bfhi(w.y)}; s += (v[j].x * v[j].x + v[j].y * v[j].y) + (v[j].z * v[j].z + v[j].w * v[j].w); }
    const float rstd = 1.0f / sqrtf(wave_sum(s) * (1.f / D) + EPS);
    u32x2* o8 = (u32x2*)orow + lane;
#pragma unroll
    for (int j = 0; j < 4; ++j) { const f32x4 gg = ((const f32x4*)g)[lane + 64 * j], ss = ((const f32x4*)sc)[lane + 64 * j], hh = ((const f32x4*)sh)[lane + 64 * j];
        const f32x4 o = v[j] * rstd * gg * (ss + 1.0f) + hh; u32x2 w; w.x = cvt_pk_bf16(o.x, o.y); w.y = cvt_pk_bf16(o.z, o.w); o8[64 * j] = w; }
}
__device__ __forceinline__ void final_norm_row(const bf16_t* xin, float* xrow, const float* g, int lane) {
    f32x4* xr = (f32x4*)xrow + lane; const u32x2* xi = (const u32x2*)xin + lane; f32x4 v[4]; float s = 0.f;
#pragma unroll
    for (int j = 0; j < 4; ++j) { const u32x2 w = xi[64 * j]; v[j] = (f32x4){bflo(w.x), bfhi(w.x), bflo(w.y), bfhi(w.y)}; s += (v[j].x * v[j].x + v[j].y * v[j].y) + (v[j].z * v[j].z + v[j].w * v[j].w); }
    const float rstd = 1.0f / sqrtf(wave_sum(s) * (1.f / D) + EPS);
#pragma unroll
    for (int j = 0; j < 4; ++j) xr[64 * j] = v[j] * rstd * ((const f32x4*)g)[lane + 64 * j];
}

__device__ __forceinline__ void dil_task(const bf16_t* Z, float* OG, float* LSE, int S, int task, LAS unsigned char* wl, int lane_in) {
    int lane = lane_in; asm volatile("" : "+v"(lane));
    const int r32 = lane & 31, hi = lane >> 5;
    const int bps = S >> 5, tps = 12 * bps;
    const int seq = task / tps; const int rem = task - seq * tps; const int hd = rem / bps; const int blk = rem - hd * bps;
    const int g = hd >> 2, sh = 2 * g, dl = 1 << sh; const int r = blk & (dl - 1), bi = blk >> sh;
    const int i0 = bi * 32, nsub = S >> sh;
    const size_t rowbase = (size_t)seq * S;
    const int tq = r + ((i0 + r32) << sh);
    const bf16_t* qp = Z + (rowbase + tq) * ZLD + 768 + hd * 64 + 8 * hi;
    bf16x8 qf[4];
#pragma unroll
    for (int s = 0; s < 4; ++s) qf[s] = *(const bf16x8*)(qp + 16 * s);
    f32x16 sc[5];
#pragma unroll
    for (int c = 0; c < 5; ++c) {
        int ik = i0 - 64 + 32 * c + r32; ik = ik < 0 ? 0 : (ik > nsub - 1 ? nsub - 1 : ik);
        const bf16_t* kp = Z + (rowbase + r + ((size_t)ik << sh)) * ZLD + 1536 + hd * 64 + 8 * hi;
        bf16x8 kf[4];
#pragma unroll
        for (int s = 0; s < 4; ++s) kf[s] = *(const bf16x8*)(kp + 16 * s);
        f32x16 a = {};
#pragma unroll
        for (int s = 0; s < 4; ++s) a = __builtin_amdgcn_mfma_f32_32x32x16_bf16(kf[s], qf[s], a, 0, 0, 0);
        sc[c] = a;
        asm volatile("" ::: "memory");
    }
    const float cb = __builtin_amdgcn_exp2f(-0.6666666667f * (float)(hd + 1)) * LOG2E * (float)dl;
    float mx = -INFINITY;
#pragma unroll
    for (int c = 0; c < 5; ++c)
#pragma unroll
        for (int e = 0; e < 16; ++e) {
            const int kvl = 32 * c + (e & 3) + 8 * (e >> 2) + 4 * hi; const int delta = kvl - 64 - r32; const int ik = i0 + r32 + delta;
            const int ad = delta < 0 ? -delta : delta; const bool valid = (ad <= 64) && (ik >= 0) && (ik < nsub);
            float v = sc[c][e] * DSCALE - cb * (float)ad; v = valid ? v : -INFINITY; sc[c][e] = v; mx = fmaxf(mx, v);
        }
    mx = swap_max(mx);
    float ls = 0.f;
#pragma unroll
    for (int c = 0; c < 5; ++c)
#pragma unroll
        for (int e = 0; e < 16; ++e) { const float p = __builtin_amdgcn_exp2f(sc[c][e] - mx); sc[c][e] = p; ls += p; }
    ls = swap_add(ls);
    f32x16 o0 = {}, o1 = {};
    const int vb = ((lane >> 4) & 1) * 32 + (lane & 3) * 8 + (4 * hi + ((lane & 15) >> 2)) * 64;
#pragma unroll
    for (int c = 0; c < 5; ++c) {
        u32x4 vv[4];
#pragma unroll
        for (int i = 0; i < 4; ++i) { const int row = (lane >> 3) + 8 * i; int ik = i0 - 64 + 32 * c + row; ik = ik < 0 ? 0 : (ik > nsub - 1 ? nsub - 1 : ik);
            vv[i] = *(const u32x4*)(Z + (rowbase + r + ((size_t)ik << sh)) * ZLD + 2304 + hd * 64 + (lane & 7) * 8); }
        asm volatile("s_waitcnt lgkmcnt(0)" ::: "memory");
#pragma unroll
        for (int i = 0; i < 4; ++i) { const int row = (lane >> 3) + 8 * i; *(LAS u32x4*)(wl + ((lane & 7) >> 2) * 2048 + row * 64 + (lane & 3) * 16) = vv[i]; }
        asm volatile("s_waitcnt lgkmcnt(0)" ::: "memory");
#pragma unroll
        for (int s = 0; s < 2; ++s) {
            u32x4 pw; pw.x = cvt_pk_bf16(sc[c][8 * s + 0], sc[c][8 * s + 1]); pw.y = cvt_pk_bf16(sc[c][8 * s + 2], sc[c][8 * s + 3]); pw.z = cvt_pk_bf16(sc[c][8 * s + 4], sc[c][8 * s + 5]); pw.w = cvt_pk_bf16(sc[c][8 * s + 6], sc[c][8 * s + 7]);
            const bf16x8 pf = __builtin_bit_cast(bf16x8, pw);
            { const s16x4 lo = vtr(wl + vb + s * 1024), hh = vtr(wl + vb + s * 1024 + 512); const bf16x8 vf = {lo[0], lo[1], lo[2], lo[3], hh[0], hh[1], hh[2], hh[3]};
              o0 = __builtin_amdgcn_mfma_f32_32x32x16_bf16(vf, pf, o0, 0, 0, 0); }
            { const s16x4 lo = vtr(wl + vb + 2048 + s * 1024), hh = vtr(wl + vb + 2048 + s * 1024 + 512); const bf16x8 vf = {lo[0], lo[1], lo[2], lo[3], hh[0], hh[1], hh[2], hh[3]};
              o1 = __builtin_amdgcn_mfma_f32_32x32x16_bf16(vf, pf, o1, 0, 0, 0); }
        }
    }
    const float inv = 1.0f / ls; const size_t rq = rowbase + tq;
    float* op = OG + (rq * 12 + hd) * 64 + 4 * hi;
#pragma unroll
    for (int i = 0; i < 4; ++i) {
        *(f32x4*)(op + 8 * i) = (f32x4){o0[4 * i] * inv, o0[4 * i + 1] * inv, o0[4 * i + 2] * inv, o0[4 * i + 3] * inv};
        *(f32x4*)(op + 32 + 8 * i) = (f32x4){o1[4 * i] * inv, o1[4 * i + 1] * inv, o1[4 * i + 2] * inv, o1[4 * i + 3] * inv};
    }
    if (hi == 0) LSE[rq * 12 + hd] = (mx + __builtin_amdgcn_logf(ls)) * LN2;
}

namespace mla {
constexpr int KPITCH = 208, KBYTES = 64 * KPITCH, VBYTES = 8192, BUF = KBYTES + VBYTES, QOFF = 2 * BUF, DUMMY = QOFF + 8 * 12288;
#define MLA_PACK(P, b) (u32x4){cvt_pk_bf16(P[b], P[b + 1]), cvt_pk_bf16(P[b + 2], P[b + 3]), cvt_pk_bf16(P[b + 4], P[b + 5]), cvt_pk_bf16(P[b + 6], P[b + 7])}
#define SGB(mask, n) __builtin_amdgcn_sched_group_barrier(mask, n, 0)
__device__ __forceinline__ float max2_(float a, float b) { return __builtin_amdgcn_fmed3f(a, b, INFINITY); }
constexpr float THR = 8.0f;
__device__ __forceinline__ void softmax_blk(f32x16& p0, f32x16& p1, f32x16& o0, f32x16& o1, float& mhat, float& lrun, u32x4 (&pf)[4], bool first) {
    float r0 = max2_(p0[0], p0[1]), r1 = max2_(p1[0], p1[1]);
#pragma unroll
    for (int e = 2; e < 16; ++e) { r0 = max2_(r0, p0[e]); r1 = max2_(r1, p1[e]); }
    const float rm = swap_max(max2_(r0, r1));
    if (first || __any(rm - mhat > THR)) {
        const float mn = first ? rm : fmaxf(rm, mhat); const float f = first ? 0.f : __builtin_amdgcn_exp2f(mhat - mn); mhat = mn; lrun *= f;
#pragma unroll
        for (int e = 0; e < 16; ++e) { o0[e] *= f; o1[e] *= f; }
    }
    float s0 = 0.f, s1 = 0.f;
#pragma unroll
    for (int e = 0; e < 16; ++e) { p0[e] = __builtin_amdgcn_exp2f(p0[e] - mhat); p1[e] = __builtin_amdgcn_exp2f(p1[e] - mhat); s0 += p0[e]; s1 += p1[e]; }
    lrun += s0 + s1;
    pf[0] = MLA_PACK(p0, 0); pf[1] = MLA_PACK(p0, 8); pf[2] = MLA_PACK(p1, 0); pf[3] = MLA_PACK(p1, 8);
}
__device__ __forceinline__ void pv_blk(const u32x4 (&pf)[4], f32x16& o0, f32x16& o1, LAS const unsigned char* vbase) {
#pragma unroll
    for (int ks = 0; ks < 4; ++ks) {
        const bf16x8 p = __builtin_bit_cast(bf16x8, pf[ks]);
        { const s16x4 lo = vtr(vbase + ks * 1024), hh = vtr(vbase + ks * 1024 + 512); const bf16x8 vf = {lo[0], lo[1], lo[2], lo[3], hh[0], hh[1], hh[2], hh[3]};
          o0 = __builtin_amdgcn_mfma_f32_32x32x16_bf16(vf, p, o0, 0, 0, 0); }
        { const s16x4 lo = vtr(vbase + 4096 + ks * 1024), hh = vtr(vbase + 4096 + ks * 1024 + 512); const bf16x8 vf = {lo[0], lo[1], lo[2], lo[3], hh[0], hh[1], hh[2], hh[3]};
          o1 = __builtin_amdgcn_mfma_f32_32x32x16_bf16(vf, p, o1, 0, 0, 0); }
    }
}
__device__ __forceinline__ void store_o(bf16_t* op, const f32x16& o0, const f32x16& o1, float inv) {
#pragma unroll
    for (int i = 0; i < 4; ++i) {
        u32x2 w0; w0.x = cvt_pk_bf16(o0[4 * i] * inv, o0[4 * i + 1] * inv); w0.y = cvt_pk_bf16(o0[4 * i + 2] * inv, o0[4 * i + 3] * inv); *(u32x2*)(op + 8 * i) = w0;
        u32x2 w1; w1.x = cvt_pk_bf16(o1[4 * i] * inv, o1[4 * i + 1] * inv); w1.y = cvt_pk_bf16(o1[4 * i + 2] * inv, o1[4 * i + 3] * inv); *(u32x2*)(op + 32 + 8 * i) = w1;
    }
}
__device__ __forceinline__ void attn_unit(const bf16_t* Qh, const bf16_t* Kh, const bf16_t* Vh, bf16_t* Oh  , int S, int qb, LAS unsigned char* lds, int tid) {
    const int lane = tid & 63, r32 = lane & 31, hi = lane >> 5; const int wid = __builtin_amdgcn_readfirstlane(tid >> 6);
    const int qrow = qb * 512 + wid * 64 + r32;
    const bf16_t* Qw = Qh + (size_t)qrow * 96 + 8 * hi;
    LAS unsigned char* ql = lds + QOFF + wid * 12288 + lane * 16;
#pragma unroll
    for (int s = 0; s < 6; ++s) { *(LAS bf16x8*)(ql + s * 1024) = *(const bf16x8*)(Qw + 16 * s); *(LAS bf16x8*)(ql + (6 + s) * 1024) = *(const bf16x8*)(Qw + 32 * 96 + 16 * s); }
    const bool has1 = tid < 256; const int kc0 = tid, kc1 = has1 ? tid + 512 : tid;
    const unsigned kd0 = (unsigned)((kc0 / 12) * KPITCH + (kc0 % 12) * 16);
    const unsigned kd1 = has1 ? (unsigned)((kc1 / 12) * KPITCH + (kc1 % 12) * 16) : (unsigned)(DUMMY + (tid - 256) * 16);
    const unsigned kd1n = has1 ? BUF : 0u;
    const unsigned vd = (unsigned)(KBYTES + ((tid & 7) >> 2) * 4096 + (tid >> 3) * 64 + (tid & 3) * 16);
    const u32x4* Kg = (const u32x4*)Kh; const u32x4* Vg = (const u32x4*)Vh;
    const int NT = S >> 6;
    u32x4 ka = Kg[kc0], kb = Kg[kc1], va = Vg[tid];
    *(LAS u32x4*)(lds + kd0) = ka; *(LAS u32x4*)(lds + kd1) = kb; *(LAS u32x4*)(lds + vd) = va;
    __syncthreads();
    f32x16 oa0 = {}, oa1 = {}, ob0 = {}, ob1 = {}; float ma = 0.f, la = 0.f, mb = 0.f, lb = 0.f;
    const unsigned kfo = (unsigned)(r32 * KPITCH + hi * 16);
    const unsigned vb = (unsigned)(KBYTES + ((lane >> 4) & 1) * 32 + (lane & 3) * 8 + (4 * hi + ((lane & 15) >> 2)) * 64);
    for (int t = 0; t < NT; ++t) {
        const unsigned cur = (unsigned)(t & 1) * BUF, nxt = BUF - cur;
        const int tn = t + 1 < NT ? t + 1 : t;
        ka = Kg[(size_t)tn * 768 + kc0]; kb = Kg[(size_t)tn * 768 + kc1]; va = Vg[(size_t)tn * 512 + tid];
        u32x4 pf[4];
        {
            f32x16 p0 = {}, p1 = {};
#pragma unroll
            for (int s = 0; s < 6; ++s) {
                const bf16x8 a0 = *(const LAS bf16x8*)(lds + cur + kfo + s * 32), a1 = *(const LAS bf16x8*)(lds + cur + kfo + 32 * KPITCH + s * 32);
                const bf16x8 q = *(const LAS bf16x8*)(ql + s * 1024);
                p0 = __builtin_amdgcn_mfma_f32_32x32x16_bf16(a0, q, p0, 0, 0, 0); p1 = __builtin_amdgcn_mfma_f32_32x32x16_bf16(a1, q, p1, 0, 0, 0);
            }
            softmax_blk(p0, p1, oa0, oa1, ma, la, pf, t == 0);
            pv_blk(pf, oa0, oa1, lds + cur + vb);
        }
        __builtin_amdgcn_sched_barrier(0);
        {
            f32x16 p0 = {}, p1 = {};
#pragma unroll
            for (int s = 0; s < 6; ++s) {
                const bf16x8 a0 = *(const LAS bf16x8*)(lds + cur + kfo + s * 32), a1 = *(const LAS bf16x8*)(lds + cur + kfo + 32 * KPITCH + s * 32);
                const bf16x8 q = *(const LAS bf16x8*)(ql + (6 + s) * 1024);
                p0 = __builtin_amdgcn_mfma_f32_32x32x16_bf16(a0, q, p0, 0, 0, 0); p1 = __builtin_amdgcn_mfma_f32_32x32x16_bf16(a1, q, p1, 0, 0, 0);
            }
            softmax_blk(p0, p1, ob0, ob1, mb, lb, pf, t == 0);
            pv_blk(pf, ob0, ob1, lds + cur + vb);
        }
        *(LAS u32x4*)(lds + nxt + kd0) = ka; *(LAS u32x4*)(lds + (has1 ? nxt : 0u) + kd1) = kb; *(LAS u32x4*)(lds + nxt + vd) = va;
        __syncthreads();
    }
    bf16_t* op = Oh + (size_t)qrow * D + 4 * hi;
    store_o(op, oa0, oa1, 1.0f / swap_add(la));
    store_o(op + 32 * D, ob0, ob1, 1.0f / swap_add(lb));
}
#undef SGB
}

#define XB_TMO      128
#define XB_XCNT(j)  (256  + 64 * (j))
#define XB_XSUB(j)  (1280 + 64 * (j))
#define XB_XGEN(j)  (2304 + 64 * (j))
#define XB_TOP      3328
#define XB_TOPGEN   3392
#define XCD_BAR_WORDS 3456
#define XB_SPIN_CAP (1u << 20)
__device__ __forceinline__ unsigned xb_ld(unsigned* p)              { return __hip_atomic_load(p, __ATOMIC_RELAXED, __HIP_MEMORY_SCOPE_AGENT); }
__device__ __forceinline__ unsigned xb_add(unsigned* p, unsigned v) { return __hip_atomic_fetch_add(p, v, __ATOMIC_RELAXED, __HIP_MEMORY_SCOPE_AGENT); }
__device__ __forceinline__ unsigned xb_xcc_id() { return (unsigned)__builtin_amdgcn_s_getreg((3 << 11) | 20) & 0xFu; }
#define XB_SPIN(cond, bar) do { unsigned _sp = 0; while (cond) { __builtin_amdgcn_s_sleep(1); \
    if ((++_sp & 255u) == 0u) { if (xb_ld(&(bar)[XB_TMO])) break; if (_sp > XB_SPIN_CAP) { atomicAdd(&(bar)[XB_TMO], 1u); break; } } } } while (0)
struct XcdBarrier { unsigned* bar; unsigned x; volatile LAS unsigned* st; };
__device__ __forceinline__ XcdBarrier xcd_barrier_post(unsigned* bar, volatile LAS unsigned* st, int tid) {
    XcdBarrier b; b.bar = bar; b.x = xb_xcc_id(); b.st = st;
    if (tid == 0) (void)xb_add(&bar[XB_XCNT(b.x)], 1u);
    return b;
}
__device__ __forceinline__ void xcd_barrier_complete(unsigned* bar, unsigned x, unsigned& nloc, unsigned& nx) {
    const unsigned G = gridDim.x * gridDim.y * gridDim.z;
    unsigned sum, cnt, mine, sp = 0u;
    for (;;) {
        sum = 0u; cnt = 0u; mine = 0u;
#pragma unroll
        for (unsigned j = 0; j < 16; ++j) { const unsigned c = xb_ld(&bar[XB_XCNT(j)]); sum += c; cnt += (c > 0u) ? 1u : 0u; mine = (j == x) ? c : mine; }
        if (sum == G) break;
        __builtin_amdgcn_s_sleep(1);
        if ((++sp & 255u) == 0u) { if (xb_ld(&bar[XB_TMO])) break; if (sp > XB_SPIN_CAP) { atomicAdd(&bar[XB_TMO], 1u); break; } }
    }
    nloc = mine > 0u ? mine : 1u; nx = cnt > 0u ? cnt : 1u;
}
__device__ __forceinline__ void xcd_barrier(const XcdBarrier& b, int tid) {
    asm volatile("s_waitcnt vmcnt(0)" ::: "memory");
    __syncthreads();
    if (tid == 0) {
        unsigned* bar = b.bar;
        __builtin_amdgcn_s_waitcnt(0);
        unsigned nloc = b.st[0], nx = b.st[1];
        if (nloc == 0u) { xcd_barrier_complete(bar, b.x, nloc, nx); b.st[0] = nloc; b.st[1] = nx; }
        const unsigned old = xb_add(&bar[XB_XSUB(b.x)], 1u);
        const unsigned gen = old / nloc;
        if (old + 1u == (gen + 1u) * nloc) {
            __builtin_amdgcn_fence(__ATOMIC_RELEASE, "agent");
            asm volatile("s_waitcnt vmcnt(0)" ::: "memory");
            const unsigned og = xb_add(&bar[XB_TOP], 1u);
            const unsigned tg = og / nx;
            if (og + 1u == (tg + 1u) * nx) xb_add(&bar[XB_TOPGEN], 1u);
            else XB_SPIN(xb_ld(&bar[XB_TOPGEN]) == tg, bar);
            __builtin_amdgcn_fence(__ATOMIC_ACQUIRE, "agent");
            xb_add(&bar[XB_XGEN(b.x)], 1u);
            asm volatile("s_waitcnt vmcnt(0)" ::: "memory");
        } else {
            XB_SPIN(xb_ld(&bar[XB_XGEN(b.x)]) == gen, bar);
            __builtin_amdgcn_fence(__ATOMIC_ACQUIRE, "agent");
            asm volatile("s_waitcnt vmcnt(0)" ::: "memory");
        }
    }
    __syncthreads();
}

constexpr int SPC = 13, NSTEP = 1 + SPC * NCHUNK + 1;
struct Args { const float* in[21]; float* out; unsigned char* ws; int ph_lo, ph_hi; };

__global__ void __launch_bounds__(512, 2) fwd_kernel(Args args) {
    extern __shared__ __attribute__((aligned(16))) unsigned char lds_raw[];
    LAS unsigned char* lds = (LAS unsigned char*)lds_raw;
    const int wave0 = __builtin_amdgcn_readfirstlane(threadIdx.x >> 6);
#if MEGA
    volatile LAS unsigned* bst = (volatile LAS unsigned*)(lds + LDS_BYTES - 16);
    if (threadIdx.x < 2) bst[threadIdx.x] = 0u;
    __syncthreads();
    XcdBarrier xbar = xcd_barrier_post((unsigned*)args.ws + 4096, bst, (int)threadIdx.x);
#endif
    for (int ph = args.ph_lo; ph < args.ph_hi; ++ph) {
    unsigned zl = 0u; asm volatile("" : "+s"(zl)); int wave_l = wave0; asm volatile("" : "+s"(wave_l));
    int tid_l = wave_l * 64 + (int)__builtin_amdgcn_mbcnt_hi(~0u, __builtin_amdgcn_mbcnt_lo(~0u, zl)); asm volatile("" : "+v"(tid_l));
    unsigned char* ws = args.ws; asm volatile("" : "+s"(ws));
    const int tid = tid_l, lane = tid & 63; const int wave = wave_l;
    const int G = gridDim.x, bx = blockIdx.x; const int vcu = (G % 8 == 0) ? (bx % 8) * (G / 8) + bx / 8 : bx;
    const int gw = vcu * 8 + wave, NGW = G * 8;
    bf16_t* Win_t = (bf16_t*)(ws + WS_WIN); bf16_t* Wuq_t = (bf16_t*)(ws + WS_WUQ); bf16_t* Wukv_t = (bf16_t*)(ws + WS_WUKV); bf16_t* Pa_t = (bf16_t*)(ws + WS_PA);
    bf16_t* Pb_t = (bf16_t*)(ws + WS_PB); bf16_t* Wout_t = (bf16_t*)(ws + WS_WOUT); bf16_t* Wup_t = (bf16_t*)(ws + WS_WUP); bf16_t* Wdown_t = (bf16_t*)(ws + WS_WDOWN);
    float* MOD = (float*)(ws + WS_MOD); float* ROPE = (float*)(ws + WS_ROPE); float* RSTD = (float*)(ws + WS_RSTD);
    bf16_t* Hb = (bf16_t*)(ws + WS_H); bf16_t* Zb = (bf16_t*)(ws + WS_Z); bf16_t* Qb = (bf16_t*)(ws + WS_Q); bf16_t* KFb = (bf16_t*)(ws + WS_KF); bf16_t* Vb = (bf16_t*)(ws + WS_V);
    bf16_t* OAb = (bf16_t*)(ws + WS_OA); bf16_t* OBb = (bf16_t*)(ws + WS_OB); float* OGb = (float*)(ws + WS_OG); float* LSEb = (float*)(ws + WS_LSE);
    bf16_t* Tb = (bf16_t*)(ws + WS_T); bf16_t* MGb = (bf16_t*)(ws + WS_MERGED); float* EDGEb = (float*)(ws + WS_EDGE); bf16_t* X1b = (bf16_t*)(ws + WS_OA); bf16_t* UPb = (bf16_t*)(ws + WS_UP); bf16_t* ACTb = (bf16_t*)(ws + WS_ACT);
    bool sync_after = true;
        if (ph == 0) {
            if (bx < 96) {
                LAS float* sl = (LAS float*)lds;
                LAS float* part = (LAS float*)(lds + 49152);
                for (int idx = tid; idx < 12 * 1024; idx += 512) { const int b = idx >> 10, d = idx & 1023; const float c = b < 8 ? args.in[2][b * 1024 + d] : args.in[3][(b - 8) * 1024 + d];
                    sl[d * 12 + b] = c / (1.0f + __expf(-c)); }
                __syncthreads();
                const int e = bx * 64 + lane; float acc[12];
#pragma unroll
                for (int b = 0; b < 12; ++b) acc[b] = 0.f;
                const float* wp = args.in[4] + (size_t)(wave * 128) * 6144 + e;
#pragma unroll 8
                for (int d = 0; d < 128; ++d) { const float w = wp[(size_t)d * 6144]; const LAS f32x4* s4 = (const LAS f32x4*)(sl + (wave * 128 + d) * 12);
                    const f32x4 a = s4[0], b4 = s4[1], c4 = s4[2];
                    acc[0] += a.x * w; acc[1] += a.y * w; acc[2] += a.z * w; acc[3] += a.w * w; acc[4] += b4.x * w; acc[5] += b4.y * w; acc[6] += b4.z * w; acc[7] += b4.w * w;
                    acc[8] += c4.x * w; acc[9] += c4.y * w; acc[10] += c4.z * w; acc[11] += c4.w * w; }
#pragma unroll
                for (int b = 0; b < 12; ++b) part[(wave * 12 + b) * 64 + lane] = acc[b];
                __syncthreads();
                if (wave == 0) {
#pragma unroll
                    for (int b = 0; b < 12; ++b) { float s = args.in[5][e];
#pragma unroll
                        for (int w = 0; w < 8; ++w) s += part[(w * 12 + b) * 64 + lane];
                        MOD[b * 6144 + e] = s; } }
                __syncthreads();
            }
            for (int idx = bx * 512 + tid; idx < 8192 * 16; idx += G * 512) { const int pos = idx >> 4, i = idx & 15; const float ang = (float)pos * ROPE_INV[i];
                const double tt = (double)ang * 0.15915494309189535; const float fr_ = (float)(tt - floor(tt));
                ROPE[idx] = __builtin_amdgcn_cosf(fr_); ROPE[131072 + idx] = __builtin_amdgcn_sinf(fr_); }
            {
                LAS float* scr = (LAS float*)(lds + wave * 16384);
                constexpr int I_IN = 16 * 157, I_UQ = 6 * 48, I_UKV = 4 * 64, I_PA = 16 * 32, I_PB = 4 * 32, I_OUT = 16 * 32, I_UP = 16 * 176, I_DOWN = 44 * 32;
                constexpr int NITEMS = I_IN + I_UQ + I_UKV + I_PA + I_PB + I_OUT + I_UP + I_DOWN;
                for (int it = gw; it < NITEMS; it += NGW) {
                    int r = it; const float* W; int K, N, kind = 0; bf16_t* WT; const float* ks = nullptr;
                    if (r < I_IN) { W = args.in[7]; K = 1024; N = 5024; WT = Win_t; kind = 1; }
                    else if ((r -= I_IN) < I_UQ) { W = args.in[10]; K = 384; N = 1536; WT = Wuq_t; kind = 2; ks = args.in[8]; }
                    else if ((r -= I_UQ) < I_UKV) { W = args.in[11]; K = 256; N = 2048; WT = Wukv_t; kind = 3; ks = args.in[9]; }
                    else if ((r -= I_UKV) < I_PA) { W = args.in[12]; K = 1024; N = 1024; WT = Pa_t; }
                    else if ((r -= I_PA) < I_PB) { W = args.in[13]; K = 256; N = 1024; WT = Pb_t; }
                    else if ((r -= I_PB) < I_OUT) { W = args.in[14]; K = 1024; N = 1024; WT = Wout_t; }
                    else if ((r -= I_OUT) < I_UP) { W = args.in[16]; K = 1024; N = 5632; WT = Wup_t; kind = 4; }
                    else { r -= I_UP; W = args.in[19]; K = 2816; N = 1024; WT = Wdown_t; }
                    transpose_item(W, K, N, WT, kind, ks, scr, r, lane);
                }
                for (int idx = bx * 512 + tid; idx < 96 * 128; idx += G * 512) *(u32x4*)(Win_t + (size_t)672 * 1024 + (size_t)idx * 8) = (u32x4){0u, 0u, 0u, 0u};
            }
            __syncthreads();
        } else if (ph == NSTEP - 1) {
            float* o = args.out + (size_t)(NCHUNK - 1) * CH * D;
            for (int m = gw; m < CH; m += NGW) final_norm_row(X1b + (size_t)m * D, o + (size_t)m * D, args.in[20], lane);
        } else {
            const int c = (ph - 1) / SPC, k = (ph - 1) - SPC * c;
            ChunkP P;
            if (c == 0) { P.x = args.in[0]; P.S = 2048; P.Sshift = 11; P.nseq = 8; P.seqbase = 0; }
            else { P.x = args.in[1] + (size_t)(c - 1) * CH * D; P.S = 8192; P.Sshift = 13; P.nseq = 2; P.seqbase = 8 + 2 * (c - 1); }
            P.out = args.out + (size_t)c * CH * D;
            sync_after = !(k == 3 || k == 6);
            pg8::Gemm g{}; pg8::EpiAny E{}; bool is_gemm = true;
            E.ws = ws; E.S = P.S; E.Sshift = P.Sshift; E.seqbase = P.seqbase;
            if (k == 1) { g = pg8::Gemm{Hb, Win_t, CH, ZLD, 1024, 1024}; E.kind = 0; }
            else if (k == 3) { g = pg8::Gemm{Zb, Wuq_t, CH, 1536, 384, ZLD}; E.kind = 1; }
            else if (k == 4) { g = pg8::Gemm{Zb + 384, Wukv_t, CH, 2048, 256, ZLD}; E.kind = 2; }
            else if (k == 6) { g = pg8::Gemm{OAb, Pa_t, CH, 1024, 1024, 1024}; E.kind = 3; }
            else if (k == 7) { g = pg8::Gemm{OBb, Pb_t, CH, 1024, 256, 256}; E.kind = 4; }
            else if (k == 8) { g = pg8::Gemm{MGb, Wout_t, CH, 1024, 1024, 1024}; E.kind = 5; E.base = P.x; E.goff = 2048; E.rmode = 0; }
            else if (k == 10) { g = pg8::Gemm{Hb, Wup_t, CH, NUP, 1024, 1024}; E.kind = 6; E.cw = args.in[17]; E.cbias = args.in[18]; E.xl = lds + 131072; }
            else if (k == 12) { g = pg8::Gemm{ACTb, Wdown_t, CH, 1024, DFF, DFF}; E.kind = 5; E.base = nullptr; E.goff = 5120; E.rmode = 1; }
            else is_gemm = false;
            if (is_gemm) { pg8::StaticOrder S; S.init(g.M, g.N, G, bx); pg8::gemm_phase(lds, g, S, E, tid); }
            else if (k == 0) {
                if (c > 0) { float* o = args.out + (size_t)(c - 1) * CH * D; for (int m = gw; m < CH; m += NGW) final_norm_row(X1b + (size_t)m * D, o + (size_t)m * D, args.in[20], lane); }
                for (int m = gw; m < CH; m += NGW) { const float* md = MOD + (size_t)(P.seqbase + (m >> P.Sshift)) * 6144;
                    norm_mod_row(P.x + (size_t)m * D, Hb + (size_t)m * D, args.in[6], md + 1024, md, lane); }
            } else if (k == 2) {
                for (int m = gw; m < CH; m += NGW) {
                    const unsigned* zr = (const unsigned*)(Zb + (size_t)m * ZLD);
                    float sq = 0.f, skv = 0.f;
#pragma unroll
                    for (int j = 0; j < 3; ++j) { const unsigned w = zr[lane + 64 * j]; const float a = bflo(w), b = bfhi(w); sq += a * a + b * b; }
#pragma unroll
                    for (int j = 0; j < 2; ++j) { const unsigned w = zr[192 + lane + 64 * j]; const float a = bflo(w), b = bfhi(w); skv += a * a + b * b; }
                    sq = wave_sum(sq); skv = wave_sum(skv);
                    if (lane == 0) { RSTD[2 * m] = 1.0f / sqrtf(sq * (1.f / 384.f) + EPS); RSTD[2 * m + 1] = 1.0f / sqrtf(skv * (1.f / 256.f) + EPS); }
                    const int seq = m >> P.Sshift, pos = m & (P.S - 1);
                    unsigned pr = 0u;
                    { const int i = lane & 15; const unsigned w = zr[320 + i]; const float a = bflo(w), b = bfhi(w); const float cs = ROPE[pos * 16 + i], sn = ROPE[131072 + pos * 16 + i];
                      pr = cvt_pk_bf16(a * cs - b * sn, a * sn + b * cs); }
                    u32x4 o; const int b4 = 4 * (lane & 3);
                    o.x = __shfl(pr, b4); o.y = __shfl(pr, b4 + 1); o.z = __shfl(pr, b4 + 2); o.w = __shfl(pr, b4 + 3);
                    const int head = lane >> 2;
                    *(u32x4*)(KFb + ((size_t)((seq * 16 + head) << P.Sshift) + pos) * 96 + 64 + 8 * (lane & 3)) = o;
                }
                LAS unsigned char* wl = lds + wave * 4096;
                for (int task = gw; task < CH * 12 / 32; task += NGW) dil_task(Zb, OGb, LSEb, P.S, task, wl, lane);
            } else if (k == 5) {
                for (int it = bx * 512 + tid; it < CH * 32; it += G * 512) { const int row = it >> 5, j = (it >> 3) & 3, d8 = (it & 7) * 8;
                    const float l0 = LSEb[row * 12 + j], l1 = LSEb[row * 12 + 4 + j], l2 = LSEb[row * 12 + 8 + j]; const float mx = fmaxf(l0, fmaxf(l1, l2));
                    float w0 = __expf(l0 - mx), w1 = __expf(l1 - mx), w2 = __expf(l2 - mx); const float inv = 1.0f / (w0 + w1 + w2); w0 *= inv; w1 *= inv; w2 *= inv;
                    const float* p0 = OGb + ((size_t)row * 12 + j) * 64 + d8; const float* p1 = p0 + 4 * 64; const float* p2 = p0 + 8 * 64;
                    const f32x4 a0 = *(const f32x4*)p0 * w0 + *(const f32x4*)p1 * w1 + *(const f32x4*)p2 * w2;
                    const f32x4 a1 = *(const f32x4*)(p0 + 4) * w0 + *(const f32x4*)(p1 + 4) * w1 + *(const f32x4*)(p2 + 4) * w2;
                    *(u32x4*)(OBb + (size_t)row * 256 + j * 64 + d8) = pg8::pack8(a0, a1); }
                const int nqb = P.S >> 9, nunits = P.nseq * 16 * nqb;
                for (int uidx = vcu; uidx < nunits; uidx += G) { const int pair = uidx / nqb, qb = uidx - pair * nqb; const int seq = pair >> 4, head = pair & 15;
                    const size_t hb = (size_t)pair << P.Sshift;
                    mla::attn_unit(Qb + hb * 96, KFb + hb * 96, Vb + hb * 64, OAb + ((size_t)seq << P.Sshift) * D + head * 64, P.S, qb, lds, tid); }
            } else if (k == 9) {
                for (int m = gw; m < CH; m += NGW) { const float* md = MOD + (size_t)(P.seqbase + (m >> P.Sshift)) * 6144;
                    norm_mod_row16(X1b + (size_t)m * D, Hb + (size_t)m * D, args.in[15], md + 4096, md + 3072, lane); }
            } else if (k == 11) {
                for (int it = bx * 512 + tid; it < 128 * 352; it += G * 512) {
                    const int r = it / 352, f0 = (it - r * 352) * 8; const int which = r & 1, pm = r >> 1; const int pos0 = (pm * 256) & (P.S - 1);
                    const bool has_nb = which == 0 ? (pos0 > 0) : (pos0 + 256 < P.S);
                    const float* nb = EDGEb + (size_t)(which == 0 ? (pm - 1) * 2 + 1 : (pm + 1) * 2) * DFF + f0;
                    const float* wv = args.in[17] + (which == 0 ? 0 : 2 * DFF) + f0;
                    const float* pp = EDGEb + (size_t)128 * DFF + (size_t)r * DFF + f0; const float* pg = EDGEb + (size_t)256 * DFF + (size_t)r * DFF + f0;
                    float o[8];
#pragma unroll
                    for (int h = 0; h < 2; ++h) { const f32x4 p4 = *(const f32x4*)(pp + 4 * h), g4 = *(const f32x4*)(pg + 4 * h), w4 = *(const f32x4*)(wv + 4 * h);
                        f32x4 n4 = (f32x4){0.f, 0.f, 0.f, 0.f}; if (has_nb) n4 = *(const f32x4*)(nb + 4 * h);
#pragma unroll
                        for (int e = 0; e < 4; ++e) o[4 * h + e] = pg8::gelu_tanh_(p4[e] + w4[e] * n4[e]) * g4[e]; }
                    u32x4 w; w.x = cvt_pk_bf16(o[0], o[1]); w.y = cvt_pk_bf16(o[2], o[3]); w.z = cvt_pk_bf16(o[4], o[5]); w.w = cvt_pk_bf16(o[6], o[7]);
                    *(u32x4*)(ACTb + (size_t)(pm * 256 + (which ? 255 : 0)) * DFF + f0) = w;
                }
            }
        }
#if MEGA
        if (sync_after && ph + 1 < args.ph_hi) { if (ph == 0) cg::this_grid().sync(); else { int tb = tid; asm volatile("" : "+v"(tb)); xcd_barrier(xbar, tb); } }
#else
        (void)sync_after;
#endif
    }
}

extern "C" void kernel_launch(void* const* d_in, const int* in_sizes, int n_in, void* d_out, int out_size, void* d_ws, size_t ws_size, hipStream_t stream) {
    static int grid = 0;
    if (grid == 0) {
        if (n_in != 21 || ws_size < WS_END) { fprintf(stderr, "kernel_launch: unexpected n_in %d / ws_size %zu\n", n_in, ws_size); grid = -1; return; }
        int dev = 0, cus = 0, per_cu = 0;
        (void)hipGetDevice(&dev); (void)hipDeviceGetAttribute(&cus, hipDeviceAttributeMultiprocessorCount, dev);
        (void)hipFuncSetAttribute((const void*)fwd_kernel, hipFuncAttributeMaxDynamicSharedMemorySize, LDS_BYTES);
        (void)hipOccupancyMaxActiveBlocksPerMultiprocessor(&per_cu, (const void*)fwd_kernel, 512, LDS_BYTES);
        (void)hipGetLastError();
        if (per_cu < 1) fprintf(stderr, "kernel_launch: occupancy query says %d blocks/CU\n", per_cu);
        grid = cus;
    }
    if (grid < 0) return;
    Args a{};
    for (int i = 0; i < 21; ++i) a.in[i] = (const float*)d_in[i];
    a.out = (float*)d_out; a.ws = (unsigned char*)d_ws;
#if MEGA
    (void)hipMemsetAsync(d_ws, 0, 65536, stream);
    a.ph_lo = 0; a.ph_hi = NSTEP;
    void* kargs[] = {&a};
    hipError_t e = hipLaunchCooperativeKernel((const void*)fwd_kernel, dim3(grid), dim3(512), kargs, LDS_BYTES, stream);
    if (e != hipSuccess) fprintf(stderr, "cooperative launch failed: %s (grid %d)\n", hipGetErrorString(e), grid);
#else
    for (int ph = 0; ph < NSTEP; ++ph) { a.ph_lo = ph; a.ph_hi = ph + 1; hipLaunchKernelGGL(fwd_kernel, dim3(grid), dim3(512), LDS_BYTES, stream, a);
#ifdef PROBE_DUP
        if (ph > 0 && ph < NSTEP - 1 && ((PROBE_DUP >> ((ph - 1) % SPC)) & 1)) hipLaunchKernelGGL(fwd_kernel, dim3(grid), dim3(512), LDS_BYTES, stream, a);
#endif
    }
#endif
}
```

```cpp
#include <hip/hip_runtime.h>
#include <hip/hip_cooperative_groups.h>
#include <cstdio>
#include <cstdint>
namespace cg = cooperative_groups;

#ifndef MEGA
#define MEGA 1
#endif

#define LAS __attribute__((address_space(3)))
typedef unsigned short bf16_t;
typedef short bf16x8 __attribute__((ext_vector_type(8)));
typedef short s16x4 __attribute__((ext_vector_type(4)));
typedef float f32x2 __attribute__((ext_vector_type(2)));
typedef float f32x4 __attribute__((ext_vector_type(4)));
typedef float f32x16 __attribute__((ext_vector_type(16)));
typedef unsigned u32x2 __attribute__((ext_vector_type(2)));
typedef unsigned u32x4 __attribute__((ext_vector_type(4)));

constexpr int D = 1024, CH = 16384, NCHUNK = 3, ZLD = 5120, NUP = 5632, DFF = 2816;

constexpr float EPS = 1e-6f, LOG2E = 1.4426950408889634f, LN2 = 0.6931471805599453f;
constexpr float QSCALE = 0.10206207261596577f * LOG2E;
constexpr float DSCALE = 0.125f * LOG2E;

constexpr size_t MiB = 1u << 20;
constexpr size_t WS_WIN = 2 * MiB, WS_WUQ = 12 * MiB, WS_WUKV = 14 * MiB, WS_PA = 15 * MiB, WS_PB = 17 * MiB, WS_WOUT = 18 * MiB,
                 WS_WUP = 20 * MiB, WS_WDOWN = 31 * MiB;
constexpr size_t WS_MOD = 37 * MiB, WS_ROPE = 38 * MiB  , WS_RSTD = 39 * MiB + 512 * 1024;
constexpr size_t WS_H = 40 * MiB, WS_Z = 72 * MiB, WS_Q = 232 * MiB, WS_KF = 280 * MiB, WS_V = 328 * MiB, WS_OA = 360 * MiB, WS_OB = 392 * MiB,
                 WS_OG = 400 * MiB, WS_LSE = 448 * MiB, WS_T = 232 * MiB, WS_MERGED = 296 * MiB, WS_UP = 72 * MiB, WS_ACT = 248 * MiB, WS_EDGE = 449 * MiB  , WS_END = 454 * MiB;

constexpr int LDS_BYTES = 147456;

__device__ __forceinline__ unsigned cvt_pk_bf16(float lo, float hi) { unsigned r; asm volatile("v_cvt_pk_bf16_f32 %0, %1, %2" : "=v"(r) : "v"(lo), "v"(hi)); return r; }
__device__ __forceinline__ float bf2f(unsigned short b) { return __uint_as_float((unsigned)b << 16); }
__device__ __forceinline__ float bflo(unsigned w) { return __uint_as_float(w << 16); }
__device__ __forceinline__ float bfhi(unsigned w) { return __uint_as_float(w & 0xffff0000u); }
__device__ __forceinline__ float wave_sum(float v) {
#pragma unroll
    for (int o = 1; o < 64; o <<= 1) v += __shfl_xor(v, o);
    return v;
}
__device__ __forceinline__ float swap_max(float m) { auto rr = __builtin_amdgcn_permlane32_swap(__float_as_uint(m), __float_as_uint(m), false, false); return fmaxf(__uint_as_float(rr[0]), __uint_as_float(rr[1])); }
__device__ __forceinline__ float swap_add(float m) { auto rr = __builtin_amdgcn_permlane32_swap(__float_as_uint(m), __float_as_uint(m), false, false); return __uint_as_float(rr[0]) + __uint_as_float(rr[1]); }
__device__ __forceinline__ s16x4 vtr(LAS const unsigned char* p) { return __builtin_bit_cast(s16x4, __builtin_amdgcn_ds_read_tr16_b64_v4i16((LAS s16x4*)p)); }
__device__ __forceinline__ float sigmoidf_(float x) { return __builtin_amdgcn_rcpf(1.0f + __builtin_amdgcn_exp2f(-x * LOG2E)); }

struct ChunkP { const float* x; float* out; int S, Sshift, nseq, seqbase; };

namespace pg8 {
constexpr int BM = 256, BK = 64, HALF = 128, HTB = HALF * BK * 2, STAGE_BYTES = 8 * HTB, NXCD = 8, WGM = 8;
__host__ __device__ __forceinline__ int lds_byte(int r, int c) { const int st = (r >> 4) * 2 + (c >> 5), rr = r & 15, cc = c & 31, ob = rr * 64 + cc * 2; return st * 1024 + (ob ^ (((ob >> 9) & 1) << 5)); }
__host__ __device__ __forceinline__ void stage_rc(int b, int& R, int& C) { const int st = b / 1024, sb = b % 1024, swz = sb ^ (((sb >> 9) & 1) << 5); R = (st >> 1) * 16 + swz / 64; C = (st & 1) * 32 + (swz % 64) / 2; }
__host__ __device__ __forceinline__ int perm32(int rho) { const int n = rho >> 4, i = rho & 15; return 8 * (i >> 2) + 4 * n + (i & 3); }
struct Unit { int pm, pn; };
struct Gemm { const bf16_t* A; const bf16_t* Bt; int M, N, K, lda; };
struct StaticOrder {
    int nM, nN, nwg, G, c;
    __device__ void init(int M, int N, int G_, int c_) { nM = M / BM; nN = N / BM; nwg = nM * nN; G = G_; c = c_; }
    __device__ bool next(int i, Unit& u) const {
        const long L = (long)i * G + c; if (L >= nwg) return false;
        int wgid = (int)L; { const int q = nwg / NXCD, r = nwg % NXCD, xcd = wgid % NXCD, off = wgid / NXCD; wgid = (xcd < r ? xcd * (q + 1) : r * (q + 1) + (xcd - r) * q) + off; }
        const int nig = WGM * nN, gid = wgid / nig, fm = gid * WGM, gsz = (nM - fm) < WGM ? (nM - fm) : WGM;
        u.pm = fm + ((wgid % nig) % gsz); u.pn = (wgid % nig) / gsz; return true;
    }
};

template <class Epi, class Sched>
__device__ __forceinline__ void gemm_phase(LAS unsigned char* lds, const Gemm g, const Sched& S, const Epi& E, int tid_in) {
    int tid_ = tid_in; asm volatile("" : "+v"(tid_));
    const int tid = tid_, wid = __builtin_amdgcn_readfirstlane(tid >> 6), lane = tid & 63, wr = wid >> 2, wc = wid & 3, fr = lane & 15, fq = lane >> 4;
    const int K = g.K, nt = K / BK, lda = g.lda;
    unsigned voffA[2], voffB[2];
#pragma unroll
    for (int i = 0; i < 2; ++i) { int R, C; stage_rc(tid * 16 + i * 8192, R, C); const int Rb = (R & ~31) + perm32(R & 31);
        voffA[i] = (unsigned)(R * lda + C) * 2u; voffB[i] = (unsigned)(Rb * K + C) * 2u; }
    const size_t kstep = (size_t)(BK * 2);
    const size_t hstepA = (size_t)HALF * lda * 2, hstepB = (size_t)HALF * K * 2;
    const size_t tstepA = 2 * hstepA, tstepB = 2 * hstepB;
    const unsigned ldsw = (unsigned)wid * 1024u;
    const int aoff = lds_byte(wr * 64 + fr, fq * 8), boff = lds_byte(wc * 32 + fr, fq * 8);
#define PG8_SA(b, h) (((b) * 2 + (h)) * HTB)
#define PG8_SB(b, h) ((4 + (b) * 2 + (h)) * HTB)
#define PG8_STAGE(bufoff, gbase, voff) do { _Pragma("unroll") for (int _i = 0; _i < 2; ++_i) \
        __builtin_amdgcn_global_load_lds((const unsigned*)((const char*)(gbase) + (voff)[_i]), (LAS unsigned*)(lds + (bufoff) + ldsw + _i * 8192), 16, 0, 0); } while (0)
#define PG8_LDA(dst, b, h) do { _Pragma("unroll") for (int m = 0; m < 4; ++m) _Pragma("unroll") for (int k = 0; k < 2; ++k) dst[m][k] = *(const LAS bf16x8*)(lds + PG8_SA(b, h) + aoff + m * 2048 + k * 1024); } while (0)
#define PG8_LDB(dst, b, h) do { _Pragma("unroll") for (int n = 0; n < 2; ++n) _Pragma("unroll") for (int k = 0; k < 2; ++k) dst[n][k] = *(const LAS bf16x8*)(lds + PG8_SB(b, h) + boff + n * 2048 + k * 1024); } while (0)
#define PG8_MMA(ai, bj, At, Bt) do { __builtin_amdgcn_s_setprio(1); _Pragma("unroll") for (int m = 0; m < 4; ++m) _Pragma("unroll") for (int n = 0; n < 2; ++n) _Pragma("unroll") for (int k = 0; k < 2; ++k) \
        acc[ai][bj][m][n] = __builtin_amdgcn_mfma_f32_16x16x32_bf16(Bt[n][k], At[m][k], acc[ai][bj][m][n], 0, 0, 0); __builtin_amdgcn_s_setprio(0); } while (0)
#define PG8_WAIT_V(n) asm volatile("s_waitcnt vmcnt(" #n ")" ::: "memory")
#define PG8_WAIT_L(n) asm volatile("s_waitcnt lgkmcnt(" #n ")" ::: "memory")
#define PG8_BAR __builtin_amdgcn_s_barrier()
#define PG8_SCHED __builtin_amdgcn_sched_barrier(0)
    Unit cur, nxt; int ui = 0;
    if (!S.next(0, cur)) return;
    f32x4 acc[2][2][4][2];
#pragma unroll
    for (int a = 0; a < 2; ++a)
#pragma unroll
        for (int b = 0; b < 2; ++b)
#pragma unroll
            for (int m = 0; m < 4; ++m)
#pragma unroll
                for (int n = 0; n < 2; ++n) acc[a][b][m][n] = (f32x4){0.f, 0.f, 0.f, 0.f};
    bf16x8 At[4][2], B0[2][2], B1[2][2];
    const char* cA = (const char*)g.A + (size_t)cur.pm * tstepA; const char* cB = (const char*)g.Bt + (size_t)cur.pn * tstepB;
    PG8_STAGE(PG8_SB(0, 0), cB, voffB); PG8_STAGE(PG8_SB(0, 1), cB + hstepB, voffB); PG8_STAGE(PG8_SA(0, 0), cA, voffA); PG8_STAGE(PG8_SA(0, 1), cA + hstepA, voffA);
    if (wr == 1) PG8_BAR;
    PG8_WAIT_V(2); PG8_BAR;
    PG8_STAGE(PG8_SB(1, 0), cB + kstep, voffB); PG8_STAGE(PG8_SA(1, 0), cA + kstep, voffA); PG8_STAGE(PG8_SB(1, 1), cB + hstepB + kstep, voffB);
    PG8_WAIT_V(6); PG8_BAR;
    for (;;) {
        const bool has_next = S.next(ui + 1, nxt);
        const char* nA = has_next ? (const char*)g.A + (size_t)nxt.pm * tstepA : cA; const char* nB = has_next ? (const char*)g.Bt + (size_t)nxt.pn * tstepB : cB;
        for (int t = 0; t < nt; t += 2) {
            const bool last = (t == nt - 2);
            const char* a1 = cA + (size_t)(t + 1) * kstep;
            const char* a2 = last ? nA : cA + (size_t)(t + 2) * kstep; const char* b2 = last ? nB : cB + (size_t)(t + 2) * kstep;
            const char* a3 = a2 + kstep; const char* b3 = b2 + kstep;
            PG8_LDB(B0, 0, 0); PG8_LDB(B1, 0, 1); PG8_SCHED; PG8_LDA(At, 0, 0); PG8_STAGE(PG8_SA(1, 1), a1 + hstepA, voffA);
            PG8_WAIT_V(8); PG8_WAIT_L(0); PG8_BAR; PG8_MMA(0, 0, At, B0); PG8_MMA(0, 1, At, B1); PG8_BAR; PG8_SCHED;
            PG8_LDA(At, 0, 1); PG8_STAGE(PG8_SB(0, 0), b2, voffB); PG8_STAGE(PG8_SB(0, 1), b2 + hstepB, voffB); PG8_STAGE(PG8_SA(0, 0), a2, voffA);
            PG8_WAIT_V(8); PG8_WAIT_L(0); PG8_BAR; PG8_MMA(1, 0, At, B0); PG8_MMA(1, 1, At, B1); PG8_BAR; PG8_SCHED;
            PG8_LDB(B0, 1, 0); PG8_LDB(B1, 1, 1); PG8_SCHED; PG8_LDA(At, 1, 0); PG8_STAGE(PG8_SA(0, 1), a2 + hstepA, voffA);
            PG8_WAIT_V(8); PG8_WAIT_L(0); PG8_BAR; PG8_MMA(0, 0, At, B0); PG8_MMA(0, 1, At, B1); PG8_BAR; PG8_SCHED;
            PG8_LDA(At, 1, 1); PG8_STAGE(PG8_SB(1, 0), b3, voffB); PG8_STAGE(PG8_SB(1, 1), b3 + hstepB, voffB); PG8_STAGE(PG8_SA(1, 0), a3, voffA);
            PG8_WAIT_V(8); PG8_WAIT_L(0); PG8_BAR; PG8_MMA(1, 0, At, B0); PG8_MMA(1, 1, At, B1); PG8_BAR; PG8_SCHED;
        }
        if (wr == 0) PG8_BAR;
        E(acc, cur, wr, wc, fr, fq);
        if (!has_next) break;
#pragma unroll
        for (int a = 0; a < 2; ++a)
#pragma unroll
            for (int b = 0; b < 2; ++b)
#pragma unroll
                for (int m = 0; m < 4; ++m)
#pragma unroll
                    for (int n = 0; n < 2; ++n) acc[a][b][m][n] = (f32x4){0.f, 0.f, 0.f, 0.f};
        cur = nxt; cA = nA; cB = nB; ++ui;
        if (wr == 1) PG8_BAR;
    }
    PG8_WAIT_V(0);
    PG8_BAR;
#undef PG8_SA
#undef PG8_SB
#undef PG8_STAGE
#undef PG8_LDA
#undef PG8_LDB
#undef PG8_MMA
#undef PG8_WAIT_V
#undef PG8_WAIT_L
#undef PG8_BAR
#undef PG8_SCHED
}

#define EPI_ARGS const f32x4 (&acc)[2][2][4][2], const Unit& u, int wr, int wc, int fr, int fq
__device__ __forceinline__ u32x4 pack8(f32x4 v0, f32x4 v1) { u32x4 w; w.x = cvt_pk_bf16(v0[0], v0[1]); w.y = cvt_pk_bf16(v0[2], v0[3]); w.z = cvt_pk_bf16(v1[0], v1[1]); w.w = cvt_pk_bf16(v1[2], v1[3]); return w; }

struct EpiStore {
    bf16_t* O; int ldc; int sig_pn;
    __device__ __forceinline__ void operator()(EPI_ARGS) const {
        const int row0 = u.pm * BM + wr * 64 + fr, col0 = u.pn * BM + wc * 32 + 8 * fq; const bool sig = u.pn >= sig_pn;
#pragma unroll
        for (int ai = 0; ai < 2; ++ai)
#pragma unroll
            for (int m = 0; m < 4; ++m) { bf16_t* rowp = O + (size_t)(row0 + ai * HALF + m * 16) * ldc + col0;
#pragma unroll
                for (int bj = 0; bj < 2; ++bj) { f32x4 v0 = acc[ai][bj][m][0], v1 = acc[ai][bj][m][1];
                    if (sig) {
#pragma unroll
                        for (int e = 0; e < 4; ++e) { v0[e] = sigmoidf_(v0[e]); v1[e] = sigmoidf_(v1[e]); } }
                    *(u32x4*)(rowp + bj * HALF) = pack8(v0, v1); } }
    }
};
struct EpiQ {
    bf16_t* Q; const float* rstd; const float* rope; int S, Sshift;
    __device__ __forceinline__ void operator()(EPI_ARGS) const {
        const int row0 = u.pm * BM + wr * 64 + fr;
#pragma unroll
        for (int ai = 0; ai < 2; ++ai)
#pragma unroll
            for (int m = 0; m < 4; ++m) { const int row = row0 + ai * HALF + m * 16; const int seq = row >> Sshift, pos = row & (S - 1);
                const float sc = rstd[2 * row] * QSCALE;
#pragma unroll
                for (int bj = 0; bj < 2; ++bj) { const int g32 = 8 * u.pn + 4 * bj + wc; const int head = g32 / 3, gl = g32 - 3 * head;
                    f32x4 v0 = acc[ai][bj][m][0] * sc, v1 = acc[ai][bj][m][1] * sc;
                    if (gl == 2) { const f32x4 cs = *(const f32x4*)(rope + (size_t)pos * 16 + 4 * fq), sn = *(const f32x4*)(rope + 131072 + (size_t)pos * 16 + 4 * fq);
                        f32x4 w0, w1;
                        w0[0] = v0[0] * cs[0] - v0[1] * sn[0]; w0[1] = v0[0] * sn[0] + v0[1] * cs[0];
                        w0[2] = v0[2] * cs[1] - v0[3] * sn[1]; w0[3] = v0[2] * sn[1] + v0[3] * cs[1];
                        w1[0] = v1[0] * cs[2] - v1[1] * sn[2]; w1[1] = v1[0] * sn[2] + v1[1] * cs[2];
                        w1[2] = v1[2] * cs[3] - v1[3] * sn[3]; w1[3] = v1[2] * sn[3] + v1[3] * cs[3];
                        v0 = w0; v1 = w1; }
                    *(u32x4*)(Q + ((size_t)((seq * 16 + head) << Sshift) + pos) * 96 + gl * 32 + 8 * fq) = pack8(v0, v1); }
                asm volatile("" ::: "memory"); }
    }
};
struct EpiKV {
    bf16_t* KF; bf16_t* V; const float* rstd; int S, Sshift;
    __device__ __forceinline__ void operator()(EPI_ARGS) const {
        const int row0 = u.pm * BM + wr * 64 + fr; const bool isv = u.pn >= 4;
#pragma unroll
        for (int ai = 0; ai < 2; ++ai)
#pragma unroll
            for (int m = 0; m < 4; ++m) { const int row = row0 + ai * HALF + m * 16; const int seq = row >> Sshift, pos = row & (S - 1);
                const float sc = rstd[2 * row + 1];
#pragma unroll
                for (int bj = 0; bj < 2; ++bj) { const int col = (u.pn & 3) * BM + bj * HALF + wc * 32 + 8 * fq; const int head = col >> 6, d = col & 63;
                    const f32x4 v0 = acc[ai][bj][m][0] * sc, v1 = acc[ai][bj][m][1] * sc; const size_t tok = (size_t)((seq * 16 + head) << Sshift) + pos;
                    bf16_t* p = isv ? V + tok * 64 + d : KF + tok * 96 + d;
                    *(u32x4*)p = pack8(v0, v1); }
                asm volatile("" ::: "memory"); }
    }
};
struct EpiGateA {
    bf16_t* T; const bf16_t* Z;
    __device__ __forceinline__ void operator()(EPI_ARGS) const {
        const int row0 = u.pm * BM + wr * 64 + fr, col0 = u.pn * BM + wc * 32 + 8 * fq;
#pragma unroll
        for (int ai = 0; ai < 2; ++ai)
#pragma unroll
            for (int m = 0; m < 4; ++m) { const int row = row0 + ai * HALF + m * 16;
#pragma unroll
                for (int bj = 0; bj < 2; ++bj) { const int col = col0 + bj * HALF; const u32x4 gw = *(const u32x4*)(Z + (size_t)row * ZLD + 3072 + col);
                    f32x4 v0 = acc[ai][bj][m][0], v1 = acc[ai][bj][m][1];
                    v0[0] *= bflo(gw.x); v0[1] *= bfhi(gw.x); v0[2] *= bflo(gw.y); v0[3] *= bfhi(gw.y); v1[0] *= bflo(gw.z); v1[1] *= bfhi(gw.z); v1[2] *= bflo(gw.w); v1[3] *= bfhi(gw.w);
                    *(u32x4*)(T + (size_t)row * D + col) = pack8(v0, v1); }
                asm volatile("" ::: "memory"); }
    }
};
struct EpiGateB {
    const bf16_t* T; const bf16_t* Z; bf16_t* O;
    __device__ __forceinline__ void operator()(EPI_ARGS) const {
        const int row0 = u.pm * BM + wr * 64 + fr, col0 = u.pn * BM + wc * 32 + 8 * fq;
#pragma unroll
        for (int ai = 0; ai < 2; ++ai)
#pragma unroll
            for (int m = 0; m < 4; ++m) { const int row = row0 + ai * HALF + m * 16;
#pragma unroll
                for (int bj = 0; bj < 2; ++bj) { const int col = col0 + bj * HALF; const u32x4 gw = *(const u32x4*)(Z + (size_t)row * ZLD + 4096 + col);
                    const u32x4 tw = *(const u32x4*)(T + (size_t)row * D + col); f32x4 v0 = {bflo(tw.x), bfhi(tw.x), bflo(tw.y), bfhi(tw.y)}, v1 = {bflo(tw.z), bfhi(tw.z), bflo(tw.w), bfhi(tw.w)};
                    const f32x4 a0 = acc[ai][bj][m][0], a1 = acc[ai][bj][m][1];
                    v0[0] += a0[0] * bflo(gw.x); v0[1] += a0[1] * bfhi(gw.x); v0[2] += a0[2] * bflo(gw.y); v0[3] += a0[3] * bfhi(gw.y);
                    v1[0] += a1[0] * bflo(gw.z); v1[1] += a1[1] * bfhi(gw.z); v1[2] += a1[2] * bflo(gw.w); v1[3] += a1[3] * bfhi(gw.w);
                    *(u32x4*)(O + (size_t)row * D + col) = pack8(v0, v1); }
                asm volatile("" ::: "memory"); }
    }
};
struct EpiResid {
    const float* base; float* out; const float* mod; int goff, Sshift, seqbase; int mode; bf16_t* x1;
    __device__ __forceinline__ void operator()(EPI_ARGS) const {
        const int row0 = u.pm * BM + wr * 64 + fr, col0 = u.pn * BM + wc * 32 + 8 * fq;
        const float* gt = mod + (size_t)(seqbase + ((u.pm * BM) >> Sshift)) * 6144 + goff + col0;
        f32x4 g[2][2];
#pragma unroll
        for (int bj = 0; bj < 2; ++bj) { g[bj][0] = *(const f32x4*)(gt + bj * HALF); g[bj][1] = *(const f32x4*)(gt + bj * HALF + 4); }
#pragma unroll
        for (int ai = 0; ai < 2; ++ai)
#pragma unroll
            for (int m = 0; m < 4; ++m) { const size_t off = (size_t)(row0 + ai * HALF + m * 16) * D + col0;
#pragma unroll
                for (int bj = 0; bj < 2; ++bj) {
                    if (mode == 0) { const f32x4 b0 = *(const f32x4*)(base + off + bj * HALF), b1 = *(const f32x4*)(base + off + bj * HALF + 4);
                        *(u32x4*)(x1 + off + bj * HALF) = pack8(b0 + g[bj][0] * acc[ai][bj][m][0], b1 + g[bj][1] * acc[ai][bj][m][1]); }
                    else { const u32x4 w = *(const u32x4*)(x1 + off + bj * HALF); const f32x4 b0 = {bflo(w.x), bfhi(w.x), bflo(w.y), bfhi(w.y)}, b1 = {bflo(w.z), bfhi(w.z), bflo(w.w), bfhi(w.w)};
                        *(u32x4*)(x1 + off + bj * HALF) = pack8(b0 + g[bj][0] * acc[ai][bj][m][0], b1 + g[bj][1] * acc[ai][bj][m][1]); } }
                if (m & 1) asm volatile("" ::: "memory"); }
    }
};

__device__ __forceinline__ float dpp_prev(float oldv, float v) { return __int_as_float(__builtin_amdgcn_update_dpp(__float_as_int(oldv), __float_as_int(v), 0x111, 0xf, 0xf, false)); }
__device__ __forceinline__ float dpp_next(float oldv, float v) { return __int_as_float(__builtin_amdgcn_update_dpp(__float_as_int(oldv), __float_as_int(v), 0x101, 0xf, 0xf, false)); }
__device__ __forceinline__ float dpp_ror1(float v)  { return __int_as_float(__builtin_amdgcn_update_dpp(0, __float_as_int(v), 0x121, 0xf, 0xf, false)); }
__device__ __forceinline__ float dpp_ror15(float v) { return __int_as_float(__builtin_amdgcn_update_dpp(0, __float_as_int(v), 0x12F, 0xf, 0xf, false)); }
__device__ __forceinline__ float gelu_tanh_(float x) { const float y = 0.7978845608028654f * (x + 0.044715f * x * x * x); return x * sigmoidf_(2.0f * y); }
struct EpiConv {
    bf16_t* ACT; const float* cw; const float* cbias; float* EDGEU; float* PARTP; float* PARTG; LAS unsigned char* xl;
    __device__ __forceinline__ void operator()(EPI_ARGS) const {
#define UU(ai, m, e) acc[ai][0][m][(e) >> 2][(e) & 3]
#define GG(ai, m, e) acc[ai][1][m][(e) >> 2][(e) & 3]
        const int c0 = u.pn * 128 + wc * 32 + 8 * fq;
        float w0[8], w1[8], w2[8], cb[8];
        { const f32x4* wp = (const f32x4*)(cw + c0); const f32x4 a0 = wp[0], a1 = wp[1], b0 = wp[DFF / 4], b1 = wp[DFF / 4 + 1], d0 = wp[2 * DFF / 4], d1 = wp[2 * DFF / 4 + 1];
          const f32x4* bp = (const f32x4*)(cbias + c0); const f32x4 e0 = bp[0], e1 = bp[1];
#pragma unroll
          for (int e = 0; e < 4; ++e) { w0[e] = a0[e]; w0[4 + e] = a1[e]; w1[e] = b0[e]; w1[4 + e] = b1[e]; w2[e] = d0[e]; w2[4 + e] = d1[e]; cb[e] = e0[e]; cb[4 + e] = e1[e]; } }
        LAS float* XE = (LAS float*)xl;
#pragma unroll
        for (int ai = 0; ai < 2; ++ai) { const int blk = 2 * ai + wr;
            if (fr == 0) {
#pragma unroll
                for (int e = 0; e < 8; ++e) XE[((blk * 2 + 0) * 4 + wc) * 32 + fq * 8 + e] = UU(ai, 0, e); }
            if (fr == 15) {
#pragma unroll
                for (int e = 0; e < 8; ++e) XE[((blk * 2 + 1) * 4 + wc) * 32 + fq * 8 + e] = UU(ai, 3, e); } }
        if (wr == 0 && fr == 0) { float* ep = EDGEU + (size_t)(u.pm * 2 + 0) * DFF + c0; *(f32x4*)ep = acc[0][0][0][0]; *(f32x4*)(ep + 4) = acc[0][0][0][1]; }
        if (wr == 1 && fr == 15) { float* ep = EDGEU + (size_t)(u.pm * 2 + 1) * DFF + c0; *(f32x4*)ep = acc[1][0][3][0]; *(f32x4*)(ep + 4) = acc[1][0][3][1]; }
        asm volatile("s_waitcnt lgkmcnt(0)" ::: "memory"); __builtin_amdgcn_s_barrier(); asm volatile("" ::: "memory");
#pragma unroll
        for (int ai = 0; ai < 2; ++ai) { const int blk = 2 * ai + wr;
#pragma unroll
            for (int m = 0; m < 4; ++m) { const int row = u.pm * BM + ai * HALF + wr * 64 + m * 16 + fr;
                float pre[8], r[8], ex[8];
#pragma unroll
                for (int e = 0; e < 8; ++e) ex[e] = 0.f;
                if (m == 0 && blk > 0 && fr == 0) {
#pragma unroll
                    for (int e = 0; e < 8; ++e) ex[e] = XE[(((blk - 1) * 2 + 1) * 4 + wc) * 32 + fq * 8 + e]; }
                if (m == 3 && blk < 3 && fr == 15) {
#pragma unroll
                    for (int e = 0; e < 8; ++e) ex[e] = XE[(((blk + 1) * 2 + 0) * 4 + wc) * 32 + fq * 8 + e]; }
#pragma unroll
                for (int e = 0; e < 8; ++e) { const float uc = UU(ai, m, e);
                    const float oldp = (m == 0) ? ex[e] : dpp_ror1(UU(ai, m == 0 ? 0 : m - 1, e));
                    const float oldn = (m == 3) ? ex[e] : dpp_ror15(UU(ai, m == 3 ? 3 : m + 1, e));
                    const float up_ = dpp_prev(oldp, uc), un_ = dpp_next(oldn, uc);
                    pre[e] = cb[e] + w0[e] * up_ + w1[e] * uc + w2[e] * un_; r[e] = gelu_tanh_(pre[e]) * GG(ai, m, e); }
                const bool edge0 = (blk == 0 && m == 0 && fr == 0), edge1 = (blk == 3 && m == 3 && fr == 15);
                if (edge0 || edge1) { const size_t o = (size_t)(u.pm * 2 + (edge1 ? 1 : 0)) * DFF + c0;
                    *(f32x4*)(PARTP + o) = (f32x4){pre[0], pre[1], pre[2], pre[3]}; *(f32x4*)(PARTP + o + 4) = (f32x4){pre[4], pre[5], pre[6], pre[7]};
                    *(f32x4*)(PARTG + o) = acc[ai][1][m][0]; *(f32x4*)(PARTG + o + 4) = acc[ai][1][m][1]; }
                else { u32x4 w; w.x = cvt_pk_bf16(r[0], r[1]); w.y = cvt_pk_bf16(r[2], r[3]); w.z = cvt_pk_bf16(r[4], r[5]); w.w = cvt_pk_bf16(r[6], r[7]);
                    *(u32x4*)(ACT + (size_t)row * DFF + c0) = w; }
                asm volatile("" ::: "memory"); }
        }
#undef UU
#undef GG
    }
};

struct EpiAny {
    int kind;
    unsigned char* ws;
    int S, Sshift, seqbase, goff, rmode; const float* base; const float* cw; const float* cbias; LAS unsigned char* xl;
    __device__ __forceinline__ void operator()(EPI_ARGS) const {
        if (kind == 0) { EpiStore e{(bf16_t*)(ws + WS_Z), ZLD, 12}; e(acc, u, wr, wc, fr, fq); }
        else if (kind == 1) { EpiQ e{(bf16_t*)(ws + WS_Q), (const float*)(ws + WS_RSTD), (const float*)(ws + WS_ROPE), S, Sshift}; e(acc, u, wr, wc, fr, fq); }
        else if (kind == 2) { EpiKV e{(bf16_t*)(ws + WS_KF), (bf16_t*)(ws + WS_V), (const float*)(ws + WS_RSTD), S, Sshift}; e(acc, u, wr, wc, fr, fq); }
        else if (kind == 3) { EpiGateA e{(bf16_t*)(ws + WS_T), (const bf16_t*)(ws + WS_Z)}; e(acc, u, wr, wc, fr, fq); }
        else if (kind == 4) { EpiGateB e{(const bf16_t*)(ws + WS_T), (const bf16_t*)(ws + WS_Z), (bf16_t*)(ws + WS_MERGED)}; e(acc, u, wr, wc, fr, fq); }
        else if (kind == 5) { EpiResid e{base, nullptr, (const float*)(ws + WS_MOD), goff, Sshift, seqbase, rmode, (bf16_t*)(ws + WS_OA)}; e(acc, u, wr, wc, fr, fq); }
        else { float* ed = (float*)(ws + WS_EDGE); EpiConv e{(bf16_t*)(ws + WS_ACT), cw, cbias, ed, ed + 128 * DFF, ed + 256 * DFF, xl}; e(acc, u, wr, wc, fr, fq); }
    }
};
}

__device__ const float ROPE_INV[16] = {1.000000000e+00f, 5.623413324e-01f, 3.162277639e-01f, 1.778279394e-01f, 1.000000015e-01f, 5.623413250e-02f, 3.162277490e-02f, 1.778279431e-02f,
                                       9.999999776e-03f, 5.623413250e-03f, 3.162277630e-03f, 1.778279431e-03f, 1.000000047e-03f, 5.623413017e-04f, 3.162277571e-04f, 1.778279402e-04f};
__device__ __forceinline__ int perm_rope(int i) { return i < 16 ? 2 * i : 2 * (i - 16) + 1; }
__device__ __forceinline__ int rowmap(int kind, int n) {
    if (kind == 1) return n < 640 ? n : (n < 672 ? 640 + perm_rope(n - 640) : n + 96);
    if (kind == 2) { const int h = n / 96, c = n - h * 96; return c < 64 ? n : h * 96 + 64 + perm_rope(c - 64); }
    if (kind == 3) { const int h = n >> 7, c = n & 127; return c < 64 ? h * 64 + c : 1024 + h * 64 + (c - 64); }
    if (kind == 4) { const int f = n < DFF ? n : n - DFF; return (f >> 7) * 256 + (n < DFF ? 0 : 128) + (f & 127); }
    return n;
}
__device__ __forceinline__ void transpose_item(const float* W, int K, int N, bf16_t* WT, int kind, const float* ks, LAS float* scr, int item, int lane) {
    const int nblk = N / 32, kb = item / nblk, nb = item - kb * nblk, k0 = 64 * kb, n0 = 32 * nb;
#pragma unroll 8
    for (int i = 0; i < 32; ++i) { const int kk = 2 * i + (lane >> 5); float w = W[(size_t)(k0 + kk) * N + n0 + (lane & 31)]; if (ks) w *= ks[k0 + kk]; scr[kk * 33 + (lane & 31)] = w; }
    asm volatile("s_waitcnt lgkmcnt(0)" ::: "memory");
    const int c = lane & 7;
#pragma unroll
    for (int j = 0; j < 4; ++j) { const int n = (lane >> 3) + 8 * j; const LAS float* s = scr + (8 * c) * 33 + n;
        u32x4 o; o.x = cvt_pk_bf16(s[0 * 33], s[1 * 33]); o.y = cvt_pk_bf16(s[2 * 33], s[3 * 33]); o.z = cvt_pk_bf16(s[4 * 33], s[5 * 33]); o.w = cvt_pk_bf16(s[6 * 33], s[7 * 33]);
        *(u32x4*)(WT + (size_t)rowmap(kind, n0 + n) * K + k0 + 8 * c) = o; }
    asm volatile("s_waitcnt lgkmcnt(0)" ::: "memory");
}

__device__ __forceinline__ void norm_mod_row(const float* xrow, bf16_t* orow, const float* g, const float* sc, const float* sh, int lane) {
    const f32x4* xr = (const f32x4*)xrow + lane; f32x4 v[4]; float s = 0.f;
#pragma unroll
    for (int j = 0; j < 4; ++j) { v[j] = xr[64 * j]; s += (v[j].x * v[j].x + v[j].y * v[j].y) + (v[j].z * v[j].z + v[j].w * v[j].w); }
    const float rstd = 1.0f / sqrtf(wave_sum(s) * (1.f / D) + EPS);
    u32x2* o8 = (u32x2*)orow + lane;
#pragma unroll
    for (int j = 0; j < 4; ++j) { const f32x4 gg = ((const f32x4*)g)[lane + 64 * j], ss = ((const f32x4*)sc)[lane + 64 * j], hh = ((const f32x4*)sh)[lane + 64 * j];
        const f32x4 o = v[j] * rstd * gg * (ss + 1.0f) + hh; u32x2 w; w.x = cvt_pk_bf16(o.x, o.y); w.y = cvt_pk_bf16(o.z, o.w); o8[64 * j] = w; }
}
__device__ __forceinline__ void norm_mod_row16(const bf16_t* xrow, bf16_t* orow, const float* g, const float* sc, const float* sh, int lane) {
    const u32x2* xr = (const u32x2*)xrow + lane; f32x4 v[4]; float s = 0.f;
#pragma unroll
    for (int j = 0; j < 4; ++j) { const u32x2 w = xr[64 * j]; v[j] = (f32x4){bflo(w.x), bfhi(w.x), bflo(w.y), bfhi(w.y)}; s += (v[j].x * v[j].x + v[j].y * v[j].y) + (v[j].z * v[j].z + v[j].w * v[j].w); }
    const float rstd = 1.0f / sqrtf(wave_sum(s) * (1.f / D) + EPS);
    u32x2* o8 = (u32x2*)orow + lane;
#pragma unroll
    for (int j = 0; j < 4; ++j) { const f32x4 gg = ((const f32x4*)g)[lane + 64 * j], ss = ((const f32x4*)sc)[lane + 64 * j], hh = ((const f32x4*)sh)[lane + 64 * j];
        const f32x4 o = v[j] * rstd * gg * (ss + 1.0f) + hh; u32x2 w; w.x = cvt_pk_bf16(o.x, o.y); w.y = cvt_pk_bf16(o.z, o.w); o8[64 * j] = w; }
}
__device__ __forceinline__ void final_norm_row(const bf16_t* xin, float* xrow, const float* g, int lane) {
    f32x4* xr = (f32x4*)xrow + lane; const u32x2* xi = (const u32x2*)xin + lane; f32x4 v[4]; float s = 0.f;
#pragma unroll
    for (int j = 0; j < 4; ++j) { const u32x2 w = xi[64 * j]; v[j] = (f32x4){bflo(w.x), bfhi(w.x), bflo(w.y), bfhi(w.y)}; s += (v[j].x * v[j].x + v[j].y * v[j].y) + (v[j].z * v[j].z + v[j].w * v[j].w); }
    const float rstd = 1.0f / sqrtf(wave_sum(s) * (1.f / D) + EPS);
#pragma unroll
    for (int j = 0; j < 4; ++j) xr[64 * j] = v[j] * rstd * ((const f32x4*)g)[lane + 64 * j];
}

__device__ __forceinline__ void dil_task(const bf16_t* Z, float* OG, float* LSE, int S, int task, LAS unsigned char* wl, int lane_in) {
    int lane = lane_in; asm volatile("" : "+v"(lane));
    const int r32 = lane & 31, hi = lane >> 5;
    const int bps = S >> 5, tps = 12 * bps;
    const int seq = task / tps; const int rem = task - seq * tps; const int hd = rem / bps; const int blk = rem - hd * bps;
    const int g = hd >> 2, sh = 2 * g, dl = 1 << sh; const int r = blk & (dl - 1), bi = blk >> sh;
    const int i0 = bi * 32, nsub = S >> sh;
    const size_t rowbase = (size_t)seq * S;
    const int tq = r + ((i0 + r32) << sh);
    const bf16_t* qp = Z + (rowbase + tq) * ZLD + 768 + hd * 64 + 8 * hi;
    bf16x8 qf[4];
#pragma unroll
    for (int s = 0; s < 4; ++s) qf[s] = *(const bf16x8*)(qp + 16 * s);
    f32x16 sc[5];
    {
        bf16x8 kf[5][4];
#pragma unroll
        for (int c = 0; c < 5; ++c) {
            int ik = i0 - 64 + 32 * c + r32; ik = ik < 0 ? 0 : (ik > nsub - 1 ? nsub - 1 : ik);
            const bf16_t* kp = Z + (rowbase + r + ((size_t)ik << sh)) * ZLD + 1536 + hd * 64 + 8 * hi;
#pragma unroll
            for (int s = 0; s < 4; ++s) kf[c][s] = *(const bf16x8*)(kp + 16 * s);
        }
#pragma unroll
        for (int c = 0; c < 5; ++c) {
            f32x16 a = {};
#pragma unroll
            for (int s = 0; s < 4; ++s) a = __builtin_amdgcn_mfma_f32_32x32x16_bf16(kf[c][s], qf[s], a, 0, 0, 0);
            sc[c] = a;
        }
    }
    asm volatile("" ::: "memory");
    u32x4 vv[5][4];
#pragma unroll
    for (int c = 0; c < 5; ++c)
#pragma unroll
        for (int i = 0; i < 4; ++i) { const int row = (lane >> 3) + 8 * i; int ik = i0 - 64 + 32 * c + row; ik = ik < 0 ? 0 : (ik > nsub - 1 ? nsub - 1 : ik);
            vv[c][i] = *(const u32x4*)(Z + (rowbase + r + ((size_t)ik << sh)) * ZLD + 2304 + hd * 64 + (lane & 7) * 8); }
    asm volatile("" ::: "memory");
    const float cb = __builtin_amdgcn_exp2f(-0.6666666667f * (float)(hd + 1)) * LOG2E * (float)dl;
    float mx = -INFINITY;
#pragma unroll
    for (int c = 0; c < 5; ++c)
#pragma unroll
        for (int e = 0; e < 16; ++e) {
            const int kvl = 32 * c + (e & 3) + 8 * (e >> 2) + 4 * hi; const int delta = kvl - 64 - r32; const int ik = i0 + r32 + delta;
            const int ad = delta < 0 ? -delta : delta; const bool valid = (ad <= 64) && (ik >= 0) && (ik < nsub);
            float v = sc[c][e] * DSCALE - cb * (float)ad; v = valid ? v : -INFINITY; sc[c][e] = v; mx = fmaxf(mx, v);
        }
    mx = swap_max(mx);
    float ls = 0.f;
#pragma unroll
    for (int c = 0; c < 5; ++c)
#pragma unroll
        for (int e = 0; e < 16; ++e) { const float p = __builtin_amdgcn_exp2f(sc[c][e] - mx); sc[c][e] = p; ls += p; }
    ls = swap_add(ls);
    f32x16 o0 = {}, o1 = {};
    const int vb = ((lane >> 4) & 1) * 32 + (lane & 3) * 8 + (4 * hi + ((lane & 15) >> 2)) * 64;
#pragma unroll
    for (int c = 0; c < 5; ++c) {
        asm volatile("s_waitcnt lgkmcnt(0)" ::: "memory");
#pragma unroll
        for (int i = 0; i < 4; ++i) { const int row = (lane >> 3) + 8 * i; *(LAS u32x4*)(wl + ((lane & 7) >> 2) * 2048 + row * 64 + (lane & 3) * 16) = vv[c][i]; }
        asm volatile("s_waitcnt lgkmcnt(0)" ::: "memory");
#pragma unroll
        for (int s = 0; s < 2; ++s) {
            u32x4 pw; pw.x = cvt_pk_bf16(sc[c][8 * s + 0], sc[c][8 * s + 1]); pw.y = cvt_pk_bf16(sc[c][8 * s + 2], sc[c][8 * s + 3]); pw.z = cvt_pk_bf16(sc[c][8 * s + 4], sc[c][8 * s + 5]); pw.w = cvt_pk_bf16(sc[c][8 * s + 6], sc[c][8 * s + 7]);
            const bf16x8 pf = __builtin_bit_cast(bf16x8, pw);
            { const s16x4 lo = vtr(wl + vb + s * 1024), hh = vtr(wl + vb + s * 1024 + 512); const bf16x8 vf = {lo[0], lo[1], lo[2], lo[3], hh[0], hh[1], hh[2], hh[3]};
              o0 = __builtin_amdgcn_mfma_f32_32x32x16_bf16(vf, pf, o0, 0, 0, 0); }
            { const s16x4 lo = vtr(wl + vb + 2048 + s * 1024), hh = vtr(wl + vb + 2048 + s * 1024 + 512); const bf16x8 vf = {lo[0], lo[1], lo[2], lo[3], hh[0], hh[1], hh[2], hh[3]};
              o1 = __builtin_amdgcn_mfma_f32_32x32x16_bf16(vf, pf, o1, 0, 0, 0); }
        }
    }
    const float inv = 1.0f / ls; const size_t rq = rowbase + tq;
    float* op = OG + (rq * 12 + hd) * 64 + 4 * hi;
#pragma unroll
    for (int i = 0; i < 4; ++i) {
        *(f32x4*)(op + 8 * i) = (f32x4){o0[4 * i] * inv, o0[4 * i + 1] * inv, o0[4 * i + 2] * inv, o0[4 * i + 3] * inv};
        *(f32x4*)(op + 32 + 8 * i) = (f32x4){o1[4 * i] * inv, o1[4 * i + 1] * inv, o1[4 * i + 2] * inv, o1[4 * i + 3] * inv};
    }
    if (hi == 0) LSE[rq * 12 + hd] = (mx + __builtin_amdgcn_logf(ls)) * LN2;
}

namespace mla {
constexpr int KPITCH = 208, KBYTES = 64 * KPITCH, VBYTES = 8192, BUF = KBYTES + VBYTES, QOFF = 2 * BUF, DUMMY = QOFF + 8 * 12288;
#define MLA_PACK(P, b) (u32x4){cvt_pk_bf16(P[b], P[b + 1]), cvt_pk_bf16(P[b + 2], P[b + 3]), cvt_pk_bf16(P[b + 4], P[b + 5]), cvt_pk_bf16(P[b + 6], P[b + 7])}
#define SGB(mask, n) __builtin_amdgcn_sched_group_barrier(mask, n, 0)
__device__ __forceinline__ float max2_(float a, float b) { return __builtin_amdgcn_fmed3f(a, b, INFINITY); }
constexpr float THR = 8.0f;
__device__ __forceinline__ void softmax_blk(f32x16& p0, f32x16& p1, f32x16& o0, f32x16& o1, float& mhat, float& lrun, u32x4 (&pf)[4], bool first) {
    float r0 = max2_(p0[0], p0[1]), r1 = max2_(p1[0], p1[1]);
#pragma unroll
    for (int e = 2; e < 16; ++e) { r0 = max2_(r0, p0[e]); r1 = max2_(r1, p1[e]); }
    const float rm = swap_max(max2_(r0, r1));
    if (first || __any(rm - mhat > THR)) {
        const float mn = first ? rm : fmaxf(rm, mhat); const float f = first ? 0.f : __builtin_amdgcn_exp2f(mhat - mn); mhat = mn; lrun *= f;
#pragma unroll
        for (int e = 0; e < 16; ++e) { o0[e] *= f; o1[e] *= f; }
    }
    float s0 = 0.f, s1 = 0.f;
#pragma unroll
    for (int e = 0; e < 16; ++e) { p0[e] = __builtin_amdgcn_exp2f(p0[e] - mhat); p1[e] = __builtin_amdgcn_exp2f(p1[e] - mhat); s0 += p0[e]; s1 += p1[e]; }
    lrun += s0 + s1;
    pf[0] = MLA_PACK(p0, 0); pf[1] = MLA_PACK(p0, 8); pf[2] = MLA_PACK(p1, 0); pf[3] = MLA_PACK(p1, 8);
}
__device__ __forceinline__ void pv_blk(const u32x4 (&pf)[4], f32x16& o0, f32x16& o1, LAS const unsigned char* vbase) {
#pragma unroll
    for (int ks = 0; ks < 4; ++ks) {
        const bf16x8 p = __builtin_bit_cast(bf16x8, pf[ks]);
        { const s16x4 lo = vtr(vbase + ks * 1024), hh = vtr(vbase + ks * 1024 + 512); const bf16x8 vf = {lo[0], lo[1], lo[2], lo[3], hh[0], hh[1], hh[2], hh[3]};
          o0 = __builtin_amdgcn_mfma_f32_32x32x16_bf16(vf, p, o0, 0, 0, 0); }
        { const s16x4 lo = vtr(vbase + 4096 + ks * 1024), hh = vtr(vbase + 4096 + ks * 1024 + 512); const bf16x8 vf = {lo[0], lo[1], lo[2], lo[3], hh[0], hh[1], hh[2], hh[3]};
          o1 = __builtin_amdgcn_mfma_f32_32x32x16_bf16(vf, p, o1, 0, 0, 0); }
    }
}
__device__ __forceinline__ void store_o(bf16_t* op, const f32x16& o0, const f32x16& o1, float inv) {
#pragma unroll
    for (int i = 0; i < 4; ++i) {
        u32x2 w0; w0.x = cvt_pk_bf16(o0[4 * i] * inv, o0[4 * i + 1] * inv); w0.y = cvt_pk_bf16(o0[4 * i + 2] * inv, o0[4 * i + 3] * inv); *(u32x2*)(op + 8 * i) = w0;
        u32x2 w1; w1.x = cvt_pk_bf16(o1[4 * i] * inv, o1[4 * i + 1] * inv); w1.y = cvt_pk_bf16(o1[4 * i + 2] * inv, o1[4 * i + 3] * inv); *(u32x2*)(op + 32 + 8 * i) = w1;
    }
}
__device__ __forceinline__ void attn_unit(const bf16_t* Qh, const bf16_t* Kh, const bf16_t* Vh, bf16_t* Oh  , int S, int qb, LAS unsigned char* lds, int tid) {
    const int lane = tid & 63, r32 = lane & 31, hi = lane >> 5; const int wid = __builtin_amdgcn_readfirstlane(tid >> 6);
    const int qrow = qb * 512 + wid * 64 + r32;
    const bf16_t* Qw = Qh + (size_t)qrow * 96 + 8 * hi;
    LAS unsigned char* ql = lds + QOFF + wid * 12288 + lane * 16;
#pragma unroll
    for (int s = 0; s < 6; ++s) { *(LAS bf16x8*)(ql + s * 1024) = *(const bf16x8*)(Qw + 16 * s); *(LAS bf16x8*)(ql + (6 + s) * 1024) = *(const bf16x8*)(Qw + 32 * 96 + 16 * s); }
    const bool has1 = tid < 256; const int kc0 = tid, kc1 = has1 ? tid + 512 : tid;
    const unsigned kd0 = (unsigned)((kc0 / 12) * KPITCH + (kc0 % 12) * 16);
    const unsigned kd1 = has1 ? (unsigned)((kc1 / 12) * KPITCH + (kc1 % 12) * 16) : (unsigned)(DUMMY + (tid - 256) * 16);
    const unsigned kd1n = has1 ? BUF : 0u;
    const unsigned vd = (unsigned)(KBYTES + ((tid & 7) >> 2) * 4096 + (tid >> 3) * 64 + (tid & 3) * 16);
    const u32x4* Kg = (const u32x4*)Kh; const u32x4* Vg = (const u32x4*)Vh;
    const int NT = S >> 6;
    u32x4 ka = Kg[kc0], kb = Kg[kc1], va = Vg[tid];
    *(LAS u32x4*)(lds + kd0) = ka; *(LAS u32x4*)(lds + kd1) = kb; *(LAS u32x4*)(lds + vd) = va;
    __syncthreads();
    f32x16 oa0 = {}, oa1 = {}, ob0 = {}, ob1 = {}; float ma = 0.f, la = 0.f, mb = 0.f, lb = 0.f;
    const unsigned kfo = (unsigned)(r32 * KPITCH + hi * 16);
    const unsigned vb = (unsigned)(KBYTES + ((lane >> 4) & 1) * 32 + (lane & 3) * 8 + (4 * hi + ((lane & 15) >> 2)) * 64);
    for (int t = 0; t < NT; ++t) {
        const unsigned cur = (unsigned)(t & 1) * BUF, nxt = BUF - cur;
        const int tn = t + 1 < NT ? t + 1 : t;
        ka = Kg[(size_t)tn * 768 + kc0]; kb = Kg[(size_t)tn * 768 + kc1]; va = Vg[(size_t)tn * 512 + tid];
        u32x4 pf[4];
        {
            f32x16 p0 = {}, p1 = {};
#pragma unroll
            for (int s = 0; s < 6; ++s) {
                const bf16x8 a0 = *(const LAS bf16x8*)(lds + cur + kfo + s * 32), a1 = *(const LAS bf16x8*)(lds + cur + kfo + 32 * KPITCH + s * 32);
                const bf16x8 q = *(const LAS bf16x8*)(ql + s * 1024);
                p0 = __builtin_amdgcn_mfma_f32_32x32x16_bf16(a0, q, p0, 0, 0, 0); p1 = __builtin_amdgcn_mfma_f32_32x32x16_bf16(a1, q, p1, 0, 0, 0);
            }
            softmax_blk(p0, p1, oa0, oa1, ma, la, pf, t == 0);
            pv_blk(pf, oa0, oa1, lds + cur + vb);
        }
        __builtin_amdgcn_sched_barrier(0);
        {
            f32x16 p0 = {}, p1 = {};
#pragma unroll
            for (int s = 0; s < 6; ++s) {
                const bf16x8 a0 = *(const LAS bf16x8*)(lds + cur + kfo + s * 32), a1 = *(const LAS bf16x8*)(lds + cur + kfo + 32 * KPITCH + s * 32);
                const bf16x8 q = *(const LAS bf16x8*)(ql + (6 + s) * 1024);
                p0 = __builtin_amdgcn_mfma_f32_32x32x16_bf16(a0, q, p0, 0, 0, 0); p1 = __builtin_amdgcn_mfma_f32_32x32x16_bf16(a1, q, p1, 0, 0, 0);
            }
            softmax_blk(p0, p1, ob0, ob1, mb, lb, pf, t == 0);
            pv_blk(pf, ob0, ob1, lds + cur + vb);
        }
        *(LAS u32x4*)(lds + nxt + kd0) = ka; *(LAS u32x4*)(lds + (has1 ? nxt : 0u) + kd1) = kb; *(LAS u32x4*)(lds + nxt + vd) = va;
        __syncthreads();
    }
    bf16_t* op = Oh + (size_t)qrow * D + 4 * hi;
    store_o(op, oa0, oa1, 1.0f / swap_add(la));
    store_o(op + 32 * D, ob0, ob1, 1.0f / swap_add(lb));
}
#undef SGB
}

#define XB_TMO      128
#define XB_XCNT(j)  (256  + 64 * (j))
#define XB_XSUB(j)  (1280 + 64 * (j))
#define XB_XGEN(j)  (2304 + 64 * (j))
#define XB_TOP      3328
#define XB_TOPGEN   3392
#define XCD_BAR_WORDS 3456
#define XB_SPIN_CAP (1u << 20)
__device__ __forceinline__ unsigned xb_ld(unsigned* p)              { return __hip_atomic_load(p, __ATOMIC_RELAXED, __HIP_MEMORY_SCOPE_AGENT); }
__device__ __forceinline__ unsigned xb_add(unsigned* p, unsigned v) { return __hip_atomic_fetch_add(p, v, __ATOMIC_RELAXED, __HIP_MEMORY_SCOPE_AGENT); }
__device__ __forceinline__ unsigned xb_xcc_id() { return (unsigned)__builtin_amdgcn_s_getreg((3 << 11) | 20) & 0xFu; }
#define XB_SPIN(cond, bar) do { unsigned _sp = 0; while (cond) { __builtin_amdgcn_s_sleep(1); \
    if ((++_sp & 255u) == 0u) { if (xb_ld(&(bar)[XB_TMO])) break; if (_sp > XB_SPIN_CAP) { atomicAdd(&(bar)[XB_TMO], 1u); break; } } } } while (0)
struct XcdBarrier { unsigned* bar; unsigned x; volatile LAS unsigned* st; };
__device__ __forceinline__ XcdBarrier xcd_barrier_post(unsigned* bar, volatile LAS unsigned* st, int tid) {
    XcdBarrier b; b.bar = bar; b.x = xb_xcc_id(); b.st = st;
    if (tid == 0) (void)xb_add(&bar[XB_XCNT(b.x)], 1u);
    return b;
}
__device__ __forceinline__ void xcd_barrier_complete(unsigned* bar, unsigned x, unsigned& nloc, unsigned& nx) {
    const unsigned G = gridDim.x * gridDim.y * gridDim.z;
    unsigned sum, cnt, mine, sp = 0u;
    for (;;) {
        sum = 0u; cnt = 0u; mine = 0u;
#pragma unroll
        for (unsigned j = 0; j < 16; ++j) { const unsigned c = xb_ld(&bar[XB_XCNT(j)]); sum += c; cnt += (c > 0u) ? 1u : 0u; mine = (j == x) ? c : mine; }
        if (sum == G) break;
        __builtin_amdgcn_s_sleep(1);
        if ((++sp & 255u) == 0u) { if (xb_ld(&bar[XB_TMO])) break; if (sp > XB_SPIN_CAP) { atomicAdd(&bar[XB_TMO], 1u); break; } }
    }
    nloc = mine > 0u ? mine : 1u; nx = cnt > 0u ? cnt : 1u;
}
__device__ __forceinline__ void xcd_barrier(const XcdBarrier& b, int tid) {
    asm volatile("s_waitcnt vmcnt(0)" ::: "memory");
    __syncthreads();
    if (tid == 0) {
        unsigned* bar = b.bar;
        __builtin_amdgcn_s_waitcnt(0);
        unsigned nloc = b.st[0], nx = b.st[1];
        if (nloc == 0u) { xcd_barrier_complete(bar, b.x, nloc, nx); b.st[0] = nloc; b.st[1] = nx; }
        const unsigned old = xb_add(&bar[XB_XSUB(b.x)], 1u);
        const unsigned gen = old / nloc;
        if (old + 1u == (gen + 1u) * nloc) {
            __builtin_amdgcn_fence(__ATOMIC_RELEASE, "agent");
            asm volatile("s_waitcnt vmcnt(0)" ::: "memory");
            const unsigned og = xb_add(&bar[XB_TOP], 1u);
            const unsigned tg = og / nx;
            if (og + 1u == (tg + 1u) * nx) xb_add(&bar[XB_TOPGEN], 1u);
            else XB_SPIN(xb_ld(&bar[XB_TOPGEN]) == tg, bar);
            __builtin_amdgcn_fence(__ATOMIC_ACQUIRE, "agent");
            xb_add(&bar[XB_XGEN(b.x)], 1u);
            asm volatile("s_waitcnt vmcnt(0)" ::: "memory");
        } else {
            XB_SPIN(xb_ld(&bar[XB_XGEN(b.x)]) == gen, bar);
            __builtin_amdgcn_fence(__ATOMIC_ACQUIRE, "agent");
            asm volatile("s_waitcnt vmcnt(0)" ::: "memory");
        }
    }
    __syncthreads();
}

constexpr int SPC = 13, NSTEP = 1 + SPC * NCHUNK + 1;
struct Args { const float* in[21]; float* out; unsigned char* ws; int ph_lo, ph_hi; };

__global__ void __launch_bounds__(512, 2) fwd_kernel(Args args) {
    extern __shared__ __attribute__((aligned(16))) unsigned char lds_raw[];
    LAS unsigned char* lds = (LAS unsigned char*)lds_raw;
    const int wave0 = __builtin_amdgcn_readfirstlane(threadIdx.x >> 6);
#if MEGA
    volatile LAS unsigned* bst = (volatile LAS unsigned*)(lds + LDS_BYTES - 16);
    if (threadIdx.x < 2) bst[threadIdx.x] = 0u;
    __syncthreads();
    XcdBarrier xbar = xcd_barrier_post((unsigned*)args.ws + 4096, bst, (int)threadIdx.x);
#endif
    for (int ph = args.ph_lo; ph < args.ph_hi; ++ph) {
    unsigned zl = 0u; asm volatile("" : "+s"(zl)); int wave_l = wave0; asm volatile("" : "+s"(wave_l));
    int tid_l = wave_l * 64 + (int)__builtin_amdgcn_mbcnt_hi(~0u, __builtin_amdgcn_mbcnt_lo(~0u, zl)); asm volatile("" : "+v"(tid_l));
    unsigned char* ws = args.ws; asm volatile("" : "+s"(ws));
    const int tid = tid_l, lane = tid & 63; const int wave = wave_l;
    const int G = gridDim.x, bx = blockIdx.x; const int vcu = (G % 8 == 0) ? (bx % 8) * (G / 8) + bx / 8 : bx;
    const int gw = vcu * 8 + wave, NGW = G * 8;
    bf16_t* Win_t = (bf16_t*)(ws + WS_WIN); bf16_t* Wuq_t = (bf16_t*)(ws + WS_WUQ); bf16_t* Wukv_t = (bf16_t*)(ws + WS_WUKV); bf16_t* Pa_t = (bf16_t*)(ws + WS_PA);
    bf16_t* Pb_t = (bf16_t*)(ws + WS_PB); bf16_t* Wout_t = (bf16_t*)(ws + WS_WOUT); bf16_t* Wup_t = (bf16_t*)(ws + WS_WUP); bf16_t* Wdown_t = (bf16_t*)(ws + WS_WDOWN);
    float* MOD = (float*)(ws + WS_MOD); float* ROPE = (float*)(ws + WS_ROPE); float* RSTD = (float*)(ws + WS_RSTD);
    bf16_t* Hb = (bf16_t*)(ws + WS_H); bf16_t* Zb = (bf16_t*)(ws + WS_Z); bf16_t* Qb = (bf16_t*)(ws + WS_Q); bf16_t* KFb = (bf16_t*)(ws + WS_KF); bf16_t* Vb = (bf16_t*)(ws + WS_V);
    bf16_t* OAb = (bf16_t*)(ws + WS_OA); bf16_t* OBb = (bf16_t*)(ws + WS_OB); float* OGb = (float*)(ws + WS_OG); float* LSEb = (float*)(ws + WS_LSE);
    bf16_t* Tb = (bf16_t*)(ws + WS_T); bf16_t* MGb = (bf16_t*)(ws + WS_MERGED); float* EDGEb = (float*)(ws + WS_EDGE); bf16_t* X1b = (bf16_t*)(ws + WS_OA); bf16_t* UPb = (bf16_t*)(ws + WS_UP); bf16_t* ACTb = (bf16_t*)(ws + WS_ACT);
    bool sync_after = true;
        if (ph == 0) {
            if (bx < 96) {
                LAS float* sl = (LAS float*)lds;
                LAS float* part = (LAS float*)(lds + 49152);
                for (int idx = tid; idx < 12 * 1024; idx += 512) { const int b = idx >> 10, d = idx & 1023; const float c = b < 8 ? args.in[2][b * 1024 + d] : args.in[3][(b - 8) * 1024 + d];
                    sl[d * 12 + b] = c / (1.0f + __expf(-c)); }
                __syncthreads();
                const int e = bx * 64 + lane; float acc[12];
#pragma unroll
                for (int b = 0; b < 12; ++b) acc[b] = 0.f;
                const float* wp = args.in[4] + (size_t)(wave * 128) * 6144 + e;
#pragma unroll 8
                for (int d = 0; d < 128; ++d) { const float w = wp[(size_t)d * 6144]; const LAS f32x4* s4 = (const LAS f32x4*)(sl + (wave * 128 + d) * 12);
                    const f32x4 a = s4[0], b4 = s4[1], c4 = s4[2];
                    acc[0] += a.x * w; acc[1] += a.y * w; acc[2] += a.z * w; acc[3] += a.w * w; acc[4] += b4.x * w; acc[5] += b4.y * w; acc[6] += b4.z * w; acc[7] += b4.w * w;
                    acc[8] += c4.x * w; acc[9] += c4.y * w; acc[10] += c4.z * w; acc[11] += c4.w * w; }
#pragma unroll
                for (int b = 0; b < 12; ++b) part[(wave * 12 + b) * 64 + lane] = acc[b];
                __syncthreads();
                if (wave == 0) {
#pragma unroll
                    for (int b = 0; b < 12; ++b) { float s = args.in[5][e];
#pragma unroll
                        for (int w = 0; w < 8; ++w) s += part[(w * 12 + b) * 64 + lane];
                        MOD[b * 6144 + e] = s; } }
                __syncthreads();
            }
            for (int idx = bx * 512 + tid; idx < 8192 * 16; idx += G * 512) { const int pos = idx >> 4, i = idx & 15; const float ang = (float)pos * ROPE_INV[i];
                const double tt = (double)ang * 0.15915494309189535; const float fr_ = (float)(tt - floor(tt));
                ROPE[idx] = __builtin_amdgcn_cosf(fr_); ROPE[131072 + idx] = __builtin_amdgcn_sinf(fr_); }
            {
                LAS float* scr = (LAS float*)(lds + wave * 16384);
                constexpr int I_IN = 16 * 157, I_UQ = 6 * 48, I_UKV = 4 * 64, I_PA = 16 * 32, I_PB = 4 * 32, I_OUT = 16 * 32, I_UP = 16 * 176, I_DOWN = 44 * 32;
                constexpr int NITEMS = I_IN + I_UQ + I_UKV + I_PA + I_PB + I_OUT + I_UP + I_DOWN;
                for (int it = gw; it < NITEMS; it += NGW) {
                    int r = it; const float* W; int K, N, kind = 0; bf16_t* WT; const float* ks = nullptr;
                    if (r < I_IN) { W = args.in[7]; K = 1024; N = 5024; WT = Win_t; kind = 1; }
                    else if ((r -= I_IN) < I_UQ) { W = args.in[10]; K = 384; N = 1536; WT = Wuq_t; kind = 2; ks = args.in[8]; }
                    else if ((r -= I_UQ) < I_UKV) { W = args.in[11]; K = 256; N = 2048; WT = Wukv_t; kind = 3; ks = args.in[9]; }
                    else if ((r -= I_UKV) < I_PA) { W = args.in[12]; K = 1024; N = 1024; WT = Pa_t; }
                    else if ((r -= I_PA) < I_PB) { W = args.in[13]; K = 256; N = 1024; WT = Pb_t; }
                    else if ((r -= I_PB) < I_OUT) { W = args.in[14]; K = 1024; N = 1024; WT = Wout_t; }
                    else if ((r -= I_OUT) < I_UP) { W = args.in[16]; K = 1024; N = 5632; WT = Wup_t; kind = 4; }
                    else { r -= I_UP; W = args.in[19]; K = 2816; N = 1024; WT = Wdown_t; }
                    transpose_item(W, K, N, WT, kind, ks, scr, r, lane);
                }
                for (int idx = bx * 512 + tid; idx < 96 * 128; idx += G * 512) *(u32x4*)(Win_t + (size_t)672 * 1024 + (size_t)idx * 8) = (u32x4){0u, 0u, 0u, 0u};
            }
            __syncthreads();
        } else if (ph == NSTEP - 1) {
            float* o = args.out + (size_t)(NCHUNK - 1) * CH * D;
            for (int m = gw; m < CH; m += NGW) final_norm_row(X1b + (size_t)m * D, o + (size_t)m * D, args.in[20], lane);
        } else {
            const int c = (ph - 1) / SPC, k = (ph - 1) - SPC * c;
            ChunkP P;
            if (c == 0) { P.x = args.in[0]; P.S = 2048; P.Sshift = 11; P.nseq = 8; P.seqbase = 0; }
            else { P.x = args.in[1] + (size_t)(c - 1) * CH * D; P.S = 8192; P.Sshift = 13; P.nseq = 2; P.seqbase = 8 + 2 * (c - 1); }
            P.out = args.out + (size_t)c * CH * D;
            sync_after = !(k == 3 || k == 6);
            pg8::Gemm g{}; pg8::EpiAny E{}; bool is_gemm = true;
            E.ws = ws; E.S = P.S; E.Sshift = P.Sshift; E.seqbase = P.seqbase;
            if (k == 1) { g = pg8::Gemm{Hb, Win_t, CH, ZLD, 1024, 1024}; E.kind = 0; }
            else if (k == 3) { g = pg8::Gemm{Zb, Wuq_t, CH, 1536, 384, ZLD}; E.kind = 1; }
            else if (k == 4) { g = pg8::Gemm{Zb + 384, Wukv_t, CH, 2048, 256, ZLD}; E.kind = 2; }
            else if (k == 6) { g = pg8::Gemm{OAb, Pa_t, CH, 1024, 1024, 1024}; E.kind = 3; }
            else if (k == 7) { g = pg8::Gemm{OBb, Pb_t, CH, 1024, 256, 256}; E.kind = 4; }
            else if (k == 8) { g = pg8::Gemm{MGb, Wout_t, CH, 1024, 1024, 1024}; E.kind = 5; E.base = P.x; E.goff = 2048; E.rmode = 0; }
            else if (k == 10) { g = pg8::Gemm{Hb, Wup_t, CH, NUP, 1024, 1024}; E.kind = 6; E.cw = args.in[17]; E.cbias = args.in[18]; E.xl = lds + 131072; }
            else if (k == 12) { g = pg8::Gemm{ACTb, Wdown_t, CH, 1024, DFF, DFF}; E.kind = 5; E.base = nullptr; E.goff = 5120; E.rmode = 1; }
            else is_gemm = false;
            if (is_gemm) { pg8::StaticOrder S; S.init(g.M, g.N, G, bx); pg8::gemm_phase(lds, g, S, E, tid); }
            else if (k == 0) {
                if (c > 0) { float* o = args.out + (size_t)(c - 1) * CH * D; for (int m = gw; m < CH; m += NGW) final_norm_row(X1b + (size_t)m * D, o + (size_t)m * D, args.in[20], lane); }
                for (int m = gw; m < CH; m += NGW) { const float* md = MOD + (size_t)(P.seqbase + (m >> P.Sshift)) * 6144;
                    norm_mod_row(P.x + (size_t)m * D, Hb + (size_t)m * D, args.in[6], md + 1024, md, lane); }
            } else if (k == 2) {
                for (int m = gw; m < CH; m += NGW) {
                    const unsigned* zr = (const unsigned*)(Zb + (size_t)m * ZLD);
                    float sq = 0.f, skv = 0.f;
#pragma unroll
                    for (int j = 0; j < 3; ++j) { const unsigned w = zr[lane + 64 * j]; const float a = bflo(w), b = bfhi(w); sq += a * a + b * b; }
#pragma unroll
                    for (int j = 0; j < 2; ++j) { const unsigned w = zr[192 + lane + 64 * j]; const float a = bflo(w), b = bfhi(w); skv += a * a + b * b; }
                    sq = wave_sum(sq); skv = wave_sum(skv);
                    if (lane == 0) { RSTD[2 * m] = 1.0f / sqrtf(sq * (1.f / 384.f) + EPS); RSTD[2 * m + 1] = 1.0f / sqrtf(skv * (1.f / 256.f) + EPS); }
                    const int seq = m >> P.Sshift, pos = m & (P.S - 1);
                    unsigned pr = 0u;
                    { const int i = lane & 15; const unsigned w = zr[320 + i]; const float a = bflo(w), b = bfhi(w); const float cs = ROPE[pos * 16 + i], sn = ROPE[131072 + pos * 16 + i];
                      pr = cvt_pk_bf16(a * cs - b * sn, a * sn + b * cs); }
                    u32x4 o; const int b4 = 4 * (lane & 3);
                    o.x = __shfl(pr, b4); o.y = __shfl(pr, b4 + 1); o.z = __shfl(pr, b4 + 2); o.w = __shfl(pr, b4 + 3);
                    const int head = lane >> 2;
                    *(u32x4*)(KFb + ((size_t)((seq * 16 + head) << P.Sshift) + pos) * 96 + 64 + 8 * (lane & 3)) = o;
                }
                LAS unsigned char* wl = lds + wave * 4096;
                for (int task = gw; task < CH * 12 / 32; task += NGW) dil_task(Zb, OGb, LSEb, P.S, task, wl, lane);
            } else if (k == 5) {
                for (int it = bx * 512 + tid; it < CH * 32; it += G * 512) { const int row = it >> 5, j = (it >> 3) & 3, d8 = (it & 7) * 8;
                    const float l0 = LSEb[row * 12 + j], l1 = LSEb[row * 12 + 4 + j], l2 = LSEb[row * 12 + 8 + j]; const float mx = fmaxf(l0, fmaxf(l1, l2));
                    float w0 = __expf(l0 - mx), w1 = __expf(l1 - mx), w2 = __expf(l2 - mx); const float inv = 1.0f / (w0 + w1 + w2); w0 *= inv; w1 *= inv; w2 *= inv;
                    const float* p0 = OGb + ((size_t)row * 12 + j) * 64 + d8; const float* p1 = p0 + 4 * 64; const float* p2 = p0 + 8 * 64;
                    const f32x4 a0 = *(const f32x4*)p0 * w0 + *(const f32x4*)p1 * w1 + *(const f32x4*)p2 * w2;
                    const f32x4 a1 = *(const f32x4*)(p0 + 4) * w0 + *(const f32x4*)(p1 + 4) * w1 + *(const f32x4*)(p2 + 4) * w2;
                    *(u32x4*)(OBb + (size_t)row * 256 + j * 64 + d8) = pg8::pack8(a0, a1); }
                const int nqb = P.S >> 9, nunits = P.nseq * 16 * nqb;
                for (int uidx = vcu; uidx < nunits; uidx += G) { const int pair = uidx / nqb, qb = uidx - pair * nqb; const int seq = pair >> 4, head = pair & 15;
                    const size_t hb = (size_t)pair << P.Sshift;
                    mla::attn_unit(Qb + hb * 96, KFb + hb * 96, Vb + hb * 64, OAb + ((size_t)seq << P.Sshift) * D + head * 64, P.S, qb, lds, tid); }
            } else if (k == 9) {
                for (int m = gw; m < CH; m += NGW) { const float* md = MOD + (size_t)(P.seqbase + (m >> P.Sshift)) * 6144;
                    norm_mod_row16(X1b + (size_t)m * D, Hb + (size_t)m * D, args.in[15], md + 4096, md + 3072, lane); }
            } else if (k == 11) {
                for (int it = bx * 512 + tid; it < 128 * 352; it += G * 512) {
                    const int r = it / 352, f0 = (it - r * 352) * 8; const int which = r & 1, pm = r >> 1; const int pos0 = (pm * 256) & (P.S - 1);
                    const bool has_nb = which == 0 ? (pos0 > 0) : (pos0 + 256 < P.S);
                    const float* nb = EDGEb + (size_t)(which == 0 ? (pm - 1) * 2 + 1 : (pm + 1) * 2) * DFF + f0;
                    const float* wv = args.in[17] + (which == 0 ? 0 : 2 * DFF) + f0;
                    const float* pp = EDGEb + (size_t)128 * DFF + (size_t)r * DFF + f0; const float* pg = EDGEb + (size_t)256 * DFF + (size_t)r * DFF + f0;
                    float o[8];
#pragma unroll
                    for (int h = 0; h < 2; ++h) { const f32x4 p4 = *(const f32x4*)(pp + 4 * h), g4 = *(const f32x4*)(pg + 4 * h), w4 = *(const f32x4*)(wv + 4 * h);
                        f32x4 n4 = (f32x4){0.f, 0.f, 0.f, 0.f}; if (has_nb) n4 = *(const f32x4*)(nb + 4 * h);
#pragma unroll
                        for (int e = 0; e < 4; ++e) o[4 * h + e] = pg8::gelu_tanh_(p4[e] + w4[e] * n4[e]) * g4[e]; }
                    u32x4 w; w.x = cvt_pk_bf16(o[0], o[1]); w.y = cvt_pk_bf16(o[2], o[3]); w.z = cvt_pk_bf16(o[4], o[5]); w.w = cvt_pk_bf16(o[6], o[7]);
                    *(u32x4*)(ACTb + (size_t)(pm * 256 + (which ? 255 : 0)) * DFF + f0) = w;
                }
            }
        }
#if MEGA
        if (sync_after && ph + 1 < args.ph_hi) { if (ph == 0) cg::this_grid().sync(); else { int tb = tid; asm volatile("" : "+v"(tb)); xcd_barrier(xbar, tb); } }
#else
        (void)sync_after;
#endif
    }
}

extern "C" void kernel_launch(void* const* d_in, const int* in_sizes, int n_in, void* d_out, int out_size, void* d_ws, size_t ws_size, hipStream_t stream) {
    static int grid = 0;
    if (grid == 0) {
        if (n_in != 21 || ws_size < WS_END) { fprintf(stderr, "kernel_launch: unexpected n_in %d / ws_size %zu\n", n_in, ws_size); grid = -1; return; }
        int dev = 0, cus = 0, per_cu = 0;
        (void)hipGetDevice(&dev); (void)hipDeviceGetAttribute(&cus, hipDeviceAttributeMultiprocessorCount, dev);
        (void)hipFuncSetAttribute((const void*)fwd_kernel, hipFuncAttributeMaxDynamicSharedMemorySize, LDS_BYTES);
        (void)hipOccupancyMaxActiveBlocksPerMultiprocessor(&per_cu, (const void*)fwd_kernel, 512, LDS_BYTES);
        (void)hipGetLastError();
        if (per_cu < 1) fprintf(stderr, "kernel_launch: occupancy query says %d blocks/CU\n", per_cu);
        grid = cus;
    }
    if (grid < 0) return;
    Args a{};
    for (int i = 0; i < 21; ++i) a.in[i] = (const float*)d_in[i];
    a.out = (float*)d_out; a.ws = (unsigned char*)d_ws;
#if MEGA
    (void)hipMemsetAsync(d_ws, 0, 65536, stream);
    a.ph_lo = 0; a.ph_hi = NSTEP;
    void* kargs[] = {&a};
    hipError_t e = hipLaunchCooperativeKernel((const void*)fwd_kernel, dim3(grid), dim3(512), kargs, LDS_BYTES, stream);
    if (e != hipSuccess) fprintf(stderr, "cooperative launch failed: %s (grid %d)\n", hipGetErrorString(e), grid);
#else
    for (int ph = 0; ph < NSTEP; ++ph) { a.ph_lo = ph; a.ph_hi = ph + 1; hipLaunchKernelGGL(fwd_kernel, dim3(grid), dim3(512), LDS_BYTES, stream, a);
#ifdef PROBE_DUP
        if (ph > 0 && ph < NSTEP - 1 && ((PROBE_DUP >> ((ph - 1) % SPC)) & 1)) hipLaunchKernelGGL(fwd_kernel, dim3(grid), dim3(512), LDS_BYTES, stream, a);
#endif
    }
#endif
}
```

```cpp
#include <hip/hip_runtime.h>
#include <hip/hip_cooperative_groups.h>
#include <cstdio>
#include <cstdint>
namespace cg = cooperative_groups;

#ifndef MEGA
#define MEGA 1
#endif

#define LAS __attribute__((address_space(3)))
typedef unsigned short bf16_t;
typedef short bf16x8 __attribute__((ext_vector_type(8)));
typedef short s16x4 __attribute__((ext_vector_type(4)));
typedef float f32x2 __attribute__((ext_vector_type(2)));
typedef float f32x4 __attribute__((ext_vector_type(4)));
typedef float f32x16 __attribute__((ext_vector_type(16)));
typedef unsigned u32x2 __attribute__((ext_vector_type(2)));
typedef unsigned u32x4 __attribute__((ext_vector_type(4)));

constexpr int D = 1024, CH = 16384, NCHUNK = 3, ZLD = 5120, NUP = 5632, DFF = 2816;

constexpr float EPS = 1e-6f, LOG2E = 1.4426950408889634f, LN2 = 0.6931471805599453f;
constexpr float QSCALE = 0.10206207261596577f * LOG2E;
constexpr float DSCALE = 0.125f * LOG2E;

constexpr size_t MiB = 1u << 20;
constexpr size_t WS_WIN = 2 * MiB, WS_WUQ = 12 * MiB, WS_WUKV = 14 * MiB, WS_PA = 15 * MiB, WS_PB = 17 * MiB, WS_WOUT = 18 * MiB,
                 WS_WUP = 20 * MiB, WS_WDOWN = 31 * MiB;
constexpr size_t WS_MOD = 37 * MiB, WS_ROPE = 38 * MiB  , WS_RSTD = 39 * MiB + 512 * 1024;
constexpr size_t WS_H = 40 * MiB, WS_Z = 72 * MiB, WS_Q = 232 * MiB, WS_KF = 280 * MiB, WS_V = 328 * MiB, WS_OA = 360 * MiB, WS_OB = 392 * MiB,
                 WS_OG = 400 * MiB, WS_LSE = 448 * MiB, WS_T = 232 * MiB, WS_MERGED = 296 * MiB, WS_UP = 72 * MiB, WS_ACT = 248 * MiB, WS_EDGE = 449 * MiB  , WS_END = 454 * MiB;

constexpr int LDS_BYTES = 147456;

__device__ __forceinline__ unsigned cvt_pk_bf16(float lo, float hi) { unsigned r; asm volatile("v_cvt_pk_bf16_f32 %0, %1, %2" : "=v"(r) : "v"(lo), "v"(hi)); return r; }
__device__ __forceinline__ float bf2f(unsigned short b) { return __uint_as_float((unsigned)b << 16); }
__device__ __forceinline__ float bflo(unsigned w) { return __uint_as_float(w << 16); }
__device__ __forceinline__ float bfhi(unsigned w) { return __uint_as_float(w & 0xffff0000u); }
__device__ __forceinline__ float swap_add(float m);
#define DPP_ROR(v, n) __int_as_float(__builtin_amdgcn_update_dpp(0, __float_as_int(v), 0x120 + (n), 0xf, 0xf, false))
__device__ __forceinline__ float wave_sum(float v) {
    v += DPP_ROR(v, 1); v += DPP_ROR(v, 2); v += DPP_ROR(v, 4); v += DPP_ROR(v, 8);
    v += __shfl_xor(v, 16);
    return swap_add(v);
}
__device__ __forceinline__ float swap_max(float m) { auto rr = __builtin_amdgcn_permlane32_swap(__float_as_uint(m), __float_as_uint(m), false, false); return fmaxf(__uint_as_float(rr[0]), __uint_as_float(rr[1])); }
__device__ __forceinline__ float swap_add(float m) { auto rr = __builtin_amdgcn_permlane32_swap(__float_as_uint(m), __float_as_uint(m), false, false); return __uint_as_float(rr[0]) + __uint_as_float(rr[1]); }
__device__ __forceinline__ s16x4 vtr(LAS const unsigned char* p) { return __builtin_bit_cast(s16x4, __builtin_amdgcn_ds_read_tr16_b64_v4i16((LAS s16x4*)p)); }
__device__ __forceinline__ float sigmoidf_(float x) { return __builtin_amdgcn_rcpf(1.0f + __builtin_amdgcn_exp2f(-x * LOG2E)); }

struct ChunkP { const float* x; float* out; int S, Sshift, nseq, seqbase; };

namespace pg8 {
constexpr int BM = 256, BK = 64, HALF = 128, HTB = HALF * BK * 2, STAGE_BYTES = 8 * HTB, NXCD = 8, WGM = 8;
__host__ __device__ __forceinline__ int lds_byte(int r, int c) { const int st = (r >> 4) * 2 + (c >> 5), rr = r & 15, cc = c & 31, ob = rr * 64 + cc * 2; return st * 1024 + (ob ^ (((ob >> 9) & 1) << 5)); }
__host__ __device__ __forceinline__ void stage_rc(int b, int& R, int& C) { const int st = b / 1024, sb = b % 1024, swz = sb ^ (((sb >> 9) & 1) << 5); R = (st >> 1) * 16 + swz / 64; C = (st & 1) * 32 + (swz % 64) / 2; }
__host__ __device__ __forceinline__ int perm32(int rho) { const int n = rho >> 4, i = rho & 15; return 8 * (i >> 2) + 4 * n + (i & 3); }
struct Unit { int pm, pn; };
struct Gemm { const bf16_t* A; const bf16_t* Bt; int M, N, K, lda; };
struct StaticOrder {
    int nM, nN, nwg, G, c;
    __device__ void init(int M, int N, int G_, int c_) { nM = M / BM; nN = N / BM; nwg = nM * nN; G = G_; c = c_; }
    __device__ bool next(int i, Unit& u) const {
        const long L = (long)i * G + c; if (L >= nwg) return false;
        int wgid = (int)L; { const int q = nwg / NXCD, r = nwg % NXCD, xcd = wgid % NXCD, off = wgid / NXCD; wgid = (xcd < r ? xcd * (q + 1) : r * (q + 1) + (xcd - r) * q) + off; }
        const int nig = WGM * nN, gid = wgid / nig, fm = gid * WGM, gsz = (nM - fm) < WGM ? (nM - fm) : WGM;
        u.pm = fm + ((wgid % nig) % gsz); u.pn = (wgid % nig) / gsz; return true;
    }
};

template <class Epi, class Sched>
__device__ __forceinline__ void gemm_phase(LAS unsigned char* lds, const Gemm g, const Sched& S, const Epi& E, int tid_in) {
    int tid_ = tid_in; asm volatile("" : "+v"(tid_));
    const int tid = tid_, wid = __builtin_amdgcn_readfirstlane(tid >> 6), lane = tid & 63, wr = wid >> 2, wc = wid & 3, fr = lane & 15, fq = lane >> 4;
    const int K = g.K, nt = K / BK, lda = g.lda;
    unsigned voffA[2], voffB[2];
#pragma unroll
    for (int i = 0; i < 2; ++i) { int R, C; stage_rc(tid * 16 + i * 8192, R, C); const int Rb = (R & ~31) + perm32(R & 31);
        voffA[i] = (unsigned)(R * lda + C) * 2u; voffB[i] = (unsigned)(Rb * K + C) * 2u; }
    const size_t kstep = (size_t)(BK * 2);
    const size_t hstepA = (size_t)HALF * lda * 2, hstepB = (size_t)HALF * K * 2;
    const size_t tstepA = 2 * hstepA, tstepB = 2 * hstepB;
    const unsigned ldsw = (unsigned)wid * 1024u;
    const int aoff = lds_byte(wr * 64 + fr, fq * 8), boff = lds_byte(wc * 32 + fr, fq * 8);
#define PG8_SA(b, h) (((b) * 2 + (h)) * HTB)
#define PG8_SB(b, h) ((4 + (b) * 2 + (h)) * HTB)
#define PG8_STAGE(bufoff, gbase, voff) do { _Pragma("unroll") for (int _i = 0; _i < 2; ++_i) \
        __builtin_amdgcn_global_load_lds((const unsigned*)((const char*)(gbase) + (voff)[_i]), (LAS unsigned*)(lds + (bufoff) + ldsw + _i * 8192), 16, 0, 0); } while (0)
#define PG8_LDA(dst, b, h) do { _Pragma("unroll") for (int m = 0; m < 4; ++m) _Pragma("unroll") for (int k = 0; k < 2; ++k) dst[m][k] = *(const LAS bf16x8*)(lds + PG8_SA(b, h) + aoff + m * 2048 + k * 1024); } while (0)
#define PG8_LDB(dst, b, h) do { _Pragma("unroll") for (int n = 0; n < 2; ++n) _Pragma("unroll") for (int k = 0; k < 2; ++k) dst[n][k] = *(const LAS bf16x8*)(lds + PG8_SB(b, h) + boff + n * 2048 + k * 1024); } while (0)
#define PG8_MMA(ai, bj, At, Bt) do { __builtin_amdgcn_s_setprio(1); _Pragma("unroll") for (int m = 0; m < 4; ++m) _Pragma("unroll") for (int n = 0; n < 2; ++n) _Pragma("unroll") for (int k = 0; k < 2; ++k) \
        acc[ai][bj][m][n] = __builtin_amdgcn_mfma_f32_16x16x32_bf16(Bt[n][k], At[m][k], acc[ai][bj][m][n], 0, 0, 0); __builtin_amdgcn_s_setprio(0); } while (0)
#define PG8_WAIT_V(n) asm volatile("s_waitcnt vmcnt(" #n ")" ::: "memory")
#define PG8_WAIT_L(n) asm volatile("s_waitcnt lgkmcnt(" #n ")" ::: "memory")
#define PG8_BAR __builtin_amdgcn_s_barrier()
#define PG8_SCHED __builtin_amdgcn_sched_barrier(0)
    Unit cur, nxt; int ui = 0;
    if (!S.next(0, cur)) return;
    f32x4 acc[2][2][4][2];
#pragma unroll
    for (int a = 0; a < 2; ++a)
#pragma unroll
        for (int b = 0; b < 2; ++b)
#pragma unroll
            for (int m = 0; m < 4; ++m)
#pragma unroll
                for (int n = 0; n < 2; ++n) acc[a][b][m][n] = (f32x4){0.f, 0.f, 0.f, 0.f};
    bf16x8 At[4][2], B0[2][2], B1[2][2];
    const char* cA = (const char*)g.A + (size_t)cur.pm * tstepA; const char* cB = (const char*)g.Bt + (size_t)cur.pn * tstepB;
    PG8_STAGE(PG8_SB(0, 0), cB, voffB); PG8_STAGE(PG8_SB(0, 1), cB + hstepB, voffB); PG8_STAGE(PG8_SA(0, 0), cA, voffA); PG8_STAGE(PG8_SA(0, 1), cA + hstepA, voffA);
    if (wr == 1) PG8_BAR;
    PG8_WAIT_V(2); PG8_BAR;
    PG8_STAGE(PG8_SB(1, 0), cB + kstep, voffB); PG8_STAGE(PG8_SA(1, 0), cA + kstep, voffA); PG8_STAGE(PG8_SB(1, 1), cB + hstepB + kstep, voffB);
    PG8_WAIT_V(6); PG8_BAR;
    for (;;) {
        const bool has_next = S.next(ui + 1, nxt);
        const char* nA = has_next ? (const char*)g.A + (size_t)nxt.pm * tstepA : cA; const char* nB = has_next ? (const char*)g.Bt + (size_t)nxt.pn * tstepB : cB;
        for (int t = 0; t < nt; t += 2) {
            const bool last = (t == nt - 2);
            const char* a1 = cA + (size_t)(t + 1) * kstep;
            const char* a2 = last ? nA : cA + (size_t)(t + 2) * kstep; const char* b2 = last ? nB : cB + (size_t)(t + 2) * kstep;
            const char* a3 = a2 + kstep; const char* b3 = b2 + kstep;
            PG8_LDB(B0, 0, 0); PG8_LDB(B1, 0, 1); PG8_SCHED; PG8_LDA(At, 0, 0); PG8_STAGE(PG8_SA(1, 1), a1 + hstepA, voffA);
            PG8_WAIT_V(8); PG8_WAIT_L(0); PG8_BAR; PG8_MMA(0, 0, At, B0); PG8_MMA(0, 1, At, B1); PG8_BAR; PG8_SCHED;
            PG8_LDA(At, 0, 1); PG8_STAGE(PG8_SB(0, 0), b2, voffB); PG8_STAGE(PG8_SB(0, 1), b2 + hstepB, voffB); PG8_STAGE(PG8_SA(0, 0), a2, voffA);
            PG8_WAIT_V(8); PG8_WAIT_L(0); PG8_BAR; PG8_MMA(1, 0, At, B0); PG8_MMA(1, 1, At, B1); PG8_BAR; PG8_SCHED;
            PG8_LDB(B0, 1, 0); PG8_LDB(B1, 1, 1); PG8_SCHED; PG8_LDA(At, 1, 0); PG8_STAGE(PG8_SA(0, 1), a2 + hstepA, voffA);
            PG8_WAIT_V(8); PG8_WAIT_L(0); PG8_BAR; PG8_MMA(0, 0, At, B0); PG8_MMA(0, 1, At, B1); PG8_BAR; PG8_SCHED;
            PG8_LDA(At, 1, 1); PG8_STAGE(PG8_SB(1, 0), b3, voffB); PG8_STAGE(PG8_SB(1, 1), b3 + hstepB, voffB); PG8_STAGE(PG8_SA(1, 0), a3, voffA);
            PG8_WAIT_V(8); PG8_WAIT_L(0); PG8_BAR; PG8_MMA(1, 0, At, B0); PG8_MMA(1, 1, At, B1); PG8_BAR; PG8_SCHED;
        }
        if (wr == 0) PG8_BAR;
        E(acc, cur, wr, wc, fr, fq);
        if (!has_next) break;
#pragma unroll
        for (int a = 0; a < 2; ++a)
#pragma unroll
            for (int b = 0; b < 2; ++b)
#pragma unroll
                for (int m = 0; m < 4; ++m)
#pragma unroll
                    for (int n = 0; n < 2; ++n) acc[a][b][m][n] = (f32x4){0.f, 0.f, 0.f, 0.f};
        cur = nxt; cA = nA; cB = nB; ++ui;
        if (wr == 1) PG8_BAR;
    }
    PG8_WAIT_V(0);
    PG8_BAR;
#undef PG8_SA
#undef PG8_SB
#undef PG8_STAGE
#undef PG8_LDA
#undef PG8_LDB
#undef PG8_MMA
#undef PG8_WAIT_V
#undef PG8_WAIT_L
#undef PG8_BAR
#undef PG8_SCHED
}

#define EPI_ARGS const f32x4 (&acc)[2][2][4][2], const Unit& u, int wr, int wc, int fr, int fq
__device__ __forceinline__ u32x4 pack8(f32x4 v0, f32x4 v1) { u32x4 w; w.x = cvt_pk_bf16(v0[0], v0[1]); w.y = cvt_pk_bf16(v0[2], v0[3]); w.z = cvt_pk_bf16(v1[0], v1[1]); w.w = cvt_pk_bf16(v1[2], v1[3]); return w; }

struct EpiStore {
    bf16_t* O; int ldc; int sig_pn;
    __device__ __forceinline__ void operator()(EPI_ARGS) const {
        const int row0 = u.pm * BM + wr * 64 + fr, col0 = u.pn * BM + wc * 32 + 8 * fq; const bool sig = u.pn >= sig_pn;
#pragma unroll
        for (int ai = 0; ai < 2; ++ai)
#pragma unroll
            for (int m = 0; m < 4; ++m) { bf16_t* rowp = O + (size_t)(row0 + ai * HALF + m * 16) * ldc + col0;
#pragma unroll
                for (int bj = 0; bj < 2; ++bj) { f32x4 v0 = acc[ai][bj][m][0], v1 = acc[ai][bj][m][1];
                    if (sig) {
#pragma unroll
                        for (int e = 0; e < 4; ++e) { v0[e] = sigmoidf_(v0[e]); v1[e] = sigmoidf_(v1[e]); } }
                    *(u32x4*)(rowp + bj * HALF) = pack8(v0, v1); } }
    }
};
struct EpiQ {
    bf16_t* Q; const float* rstd; const float* rope; int S, Sshift;
    __device__ __forceinline__ void operator()(EPI_ARGS) const {
        const int row0 = u.pm * BM + wr * 64 + fr;
#pragma unroll
        for (int ai = 0; ai < 2; ++ai)
#pragma unroll
            for (int m = 0; m < 4; ++m) { const int row = row0 + ai * HALF + m * 16; const int seq = row >> Sshift, pos = row & (S - 1);
                const float sc = rstd[2 * row] * QSCALE;
#pragma unroll
                for (int bj = 0; bj < 2; ++bj) { const int g32 = 8 * u.pn + 4 * bj + wc; const int head = g32 / 3, gl = g32 - 3 * head;
                    f32x4 v0 = acc[ai][bj][m][0] * sc, v1 = acc[ai][bj][m][1] * sc;
                    if (gl == 2) { const f32x4 cs = *(const f32x4*)(rope + (size_t)pos * 16 + 4 * fq), sn = *(const f32x4*)(rope + 131072 + (size_t)pos * 16 + 4 * fq);
                        f32x4 w0, w1;
                        w0[0] = v0[0] * cs[0] - v0[1] * sn[0]; w0[1] = v0[0] * sn[0] + v0[1] * cs[0];
                        w0[2] = v0[2] * cs[1] - v0[3] * sn[1]; w0[3] = v0[2] * sn[1] + v0[3] * cs[1];
                        w1[0] = v1[0] * cs[2] - v1[1] * sn[2]; w1[1] = v1[0] * sn[2] + v1[1] * cs[2];
                        w1[2] = v1[2] * cs[3] - v1[3] * sn[3]; w1[3] = v1[2] * sn[3] + v1[3] * cs[3];
                        v0 = w0; v1 = w1; }
                    *(u32x4*)(Q + ((size_t)((seq * 16 + head) << Sshift) + pos) * 96 + gl * 32 + 8 * fq) = pack8(v0, v1); }
                asm volatile("" ::: "memory"); }
    }
};
struct EpiKV {
    bf16_t* KF; bf16_t* V; const float* rstd; int S, Sshift;
    __device__ __forceinline__ void operator()(EPI_ARGS) const {
        const int row0 = u.pm * BM + wr * 64 + fr; const bool isv = u.pn >= 4;
#pragma unroll
        for (int ai = 0; ai < 2; ++ai)
#pragma unroll
            for (int m = 0; m < 4; ++m) { const int row = row0 + ai * HALF + m * 16; const int seq = row >> Sshift, pos = row & (S - 1);
                const float sc = rstd[2 * row + 1];
#pragma unroll
                for (int bj = 0; bj < 2; ++bj) { const int col = (u.pn & 3) * BM + bj * HALF + wc * 32 + 8 * fq; const int head = col >> 6, d = col & 63;
                    const f32x4 v0 = acc[ai][bj][m][0] * sc, v1 = acc[ai][bj][m][1] * sc; const size_t tok = (size_t)((seq * 16 + head) << Sshift) + pos;
                    bf16_t* p = isv ? V + tok * 64 + d : KF + tok * 96 + d;
                    *(u32x4*)p = pack8(v0, v1); }
                asm volatile("" ::: "memory"); }
    }
};
struct EpiGateA {
    bf16_t* T; const bf16_t* Z;
    __device__ __forceinline__ void operator()(EPI_ARGS) const {
        const int row0 = u.pm * BM + wr * 64 + fr, col0 = u.pn * BM + wc * 32 + 8 * fq;
#pragma unroll
        for (int ai = 0; ai < 2; ++ai)
#pragma unroll
            for (int m = 0; m < 4; ++m) { const int row = row0 + ai * HALF + m * 16;
#pragma unroll
                for (int bj = 0; bj < 2; ++bj) { const int col = col0 + bj * HALF; const u32x4 gw = *(const u32x4*)(Z + (size_t)row * ZLD + 3072 + col);
                    f32x4 v0 = acc[ai][bj][m][0], v1 = acc[ai][bj][m][1];
                    v0[0] *= bflo(gw.x); v0[1] *= bfhi(gw.x); v0[2] *= bflo(gw.y); v0[3] *= bfhi(gw.y); v1[0] *= bflo(gw.z); v1[1] *= bfhi(gw.z); v1[2] *= bflo(gw.w); v1[3] *= bfhi(gw.w);
                    *(u32x4*)(T + (size_t)row * D + col) = pack8(v0, v1); }
                asm volatile("" ::: "memory"); }
    }
};
struct EpiGateB {
    const bf16_t* T; const bf16_t* Z; bf16_t* O;
    __device__ __forceinline__ void operator()(EPI_ARGS) const {
        const int row0 = u.pm * BM + wr * 64 + fr, col0 = u.pn * BM + wc * 32 + 8 * fq;
#pragma unroll
        for (int ai = 0; ai < 2; ++ai)
#pragma unroll
            for (int m = 0; m < 4; ++m) { const int row = row0 + ai * HALF + m * 16;
#pragma unroll
                for (int bj = 0; bj < 2; ++bj) { const int col = col0 + bj * HALF; const u32x4 gw = *(const u32x4*)(Z + (size_t)row * ZLD + 4096 + col);
                    const u32x4 tw = *(const u32x4*)(T + (size_t)row * D + col); f32x4 v0 = {bflo(tw.x), bfhi(tw.x), bflo(tw.y), bfhi(tw.y)}, v1 = {bflo(tw.z), bfhi(tw.z), bflo(tw.w), bfhi(tw.w)};
                    const f32x4 a0 = acc[ai][bj][m][0], a1 = acc[ai][bj][m][1];
                    v0[0] += a0[0] * bflo(gw.x); v0[1] += a0[1] * bfhi(gw.x); v0[2] += a0[2] * bflo(gw.y); v0[3] += a0[3] * bfhi(gw.y);
                    v1[0] += a1[0] * bflo(gw.z); v1[1] += a1[1] * bfhi(gw.z); v1[2] += a1[2] * bflo(gw.w); v1[3] += a1[3] * bfhi(gw.w);
                    *(u32x4*)(O + (size_t)row * D + col) = pack8(v0, v1); }
                asm volatile("" ::: "memory"); }
    }
};
struct EpiResid {
    const float* base; float* out; const float* mod; int goff, Sshift, seqbase; int mode; bf16_t* x1;
    __device__ __forceinline__ void operator()(EPI_ARGS) const {
        const int row0 = u.pm * BM + wr * 64 + fr, col0 = u.pn * BM + wc * 32 + 8 * fq;
        const float* gt = mod + (size_t)(seqbase + ((u.pm * BM) >> Sshift)) * 6144 + goff + col0;
        f32x4 g[2][2];
#pragma unroll
        for (int bj = 0; bj < 2; ++bj) { g[bj][0] = *(const f32x4*)(gt + bj * HALF); g[bj][1] = *(const f32x4*)(gt + bj * HALF + 4); }
#pragma unroll
        for (int ai = 0; ai < 2; ++ai)
#pragma unroll
            for (int m = 0; m < 4; ++m) { const size_t off = (size_t)(row0 + ai * HALF + m * 16) * D + col0;
#pragma unroll
                for (int bj = 0; bj < 2; ++bj) {
                    if (mode == 0) { const f32x4 b0 = *(const f32x4*)(base + off + bj * HALF), b1 = *(const f32x4*)(base + off + bj * HALF + 4);
                        *(u32x4*)(x1 + off + bj * HALF) = pack8(b0 + g[bj][0] * acc[ai][bj][m][0], b1 + g[bj][1] * acc[ai][bj][m][1]); }
                    else { const u32x4 w = *(const u32x4*)(x1 + off + bj * HALF); const f32x4 b0 = {bflo(w.x), bfhi(w.x), bflo(w.y), bfhi(w.y)}, b1 = {bflo(w.z), bfhi(w.z), bflo(w.w), bfhi(w.w)};
                        *(u32x4*)(x1 + off + bj * HALF) = pack8(b0 + g[bj][0] * acc[ai][bj][m][0], b1 + g[bj][1] * acc[ai][bj][m][1]); } }
                if (m & 1) asm volatile("" ::: "memory"); }
    }
};

__device__ __forceinline__ float dpp_prev(float oldv, float v) { return __int_as_float(__builtin_amdgcn_update_dpp(__float_as_int(oldv), __float_as_int(v), 0x111, 0xf, 0xf, false)); }
__device__ __forceinline__ float dpp_next(float oldv, float v) { return __int_as_float(__builtin_amdgcn_update_dpp(__float_as_int(oldv), __float_as_int(v), 0x101, 0xf, 0xf, false)); }
__device__ __forceinline__ float dpp_ror1(float v)  { return __int_as_float(__builtin_amdgcn_update_dpp(0, __float_as_int(v), 0x121, 0xf, 0xf, false)); }
__device__ __forceinline__ float dpp_ror15(float v) { return __int_as_float(__builtin_amdgcn_update_dpp(0, __float_as_int(v), 0x12F, 0xf, 0xf, false)); }
__device__ __forceinline__ float gelu_tanh_(float x) { const float y = 0.7978845608028654f * (x + 0.044715f * x * x * x); return x * sigmoidf_(2.0f * y); }
struct EpiConv {
    bf16_t* ACT; const float* cw; const float* cbias; float* EDGEU; float* PARTP; float* PARTG; LAS unsigned char* xl;
    __device__ __forceinline__ void operator()(EPI_ARGS) const {
#define UU(ai, m, e) acc[ai][0][m][(e) >> 2][(e) & 3]
#define GG(ai, m, e) acc[ai][1][m][(e) >> 2][(e) & 3]
        const int c0 = u.pn * 128 + wc * 32 + 8 * fq;
        float w0[8], w1[8], w2[8], cb[8];
        { const f32x4* wp = (const f32x4*)(cw + c0); const f32x4 a0 = wp[0], a1 = wp[1], b0 = wp[DFF / 4], b1 = wp[DFF / 4 + 1], d0 = wp[2 * DFF / 4], d1 = wp[2 * DFF / 4 + 1];
          const f32x4* bp = (const f32x4*)(cbias + c0); const f32x4 e0 = bp[0], e1 = bp[1];
#pragma unroll
          for (int e = 0; e < 4; ++e) { w0[e] = a0[e]; w0[4 + e] = a1[e]; w1[e] = b0[e]; w1[4 + e] = b1[e]; w2[e] = d0[e]; w2[4 + e] = d1[e]; cb[e] = e0[e]; cb[4 + e] = e1[e]; } }
        LAS float* XE = (LAS float*)xl;
#pragma unroll
        for (int ai = 0; ai < 2; ++ai) { const int blk = 2 * ai + wr;
            if (fr == 0) {
#pragma unroll
                for (int e = 0; e < 8; ++e) XE[((blk * 2 + 0) * 4 + wc) * 32 + fq * 8 + e] = UU(ai, 0, e); }
            if (fr == 15) {
#pragma unroll
                for (int e = 0; e < 8; ++e) XE[((blk * 2 + 1) * 4 + wc) * 32 + fq * 8 + e] = UU(ai, 3, e); } }
        if (wr == 0 && fr == 0) { float* ep = EDGEU + (size_t)(u.pm * 2 + 0) * DFF + c0; *(f32x4*)ep = acc[0][0][0][0]; *(f32x4*)(ep + 4) = acc[0][0][0][1]; }
        if (wr == 1 && fr == 15) { float* ep = EDGEU + (size_t)(u.pm * 2 + 1) * DFF + c0; *(f32x4*)ep = acc[1][0][3][0]; *(f32x4*)(ep + 4) = acc[1][0][3][1]; }
        asm volatile("s_waitcnt lgkmcnt(0)" ::: "memory"); __builtin_amdgcn_s_barrier(); asm volatile("" ::: "memory");
#pragma unroll
        for (int ai = 0; ai < 2; ++ai) { const int blk = 2 * ai + wr;
#pragma unroll
            for (int m = 0; m < 4; ++m) { const int row = u.pm * BM + ai * HALF + wr * 64 + m * 16 + fr;
                float pre[8], r[8], ex[8];
#pragma unroll
                for (int e = 0; e < 8; ++e) ex[e] = 0.f;
                if (m == 0 && blk > 0 && fr == 0) {
#pragma unroll
                    for (int e = 0; e < 8; ++e) ex[e] = XE[(((blk - 1) * 2 + 1) * 4 + wc) * 32 + fq * 8 + e]; }
                if (m == 3 && blk < 3 && fr == 15) {
#pragma unroll
                    for (int e = 0; e < 8; ++e) ex[e] = XE[(((blk + 1) * 2 + 0) * 4 + wc) * 32 + fq * 8 + e]; }
#pragma unroll
                for (int e = 0; e < 8; ++e) { const float uc = UU(ai, m, e);
                    const float oldp = (m == 0) ? ex[e] : dpp_ror1(UU(ai, m == 0 ? 0 : m - 1, e));
                    const float oldn = (m == 3) ? ex[e] : dpp_ror15(UU(ai, m == 3 ? 3 : m + 1, e));
                    const float up_ = dpp_prev(oldp, uc), un_ = dpp_next(oldn, uc);
                    pre[e] = cb[e] + w0[e] * up_ + w1[e] * uc + w2[e] * un_; r[e] = gelu_tanh_(pre[e]) * GG(ai, m, e); }
                const bool edge0 = (blk == 0 && m == 0 && fr == 0), edge1 = (blk == 3 && m == 3 && fr == 15);
                if (edge0 || edge1) { const size_t o = (size_t)(u.pm * 2 + (edge1 ? 1 : 0)) * DFF + c0;
                    *(f32x4*)(PARTP + o) = (f32x4){pre[0], pre[1], pre[2], pre[3]}; *(f32x4*)(PARTP + o + 4) = (f32x4){pre[4], pre[5], pre[6], pre[7]};
                    *(f32x4*)(PARTG + o) = acc[ai][1][m][0]; *(f32x4*)(PARTG + o + 4) = acc[ai][1][m][1]; }
                else { u32x4 w; w.x = cvt_pk_bf16(r[0], r[1]); w.y = cvt_pk_bf16(r[2], r[3]); w.z = cvt_pk_bf16(r[4], r[5]); w.w = cvt_pk_bf16(r[6], r[7]);
                    *(u32x4*)(ACT + (size_t)row * DFF + c0) = w; }
                asm volatile("" ::: "memory"); }
        }
#undef UU
#undef GG
    }
};

struct EpiAny {
    int kind;
    unsigned char* ws;
    int S, Sshift, seqbase, goff, rmode; const float* base; const float* cw; const float* cbias; LAS unsigned char* xl;
    __device__ __forceinline__ void operator()(EPI_ARGS) const {
        if (kind == 0) { EpiStore e{(bf16_t*)(ws + WS_Z), ZLD, 12}; e(acc, u, wr, wc, fr, fq); }
        else if (kind == 1) { EpiQ e{(bf16_t*)(ws + WS_Q), (const float*)(ws + WS_RSTD), (const float*)(ws + WS_ROPE), S, Sshift}; e(acc, u, wr, wc, fr, fq); }
        else if (kind == 2) { EpiKV e{(bf16_t*)(ws + WS_KF), (bf16_t*)(ws + WS_V), (const float*)(ws + WS_RSTD), S, Sshift}; e(acc, u, wr, wc, fr, fq); }
        else if (kind == 3) { EpiGateA e{(bf16_t*)(ws + WS_T), (const bf16_t*)(ws + WS_Z)}; e(acc, u, wr, wc, fr, fq); }
        else if (kind == 4) { EpiGateB e{(const bf16_t*)(ws + WS_T), (const bf16_t*)(ws + WS_Z), (bf16_t*)(ws + WS_MERGED)}; e(acc, u, wr, wc, fr, fq); }
        else if (kind == 5) { EpiResid e{base, nullptr, (const float*)(ws + WS_MOD), goff, Sshift, seqbase, rmode, (bf16_t*)(ws + WS_OA)}; e(acc, u, wr, wc, fr, fq); }
        else { float* ed = (float*)(ws + WS_EDGE); EpiConv e{(bf16_t*)(ws + WS_ACT), cw, cbias, ed, ed + 128 * DFF, ed + 256 * DFF, xl}; e(acc, u, wr, wc, fr, fq); }
    }
};
}

__device__ const float ROPE_INV[16] = {1.000000000e+00f, 5.623413324e-01f, 3.162277639e-01f, 1.778279394e-01f, 1.000000015e-01f, 5.623413250e-02f, 3.162277490e-02f, 1.778279431e-02f,
                                       9.999999776e-03f, 5.623413250e-03f, 3.162277630e-03f, 1.778279431e-03f, 1.000000047e-03f, 5.623413017e-04f, 3.162277571e-04f, 1.778279402e-04f};
__device__ __forceinline__ int perm_rope(int i) { return i < 16 ? 2 * i : 2 * (i - 16) + 1; }
__device__ __forceinline__ int rowmap(int kind, int n) {
    if (kind == 1) return n < 640 ? n : (n < 672 ? 640 + perm_rope(n - 640) : n + 96);
    if (kind == 2) { const int h = n / 96, c = n - h * 96; return c < 64 ? n : h * 96 + 64 + perm_rope(c - 64); }
    if (kind == 3) { const int h = n >> 7, c = n & 127; return c < 64 ? h * 64 + c : 1024 + h * 64 + (c - 64); }
    if (kind == 4) { const int f = n < DFF ? n : n - DFF; return (f >> 7) * 256 + (n < DFF ? 0 : 128) + (f & 127); }
    return n;
}
__device__ __forceinline__ void transpose_item(const float* W, int K, int N, bf16_t* WT, int kind, const float* ks, LAS float* scr, int item, int lane) {
    const int nblk = N / 32, kb = item / nblk, nb = item - kb * nblk, k0 = 64 * kb, n0 = 32 * nb;
#pragma unroll 8
    for (int i = 0; i < 32; ++i) { const int kk = 2 * i + (lane >> 5); float w = W[(size_t)(k0 + kk) * N + n0 + (lane & 31)]; if (ks) w *= ks[k0 + kk]; scr[kk * 33 + (lane & 31)] = w; }
    asm volatile("s_waitcnt lgkmcnt(0)" ::: "memory");
    const int c = lane & 7;
#pragma unroll
    for (int j = 0; j < 4; ++j) { const int n = (lane >> 3) + 8 * j; const LAS float* s = scr + (8 * c) * 33 + n;
        u32x4 o; o.x = cvt_pk_bf16(s[0 * 33], s[1 * 33]); o.y = cvt_pk_bf16(s[2 * 33], s[3 * 33]); o.z = cvt_pk_bf16(s[4 * 33], s[5 * 33]); o.w = cvt_pk_bf16(s[6 * 33], s[7 * 33]);
        *(u32x4*)(WT + (size_t)rowmap(kind, n0 + n) * K + k0 + 8 * c) = o; }
    asm volatile("s_waitcnt lgkmcnt(0)" ::: "memory");
}

__device__ __forceinline__ void norm_mod_row(const float* xrow, bf16_t* orow, const float* g, const float* sc, const float* sh, int lane) {
    const f32x4* xr = (const f32x4*)xrow + lane; f32x4 v[4]; float s = 0.f;
#pragma unroll
    for (int j = 0; j < 4; ++j) { v[j] = xr[64 * j]; s += (v[j].x * v[j].x + v[j].y * v[j].y) + (v[j].z * v[j].z + v[j].w * v[j].w); }
    const float rstd = 1.0f / sqrtf(wave_sum(s) * (1.f / D) + EPS);
    u32x2* o8 = (u32x2*)orow + lane;
#pragma unroll
    for (int j = 0; j < 4; ++j) { const f32x4 gg = ((const f32x4*)g)[lane + 64 * j], ss = ((const f32x4*)sc)[lane + 64 * j], hh = ((const f32x4*)sh)[lane + 64 * j];
        const f32x4 o = v[j] * rstd * gg * (ss + 1.0f) + hh; u32x2 w; w.x = cvt_pk_bf16(o.x, o.y); w.y = cvt_pk_bf16(o.z, o.w); o8[64 * j] = w; }
}
__device__ __forceinline__ void norm_mod_row16(const bf16_t* xrow, bf16_t* orow, const float* g, const float* sc, const float* sh, int lane) {
    const u32x2* xr = (const u32x2*)xrow + lane; f32x4 v[4]; float s = 0.f;
#pragma unroll
    for (int j = 0; j < 4; ++j) { const u32x2 w = xr[64 * j]; v[j] = (f32x4){bflo(w.x), bfhi(w.x), bflo(w.y), bfhi(w.y)}; s += (v[j].x * v[j].x + v[j].y * v[j].y) + (v[j].z * v[j].z + v[j].w * v[j].w); }
    const float rstd = 1.0f / sqrtf(wave_sum(s) * (1.f / D) + EPS);
    u32x2* o8 = (u32x2*)orow + lane;
#pragma unroll
    for (int j = 0; j < 4; ++j) { const f32x4 gg = ((const f32x4*)g)[lane + 64 * j], ss = ((const f32x4*)sc)[lane + 64 * j], hh = ((const f32x4*)sh)[lane + 64 * j];
        const f32x4 o = v[j] * rstd * gg * (ss + 1.0f) + hh; u32x2 w; w.x = cvt_pk_bf16(o.x, o.y); w.y = cvt_pk_bf16(o.z, o.w); o8[64 * j] = w; }
}
__device__ __forceinline__ void final_norm_row(const bf16_t* xin, float* xrow, const float* g, int lane) {
    f32x4* xr = (f32x4*)xrow + lane; const u32x2* xi = (const u32x2*)xin + lane; f32x4 v[4]; float s = 0.f;
#pragma unroll
    for (int j = 0; j < 4; ++j) { const u32x2 w = xi[64 * j]; v[j] = (f32x4){bflo(w.x), bfhi(w.x), bflo(w.y), bfhi(w.y)}; s += (v[j].x * v[j].x + v[j].y * v[j].y) + (v[j].z * v[j].z + v[j].w * v[j].w); }
    const float rstd = 1.0f / sqrtf(wave_sum(s) * (1.f / D) + EPS);
#pragma unroll
    for (int j = 0; j < 4; ++j) xr[64 * j] = v[j] * rstd * ((const f32x4*)g)[lane + 64 * j];
}

__device__ __forceinline__ void ld_f32(const float* p, int lane, f32x4 (&v)[4]) { const f32x4* r = (const f32x4*)p + lane;
#pragma unroll
    for (int j = 0; j < 4; ++j) v[j] = r[64 * j]; }
__device__ __forceinline__ void ld_b16(const bf16_t* p, int lane, f32x4 (&v)[4]) { const u32x2* r = (const u32x2*)p + lane;
#pragma unroll
    for (int j = 0; j < 4; ++j) { const u32x2 w = r[64 * j]; v[j] = (f32x4){bflo(w.x), bfhi(w.x), bflo(w.y), bfhi(w.y)}; } }
__device__ __forceinline__ float ssq4(const f32x4 (&v)[4]) { float s = 0.f;
#pragma unroll
    for (int j = 0; j < 4; ++j) s += (v[j].x * v[j].x + v[j].y * v[j].y) + (v[j].z * v[j].z + v[j].w * v[j].w);
    return s; }
__device__ __forceinline__ void st_mod_b16(bf16_t* orow, int lane, const f32x4 (&v)[4], float rstd, const float* g, const float* sc, const float* sh) { u32x2* o8 = (u32x2*)orow + lane;
#pragma unroll
    for (int j = 0; j < 4; ++j) { const f32x4 gg = ((const f32x4*)g)[lane + 64 * j], ss = ((const f32x4*)sc)[lane + 64 * j], hh = ((const f32x4*)sh)[lane + 64 * j];
        const f32x4 o = v[j] * rstd * gg * (ss + 1.0f) + hh; u32x2 w; w.x = cvt_pk_bf16(o.x, o.y); w.y = cvt_pk_bf16(o.z, o.w); o8[64 * j] = w; } }
__device__ __forceinline__ void st_fin_f32(float* orow, int lane, const f32x4 (&v)[4], float rstd, const float* g) { f32x4* xr = (f32x4*)orow + lane;
#pragma unroll
    for (int j = 0; j < 4; ++j) xr[64 * j] = v[j] * rstd * ((const f32x4*)g)[lane + 64 * j]; }
#define RSTD_OF(s) (1.0f / sqrtf(wave_sum(s) * (1.f / D) + EPS))

__device__ __forceinline__ void dil_task(const bf16_t* Z, float* OG, float* LSE, int S, int task, LAS unsigned char* wl, int lane_in) {
    int lane = lane_in; asm volatile("" : "+v"(lane));
    const int r32 = lane & 31, hi = lane >> 5;
    const int bps = S >> 5, tps = 12 * bps;
    const int seq = task / tps; const int rem = task - seq * tps; const int hd = rem / bps; const int blk = rem - hd * bps;
    const int g = hd >> 2, sh = 2 * g, dl = 1 << sh; const int r = blk & (dl - 1), bi = blk >> sh;
    const int i0 = bi * 32, nsub = S >> sh;
    const size_t rowbase = (size_t)seq * S;
    const int tq = r + ((i0 + r32) << sh);
    const bf16_t* qp = Z + (rowbase + tq) * ZLD + 768 + hd * 64 + 8 * hi;
    bf16x8 qf[4];
#pragma unroll
    for (int s = 0; s < 4; ++s) qf[s] = *(const bf16x8*)(qp + 16 * s);
    f32x16 sc[5];
    {
        bf16x8 kf[5][4];
#pragma unroll
        for (int c = 0; c < 5; ++c) {
            int ik = i0 - 64 + 32 * c + r32; ik = ik < 0 ? 0 : (ik > nsub - 1 ? nsub - 1 : ik);
            const bf16_t* kp = Z + (rowbase + r + ((size_t)ik << sh)) * ZLD + 1536 + hd * 64 + 8 * hi;
#pragma unroll
            for (int s = 0; s < 4; ++s) kf[c][s] = *(const bf16x8*)(kp + 16 * s);
        }
#pragma unroll
        for (int c = 0; c < 5; ++c) {
            f32x16 a = {};
#pragma unroll
            for (int s = 0; s < 4; ++s) a = __builtin_amdgcn_mfma_f32_32x32x16_bf16(kf[c][s], qf[s], a, 0, 0, 0);
            sc[c] = a;
        }
    }
    asm volatile("" ::: "memory");
    u32x4 vv[5][4];
#pragma unroll
    for (int c = 0; c < 5; ++c)
#pragma unroll
        for (int i = 0; i < 4; ++i) { const int row = (lane >> 3) + 8 * i; int ik = i0 - 64 + 32 * c + row; ik = ik < 0 ? 0 : (ik > nsub - 1 ? nsub - 1 : ik);
            vv[c][i] = *(const u32x4*)(Z + (rowbase + r + ((size_t)ik << sh)) * ZLD + 2304 + hd * 64 + (lane & 7) * 8); }
    asm volatile("" ::: "memory");
    const float cb = __builtin_amdgcn_exp2f(-0.6666666667f * (float)(hd + 1)) * LOG2E * (float)dl;
    float mx = -INFINITY;
#pragma unroll
    for (int c = 0; c < 5; ++c)
#pragma unroll
        for (int e = 0; e < 16; ++e) {
            const int kvl = 32 * c + (e & 3) + 8 * (e >> 2) + 4 * hi; const int delta = kvl - 64 - r32; const int ik = i0 + r32 + delta;
            const int ad = delta < 0 ? -delta : delta; const bool valid = (ad <= 64) && (ik >= 0) && (ik < nsub);
            float v = sc[c][e] * DSCALE - cb * (float)ad; v = valid ? v : -INFINITY; sc[c][e] = v; mx = fmaxf(mx, v);
        }
    mx = swap_max(mx);
    float ls = 0.f;
#pragma unroll
    for (int c = 0; c < 5; ++c)
#pragma unroll
        for (int e = 0; e < 16; ++e) { const float p = __builtin_amdgcn_exp2f(sc[c][e] - mx); sc[c][e] = p; ls += p; }
    ls = swap_add(ls);
    f32x16 o0 = {}, o1 = {};
    const int vb = ((lane >> 4) & 1) * 32 + (lane & 3) * 8 + (4 * hi + ((lane & 15) >> 2)) * 64;
#pragma unroll
    for (int c = 0; c < 5; ++c) {
        asm volatile("s_waitcnt lgkmcnt(0)" ::: "memory");
#pragma unroll
        for (int i = 0; i < 4; ++i) { const int row = (lane >> 3) + 8 * i; *(LAS u32x4*)(wl + ((lane & 7) >> 2) * 2048 + row * 64 + (lane & 3) * 16) = vv[c][i]; }
        asm volatile("s_waitcnt lgkmcnt(0)" ::: "memory");
#pragma unroll
        for (int s = 0; s < 2; ++s) {
            u32x4 pw; pw.x = cvt_pk_bf16(sc[c][8 * s + 0], sc[c][8 * s + 1]); pw.y = cvt_pk_bf16(sc[c][8 * s + 2], sc[c][8 * s + 3]); pw.z = cvt_pk_bf16(sc[c][8 * s + 4], sc[c][8 * s + 5]); pw.w = cvt_pk_bf16(sc[c][8 * s + 6], sc[c][8 * s + 7]);
            const bf16x8 pf = __builtin_bit_cast(bf16x8, pw);
            { const s16x4 lo = vtr(wl + vb + s * 1024), hh = vtr(wl + vb + s * 1024 + 512); const bf16x8 vf = {lo[0], lo[1], lo[2], lo[3], hh[0], hh[1], hh[2], hh[3]};
              o0 = __builtin_amdgcn_mfma_f32_32x32x16_bf16(vf, pf, o0, 0, 0, 0); }
            { const s16x4 lo = vtr(wl + vb + 2048 + s * 1024), hh = vtr(wl + vb + 2048 + s * 1024 + 512); const bf16x8 vf = {lo[0], lo[1], lo[2], lo[3], hh[0], hh[1], hh[2], hh[3]};
              o1 = __builtin_amdgcn_mfma_f32_32x32x16_bf16(vf, pf, o1, 0, 0, 0); }
        }
    }
    const float inv = 1.0f / ls; const size_t rq = rowbase + tq;
    float* op = OG + (rq * 12 + hd) * 64 + 4 * hi;
#pragma unroll
    for (int i = 0; i < 4; ++i) {
        *(f32x4*)(op + 8 * i) = (f32x4){o0[4 * i] * inv, o0[4 * i + 1] * inv, o0[4 * i + 2] * inv, o0[4 * i + 3] * inv};
        *(f32x4*)(op + 32 + 8 * i) = (f32x4){o1[4 * i] * inv, o1[4 * i + 1] * inv, o1[4 * i + 2] * inv, o1[4 * i + 3] * inv};
    }
    if (hi == 0) LSE[rq * 12 + hd] = (mx + __builtin_amdgcn_logf(ls)) * LN2;
}

namespace mla {
constexpr int KPITCH = 208, KBYTES = 64 * KPITCH, VBYTES = 8192, BUF = KBYTES + VBYTES, QOFF = 2 * BUF, DUMMY = QOFF + 8 * 12288;
#define MLA_PACK(P, b) (u32x4){cvt_pk_bf16(P[b], P[b + 1]), cvt_pk_bf16(P[b + 2], P[b + 3]), cvt_pk_bf16(P[b + 4], P[b + 5]), cvt_pk_bf16(P[b + 6], P[b + 7])}
#define SGB(mask, n) __builtin_amdgcn_sched_group_barrier(mask, n, 0)
__device__ __forceinline__ float max2_(float a, float b) { return __builtin_amdgcn_fmed3f(a, b, INFINITY); }
constexpr float THR = 8.0f;
__device__ __forceinline__ void softmax_blk(f32x16& p0, f32x16& p1, f32x16& o0, f32x16& o1, float& mhat, float& lrun, u32x4 (&pf)[4], bool first) {
    float r0 = max2_(p0[0], p0[1]), r1 = max2_(p1[0], p1[1]);
#pragma unroll
    for (int e = 2; e < 16; ++e) { r0 = max2_(r0, p0[e]); r1 = max2_(r1, p1[e]); }
    const float rm = swap_max(max2_(r0, r1));
    if (first || __any(rm - mhat > THR)) {
        const float mn = first ? rm : fmaxf(rm, mhat); const float f = first ? 0.f : __builtin_amdgcn_exp2f(mhat - mn); mhat = mn; lrun *= f;
#pragma unroll
        for (int e = 0; e < 16; ++e) { o0[e] *= f; o1[e] *= f; }
    }
    float s0 = 0.f, s1 = 0.f;
#pragma unroll
    for (int e = 0; e < 16; ++e) { p0[e] = __builtin_amdgcn_exp2f(p0[e] - mhat); p1[e] = __builtin_amdgcn_exp2f(p1[e] - mhat); s0 += p0[e]; s1 += p1[e]; }
    lrun += s0 + s1;
    pf[0] = MLA_PACK(p0, 0); pf[1] = MLA_PACK(p0, 8); pf[2] = MLA_PACK(p1, 0); pf[3] = MLA_PACK(p1, 8);
}
__device__ __forceinline__ void pv_blk(const u32x4 (&pf)[4], f32x16& o0, f32x16& o1, LAS const unsigned char* vbase) {
#pragma unroll
    for (int ks = 0; ks < 4; ++ks) {
        const bf16x8 p = __builtin_bit_cast(bf16x8, pf[ks]);
        { const s16x4 lo = vtr(vbase + ks * 1024), hh = vtr(vbase + ks * 1024 + 512); const bf16x8 vf = {lo[0], lo[1], lo[2], lo[3], hh[0], hh[1], hh[2], hh[3]};
          o0 = __builtin_amdgcn_mfma_f32_32x32x16_bf16(vf, p, o0, 0, 0, 0); }
        { const s16x4 lo = vtr(vbase + 4096 + ks * 1024), hh = vtr(vbase + 4096 + ks * 1024 + 512); const bf16x8 vf = {lo[0], lo[1], lo[2], lo[3], hh[0], hh[1], hh[2], hh[3]};
          o1 = __builtin_amdgcn_mfma_f32_32x32x16_bf16(vf, p, o1, 0, 0, 0); }
    }
}
__device__ __forceinline__ void store_o(bf16_t* op, const f32x16& o0, const f32x16& o1, float inv) {
#pragma unroll
    for (int i = 0; i < 4; ++i) {
        u32x2 w0; w0.x = cvt_pk_bf16(o0[4 * i] * inv, o0[4 * i + 1] * inv); w0.y = cvt_pk_bf16(o0[4 * i + 2] * inv, o0[4 * i + 3] * inv); *(u32x2*)(op + 8 * i) = w0;
        u32x2 w1; w1.x = cvt_pk_bf16(o1[4 * i] * inv, o1[4 * i + 1] * inv); w1.y = cvt_pk_bf16(o1[4 * i + 2] * inv, o1[4 * i + 3] * inv); *(u32x2*)(op + 32 + 8 * i) = w1;
    }
}
__device__ __forceinline__ void attn_unit(const bf16_t* Qh, const bf16_t* Kh, const bf16_t* Vh, bf16_t* Oh  , int S, int qb, LAS unsigned char* lds, int tid) {
    const int lane = tid & 63, r32 = lane & 31, hi = lane >> 5; const int wid = __builtin_amdgcn_readfirstlane(tid >> 6);
    const int qrow = qb * 512 + wid * 64 + r32;
    const bf16_t* Qw = Qh + (size_t)qrow * 96 + 8 * hi;
    LAS unsigned char* ql = lds + QOFF + wid * 12288 + lane * 16;
#pragma unroll
    for (int s = 0; s < 6; ++s) { *(LAS bf16x8*)(ql + s * 1024) = *(const bf16x8*)(Qw + 16 * s); *(LAS bf16x8*)(ql + (6 + s) * 1024) = *(const bf16x8*)(Qw + 32 * 96 + 16 * s); }
    const bool has1 = tid < 256; const int kc0 = tid, kc1 = has1 ? tid + 512 : tid;
    const unsigned kd0 = (unsigned)((kc0 / 12) * KPITCH + (kc0 % 12) * 16);
    const unsigned kd1 = has1 ? (unsigned)((kc1 / 12) * KPITCH + (kc1 % 12) * 16) : (unsigned)(DUMMY + (tid - 256) * 16);
    const unsigned kd1n = has1 ? BUF : 0u;
    const unsigned vd = (unsigned)(KBYTES + ((tid & 7) >> 2) * 4096 + (tid >> 3) * 64 + (tid & 3) * 16);
    const u32x4* Kg = (const u32x4*)Kh; const u32x4* Vg = (const u32x4*)Vh;
    const int NT = S >> 6;
    u32x4 ka = Kg[kc0], kb = Kg[kc1], va = Vg[tid];
    *(LAS u32x4*)(lds + kd0) = ka; *(LAS u32x4*)(lds + kd1) = kb; *(LAS u32x4*)(lds + vd) = va;
    __syncthreads();
    f32x16 oa0 = {}, oa1 = {}, ob0 = {}, ob1 = {}; float ma = 0.f, la = 0.f, mb = 0.f, lb = 0.f;
    const unsigned kfo = (unsigned)(r32 * KPITCH + hi * 16);
    const unsigned vb = (unsigned)(KBYTES + ((lane >> 4) & 1) * 32 + (lane & 3) * 8 + (4 * hi + ((lane & 15) >> 2)) * 64);
    for (int t = 0; t < NT; ++t) {
        const unsigned cur = (unsigned)(t & 1) * BUF, nxt = BUF - cur;
        const int tn = t + 1 < NT ? t + 1 : t;
        ka = Kg[(size_t)tn * 768 + kc0]; kb = Kg[(size_t)tn * 768 + kc1]; va = Vg[(size_t)tn * 512 + tid];
        u32x4 pf[4];
        {
            f32x16 p0 = {}, p1 = {};
#pragma unroll
            for (int s = 0; s < 6; ++s) {
                const bf16x8 a0 = *(const LAS bf16x8*)(lds + cur + kfo + s * 32), a1 = *(const LAS bf16x8*)(lds + cur + kfo + 32 * KPITCH + s * 32);
                const bf16x8 q = *(const LAS bf16x8*)(ql + s * 1024);
                p0 = __builtin_amdgcn_mfma_f32_32x32x16_bf16(a0, q, p0, 0, 0, 0); p1 = __builtin_amdgcn_mfma_f32_32x32x16_bf16(a1, q, p1, 0, 0, 0);
            }
            softmax_blk(p0, p1, oa0, oa1, ma, la, pf, t == 0);
            pv_blk(pf, oa0, oa1, lds + cur + vb);
        }
        __builtin_amdgcn_sched_barrier(0);
        {
            f32x16 p0 = {}, p1 = {};
#pragma unroll
            for (int s = 0; s < 6; ++s) {
                const bf16x8 a0 = *(const LAS bf16x8*)(lds + cur + kfo + s * 32), a1 = *(const LAS bf16x8*)(lds + cur + kfo + 32 * KPITCH + s * 32);
                const bf16x8 q = *(const LAS bf16x8*)(ql + (6 + s) * 1024);
                p0 = __builtin_amdgcn_mfma_f32_32x32x16_bf16(a0, q, p0, 0, 0, 0); p1 = __builtin_amdgcn_mfma_f32_32x32x16_bf16(a1, q, p1, 0, 0, 0);
            }
            softmax_blk(p0, p1, ob0, ob1, mb, lb, pf, t == 0);
            pv_blk(pf, ob0, ob1, lds + cur + vb);
        }
        *(LAS u32x4*)(lds + nxt + kd0) = ka; *(LAS u32x4*)(lds + (has1 ? nxt : 0u) + kd1) = kb; *(LAS u32x4*)(lds + nxt + vd) = va;
        __syncthreads();
    }
    bf16_t* op = Oh + (size_t)qrow * D + 4 * hi;
    store_o(op, oa0, oa1, 1.0f / swap_add(la));
    store_o(op + 32 * D, ob0, ob1, 1.0f / swap_add(lb));
}
#undef SGB
}

#define XB_TMO      128
#define XB_XCNT(j)  (256  + 64 * (j))
#define XB_XSUB(j)  (1280 + 64 * (j))
#define XB_XGEN(j)  (2304 + 64 * (j))
#define XB_TOP      3328
#define XB_TOPGEN   3392
#define XCD_BAR_WORDS 3456
#define XB_SPIN_CAP (1u << 20)
__device__ __forceinline__ unsigned xb_ld(unsigned* p)              { return __hip_atomic_load(p, __ATOMIC_RELAXED, __HIP_MEMORY_SCOPE_AGENT); }
__device__ __forceinline__ unsigned xb_add(unsigned* p, unsigned v) { return __hip_atomic_fetch_add(p, v, __ATOMIC_RELAXED, __HIP_MEMORY_SCOPE_AGENT); }
__device__ __forceinline__ unsigned xb_xcc_id() { return (unsigned)__builtin_amdgcn_s_getreg((3 << 11) | 20) & 0xFu; }
#define XB_SPIN(cond, bar) do { unsigned _sp = 0; while (cond) { __builtin_amdgcn_s_sleep(1); \
    if ((++_sp & 255u) == 0u) { if (xb_ld(&(bar)[XB_TMO])) break; if (_sp > XB_SPIN_CAP) { atomicAdd(&(bar)[XB_TMO], 1u); break; } } } } while (0)
struct XcdBarrier { unsigned* bar; unsigned x; volatile LAS unsigned* st; };
__device__ __forceinline__ XcdBarrier xcd_barrier_post(unsigned* bar, volatile LAS unsigned* st, int tid) {
    XcdBarrier b; b.bar = bar; b.x = xb_xcc_id(); b.st = st;
    if (tid == 0) (void)xb_add(&bar[XB_XCNT(b.x)], 1u);
    return b;
}
__device__ __forceinline__ void xcd_barrier_complete(unsigned* bar, unsigned x, unsigned& nloc, unsigned& nx) {
    const unsigned G = gridDim.x * gridDim.y * gridDim.z;
    unsigned sum, cnt, mine, sp = 0u;
    for (;;) {
        sum = 0u; cnt = 0u; mine = 0u;
#pragma unroll
        for (unsigned j = 0; j < 16; ++j) { const unsigned c = xb_ld(&bar[XB_XCNT(j)]); sum += c; cnt += (c > 0u) ? 1u : 0u; mine = (j == x) ? c : mine; }
        if (sum == G) break;
        __builtin_amdgcn_s_sleep(1);
        if ((++sp & 255u) == 0u) { if (xb_ld(&bar[XB_TMO])) break; if (sp > XB_SPIN_CAP) { atomicAdd(&bar[XB_TMO], 1u); break; } }
    }
    nloc = mine > 0u ? mine : 1u; nx = cnt > 0u ? cnt : 1u;
}
__device__ __forceinline__ void xcd_barrier(const XcdBarrier& b, int tid) {
    asm volatile("s_waitcnt vmcnt(0)" ::: "memory");
    __syncthreads();
    if (tid == 0) {
        unsigned* bar = b.bar;
        __builtin_amdgcn_s_waitcnt(0);
        unsigned nloc = b.st[0], nx = b.st[1];
        if (nloc == 0u) { xcd_barrier_complete(bar, b.x, nloc, nx); b.st[0] = nloc; b.st[1] = nx; }
        const unsigned old = xb_add(&bar[XB_XSUB(b.x)], 1u);
        const unsigned gen = old / nloc;
        if (old + 1u == (gen + 1u) * nloc) {
            __builtin_amdgcn_fence(__ATOMIC_RELEASE, "agent");
            asm volatile("s_waitcnt vmcnt(0)" ::: "memory");
            const unsigned og = xb_add(&bar[XB_TOP], 1u);
            const unsigned tg = og / nx;
            if (og + 1u == (tg + 1u) * nx) xb_add(&bar[XB_TOPGEN], 1u);
            else XB_SPIN(xb_ld(&bar[XB_TOPGEN]) == tg, bar);
            __builtin_amdgcn_fence(__ATOMIC_ACQUIRE, "agent");
            xb_add(&bar[XB_XGEN(b.x)], 1u);
            asm volatile("s_waitcnt vmcnt(0)" ::: "memory");
        } else {
            XB_SPIN(xb_ld(&bar[XB_XGEN(b.x)]) == gen, bar);
            __builtin_amdgcn_fence(__ATOMIC_ACQUIRE, "agent");
            asm volatile("s_waitcnt vmcnt(0)" ::: "memory");
        }
    }
    __syncthreads();
}

constexpr int SPC = 13, NSTEP = 1 + SPC * NCHUNK + 1;
struct Args { const float* in[21]; float* out; unsigned char* ws; int ph_lo, ph_hi; };

__global__ void __launch_bounds__(512, 2) fwd_kernel(Args args) {
    extern __shared__ __attribute__((aligned(16))) unsigned char lds_raw[];
    LAS unsigned char* lds = (LAS unsigned char*)lds_raw;
    const int wave0 = __builtin_amdgcn_readfirstlane(threadIdx.x >> 6);
#if MEGA
    volatile LAS unsigned* bst = (volatile LAS unsigned*)(lds + LDS_BYTES - 16);
    if (threadIdx.x < 2) bst[threadIdx.x] = 0u;
    __syncthreads();
    XcdBarrier xbar = xcd_barrier_post((unsigned*)args.ws + 4096, bst, (int)threadIdx.x);
#endif
    for (int ph = args.ph_lo; ph < args.ph_hi; ++ph) {
    unsigned zl = 0u; asm volatile("" : "+s"(zl)); int wave_l = wave0; asm volatile("" : "+s"(wave_l));
    int tid_l = wave_l * 64 + (int)__builtin_amdgcn_mbcnt_hi(~0u, __builtin_amdgcn_mbcnt_lo(~0u, zl)); asm volatile("" : "+v"(tid_l));
    unsigned char* ws = args.ws; asm volatile("" : "+s"(ws));
    const int tid = tid_l, lane = tid & 63; const int wave = wave_l;
    const int G = gridDim.x, bx = blockIdx.x; const int vcu = (G % 8 == 0) ? (bx % 8) * (G / 8) + bx / 8 : bx;
    const int gw = vcu * 8 + wave, NGW = G * 8;
    bf16_t* Win_t = (bf16_t*)(ws + WS_WIN); bf16_t* Wuq_t = (bf16_t*)(ws + WS_WUQ); bf16_t* Wukv_t = (bf16_t*)(ws + WS_WUKV); bf16_t* Pa_t = (bf16_t*)(ws + WS_PA);
    bf16_t* Pb_t = (bf16_t*)(ws + WS_PB); bf16_t* Wout_t = (bf16_t*)(ws + WS_WOUT); bf16_t* Wup_t = (bf16_t*)(ws + WS_WUP); bf16_t* Wdown_t = (bf16_t*)(ws + WS_WDOWN);
    float* MOD = (float*)(ws + WS_MOD); float* ROPE = (float*)(ws + WS_ROPE); float* RSTD = (float*)(ws + WS_RSTD);
    bf16_t* Hb = (bf16_t*)(ws + WS_H); bf16_t* Zb = (bf16_t*)(ws + WS_Z); bf16_t* Qb = (bf16_t*)(ws + WS_Q); bf16_t* KFb = (bf16_t*)(ws + WS_KF); bf16_t* Vb = (bf16_t*)(ws + WS_V);
    bf16_t* OAb = (bf16_t*)(ws + WS_OA); bf16_t* OBb = (bf16_t*)(ws + WS_OB); float* OGb = (float*)(ws + WS_OG); float* LSEb = (float*)(ws + WS_LSE);
    bf16_t* Tb = (bf16_t*)(ws + WS_T); bf16_t* MGb = (bf16_t*)(ws + WS_MERGED); float* EDGEb = (float*)(ws + WS_EDGE); bf16_t* X1b = (bf16_t*)(ws + WS_OA); bf16_t* UPb = (bf16_t*)(ws + WS_UP); bf16_t* ACTb = (bf16_t*)(ws + WS_ACT);
    bool sync_after = true;
        if (ph == 0) {
            if (bx < 96) {
                LAS float* sl = (LAS float*)lds;
                LAS float* part = (LAS float*)(lds + 49152);
                for (int idx = tid; idx < 12 * 1024; idx += 512) { const int b = idx >> 10, d = idx & 1023; const float c = b < 8 ? args.in[2][b * 1024 + d] : args.in[3][(b - 8) * 1024 + d];
                    sl[d * 12 + b] = c / (1.0f + __expf(-c)); }
                __syncthreads();
                const int e = bx * 64 + lane; float acc[12];
#pragma unroll
                for (int b = 0; b < 12; ++b) acc[b] = 0.f;
                const float* wp = args.in[4] + (size_t)(wave * 128) * 6144 + e;
#pragma unroll 8
                for (int d = 0; d < 128; ++d) { const float w = wp[(size_t)d * 6144]; const LAS f32x4* s4 = (const LAS f32x4*)(sl + (wave * 128 + d) * 12);
                    const f32x4 a = s4[0], b4 = s4[1], c4 = s4[2];
                    acc[0] += a.x * w; acc[1] += a.y * w; acc[2] += a.z * w; acc[3] += a.w * w; acc[4] += b4.x * w; acc[5] += b4.y * w; acc[6] += b4.z * w; acc[7] += b4.w * w;
                    acc[8] += c4.x * w; acc[9] += c4.y * w; acc[10] += c4.z * w; acc[11] += c4.w * w; }
#pragma unroll
                for (int b = 0; b < 12; ++b) part[(wave * 12 + b) * 64 + lane] = acc[b];
                __syncthreads();
                if (wave == 0) {
#pragma unroll
                    for (int b = 0; b < 12; ++b) { float s = args.in[5][e];
#pragma unroll
                        for (int w = 0; w < 8; ++w) s += part[(w * 12 + b) * 64 + lane];
                        MOD[b * 6144 + e] = s; } }
                __syncthreads();
            }
            for (int idx = bx * 512 + tid; idx < 8192 * 16; idx += G * 512) { const int pos = idx >> 4, i = idx & 15; const float ang = (float)pos * ROPE_INV[i];
                const double tt = (double)ang * 0.15915494309189535; const float fr_ = (float)(tt - floor(tt));
                ROPE[idx] = __builtin_amdgcn_cosf(fr_); ROPE[131072 + idx] = __builtin_amdgcn_sinf(fr_); }
            {
                LAS float* scr = (LAS float*)(lds + wave * 16384);
                constexpr int I_IN = 16 * 157, I_UQ = 6 * 48, I_UKV = 4 * 64, I_PA = 16 * 32, I_PB = 4 * 32, I_OUT = 16 * 32, I_UP = 16 * 176, I_DOWN = 44 * 32;
                constexpr int NITEMS = I_IN + I_UQ + I_UKV + I_PA + I_PB + I_OUT + I_UP + I_DOWN;
                for (int it = gw; it < NITEMS; it += NGW) {
                    int r = it; const float* W; int K, N, kind = 0; bf16_t* WT; const float* ks = nullptr;
                    if (r < I_IN) { W = args.in[7]; K = 1024; N = 5024; WT = Win_t; kind = 1; }
                    else if ((r -= I_IN) < I_UQ) { W = args.in[10]; K = 384; N = 1536; WT = Wuq_t; kind = 2; ks = args.in[8]; }
                    else if ((r -= I_UQ) < I_UKV) { W = args.in[11]; K = 256; N = 2048; WT = Wukv_t; kind = 3; ks = args.in[9]; }
                    else if ((r -= I_UKV) < I_PA) { W = args.in[12]; K = 1024; N = 1024; WT = Pa_t; }
                    else if ((r -= I_PA) < I_PB) { W = args.in[13]; K = 256; N = 1024; WT = Pb_t; }
                    else if ((r -= I_PB) < I_OUT) { W = args.in[14]; K = 1024; N = 1024; WT = Wout_t; }
                    else if ((r -= I_OUT) < I_UP) { W = args.in[16]; K = 1024; N = 5632; WT = Wup_t; kind = 4; }
                    else { r -= I_UP; W = args.in[19]; K = 2816; N = 1024; WT = Wdown_t; }
                    transpose_item(W, K, N, WT, kind, ks, scr, r, lane);
                }
                for (int idx = bx * 512 + tid; idx < 96 * 128; idx += G * 512) *(u32x4*)(Win_t + (size_t)672 * 1024 + (size_t)idx * 8) = (u32x4){0u, 0u, 0u, 0u};
            }
            __syncthreads();
        } else if (ph == NSTEP - 1) {
            float* o = args.out + (size_t)(NCHUNK - 1) * CH * D;
            for (int m = gw; m < CH; m += 2 * NGW) { const int m2 = m + NGW; const bool ok2 = m2 < CH;
                    f32x4 va[4], vb[4]; ld_b16(X1b + (size_t)m * D, lane, va); ld_b16(X1b + (size_t)(ok2 ? m2 : m) * D, lane, vb);
                    const float ra = RSTD_OF(ssq4(va)), rb = RSTD_OF(ssq4(vb));
                    st_fin_f32(o + (size_t)m * D, lane, va, ra, args.in[20]); if (ok2) st_fin_f32(o + (size_t)m2 * D, lane, vb, rb, args.in[20]); }
        } else {
            const int c = (ph - 1) / SPC, k = (ph - 1) - SPC * c;
            ChunkP P;
            if (c == 0) { P.x = args.in[0]; P.S = 2048; P.Sshift = 11; P.nseq = 8; P.seqbase = 0; }
            else { P.x = args.in[1] + (size_t)(c - 1) * CH * D; P.S = 8192; P.Sshift = 13; P.nseq = 2; P.seqbase = 8 + 2 * (c - 1); }
            P.out = args.out + (size_t)c * CH * D;
            sync_after = !(k == 3 || k == 6);
            pg8::Gemm g{}; pg8::EpiAny E{}; bool is_gemm = true;
            E.ws = ws; E.S = P.S; E.Sshift = P.Sshift; E.seqbase = P.seqbase;
            if (k == 1) { g = pg8::Gemm{Hb, Win_t, CH, ZLD, 1024, 1024}; E.kind = 0; }
            else if (k == 3) { g = pg8::Gemm{Zb, Wuq_t, CH, 1536, 384, ZLD}; E.kind = 1; }
            else if (k == 4) { g = pg8::Gemm{Zb + 384, Wukv_t, CH, 2048, 256, ZLD}; E.kind = 2; }
            else if (k == 6) { g = pg8::Gemm{OAb, Pa_t, CH, 1024, 1024, 1024}; E.kind = 3; }
            else if (k == 7) { g = pg8::Gemm{OBb, Pb_t, CH, 1024, 256, 256}; E.kind = 4; }
            else if (k == 8) { g = pg8::Gemm{MGb, Wout_t, CH, 1024, 1024, 1024}; E.kind = 5; E.base = P.x; E.goff = 2048; E.rmode = 0; }
            else if (k == 10) { g = pg8::Gemm{Hb, Wup_t, CH, NUP, 1024, 1024}; E.kind = 6; E.cw = args.in[17]; E.cbias = args.in[18]; E.xl = lds + 131072; }
            else if (k == 12) { g = pg8::Gemm{ACTb, Wdown_t, CH, 1024, DFF, DFF}; E.kind = 5; E.base = nullptr; E.goff = 5120; E.rmode = 1; }
            else is_gemm = false;
            if (is_gemm) { pg8::StaticOrder S; S.init(g.M, g.N, G, bx); pg8::gemm_phase(lds, g, S, E, tid); }
            else if (k == 0) {
                if (c > 0) { float* o = args.out + (size_t)(c - 1) * CH * D; for (int m = gw; m < CH; m += 2 * NGW) { const int m2 = m + NGW; const bool ok2 = m2 < CH;
                    f32x4 va[4], vb[4]; ld_b16(X1b + (size_t)m * D, lane, va); ld_b16(X1b + (size_t)(ok2 ? m2 : m) * D, lane, vb);
                    const float ra = RSTD_OF(ssq4(va)), rb = RSTD_OF(ssq4(vb));
                    st_fin_f32(o + (size_t)m * D, lane, va, ra, args.in[20]); if (ok2) st_fin_f32(o + (size_t)m2 * D, lane, vb, rb, args.in[20]); } }
                for (int m = gw; m < CH; m += 2 * NGW) { const int m2 = m + NGW; const bool ok2 = m2 < CH;
                    f32x4 va[4], vb[4]; ld_f32(P.x + (size_t)m * D, lane, va); if (ok2) ld_f32(P.x + (size_t)m2 * D, lane, vb); else ld_f32(P.x + (size_t)m * D, lane, vb);
                    const float ra = RSTD_OF(ssq4(va)), rb = RSTD_OF(ssq4(vb));
                    const float* md = MOD + (size_t)(P.seqbase + (m >> P.Sshift)) * 6144; st_mod_b16(Hb + (size_t)m * D, lane, va, ra, args.in[6], md + 1024, md);
                    if (ok2) { const float* md2 = MOD + (size_t)(P.seqbase + (m2 >> P.Sshift)) * 6144; st_mod_b16(Hb + (size_t)m2 * D, lane, vb, rb, args.in[6], md2 + 1024, md2); } }
            } else if (k == 2) {
                for (int m = gw; m < CH; m += NGW) {
                    const unsigned* zr = (const unsigned*)(Zb + (size_t)m * ZLD);
                    float sq = 0.f, skv = 0.f;
#pragma unroll
                    for (int j = 0; j < 3; ++j) { const unsigned w = zr[lane + 64 * j]; const float a = bflo(w), b = bfhi(w); sq += a * a + b * b; }
#pragma unroll
                    for (int j = 0; j < 2; ++j) { const unsigned w = zr[192 + lane + 64 * j]; const float a = bflo(w), b = bfhi(w); skv += a * a + b * b; }
                    sq = wave_sum(sq); skv = wave_sum(skv);
                    if (lane == 0) { RSTD[2 * m] = 1.0f / sqrtf(sq * (1.f / 384.f) + EPS); RSTD[2 * m + 1] = 1.0f / sqrtf(skv * (1.f / 256.f) + EPS); }
                    const int seq = m >> P.Sshift, pos = m & (P.S - 1);
                    unsigned pr = 0u;
                    { const int i = lane & 15; const unsigned w = zr[320 + i]; const float a = bflo(w), b = bfhi(w); const float cs = ROPE[pos * 16 + i], sn = ROPE[131072 + pos * 16 + i];
                      pr = cvt_pk_bf16(a * cs - b * sn, a * sn + b * cs); }
                    u32x4 o; const int b4 = 4 * (lane & 3);
                    o.x = __shfl(pr, b4); o.y = __shfl(pr, b4 + 1); o.z = __shfl(pr, b4 + 2); o.w = __shfl(pr, b4 + 3);
                    const int head = lane >> 2;
                    *(u32x4*)(KFb + ((size_t)((seq * 16 + head) << P.Sshift) + pos) * 96 + 64 + 8 * (lane & 3)) = o;
                }
                LAS unsigned char* wl = lds + wave * 4096;
                for (int task = gw; task < CH * 12 / 32; task += NGW) dil_task(Zb, OGb, LSEb, P.S, task, wl, lane);
            } else if (k == 5) {
                for (int it = bx * 512 + tid; it < CH * 32; it += G * 512) { const int row = it >> 5, j = (it >> 3) & 3, d8 = (it & 7) * 8;
                    const float l0 = LSEb[row * 12 + j], l1 = LSEb[row * 12 + 4 + j], l2 = LSEb[row * 12 + 8 + j]; const float mx = fmaxf(l0, fmaxf(l1, l2));
                    float w0 = __expf(l0 - mx), w1 = __expf(l1 - mx), w2 = __expf(l2 - mx); const float inv = 1.0f / (w0 + w1 + w2); w0 *= inv; w1 *= inv; w2 *= inv;
                    const float* p0 = OGb + ((size_t)row * 12 + j) * 64 + d8; const float* p1 = p0 + 4 * 64; const float* p2 = p0 + 8 * 64;
                    const f32x4 a0 = *(const f32x4*)p0 * w0 + *(const f32x4*)p1 * w1 + *(const f32x4*)p2 * w2;
                    const f32x4 a1 = *(const f32x4*)(p0 + 4) * w0 + *(const f32x4*)(p1 + 4) * w1 + *(const f32x4*)(p2 + 4) * w2;
                    *(u32x4*)(OBb + (size_t)row * 256 + j * 64 + d8) = pg8::pack8(a0, a1); }
                const int nqb = P.S >> 9, nunits = P.nseq * 16 * nqb;
                for (int uidx = vcu; uidx < nunits; uidx += G) { const int pair = uidx / nqb, qb = uidx - pair * nqb; const int seq = pair >> 4, head = pair & 15;
                    const size_t hb = (size_t)pair << P.Sshift;
                    mla::attn_unit(Qb + hb * 96, KFb + hb * 96, Vb + hb * 64, OAb + ((size_t)seq << P.Sshift) * D + head * 64, P.S, qb, lds, tid); }
            } else if (k == 9) {
                for (int m = gw; m < CH; m += 2 * NGW) { const int m2 = m + NGW; const bool ok2 = m2 < CH;
                    f32x4 va[4], vb[4]; ld_b16(X1b + (size_t)m * D, lane, va); ld_b16(X1b + (size_t)(ok2 ? m2 : m) * D, lane, vb);
                    const float ra = RSTD_OF(ssq4(va)), rb = RSTD_OF(ssq4(vb));
                    const float* md = MOD + (size_t)(P.seqbase + (m >> P.Sshift)) * 6144; st_mod_b16(Hb + (size_t)m * D, lane, va, ra, args.in[15], md + 4096, md + 3072);
                    if (ok2) { const float* md2 = MOD + (size_t)(P.seqbase + (m2 >> P.Sshift)) * 6144; st_mod_b16(Hb + (size_t)m2 * D, lane, vb, rb, args.in[15], md2 + 4096, md2 + 3072); } }
            } else if (k == 11) {
                for (int it = bx * 512 + tid; it < 128 * 352; it += G * 512) {
                    const int r = it / 352, f0 = (it - r * 352) * 8; const int which = r & 1, pm = r >> 1; const int pos0 = (pm * 256) & (P.S - 1);
                    const bool has_nb = which == 0 ? (pos0 > 0) : (pos0 + 256 < P.S);
                    const float* nb = EDGEb + (size_t)(which == 0 ? (pm - 1) * 2 + 1 : (pm + 1) * 2) * DFF + f0;
                    const float* wv = args.in[17] + (which == 0 ? 0 : 2 * DFF) + f0;
                    const float* pp = EDGEb + (size_t)128 * DFF + (size_t)r * DFF + f0; const float* pg = EDGEb + (size_t)256 * DFF + (size_t)r * DFF + f0;
                    float o[8];
#pragma unroll
                    for (int h = 0; h < 2; ++h) { const f32x4 p4 = *(const f32x4*)(pp + 4 * h), g4 = *(const f32x4*)(pg + 4 * h), w4 = *(const f32x4*)(wv + 4 * h);
                        f32x4 n4 = (f32x4){0.f, 0.f, 0.f, 0.f}; if (has_nb) n4 = *(const f32x4*)(nb + 4 * h);
#pragma unroll
                        for (int e = 0; e < 4; ++e) o[4 * h + e] = pg8::gelu_tanh_(p4[e] + w4[e] * n4[e]) * g4[e]; }
                    u32x4 w; w.x = cvt_pk_bf16(o[0], o[1]); w.y = cvt_pk_bf16(o[2], o[3]); w.z = cvt_pk_bf16(o[4], o[5]); w.w = cvt_pk_bf16(o[6], o[7]);
                    *(u32x4*)(ACTb + (size_t)(pm * 256 + (which ? 255 : 0)) * DFF + f0) = w;
                }
            }
        }
#if MEGA
        if (sync_after && ph + 1 < args.ph_hi) { if (ph == 0) cg::this_grid().sync(); else { int tb = tid; asm volatile("" : "+v"(tb)); xcd_barrier(xbar, tb); } }
#else
        (void)sync_after;
#endif
    }
}

extern "C" void kernel_launch(void* const* d_in, const int* in_sizes, int n_in, void* d_out, int out_size, void* d_ws, size_t ws_size, hipStream_t stream) {
    static int grid = 0;
    if (grid == 0) {
        if (n_in != 21 || ws_size < WS_END) { fprintf(stderr, "kernel_launch: unexpected n_in %d / ws_size %zu\n", n_in, ws_size); grid = -1; return; }
        int dev = 0, cus = 0, per_cu = 0;
        (void)hipGetDevice(&dev); (void)hipDeviceGetAttribute(&cus, hipDeviceAttributeMultiprocessorCount, dev);
        (void)hipFuncSetAttribute((const void*)fwd_kernel, hipFuncAttributeMaxDynamicSharedMemorySize, LDS_BYTES);
        (void)hipOccupancyMaxActiveBlocksPerMultiprocessor(&per_cu, (const void*)fwd_kernel, 512, LDS_BYTES);
        (void)hipGetLastError();
        if (per_cu < 1) fprintf(stderr, "kernel_launch: occupancy query says %d blocks/CU\n", per_cu);
        grid = cus;
    }
    if (grid < 0) return;
    Args a{};
    for (int i = 0; i < 21; ++i) a.in[i] = (const float*)d_in[i];
    a.out = (float*)d_out; a.ws = (unsigned char*)d_ws;
#if MEGA
    (void)hipMemsetAsync(d_ws, 0, 65536, stream);
    a.ph_lo = 0; a.ph_hi = NSTEP;
    void* kargs[] = {&a};
    hipError_t e = hipLaunchCooperativeKernel((const void*)fwd_kernel, dim3(grid), dim3(512), kargs, LDS_BYTES, stream);
    if (e != hipSuccess) fprintf(stderr, "cooperative launch failed: %s (grid %d)\n", hipGetErrorString(e), grid);
#else
    for (int ph = 0; ph < NSTEP; ++ph) { a.ph_lo = ph; a.ph_hi = ph + 1; hipLaunchKernelGGL(fwd_kernel, dim3(grid), dim3(512), LDS_BYTES, stream, a);
#ifdef PROBE_DUP
        if (ph > 0 && ph < NSTEP - 1 && ((PROBE_DUP >> ((ph - 1) % SPC)) & 1)) hipLaunchKernelGGL(fwd_kernel, dim3(grid), dim3(512), LDS_BYTES, stream, a);
#endif
    }
#endif
}
```

```cpp
#include <hip/hip_runtime.h>
#include <hip/hip_cooperative_groups.h>
#include <cstdio>
#include <cstdint>
namespace cg = cooperative_groups;

#ifndef MEGA
#define MEGA 1
#endif

#define LAS __attribute__((address_space(3)))
#define GAS __attribute__((address_space(1)))
#define GLD(T, p) (*(const GAS T*)(p))
#define GST(T, p, v) (*(GAS T*)(p) = (v))
typedef unsigned short bf16_t;
typedef short bf16x8 __attribute__((ext_vector_type(8)));
typedef short s16x4 __attribute__((ext_vector_type(4)));
typedef float f32x2 __attribute__((ext_vector_type(2)));
typedef float f32x4 __attribute__((ext_vector_type(4)));
typedef float f32x16 __attribute__((ext_vector_type(16)));
typedef unsigned u32x2 __attribute__((ext_vector_type(2)));
typedef unsigned u32x4 __attribute__((ext_vector_type(4)));

constexpr int D = 1024, CH = 16384, NCHUNK = 3, ZLD = 5120, NUP = 5632, DFF = 2816;

constexpr float EPS = 1e-6f, LOG2E = 1.4426950408889634f, LN2 = 0.6931471805599453f;
constexpr float QSCALE = 0.10206207261596577f * LOG2E;
constexpr float DSCALE = 0.125f * LOG2E;

constexpr size_t MiB = 1u << 20;
constexpr size_t WS_WIN = 2 * MiB, WS_WUQ = 12 * MiB, WS_WUKV = 14 * MiB, WS_PA = 15 * MiB, WS_PB = 17 * MiB, WS_WOUT = 18 * MiB,
                 WS_WUP = 20 * MiB, WS_WDOWN = 31 * MiB;
constexpr size_t WS_MOD = 37 * MiB, WS_ROPE = 38 * MiB  , WS_RSTD = 39 * MiB + 512 * 1024;
constexpr size_t WS_H = 40 * MiB, WS_Z = 72 * MiB, WS_Q = 232 * MiB, WS_KF = 280 * MiB, WS_V = 328 * MiB, WS_OA = 360 * MiB, WS_OB = 392 * MiB,
                 WS_OG = 400 * MiB, WS_LSE = 448 * MiB, WS_T = 232 * MiB, WS_MERGED = 296 * MiB, WS_UP = 72 * MiB, WS_ACT = 248 * MiB, WS_EDGE = 449 * MiB  , WS_END = 454 * MiB;

constexpr int LDS_BYTES = 147456;

__device__ __forceinline__ unsigned cvt_pk_bf16(float lo, float hi) { unsigned r; asm volatile("v_cvt_pk_bf16_f32 %0, %1, %2" : "=v"(r) : "v"(lo), "v"(hi)); return r; }
__device__ __forceinline__ float bf2f(unsigned short b) { return __uint_as_float((unsigned)b << 16); }
__device__ __forceinline__ float bflo(unsigned w) { return __uint_as_float(w << 16); }
__device__ __forceinline__ float bfhi(unsigned w) { return __uint_as_float(w & 0xffff0000u); }
__device__ __forceinline__ float swap_add(float m);
#define DPP_ROR(v, n) __int_as_float(__builtin_amdgcn_update_dpp(0, __float_as_int(v), 0x120 + (n), 0xf, 0xf, false))
__device__ __forceinline__ float wave_sum(float v) {
    v += DPP_ROR(v, 1); v += DPP_ROR(v, 2); v += DPP_ROR(v, 4); v += DPP_ROR(v, 8);
    v += __shfl_xor(v, 16);
    return swap_add(v);
}
__device__ __forceinline__ float swap_max(float m) { auto rr = __builtin_amdgcn_permlane32_swap(__float_as_uint(m), __float_as_uint(m), false, false); return fmaxf(__uint_as_float(rr[0]), __uint_as_float(rr[1])); }
__device__ __forceinline__ float swap_add(float m) { auto rr = __builtin_amdgcn_permlane32_swap(__float_as_uint(m), __float_as_uint(m), false, false); return __uint_as_float(rr[0]) + __uint_as_float(rr[1]); }
__device__ __forceinline__ s16x4 vtr(LAS const unsigned char* p) { return __builtin_bit_cast(s16x4, __builtin_amdgcn_ds_read_tr16_b64_v4i16((LAS s16x4*)p)); }
__device__ __forceinline__ float sigmoidf_(float x) { return __builtin_amdgcn_rcpf(1.0f + __builtin_amdgcn_exp2f(-x * LOG2E)); }

struct ChunkP { const float* x; float* out; int S, Sshift, nseq, seqbase; };

namespace pg8 {
constexpr int BM = 256, BK = 64, HALF = 128, HTB = HALF * BK * 2, STAGE_BYTES = 8 * HTB, NXCD = 8, WGM = 8;
__host__ __device__ __forceinline__ int lds_byte(int r, int c) { const int st = (r >> 4) * 2 + (c >> 5), rr = r & 15, cc = c & 31, ob = rr * 64 + cc * 2; return st * 1024 + (ob ^ (((ob >> 9) & 1) << 5)); }
__host__ __device__ __forceinline__ void stage_rc(int b, int& R, int& C) { const int st = b / 1024, sb = b % 1024, swz = sb ^ (((sb >> 9) & 1) << 5); R = (st >> 1) * 16 + swz / 64; C = (st & 1) * 32 + (swz % 64) / 2; }
__host__ __device__ __forceinline__ int perm32(int rho) { const int n = rho >> 4, i = rho & 15; return 8 * (i >> 2) + 4 * n + (i & 3); }
struct Unit { int pm, pn; };
struct Gemm { const bf16_t* A; const bf16_t* Bt; int M, N, K, lda; };
struct StaticOrder {
    int nM, nN, nwg, G, c;
    __device__ void init(int M, int N, int G_, int c_) { nM = M / BM; nN = N / BM; nwg = nM * nN; G = G_; c = c_; }
    __device__ bool next(int i, Unit& u) const {
        const long L = (long)i * G + c; if (L >= nwg) return false;
        int wgid = (int)L; { const int q = nwg / NXCD, r = nwg % NXCD, xcd = wgid % NXCD, off = wgid / NXCD; wgid = (xcd < r ? xcd * (q + 1) : r * (q + 1) + (xcd - r) * q) + off; }
        const int nig = WGM * nN, gid = wgid / nig, fm = gid * WGM, gsz = (nM - fm) < WGM ? (nM - fm) : WGM;
        u.pm = fm + ((wgid % nig) % gsz); u.pn = (wgid % nig) / gsz; return true;
    }
};

template <class Epi, class Sched>
__device__ __forceinline__ void gemm_phase(LAS unsigned char* lds, const Gemm g, const Sched& S, const Epi& E, int tid_in) {
    int tid_ = tid_in; asm volatile("" : "+v"(tid_));
    const int tid = tid_, wid = __builtin_amdgcn_readfirstlane(tid >> 6), lane = tid & 63, wr = wid >> 2, wc = wid & 3, fr = lane & 15, fq = lane >> 4;
    const int K = g.K, nt = K / BK, lda = g.lda;
    unsigned voffA[2], voffB[2];
#pragma unroll
    for (int i = 0; i < 2; ++i) { int R, C; stage_rc(tid * 16 + i * 8192, R, C); const int Rb = (R & ~31) + perm32(R & 31);
        voffA[i] = (unsigned)(R * lda + C) * 2u; voffB[i] = (unsigned)(Rb * K + C) * 2u; }
    const size_t kstep = (size_t)(BK * 2);
    const size_t hstepA = (size_t)HALF * lda * 2, hstepB = (size_t)HALF * K * 2;
    const size_t tstepA = 2 * hstepA, tstepB = 2 * hstepB;
    const unsigned ldsw = (unsigned)wid * 1024u;
    const int aoff = lds_byte(wr * 64 + fr, fq * 8), boff = lds_byte(wc * 32 + fr, fq * 8);
#define PG8_SA(b, h) (((b) * 2 + (h)) * HTB)
#define PG8_SB(b, h) ((4 + (b) * 2 + (h)) * HTB)
#define PG8_STAGE(bufoff, gbase, voff) do { _Pragma("unroll") for (int _i = 0; _i < 2; ++_i) \
        __builtin_amdgcn_global_load_lds((const unsigned*)((const char*)(gbase) + (voff)[_i]), (LAS unsigned*)(lds + (bufoff) + ldsw + _i * 8192), 16, 0, 0); } while (0)
#define PG8_LDA(dst, b, h) do { _Pragma("unroll") for (int m = 0; m < 4; ++m) _Pragma("unroll") for (int k = 0; k < 2; ++k) dst[m][k] = *(const LAS bf16x8*)(lds + PG8_SA(b, h) + aoff + m * 2048 + k * 1024); } while (0)
#define PG8_LDB(dst, b, h) do { _Pragma("unroll") for (int n = 0; n < 2; ++n) _Pragma("unroll") for (int k = 0; k < 2; ++k) dst[n][k] = *(const LAS bf16x8*)(lds + PG8_SB(b, h) + boff + n * 2048 + k * 1024); } while (0)
#define PG8_MMA(ai, bj, At, Bt) do { __builtin_amdgcn_s_setprio(1); _Pragma("unroll") for (int m = 0; m < 4; ++m) _Pragma("unroll") for (int n = 0; n < 2; ++n) _Pragma("unroll") for (int k = 0; k < 2; ++k) \
        acc[ai][bj][m][n] = __builtin_amdgcn_mfma_f32_16x16x32_bf16(Bt[n][k], At[m][k], acc[ai][bj][m][n], 0, 0, 0); __builtin_amdgcn_s_setprio(0); } while (0)
#define PG8_WAIT_V(n) asm volatile("s_waitcnt vmcnt(" #n ")" ::: "memory")
#define PG8_WAIT_L(n) asm volatile("s_waitcnt lgkmcnt(" #n ")" ::: "memory")
#define PG8_BAR __builtin_amdgcn_s_barrier()
#define PG8_SCHED __builtin_amdgcn_sched_barrier(0)
    Unit cur, nxt; int ui = 0;
    if (!S.next(0, cur)) return;
    f32x4 acc[2][2][4][2];
#pragma unroll
    for (int a = 0; a < 2; ++a)
#pragma unroll
        for (int b = 0; b < 2; ++b)
#pragma unroll
            for (int m = 0; m < 4; ++m)
#pragma unroll
                for (int n = 0; n < 2; ++n) acc[a][b][m][n] = (f32x4){0.f, 0.f, 0.f, 0.f};
    bf16x8 At[4][2], B0[2][2], B1[2][2];
    const char* cA = (const char*)g.A + (size_t)cur.pm * tstepA; const char* cB = (const char*)g.Bt + (size_t)cur.pn * tstepB;
    PG8_STAGE(PG8_SB(0, 0), cB, voffB); PG8_STAGE(PG8_SB(0, 1), cB + hstepB, voffB); PG8_STAGE(PG8_SA(0, 0), cA, voffA); PG8_STAGE(PG8_SA(0, 1), cA + hstepA, voffA);
    if (wr == 1) PG8_BAR;
    PG8_WAIT_V(2); PG8_BAR;
    PG8_STAGE(PG8_SB(1, 0), cB + kstep, voffB); PG8_STAGE(PG8_SA(1, 0), cA + kstep, voffA); PG8_STAGE(PG8_SB(1, 1), cB + hstepB + kstep, voffB);
    PG8_WAIT_V(6); PG8_BAR;
    for (;;) {
        const bool has_next = S.next(ui + 1, nxt);
        const char* nA = has_next ? (const char*)g.A + (size_t)nxt.pm * tstepA : cA; const char* nB = has_next ? (const char*)g.Bt + (size_t)nxt.pn * tstepB : cB;
        for (int t = 0; t < nt; t += 2) {
            const bool last = (t == nt - 2);
            const char* a1 = cA + (size_t)(t + 1) * kstep;
            const char* a2 = last ? nA : cA + (size_t)(t + 2) * kstep; const char* b2 = last ? nB : cB + (size_t)(t + 2) * kstep;
            const char* a3 = a2 + kstep; const char* b3 = b2 + kstep;
            PG8_LDB(B0, 0, 0); PG8_LDB(B1, 0, 1); PG8_SCHED; PG8_LDA(At, 0, 0); PG8_STAGE(PG8_SA(1, 1), a1 + hstepA, voffA);
            PG8_WAIT_V(8); PG8_WAIT_L(0); PG8_BAR; PG8_MMA(0, 0, At, B0); PG8_MMA(0, 1, At, B1); PG8_BAR; PG8_SCHED;
            PG8_LDA(At, 0, 1); PG8_STAGE(PG8_SB(0, 0), b2, voffB); PG8_STAGE(PG8_SB(0, 1), b2 + hstepB, voffB); PG8_STAGE(PG8_SA(0, 0), a2, voffA);
            PG8_WAIT_V(8); PG8_WAIT_L(0); PG8_BAR; PG8_MMA(1, 0, At, B0); PG8_MMA(1, 1, At, B1); PG8_BAR; PG8_SCHED;
            PG8_LDB(B0, 1, 0); PG8_LDB(B1, 1, 1); PG8_SCHED; PG8_LDA(At, 1, 0); PG8_STAGE(PG8_SA(0, 1), a2 + hstepA, voffA);
            PG8_WAIT_V(8); PG8_WAIT_L(0); PG8_BAR; PG8_MMA(0, 0, At, B0); PG8_MMA(0, 1, At, B1); PG8_BAR; PG8_SCHED;
            PG8_LDA(At, 1, 1); PG8_STAGE(PG8_SB(1, 0), b3, voffB); PG8_STAGE(PG8_SB(1, 1), b3 + hstepB, voffB); PG8_STAGE(PG8_SA(1, 0), a3, voffA);
            PG8_WAIT_V(8); PG8_WAIT_L(0); PG8_BAR; PG8_MMA(1, 0, At, B0); PG8_MMA(1, 1, At, B1); PG8_BAR; PG8_SCHED;
        }
        if (wr == 0) PG8_BAR;
        E(acc, cur, wr, wc, fr, fq);
        if (!has_next) break;
#pragma unroll
        for (int a = 0; a < 2; ++a)
#pragma unroll
            for (int b = 0; b < 2; ++b)
#pragma unroll
                for (int m = 0; m < 4; ++m)
#pragma unroll
                    for (int n = 0; n < 2; ++n) acc[a][b][m][n] = (f32x4){0.f, 0.f, 0.f, 0.f};
        cur = nxt; cA = nA; cB = nB; ++ui;
        if (wr == 1) PG8_BAR;
    }
    PG8_WAIT_V(0);
    PG8_BAR;
#undef PG8_SA
#undef PG8_SB
#undef PG8_STAGE
#undef PG8_LDA
#undef PG8_LDB
#undef PG8_MMA
#undef PG8_WAIT_V
#undef PG8_WAIT_L
#undef PG8_BAR
#undef PG8_SCHED
}

#define EPI_ARGS const f32x4 (&acc)[2][2][4][2], const Unit& u, int wr, int wc, int fr, int fq
__device__ __forceinline__ u32x4 pack8(f32x4 v0, f32x4 v1) { u32x4 w; w.x = cvt_pk_bf16(v0[0], v0[1]); w.y = cvt_pk_bf16(v0[2], v0[3]); w.z = cvt_pk_bf16(v1[0], v1[1]); w.w = cvt_pk_bf16(v1[2], v1[3]); return w; }

struct EpiStore {
    bf16_t* O; int ldc; int sig_pn;
    __device__ __forceinline__ void operator()(EPI_ARGS) const {
        const int row0 = u.pm * BM + wr * 64 + fr, col0 = u.pn * BM + wc * 32 + 8 * fq; const bool sig = u.pn >= sig_pn;
#pragma unroll
        for (int ai = 0; ai < 2; ++ai)
#pragma unroll
            for (int m = 0; m < 4; ++m) { bf16_t* rowp = O + (size_t)(row0 + ai * HALF + m * 16) * ldc + col0;
#pragma unroll
                for (int bj = 0; bj < 2; ++bj) { f32x4 v0 = acc[ai][bj][m][0], v1 = acc[ai][bj][m][1];
                    if (sig) {
#pragma unroll
                        for (int e = 0; e < 4; ++e) { v0[e] = sigmoidf_(v0[e]); v1[e] = sigmoidf_(v1[e]); } }
                    *(GAS u32x4*)(rowp + bj * HALF) = pack8(v0, v1); } }
    }
};
struct EpiQ {
    bf16_t* Q; const float* rstd; const float* rope; int S, Sshift;
    __device__ __forceinline__ void operator()(EPI_ARGS) const {
        const int row0 = u.pm * BM + wr * 64 + fr;
#pragma unroll
        for (int ai = 0; ai < 2; ++ai)
#pragma unroll
            for (int m = 0; m < 4; ++m) { const int row = row0 + ai * HALF + m * 16; const int seq = row >> Sshift, pos = row & (S - 1);
                const float sc = rstd[2 * row] * QSCALE;
#pragma unroll
                for (int bj = 0; bj < 2; ++bj) { const int g32 = 8 * u.pn + 4 * bj + wc; const int head = g32 / 3, gl = g32 - 3 * head;
                    f32x4 v0 = acc[ai][bj][m][0] * sc, v1 = acc[ai][bj][m][1] * sc;
                    if (gl == 2) { const f32x4 cs = *(const GAS f32x4*)(rope + (size_t)pos * 16 + 4 * fq), sn = *(const GAS f32x4*)(rope + 131072 + (size_t)pos * 16 + 4 * fq);
                        f32x4 w0, w1;
                        w0[0] = v0[0] * cs[0] - v0[1] * sn[0]; w0[1] = v0[0] * sn[0] + v0[1] * cs[0];
                        w0[2] = v0[2] * cs[1] - v0[3] * sn[1]; w0[3] = v0[2] * sn[1] + v0[3] * cs[1];
                        w1[0] = v1[0] * cs[2] - v1[1] * sn[2]; w1[1] = v1[0] * sn[2] + v1[1] * cs[2];
                        w1[2] = v1[2] * cs[3] - v1[3] * sn[3]; w1[3] = v1[2] * sn[3] + v1[3] * cs[3];
                        v0 = w0; v1 = w1; }
                    *(GAS u32x4*)(Q + ((size_t)((seq * 16 + head) << Sshift) + pos) * 96 + gl * 32 + 8 * fq) = pack8(v0, v1); }
                asm volatile("" ::: "memory"); }
    }
};
struct EpiKV {
    bf16_t* KF; bf16_t* V; const float* rstd; int S, Sshift;
    __device__ __forceinline__ void operator()(EPI_ARGS) const {
        const int row0 = u.pm * BM + wr * 64 + fr; const bool isv = u.pn >= 4;
#pragma unroll
        for (int ai = 0; ai < 2; ++ai)
#pragma unroll
            for (int m = 0; m < 4; ++m) { const int row = row0 + ai * HALF + m * 16; const int seq = row >> Sshift, pos = row & (S - 1);
                const float sc = rstd[2 * row + 1];
#pragma unroll
                for (int bj = 0; bj < 2; ++bj) { const int col = (u.pn & 3) * BM + bj * HALF + wc * 32 + 8 * fq; const int head = col >> 6, d = col & 63;
                    const f32x4 v0 = acc[ai][bj][m][0] * sc, v1 = acc[ai][bj][m][1] * sc; const size_t tok = (size_t)((seq * 16 + head) << Sshift) + pos;
                    bf16_t* p = isv ? V + tok * 64 + d : KF + tok * 96 + d;
                    *(GAS u32x4*)p = pack8(v0, v1); }
                asm volatile("" ::: "memory"); }
    }
};
struct EpiGateA {
    bf16_t* T; const bf16_t* Z;
    __device__ __forceinline__ void operator()(EPI_ARGS) const {
        const int row0 = u.pm * BM + wr * 64 + fr, col0 = u.pn * BM + wc * 32 + 8 * fq;
#pragma unroll
        for (int ai = 0; ai < 2; ++ai)
#pragma unroll
            for (int m = 0; m < 4; ++m) { const int row = row0 + ai * HALF + m * 16;
#pragma unroll
                for (int bj = 0; bj < 2; ++bj) { const int col = col0 + bj * HALF; const u32x4 gw = *(const GAS u32x4*)(Z + (size_t)row * ZLD + 3072 + col);
                    f32x4 v0 = acc[ai][bj][m][0], v1 = acc[ai][bj][m][1];
                    v0[0] *= bflo(gw.x); v0[1] *= bfhi(gw.x); v0[2] *= bflo(gw.y); v0[3] *= bfhi(gw.y); v1[0] *= bflo(gw.z); v1[1] *= bfhi(gw.z); v1[2] *= bflo(gw.w); v1[3] *= bfhi(gw.w);
                    *(GAS u32x4*)(T + (size_t)row * D + col) = pack8(v0, v1); }
                asm volatile("" ::: "memory"); }
    }
};
struct EpiGateB {
    const bf16_t* T; const bf16_t* Z; bf16_t* O;
    __device__ __forceinline__ void operator()(EPI_ARGS) const {
        const int row0 = u.pm * BM + wr * 64 + fr, col0 = u.pn * BM + wc * 32 + 8 * fq;
#pragma unroll
        for (int ai = 0; ai < 2; ++ai)
#pragma unroll
            for (int m = 0; m < 4; ++m) { const int row = row0 + ai * HALF + m * 16;
#pragma unroll
                for (int bj = 0; bj < 2; ++bj) { const int col = col0 + bj * HALF; const u32x4 gw = *(const GAS u32x4*)(Z + (size_t)row * ZLD + 4096 + col);
                    const u32x4 tw = *(const GAS u32x4*)(T + (size_t)row * D + col); f32x4 v0 = {bflo(tw.x), bfhi(tw.x), bflo(tw.y), bfhi(tw.y)}, v1 = {bflo(tw.z), bfhi(tw.z), bflo(tw.w), bfhi(tw.w)};
                    const f32x4 a0 = acc[ai][bj][m][0], a1 = acc[ai][bj][m][1];
                    v0[0] += a0[0] * bflo(gw.x); v0[1] += a0[1] * bfhi(gw.x); v0[2] += a0[2] * bflo(gw.y); v0[3] += a0[3] * bfhi(gw.y);
                    v1[0] += a1[0] * bflo(gw.z); v1[1] += a1[1] * bfhi(gw.z); v1[2] += a1[2] * bflo(gw.w); v1[3] += a1[3] * bfhi(gw.w);
                    *(GAS u32x4*)(O + (size_t)row * D + col) = pack8(v0, v1); }
                asm volatile("" ::: "memory"); }
    }
};
struct EpiResid {
    const float* base; float* out; const float* mod; int goff, Sshift, seqbase; int mode; bf16_t* x1;
    __device__ __forceinline__ void operator()(EPI_ARGS) const {
        const int row0 = u.pm * BM + wr * 64 + fr, col0 = u.pn * BM + wc * 32 + 8 * fq;
        const float* gt = mod + (size_t)(seqbase + ((u.pm * BM) >> Sshift)) * 6144 + goff + col0;
        f32x4 g[2][2];
#pragma unroll
        for (int bj = 0; bj < 2; ++bj) { g[bj][0] = *(const GAS f32x4*)(gt + bj * HALF); g[bj][1] = *(const GAS f32x4*)(gt + bj * HALF + 4); }
#pragma unroll
        for (int ai = 0; ai < 2; ++ai)
#pragma unroll
            for (int m = 0; m < 4; ++m) { const size_t off = (size_t)(row0 + ai * HALF + m * 16) * D + col0;
#pragma unroll
                for (int bj = 0; bj < 2; ++bj) {
                    if (mode == 0) { const f32x4 b0 = *(const GAS f32x4*)(base + off + bj * HALF), b1 = *(const GAS f32x4*)(base + off + bj * HALF + 4);
                        *(GAS u32x4*)(x1 + off + bj * HALF) = pack8(b0 + g[bj][0] * acc[ai][bj][m][0], b1 + g[bj][1] * acc[ai][bj][m][1]); }
                    else { const u32x4 w = *(const GAS u32x4*)(x1 + off + bj * HALF); const f32x4 b0 = {bflo(w.x), bfhi(w.x), bflo(w.y), bfhi(w.y)}, b1 = {bflo(w.z), bfhi(w.z), bflo(w.w), bfhi(w.w)};
                        *(GAS u32x4*)(x1 + off + bj * HALF) = pack8(b0 + g[bj][0] * acc[ai][bj][m][0], b1 + g[bj][1] * acc[ai][bj][m][1]); } }
                if (m & 1) asm volatile("" ::: "memory"); }
    }
};

__device__ __forceinline__ float dpp_prev(float oldv, float v) { return __int_as_float(__builtin_amdgcn_update_dpp(__float_as_int(oldv), __float_as_int(v), 0x111, 0xf, 0xf, false)); }
__device__ __forceinline__ float dpp_next(float oldv, float v) { return __int_as_float(__builtin_amdgcn_update_dpp(__float_as_int(oldv), __float_as_int(v), 0x101, 0xf, 0xf, false)); }
__device__ __forceinline__ float dpp_ror1(float v)  { return __int_as_float(__builtin_amdgcn_update_dpp(0, __float_as_int(v), 0x121, 0xf, 0xf, false)); }
__device__ __forceinline__ float dpp_ror15(float v) { return __int_as_float(__builtin_amdgcn_update_dpp(0, __float_as_int(v), 0x12F, 0xf, 0xf, false)); }
__device__ __forceinline__ float gelu_tanh_(float x) { const float y = 0.7978845608028654f * (x + 0.044715f * x * x * x); return x * sigmoidf_(2.0f * y); }
struct EpiConv {
    bf16_t* ACT; const float* cw; const float* cbias; float* EDGEU; float* PARTP; float* PARTG; LAS unsigned char* xl;
    __device__ __forceinline__ void operator()(EPI_ARGS) const {
#define UU(ai, m, e) acc[ai][0][m][(e) >> 2][(e) & 3]
#define GG(ai, m, e) acc[ai][1][m][(e) >> 2][(e) & 3]
        const int c0 = u.pn * 128 + wc * 32 + 8 * fq;
        float w0[8], w1[8], w2[8], cb[8];
        { const GAS f32x4* wp = (const GAS f32x4*)(cw + c0); const f32x4 a0 = wp[0], a1 = wp[1], b0 = wp[DFF / 4], b1 = wp[DFF / 4 + 1], d0 = wp[2 * DFF / 4], d1 = wp[2 * DFF / 4 + 1];
          const GAS f32x4* bp = (const GAS f32x4*)(cbias + c0); const f32x4 e0 = bp[0], e1 = bp[1];
#pragma unroll
          for (int e = 0; e < 4; ++e) { w0[e] = a0[e]; w0[4 + e] = a1[e]; w1[e] = b0[e]; w1[4 + e] = b1[e]; w2[e] = d0[e]; w2[4 + e] = d1[e]; cb[e] = e0[e]; cb[4 + e] = e1[e]; } }
        LAS float* XE = (LAS float*)xl;
#pragma unroll
        for (int ai = 0; ai < 2; ++ai) { const int blk = 2 * ai + wr;
            if (fr == 0) {
#pragma unroll
                for (int e = 0; e < 8; ++e) XE[((blk * 2 + 0) * 4 + wc) * 32 + fq * 8 + e] = UU(ai, 0, e); }
            if (fr == 15) {
#pragma unroll
                for (int e = 0; e < 8; ++e) XE[((blk * 2 + 1) * 4 + wc) * 32 + fq * 8 + e] = UU(ai, 3, e); } }
        if (wr == 0 && fr == 0) { float* ep = EDGEU + (size_t)(u.pm * 2 + 0) * DFF + c0; *(GAS f32x4*)ep = acc[0][0][0][0]; *(GAS f32x4*)(ep + 4) = acc[0][0][0][1]; }
        if (wr == 1 && fr == 15) { float* ep = EDGEU + (size_t)(u.pm * 2 + 1) * DFF + c0; *(GAS f32x4*)ep = acc[1][0][3][0]; *(GAS f32x4*)(ep + 4) = acc[1][0][3][1]; }
        asm volatile("s_waitcnt lgkmcnt(0)" ::: "memory"); __builtin_amdgcn_s_barrier(); asm volatile("" ::: "memory");
#pragma unroll
        for (int ai = 0; ai < 2; ++ai) { const int blk = 2 * ai + wr;
#pragma unroll
            for (int m = 0; m < 4; ++m) { const int row = u.pm * BM + ai * HALF + wr * 64 + m * 16 + fr;
                float pre[8], r[8], ex[8];
#pragma unroll
                for (int e = 0; e < 8; ++e) ex[e] = 0.f;
                if (m == 0 && blk > 0 && fr == 0) {
#pragma unroll
                    for (int e = 0; e < 8; ++e) ex[e] = XE[(((blk - 1) * 2 + 1) * 4 + wc) * 32 + fq * 8 + e]; }
                if (m == 3 && blk < 3 && fr == 15) {
#pragma unroll
                    for (int e = 0; e < 8; ++e) ex[e] = XE[(((blk + 1) * 2 + 0) * 4 + wc) * 32 + fq * 8 + e]; }
#pragma unroll
                for (int e = 0; e < 8; ++e) { const float uc = UU(ai, m, e);
                    const float oldp = (m == 0) ? ex[e] : dpp_ror1(UU(ai, m == 0 ? 0 : m - 1, e));
                    const float oldn = (m == 3) ? ex[e] : dpp_ror15(UU(ai, m == 3 ? 3 : m + 1, e));
                    const float up_ = dpp_prev(oldp, uc), un_ = dpp_next(oldn, uc);
                    pre[e] = cb[e] + w0[e] * up_ + w1[e] * uc + w2[e] * un_; r[e] = gelu_tanh_(pre[e]) * GG(ai, m, e); }
                const bool edge0 = (blk == 0 && m == 0 && fr == 0), edge1 = (blk == 3 && m == 3 && fr == 15);
                if (edge0 || edge1) { const size_t o = (size_t)(u.pm * 2 + (edge1 ? 1 : 0)) * DFF + c0;
                    *(GAS f32x4*)(PARTP + o) = (f32x4){pre[0], pre[1], pre[2], pre[3]}; *(GAS f32x4*)(PARTP + o + 4) = (f32x4){pre[4], pre[5], pre[6], pre[7]};
                    *(GAS f32x4*)(PARTG + o) = acc[ai][1][m][0]; *(GAS f32x4*)(PARTG + o + 4) = acc[ai][1][m][1]; }
                else { u32x4 w; w.x = cvt_pk_bf16(r[0], r[1]); w.y = cvt_pk_bf16(r[2], r[3]); w.z = cvt_pk_bf16(r[4], r[5]); w.w = cvt_pk_bf16(r[6], r[7]);
                    *(GAS u32x4*)(ACT + (size_t)row * DFF + c0) = w; }
                asm volatile("" ::: "memory"); }
        }
#undef UU
#undef GG
    }
};

struct EpiAny {
    int kind;
    unsigned char* ws;
    int S, Sshift, seqbase, goff, rmode; const float* base; const float* cw; const float* cbias; LAS unsigned char* xl;
    __device__ __forceinline__ void operator()(EPI_ARGS) const {
        if (kind == 0) { EpiStore e{(bf16_t*)(ws + WS_Z), ZLD, 12}; e(acc, u, wr, wc, fr, fq); }
        else if (kind == 1) { EpiQ e{(bf16_t*)(ws + WS_Q), (const float*)(ws + WS_RSTD), (const float*)(ws + WS_ROPE), S, Sshift}; e(acc, u, wr, wc, fr, fq); }
        else if (kind == 2) { EpiKV e{(bf16_t*)(ws + WS_KF), (bf16_t*)(ws + WS_V), (const float*)(ws + WS_RSTD), S, Sshift}; e(acc, u, wr, wc, fr, fq); }
        else if (kind == 3) { EpiGateA e{(bf16_t*)(ws + WS_T), (const bf16_t*)(ws + WS_Z)}; e(acc, u, wr, wc, fr, fq); }
        else if (kind == 4) { EpiGateB e{(const bf16_t*)(ws + WS_T), (const bf16_t*)(ws + WS_Z), (bf16_t*)(ws + WS_MERGED)}; e(acc, u, wr, wc, fr, fq); }
        else if (kind == 5) { EpiResid e{base, nullptr, (const float*)(ws + WS_MOD), goff, Sshift, seqbase, rmode, (bf16_t*)(ws + WS_OA)}; e(acc, u, wr, wc, fr, fq); }
        else { float* ed = (float*)(ws + WS_EDGE); EpiConv e{(bf16_t*)(ws + WS_ACT), cw, cbias, ed, ed + 128 * DFF, ed + 256 * DFF, xl}; e(acc, u, wr, wc, fr, fq); }
    }
};
}

__device__ const float ROPE_INV[16] = {1.000000000e+00f, 5.623413324e-01f, 3.162277639e-01f, 1.778279394e-01f, 1.000000015e-01f, 5.623413250e-02f, 3.162277490e-02f, 1.778279431e-02f,
                                       9.999999776e-03f, 5.623413250e-03f, 3.162277630e-03f, 1.778279431e-03f, 1.000000047e-03f, 5.623413017e-04f, 3.162277571e-04f, 1.778279402e-04f};
__device__ __forceinline__ int perm_rope(int i) { return i < 16 ? 2 * i : 2 * (i - 16) + 1; }
__device__ __forceinline__ int rowmap(int kind, int n) {
    if (kind == 1) return n < 640 ? n : (n < 672 ? 640 + perm_rope(n - 640) : n + 96);
    if (kind == 2) { const int h = n / 96, c = n - h * 96; return c < 64 ? n : h * 96 + 64 + perm_rope(c - 64); }
    if (kind == 3) { const int h = n >> 7, c = n & 127; return c < 64 ? h * 64 + c : 1024 + h * 64 + (c - 64); }
    if (kind == 4) { const int f = n < DFF ? n : n - DFF; return (f >> 7) * 256 + (n < DFF ? 0 : 128) + (f & 127); }
    return n;
}
__device__ __forceinline__ void transpose_item(const float* W, int K, int N, bf16_t* WT, int kind, const float* ks, LAS float* scr, int item, int lane) {
    const int nblk = N / 32, kb = item / nblk, nb = item - kb * nblk, k0 = 64 * kb, n0 = 32 * nb;
#pragma unroll 8
    for (int i = 0; i < 32; ++i) { const int kk = 2 * i + (lane >> 5); float w = W[(size_t)(k0 + kk) * N + n0 + (lane & 31)]; if (ks) w *= ks[k0 + kk]; scr[kk * 33 + (lane & 31)] = w; }
    asm volatile("s_waitcnt lgkmcnt(0)" ::: "memory");
    const int c = lane & 7;
#pragma unroll
    for (int j = 0; j < 4; ++j) { const int n = (lane >> 3) + 8 * j; const LAS float* s = scr + (8 * c) * 33 + n;
        u32x4 o; o.x = cvt_pk_bf16(s[0 * 33], s[1 * 33]); o.y = cvt_pk_bf16(s[2 * 33], s[3 * 33]); o.z = cvt_pk_bf16(s[4 * 33], s[5 * 33]); o.w = cvt_pk_bf16(s[6 * 33], s[7 * 33]);
        *(GAS u32x4*)(WT + (size_t)rowmap(kind, n0 + n) * K + k0 + 8 * c) = o; }
    asm volatile("s_waitcnt lgkmcnt(0)" ::: "memory");
}

__device__ __forceinline__ void norm_mod_row(const float* xrow, bf16_t* orow, const float* g, const float* sc, const float* sh, int lane) {
    const GAS f32x4* xr = (const GAS f32x4*)xrow + lane; f32x4 v[4]; float s = 0.f;
#pragma unroll
    for (int j = 0; j < 4; ++j) { v[j] = xr[64 * j]; s += (v[j].x * v[j].x + v[j].y * v[j].y) + (v[j].z * v[j].z + v[j].w * v[j].w); }
    const float rstd = 1.0f / sqrtf(wave_sum(s) * (1.f / D) + EPS);
    GAS u32x2* o8 = (GAS u32x2*)orow + lane;
#pragma unroll
    for (int j = 0; j < 4; ++j) { const f32x4 gg = ((const GAS f32x4*)g)[lane + 64 * j], ss = ((const GAS f32x4*)sc)[lane + 64 * j], hh = ((const GAS f32x4*)sh)[lane + 64 * j];
        const f32x4 o = v[j] * rstd * gg * (ss + 1.0f) + hh; u32x2 w; w.x = cvt_pk_bf16(o.x, o.y); w.y = cvt_pk_bf16(o.z, o.w); o8[64 * j] = w; }
}
__device__ __forceinline__ void norm_mod_row16(const bf16_t* xrow, bf16_t* orow, const float* g, const float* sc, const float* sh, int lane) {
    const GAS u32x2* xr = (const GAS u32x2*)xrow + lane; f32x4 v[4]; float s = 0.f;
#pragma unroll
    for (int j = 0; j < 4; ++j) { const u32x2 w = xr[64 * j]; v[j] = (f32x4){bflo(w.x), bfhi(w.x), bflo(w.y), bfhi(w.y)}; s += (v[j].x * v[j].x + v[j].y * v[j].y) + (v[j].z * v[j].z + v[j].w * v[j].w); }
    const float rstd = 1.0f / sqrtf(wave_sum(s) * (1.f / D) + EPS);
    GAS u32x2* o8 = (GAS u32x2*)orow + lane;
#pragma unroll
    for (int j = 0; j < 4; ++j) { const f32x4 gg = ((const GAS f32x4*)g)[lane + 64 * j], ss = ((const GAS f32x4*)sc)[lane + 64 * j], hh = ((const GAS f32x4*)sh)[lane + 64 * j];
        const f32x4 o = v[j] * rstd * gg * (ss + 1.0f) + hh; u32x2 w; w.x = cvt_pk_bf16(o.x, o.y); w.y = cvt_pk_bf16(o.z, o.w); o8[64 * j] = w; }
}
__device__ __forceinline__ void final_norm_row(const bf16_t* xin, float* xrow, const float* g, int lane) {
    GAS f32x4* xr = (GAS f32x4*)xrow + lane; const GAS u32x2* xi = (const GAS u32x2*)xin + lane; f32x4 v[4]; float s = 0.f;
#pragma unroll
    for (int j = 0; j < 4; ++j) { const u32x2 w = xi[64 * j]; v[j] = (f32x4){bflo(w.x), bfhi(w.x), bflo(w.y), bfhi(w.y)}; s += (v[j].x * v[j].x + v[j].y * v[j].y) + (v[j].z * v[j].z + v[j].w * v[j].w); }
    const float rstd = 1.0f / sqrtf(wave_sum(s) * (1.f / D) + EPS);
#pragma unroll
    for (int j = 0; j < 4; ++j) xr[64 * j] = v[j] * rstd * ((const GAS f32x4*)g)[lane + 64 * j];
}

__device__ __forceinline__ void ld_f32(const float* p, int lane, f32x4 (&v)[4]) { const GAS f32x4* r = (const GAS f32x4*)p + lane;
#pragma unroll
    for (int j = 0; j < 4; ++j) v[j] = r[64 * j]; }
__device__ __forceinline__ void ld_b16(const bf16_t* p, int lane, f32x4 (&v)[4]) { const GAS u32x2* r = (const GAS u32x2*)p + lane;
#pragma unroll
    for (int j = 0; j < 4; ++j) { const u32x2 w = r[64 * j]; v[j] = (f32x4){bflo(w.x), bfhi(w.x), bflo(w.y), bfhi(w.y)}; } }
__device__ __forceinline__ float ssq4(const f32x4 (&v)[4]) { float s = 0.f;
#pragma unroll
    for (int j = 0; j < 4; ++j) s += (v[j].x * v[j].x + v[j].y * v[j].y) + (v[j].z * v[j].z + v[j].w * v[j].w);
    return s; }
__device__ __forceinline__ void st_mod_b16(bf16_t* orow, int lane, const f32x4 (&v)[4], float rstd, const float* g, const float* sc, const float* sh) { GAS u32x2* o8 = (GAS u32x2*)orow + lane;
#pragma unroll
    for (int j = 0; j < 4; ++j) { const f32x4 gg = ((const GAS f32x4*)g)[lane + 64 * j], ss = ((const GAS f32x4*)sc)[lane + 64 * j], hh = ((const GAS f32x4*)sh)[lane + 64 * j];
        const f32x4 o = v[j] * rstd * gg * (ss + 1.0f) + hh; u32x2 w; w.x = cvt_pk_bf16(o.x, o.y); w.y = cvt_pk_bf16(o.z, o.w); o8[64 * j] = w; } }
__device__ __forceinline__ void st_fin_f32(float* orow, int lane, const f32x4 (&v)[4], float rstd, const float* g) { GAS f32x4* xr = (GAS f32x4*)orow + lane;
#pragma unroll
    for (int j = 0; j < 4; ++j) xr[64 * j] = v[j] * rstd * ((const GAS f32x4*)g)[lane + 64 * j]; }
#define RSTD_OF(s) (1.0f / sqrtf(wave_sum(s) * (1.f / D) + EPS))

__device__ __forceinline__ void dil_task(const bf16_t* Z, float* OG, float* LSE, int S, int task, LAS unsigned char* wl, int lane_in) {
    int lane = lane_in; asm volatile("" : "+v"(lane));
    const int r32 = lane & 31, hi = lane >> 5;
    const int bps = S >> 5, tps = 12 * bps;
    const int seq = task / tps; const int rem = task - seq * tps; const int hd = rem / bps; const int blk = rem - hd * bps;
    const int g = hd >> 2, sh = 2 * g, dl = 1 << sh; const int r = blk & (dl - 1), bi = blk >> sh;
    const int i0 = bi * 32, nsub = S >> sh;
    const size_t rowbase = (size_t)seq * S;
    const int tq = r + ((i0 + r32) << sh);
    const bf16_t* qp = Z + (rowbase + tq) * ZLD + 768 + hd * 64 + 8 * hi;
    bf16x8 qf[4];
#pragma unroll
    for (int s = 0; s < 4; ++s) qf[s] = *(const GAS bf16x8*)(qp + 16 * s);
    f32x16 sc[5];
    {
        bf16x8 kf[5][4];
#pragma unroll
        for (int c = 0; c < 5; ++c) {
            int ik = i0 - 64 + 32 * c + r32; ik = ik < 0 ? 0 : (ik > nsub - 1 ? nsub - 1 : ik);
            const bf16_t* kp = Z + (rowbase + r + ((size_t)ik << sh)) * ZLD + 1536 + hd * 64 + 8 * hi;
#pragma unroll
            for (int s = 0; s < 4; ++s) kf[c][s] = *(const GAS bf16x8*)(kp + 16 * s);
        }
#pragma unroll
        for (int c = 0; c < 5; ++c) {
            f32x16 a = {};
#pragma unroll
            for (int s = 0; s < 4; ++s) a = __builtin_amdgcn_mfma_f32_32x32x16_bf16(kf[c][s], qf[s], a, 0, 0, 0);
            sc[c] = a;
        }
    }
    asm volatile("" ::: "memory");
    u32x4 vv[5][4];
#pragma unroll
    for (int c = 0; c < 5; ++c)
#pragma unroll
        for (int i = 0; i < 4; ++i) { const int row = (lane >> 3) + 8 * i; int ik = i0 - 64 + 32 * c + row; ik = ik < 0 ? 0 : (ik > nsub - 1 ? nsub - 1 : ik);
            vv[c][i] = *(const GAS u32x4*)(Z + (rowbase + r + ((size_t)ik << sh)) * ZLD + 2304 + hd * 64 + (lane & 7) * 8); }
    asm volatile("" ::: "memory");
    const float cb = __builtin_amdgcn_exp2f(-0.6666666667f * (float)(hd + 1)) * LOG2E * (float)dl;
    float mx = -INFINITY;
#pragma unroll
    for (int c = 0; c < 5; ++c)
#pragma unroll
        for (int e = 0; e < 16; ++e) {
            const int kvl = 32 * c + (e & 3) + 8 * (e >> 2) + 4 * hi; const int delta = kvl - 64 - r32; const int ik = i0 + r32 + delta;
            const int ad = delta < 0 ? -delta : delta; const bool valid = (ad <= 64) && (ik >= 0) && (ik < nsub);
            float v = sc[c][e] * DSCALE - cb * (float)ad; v = valid ? v : -INFINITY; sc[c][e] = v; mx = fmaxf(mx, v);
        }
    mx = swap_max(mx);
    float ls = 0.f;
#pragma unroll
    for (int c = 0; c < 5; ++c)
#pragma unroll
        for (int e = 0; e < 16; ++e) { const float p = __builtin_amdgcn_exp2f(sc[c][e] - mx); sc[c][e] = p; ls += p; }
    ls = swap_add(ls);
    f32x16 o0 = {}, o1 = {};
    const int vb = ((lane >> 4) & 1) * 32 + (lane & 3) * 8 + (4 * hi + ((lane & 15) >> 2)) * 64;
#pragma unroll
    for (int c = 0; c < 5; ++c) {
        asm volatile("s_waitcnt lgkmcnt(0)" ::: "memory");
#pragma unroll
        for (int i = 0; i < 4; ++i) { const int row = (lane >> 3) + 8 * i; *(LAS u32x4*)(wl + ((lane & 7) >> 2) * 2048 + row * 64 + (lane & 3) * 16) = vv[c][i]; }
        asm volatile("s_waitcnt lgkmcnt(0)" ::: "memory");
#pragma unroll
        for (int s = 0; s < 2; ++s) {
            u32x4 pw; pw.x = cvt_pk_bf16(sc[c][8 * s + 0], sc[c][8 * s + 1]); pw.y = cvt_pk_bf16(sc[c][8 * s + 2], sc[c][8 * s + 3]); pw.z = cvt_pk_bf16(sc[c][8 * s + 4], sc[c][8 * s + 5]); pw.w = cvt_pk_bf16(sc[c][8 * s + 6], sc[c][8 * s + 7]);
            const bf16x8 pf = __builtin_bit_cast(bf16x8, pw);
            { const s16x4 lo = vtr(wl + vb + s * 1024), hh = vtr(wl + vb + s * 1024 + 512); const bf16x8 vf = {lo[0], lo[1], lo[2], lo[3], hh[0], hh[1], hh[2], hh[3]};
              o0 = __builtin_amdgcn_mfma_f32_32x32x16_bf16(vf, pf, o0, 0, 0, 0); }
            { const s16x4 lo = vtr(wl + vb + 2048 + s * 1024), hh = vtr(wl + vb + 2048 + s * 1024 + 512); const bf16x8 vf = {lo[0], lo[1], lo[2], lo[3], hh[0], hh[1], hh[2], hh[3]};
              o1 = __builtin_amdgcn_mfma_f32_32x32x16_bf16(vf, pf, o1, 0, 0, 0); }
        }
    }
    const float inv = 1.0f / ls; const size_t rq = rowbase + tq;
    float* op = OG + (rq * 12 + hd) * 64 + 4 * hi;
#pragma unroll
    for (int i = 0; i < 4; ++i) {
        *(GAS f32x4*)(op + 8 * i) = (f32x4){o0[4 * i] * inv, o0[4 * i + 1] * inv, o0[4 * i + 2] * inv, o0[4 * i + 3] * inv};
        *(GAS f32x4*)(op + 32 + 8 * i) = (f32x4){o1[4 * i] * inv, o1[4 * i + 1] * inv, o1[4 * i + 2] * inv, o1[4 * i + 3] * inv};
    }
    if (hi == 0) LSE[rq * 12 + hd] = (mx + __builtin_amdgcn_logf(ls)) * LN2;
}

namespace mla {
constexpr int KPITCH = 208, KBYTES = 64 * KPITCH, VBYTES = 8192, BUF = KBYTES + VBYTES, QOFF = 2 * BUF, DUMMY = QOFF + 8 * 12288;
#define MLA_PACK(P, b) (u32x4){cvt_pk_bf16(P[b], P[b + 1]), cvt_pk_bf16(P[b + 2], P[b + 3]), cvt_pk_bf16(P[b + 4], P[b + 5]), cvt_pk_bf16(P[b + 6], P[b + 7])}
#define SGB(mask, n) __builtin_amdgcn_sched_group_barrier(mask, n, 0)
__device__ __forceinline__ float max2_(float a, float b) { return __builtin_amdgcn_fmed3f(a, b, INFINITY); }
constexpr float THR = 8.0f;
__device__ __forceinline__ void softmax_blk(f32x16& p0, f32x16& p1, f32x16& o0, f32x16& o1, float& mhat, float& lrun, u32x4 (&pf)[4], bool first) {
    float r0 = max2_(p0[0], p0[1]), r1 = max2_(p1[0], p1[1]);
#pragma unroll
    for (int e = 2; e < 16; ++e) { r0 = max2_(r0, p0[e]); r1 = max2_(r1, p1[e]); }
    const float rm = swap_max(max2_(r0, r1));
    if (first || __any(rm - mhat > THR)) {
        const float mn = first ? rm : fmaxf(rm, mhat); const float f = first ? 0.f : __builtin_amdgcn_exp2f(mhat - mn); mhat = mn; lrun *= f;
#pragma unroll
        for (int e = 0; e < 16; ++e) { o0[e] *= f; o1[e] *= f; }
    }
    float s0 = 0.f, s1 = 0.f;
#pragma unroll
    for (int e = 0; e < 16; ++e) { p0[e] = __builtin_amdgcn_exp2f(p0[e] - mhat); p1[e] = __builtin_amdgcn_exp2f(p1[e] - mhat); s0 += p0[e]; s1 += p1[e]; }
    lrun += s0 + s1;
    pf[0] = MLA_PACK(p0, 0); pf[1] = MLA_PACK(p0, 8); pf[2] = MLA_PACK(p1, 0); pf[3] = MLA_PACK(p1, 8);
}
__device__ __forceinline__ void pv_blk(const u32x4 (&pf)[4], f32x16& o0, f32x16& o1, LAS const unsigned char* vbase) {
#pragma unroll
    for (int ks = 0; ks < 4; ++ks) {
        const bf16x8 p = __builtin_bit_cast(bf16x8, pf[ks]);
        { const s16x4 lo = vtr(vbase + ks * 1024), hh = vtr(vbase + ks * 1024 + 512); const bf16x8 vf = {lo[0], lo[1], lo[2], lo[3], hh[0], hh[1], hh[2], hh[3]};
          o0 = __builtin_amdgcn_mfma_f32_32x32x16_bf16(vf, p, o0, 0, 0, 0); }
        { const s16x4 lo = vtr(vbase + 4096 + ks * 1024), hh = vtr(vbase + 4096 + ks * 1024 + 512); const bf16x8 vf = {lo[0], lo[1], lo[2], lo[3], hh[0], hh[1], hh[2], hh[3]};
          o1 = __builtin_amdgcn_mfma_f32_32x32x16_bf16(vf, p, o1, 0, 0, 0); }
    }
}
__device__ __forceinline__ void store_o(bf16_t* op, const f32x16& o0, const f32x16& o1, float inv) {
#pragma unroll
    for (int i = 0; i < 4; ++i) {
        u32x2 w0; w0.x = cvt_pk_bf16(o0[4 * i] * inv, o0[4 * i + 1] * inv); w0.y = cvt_pk_bf16(o0[4 * i + 2] * inv, o0[4 * i + 3] * inv); GST(u32x2, op + 8 * i, w0);
        u32x2 w1; w1.x = cvt_pk_bf16(o1[4 * i] * inv, o1[4 * i + 1] * inv); w1.y = cvt_pk_bf16(o1[4 * i + 2] * inv, o1[4 * i + 3] * inv); GST(u32x2, op + 32 + 8 * i, w1);
    }
}
__device__ __forceinline__ void attn_unit(const bf16_t* Qh, const bf16_t* Kh, const bf16_t* Vh, bf16_t* Oh  , int S, int qb, LAS unsigned char* lds, int tid) {
    const int lane = tid & 63, r32 = lane & 31, hi = lane >> 5; const int wid = __builtin_amdgcn_readfirstlane(tid >> 6);
    const int qrow = qb * 512 + wid * 64 + r32;
    const bf16_t* Qw = Qh + (size_t)qrow * 96 + 8 * hi;
    LAS unsigned char* ql = lds + QOFF + wid * 12288 + lane * 16;
#pragma unroll
    for (int s = 0; s < 6; ++s) { *(LAS bf16x8*)(ql + s * 1024) = GLD(bf16x8, Qw + 16 * s); *(LAS bf16x8*)(ql + (6 + s) * 1024) = GLD(bf16x8, Qw + 32 * 96 + 16 * s); }
    const bool has1 = tid < 256; const int kc0 = tid, kc1 = has1 ? tid + 512 : tid;
    const unsigned kd0 = (unsigned)((kc0 / 12) * KPITCH + (kc0 % 12) * 16);
    const unsigned kd1 = has1 ? (unsigned)((kc1 / 12) * KPITCH + (kc1 % 12) * 16) : (unsigned)(DUMMY + (tid - 256) * 16);
    const unsigned kd1n = has1 ? BUF : 0u;
    const unsigned vd = (unsigned)(KBYTES + ((tid & 7) >> 2) * 4096 + (tid >> 3) * 64 + (tid & 3) * 16);
    const GAS u32x4* Kg = (const GAS u32x4*)Kh; const GAS u32x4* Vg = (const GAS u32x4*)Vh;
    const int NT = S >> 6;
    u32x4 ka = GLD(u32x4, Kg + kc0), kb = GLD(u32x4, Kg + kc1), va = GLD(u32x4, Vg + tid);
    *(LAS u32x4*)(lds + kd0) = ka; *(LAS u32x4*)(lds + kd1) = kb; *(LAS u32x4*)(lds + vd) = va;
    __syncthreads();
    f32x16 oa0 = {}, oa1 = {}, ob0 = {}, ob1 = {}; float ma = 0.f, la = 0.f, mb = 0.f, lb = 0.f;
    const unsigned kfo = (unsigned)(r32 * KPITCH + hi * 16);
    const unsigned vb = (unsigned)(KBYTES + ((lane >> 4) & 1) * 32 + (lane & 3) * 8 + (4 * hi + ((lane & 15) >> 2)) * 64);
    for (int t = 0; t < NT; ++t) {
        const unsigned cur = (unsigned)(t & 1) * BUF, nxt = BUF - cur;
        const int tn = t + 1 < NT ? t + 1 : t;
        ka = GLD(u32x4, Kg + (size_t)tn * 768 + kc0); kb = GLD(u32x4, Kg + (size_t)tn * 768 + kc1); va = GLD(u32x4, Vg + (size_t)tn * 512 + tid);
        u32x4 pf[4];
        {
            f32x16 p0 = {}, p1 = {};
#pragma unroll
            for (int s = 0; s < 6; ++s) {
                const bf16x8 a0 = *(const LAS bf16x8*)(lds + cur + kfo + s * 32), a1 = *(const LAS bf16x8*)(lds + cur + kfo + 32 * KPITCH + s * 32);
                const bf16x8 q = *(const LAS bf16x8*)(ql + s * 1024);
                p0 = __builtin_amdgcn_mfma_f32_32x32x16_bf16(a0, q, p0, 0, 0, 0); p1 = __builtin_amdgcn_mfma_f32_32x32x16_bf16(a1, q, p1, 0, 0, 0);
            }
            softmax_blk(p0, p1, oa0, oa1, ma, la, pf, t == 0);
            pv_blk(pf, oa0, oa1, lds + cur + vb);
        }
        __builtin_amdgcn_sched_barrier(0);
        {
            f32x16 p0 = {}, p1 = {};
#pragma unroll
            for (int s = 0; s < 6; ++s) {
                const bf16x8 a0 = *(const LAS bf16x8*)(lds + cur + kfo + s * 32), a1 = *(const LAS bf16x8*)(lds + cur + kfo + 32 * KPITCH + s * 32);
                const bf16x8 q = *(const LAS bf16x8*)(ql + (6 + s) * 1024);
                p0 = __builtin_amdgcn_mfma_f32_32x32x16_bf16(a0, q, p0, 0, 0, 0); p1 = __builtin_amdgcn_mfma_f32_32x32x16_bf16(a1, q, p1, 0, 0, 0);
            }
            softmax_blk(p0, p1, ob0, ob1, mb, lb, pf, t == 0);
            pv_blk(pf, ob0, ob1, lds + cur + vb);
        }
        *(LAS u32x4*)(lds + nxt + kd0) = ka; *(LAS u32x4*)(lds + (has1 ? nxt : 0u) + kd1) = kb; *(LAS u32x4*)(lds + nxt + vd) = va;
        __syncthreads();
    }
    bf16_t* op = Oh + (size_t)qrow * D + 4 * hi;
    store_o(op, oa0, oa1, 1.0f / swap_add(la));
    store_o(op + 32 * D, ob0, ob1, 1.0f / swap_add(lb));
}
#undef SGB
}

#define XB_TMO      128
#define XB_XCNT(j)  (256  + 64 * (j))
#define XB_XSUB(j)  (1280 + 64 * (j))
#define XB_XGEN(j)  (2304 + 64 * (j))
#define XB_TOP      3328
#define XB_TOPGEN   3392
#define XCD_BAR_WORDS 3456
#define XB_SPIN_CAP (1u << 20)
__device__ __forceinline__ unsigned xb_ld(unsigned* p)              { return __hip_atomic_load(p, __ATOMIC_RELAXED, __HIP_MEMORY_SCOPE_AGENT); }
__device__ __forceinline__ unsigned xb_add(unsigned* p, unsigned v) { return __hip_atomic_fetch_add(p, v, __ATOMIC_RELAXED, __HIP_MEMORY_SCOPE_AGENT); }
__device__ __forceinline__ unsigned xb_xcc_id() { return (unsigned)__builtin_amdgcn_s_getreg((3 << 11) | 20) & 0xFu; }
#define XB_SPIN(cond, bar) do { unsigned _sp = 0; while (cond) { __builtin_amdgcn_s_sleep(1); \
    if ((++_sp & 255u) == 0u) { if (xb_ld(&(bar)[XB_TMO])) break; if (_sp > XB_SPIN_CAP) { atomicAdd(&(bar)[XB_TMO], 1u); break; } } } } while (0)
struct XcdBarrier { unsigned* bar; unsigned x; volatile LAS unsigned* st; };
__device__ __forceinline__ XcdBarrier xcd_barrier_post(unsigned* bar, volatile LAS unsigned* st, int tid) {
    XcdBarrier b; b.bar = bar; b.x = xb_xcc_id(); b.st = st;
    if (tid == 0) (void)xb_add(&bar[XB_XCNT(b.x)], 1u);
    return b;
}
__device__ __forceinline__ void xcd_barrier_complete(unsigned* bar, unsigned x, unsigned& nloc, unsigned& nx) {
    const unsigned G = gridDim.x * gridDim.y * gridDim.z;
    unsigned sum, cnt, mine, sp = 0u;
    for (;;) {
        sum = 0u; cnt = 0u; mine = 0u;
#pragma unroll
        for (unsigned j = 0; j < 16; ++j) { const unsigned c = xb_ld(&bar[XB_XCNT(j)]); sum += c; cnt += (c > 0u) ? 1u : 0u; mine = (j == x) ? c : mine; }
        if (sum == G) break;
        __builtin_amdgcn_s_sleep(1);
        if ((++sp & 255u) == 0u) { if (xb_ld(&bar[XB_TMO])) break; if (sp > XB_SPIN_CAP) { atomicAdd(&bar[XB_TMO], 1u); break; } }
    }
    nloc = mine > 0u ? mine : 1u; nx = cnt > 0u ? cnt : 1u;
}
__device__ __forceinline__ void xcd_barrier(const XcdBarrier& b, int tid) {
    asm volatile("s_waitcnt vmcnt(0)" ::: "memory");
    __syncthreads();
    if (tid == 0) {
        unsigned* bar = b.bar;
        __builtin_amdgcn_s_waitcnt(0);
        unsigned nloc = b.st[0], nx = b.st[1];
        if (nloc == 0u) { xcd_barrier_complete(bar, b.x, nloc, nx); b.st[0] = nloc; b.st[1] = nx; }
        const unsigned old = xb_add(&bar[XB_XSUB(b.x)], 1u);
        const unsigned gen = old / nloc;
        if (old + 1u == (gen + 1u) * nloc) {
            __builtin_amdgcn_fence(__ATOMIC_RELEASE, "agent");
            asm volatile("s_waitcnt vmcnt(0)" ::: "memory");
            const unsigned og = xb_add(&bar[XB_TOP], 1u);
            const unsigned tg = og / nx;
            if (og + 1u == (tg + 1u) * nx) xb_add(&bar[XB_TOPGEN], 1u);
            else XB_SPIN(xb_ld(&bar[XB_TOPGEN]) == tg, bar);
            __builtin_amdgcn_fence(__ATOMIC_ACQUIRE, "agent");
            xb_add(&bar[XB_XGEN(b.x)], 1u);
            asm volatile("s_waitcnt vmcnt(0)" ::: "memory");
        } else {
            XB_SPIN(xb_ld(&bar[XB_XGEN(b.x)]) == gen, bar);
            __builtin_amdgcn_fence(__ATOMIC_ACQUIRE, "agent");
            asm volatile("s_waitcnt vmcnt(0)" ::: "memory");
        }
    }
    __syncthreads();
}

constexpr int SPC = 13, NSTEP = 1 + SPC * NCHUNK + 1;
struct Args { const float* in[21]; float* out; unsigned char* ws; int ph_lo, ph_hi; };

__global__ void __launch_bounds__(512, 2) fwd_kernel(Args args) {
    extern __shared__ __attribute__((aligned(16))) unsigned char lds_raw[];
    LAS unsigned char* lds = (LAS unsigned char*)lds_raw;
    const int wave0 = __builtin_amdgcn_readfirstlane(threadIdx.x >> 6);
#if MEGA
    volatile LAS unsigned* bst = (volatile LAS unsigned*)(lds + LDS_BYTES - 16);
    if (threadIdx.x < 2) bst[threadIdx.x] = 0u;
    __syncthreads();
    XcdBarrier xbar = xcd_barrier_post((unsigned*)args.ws + 4096, bst, (int)threadIdx.x);
#endif
    for (int ph = args.ph_lo; ph < args.ph_hi; ++ph) {
    unsigned zl = 0u; asm volatile("" : "+s"(zl)); int wave_l = wave0; asm volatile("" : "+s"(wave_l));
    int tid_l = wave_l * 64 + (int)__builtin_amdgcn_mbcnt_hi(~0u, __builtin_amdgcn_mbcnt_lo(~0u, zl)); asm volatile("" : "+v"(tid_l));
    unsigned char* ws = args.ws; asm volatile("" : "+s"(ws));
    const int tid = tid_l, lane = tid & 63; const int wave = wave_l;
    const int G = gridDim.x, bx = blockIdx.x; const int vcu = (G % 8 == 0) ? (bx % 8) * (G / 8) + bx / 8 : bx;
    const int gw = vcu * 8 + wave, NGW = G * 8;
    bf16_t* Win_t = (bf16_t*)(ws + WS_WIN); bf16_t* Wuq_t = (bf16_t*)(ws + WS_WUQ); bf16_t* Wukv_t = (bf16_t*)(ws + WS_WUKV); bf16_t* Pa_t = (bf16_t*)(ws + WS_PA);
    bf16_t* Pb_t = (bf16_t*)(ws + WS_PB); bf16_t* Wout_t = (bf16_t*)(ws + WS_WOUT); bf16_t* Wup_t = (bf16_t*)(ws + WS_WUP); bf16_t* Wdown_t = (bf16_t*)(ws + WS_WDOWN);
    float* MOD = (float*)(ws + WS_MOD); float* ROPE = (float*)(ws + WS_ROPE); float* RSTD = (float*)(ws + WS_RSTD);
    bf16_t* Hb = (bf16_t*)(ws + WS_H); bf16_t* Zb = (bf16_t*)(ws + WS_Z); bf16_t* Qb = (bf16_t*)(ws + WS_Q); bf16_t* KFb = (bf16_t*)(ws + WS_KF); bf16_t* Vb = (bf16_t*)(ws + WS_V);
    bf16_t* OAb = (bf16_t*)(ws + WS_OA); bf16_t* OBb = (bf16_t*)(ws + WS_OB); float* OGb = (float*)(ws + WS_OG); float* LSEb = (float*)(ws + WS_LSE);
    bf16_t* Tb = (bf16_t*)(ws + WS_T); bf16_t* MGb = (bf16_t*)(ws + WS_MERGED); float* EDGEb = (float*)(ws + WS_EDGE); bf16_t* X1b = (bf16_t*)(ws + WS_OA); bf16_t* UPb = (bf16_t*)(ws + WS_UP); bf16_t* ACTb = (bf16_t*)(ws + WS_ACT);
    bool sync_after = true;
        if (ph == 0) {
            if (bx < 96) {
                LAS float* sl = (LAS float*)lds;
                LAS float* part = (LAS float*)(lds + 49152);
                for (int idx = tid; idx < 12 * 1024; idx += 512) { const int b = idx >> 10, d = idx & 1023; const float c = b < 8 ? args.in[2][b * 1024 + d] : args.in[3][(b - 8) * 1024 + d];
                    sl[d * 12 + b] = c / (1.0f + __expf(-c)); }
                __syncthreads();
                const int e = bx * 64 + lane; float acc[12];
#pragma unroll
                for (int b = 0; b < 12; ++b) acc[b] = 0.f;
                const float* wp = args.in[4] + (size_t)(wave * 128) * 6144 + e;
#pragma unroll 8
                for (int d = 0; d < 128; ++d) { const float w = wp[(size_t)d * 6144]; const LAS f32x4* s4 = (const LAS f32x4*)(sl + (wave * 128 + d) * 12);
                    const f32x4 a = s4[0], b4 = s4[1], c4 = s4[2];
                    acc[0] += a.x * w; acc[1] += a.y * w; acc[2] += a.z * w; acc[3] += a.w * w; acc[4] += b4.x * w; acc[5] += b4.y * w; acc[6] += b4.z * w; acc[7] += b4.w * w;
                    acc[8] += c4.x * w; acc[9] += c4.y * w; acc[10] += c4.z * w; acc[11] += c4.w * w; }
#pragma unroll
                for (int b = 0; b < 12; ++b) part[(wave * 12 + b) * 64 + lane] = acc[b];
                __syncthreads();
                if (wave == 0) {
#pragma unroll
                    for (int b = 0; b < 12; ++b) { float s = args.in[5][e];
#pragma unroll
                        for (int w = 0; w < 8; ++w) s += part[(w * 12 + b) * 64 + lane];
                        MOD[b * 6144 + e] = s; } }
                __syncthreads();
            }
            for (int idx = bx * 512 + tid; idx < 8192 * 16; idx += G * 512) { const int pos = idx >> 4, i = idx & 15; const float ang = (float)pos * ROPE_INV[i];
                const double tt = (double)ang * 0.15915494309189535; const float fr_ = (float)(tt - floor(tt));
                ROPE[idx] = __builtin_amdgcn_cosf(fr_); ROPE[131072 + idx] = __builtin_amdgcn_sinf(fr_); }
            {
                LAS float* scr = (LAS float*)(lds + wave * 16384);
                constexpr int I_IN = 16 * 157, I_UQ = 6 * 48, I_UKV = 4 * 64, I_PA = 16 * 32, I_PB = 4 * 32, I_OUT = 16 * 32, I_UP = 16 * 176, I_DOWN = 44 * 32;
                constexpr int NITEMS = I_IN + I_UQ + I_UKV + I_PA + I_PB + I_OUT + I_UP + I_DOWN;
                for (int it = gw; it < NITEMS; it += NGW) {
                    int r = it; const float* W; int K, N, kind = 0; bf16_t* WT; const float* ks = nullptr;
                    if (r < I_IN) { W = args.in[7]; K = 1024; N = 5024; WT = Win_t; kind = 1; }
                    else if ((r -= I_IN) < I_UQ) { W = args.in[10]; K = 384; N = 1536; WT = Wuq_t; kind = 2; ks = args.in[8]; }
                    else if ((r -= I_UQ) < I_UKV) { W = args.in[11]; K = 256; N = 2048; WT = Wukv_t; kind = 3; ks = args.in[9]; }
                    else if ((r -= I_UKV) < I_PA) { W = args.in[12]; K = 1024; N = 1024; WT = Pa_t; }
                    else if ((r -= I_PA) < I_PB) { W = args.in[13]; K = 256; N = 1024; WT = Pb_t; }
                    else if ((r -= I_PB) < I_OUT) { W = args.in[14]; K = 1024; N = 1024; WT = Wout_t; }
                    else if ((r -= I_OUT) < I_UP) { W = args.in[16]; K = 1024; N = 5632; WT = Wup_t; kind = 4; }
                    else { r -= I_UP; W = args.in[19]; K = 2816; N = 1024; WT = Wdown_t; }
                    transpose_item(W, K, N, WT, kind, ks, scr, r, lane);
                }
                for (int idx = bx * 512 + tid; idx < 96 * 128; idx += G * 512) *(GAS u32x4*)(Win_t + (size_t)672 * 1024 + (size_t)idx * 8) = (u32x4){0u, 0u, 0u, 0u};
            }
            __syncthreads();
        } else if (ph == NSTEP - 1) {
            float* o = args.out + (size_t)(NCHUNK - 1) * CH * D;
            for (int m = gw; m < CH; m += 2 * NGW) { const int m2 = m + NGW; const bool ok2 = m2 < CH;
                    f32x4 va[4], vb[4]; ld_b16(X1b + (size_t)m * D, lane, va); ld_b16(X1b + (size_t)(ok2 ? m2 : m) * D, lane, vb);
                    const float ra = RSTD_OF(ssq4(va)), rb = RSTD_OF(ssq4(vb));
                    st_fin_f32(o + (size_t)m * D, lane, va, ra, args.in[20]); if (ok2) st_fin_f32(o + (size_t)m2 * D, lane, vb, rb, args.in[20]); }
        } else {
            const int c = (ph - 1) / SPC, k = (ph - 1) - SPC * c;
            ChunkP P;
            if (c == 0) { P.x = args.in[0]; P.S = 2048; P.Sshift = 11; P.nseq = 8; P.seqbase = 0; }
            else { P.x = args.in[1] + (size_t)(c - 1) * CH * D; P.S = 8192; P.Sshift = 13; P.nseq = 2; P.seqbase = 8 + 2 * (c - 1); }
            P.out = args.out + (size_t)c * CH * D;
            sync_after = !(k == 3 || k == 6);
            pg8::Gemm g{}; pg8::EpiAny E{}; bool is_gemm = true;
            E.ws = ws; E.S = P.S; E.Sshift = P.Sshift; E.seqbase = P.seqbase;
            if (k == 1) { g = pg8::Gemm{Hb, Win_t, CH, ZLD, 1024, 1024}; E.kind = 0; }
            else if (k == 3) { g = pg8::Gemm{Zb, Wuq_t, CH, 1536, 384, ZLD}; E.kind = 1; }
            else if (k == 4) { g = pg8::Gemm{Zb + 384, Wukv_t, CH, 2048, 256, ZLD}; E.kind = 2; }
            else if (k == 6) { g = pg8::Gemm{OAb, Pa_t, CH, 1024, 1024, 1024}; E.kind = 3; }
            else if (k == 7) { g = pg8::Gemm{OBb, Pb_t, CH, 1024, 256, 256}; E.kind = 4; }
            else if (k == 8) { g = pg8::Gemm{MGb, Wout_t, CH, 1024, 1024, 1024}; E.kind = 5; E.base = P.x; E.goff = 2048; E.rmode = 0; }
            else if (k == 10) { g = pg8::Gemm{Hb, Wup_t, CH, NUP, 1024, 1024}; E.kind = 6; E.cw = args.in[17]; E.cbias = args.in[18]; E.xl = lds + 131072; }
            else if (k == 12) { g = pg8::Gemm{ACTb, Wdown_t, CH, 1024, DFF, DFF}; E.kind = 5; E.base = nullptr; E.goff = 5120; E.rmode = 1; }
            else is_gemm = false;
            if (is_gemm) { pg8::StaticOrder S; S.init(g.M, g.N, G, bx); pg8::gemm_phase(lds, g, S, E, tid); }
            else if (k == 0) {
                if (c > 0) { float* o = args.out + (size_t)(c - 1) * CH * D; for (int m = gw; m < CH; m += 2 * NGW) { const int m2 = m + NGW; const bool ok2 = m2 < CH;
                    f32x4 va[4], vb[4]; ld_b16(X1b + (size_t)m * D, lane, va); ld_b16(X1b + (size_t)(ok2 ? m2 : m) * D, lane, vb);
                    const float ra = RSTD_OF(ssq4(va)), rb = RSTD_OF(ssq4(vb));
                    st_fin_f32(o + (size_t)m * D, lane, va, ra, args.in[20]); if (ok2) st_fin_f32(o + (size_t)m2 * D, lane, vb, rb, args.in[20]); } }
                for (int m = gw; m < CH; m += 2 * NGW) { const int m2 = m + NGW; const bool ok2 = m2 < CH;
                    f32x4 va[4], vb[4]; ld_f32(P.x + (size_t)m * D, lane, va); if (ok2) ld_f32(P.x + (size_t)m2 * D, lane, vb); else ld_f32(P.x + (size_t)m * D, lane, vb);
                    const float ra = RSTD_OF(ssq4(va)), rb = RSTD_OF(ssq4(vb));
                    const float* md = MOD + (size_t)(P.seqbase + (m >> P.Sshift)) * 6144; st_mod_b16(Hb + (size_t)m * D, lane, va, ra, args.in[6], md + 1024, md);
                    if (ok2) { const float* md2 = MOD + (size_t)(P.seqbase + (m2 >> P.Sshift)) * 6144; st_mod_b16(Hb + (size_t)m2 * D, lane, vb, rb, args.in[6], md2 + 1024, md2); } }
            } else if (k == 2) {
                for (int m = gw; m < CH; m += NGW) {
                    const GAS unsigned* zr = (const GAS unsigned*)(Zb + (size_t)m * ZLD);
                    float sq = 0.f, skv = 0.f;
#pragma unroll
                    for (int j = 0; j < 3; ++j) { const unsigned w = zr[lane + 64 * j]; const float a = bflo(w), b = bfhi(w); sq += a * a + b * b; }
#pragma unroll
                    for (int j = 0; j < 2; ++j) { const unsigned w = zr[192 + lane + 64 * j]; const float a = bflo(w), b = bfhi(w); skv += a * a + b * b; }
                    sq = wave_sum(sq); skv = wave_sum(skv);
                    if (lane == 0) { RSTD[2 * m] = 1.0f / sqrtf(sq * (1.f / 384.f) + EPS); RSTD[2 * m + 1] = 1.0f / sqrtf(skv * (1.f / 256.f) + EPS); }
                    const int seq = m >> P.Sshift, pos = m & (P.S - 1);
                    unsigned pr = 0u;
                    { const int i = lane & 15; const unsigned w = zr[320 + i]; const float a = bflo(w), b = bfhi(w); const float cs = ROPE[pos * 16 + i], sn = ROPE[131072 + pos * 16 + i];
                      pr = cvt_pk_bf16(a * cs - b * sn, a * sn + b * cs); }
                    u32x4 o; const int b4 = 4 * (lane & 3);
                    o.x = __shfl(pr, b4); o.y = __shfl(pr, b4 + 1); o.z = __shfl(pr, b4 + 2); o.w = __shfl(pr, b4 + 3);
                    const int head = lane >> 2;
                    *(GAS u32x4*)(KFb + ((size_t)((seq * 16 + head) << P.Sshift) + pos) * 96 + 64 + 8 * (lane & 3)) = o;
                }
                LAS unsigned char* wl = lds + wave * 4096;
                for (int task = gw; task < CH * 12 / 32; task += NGW) dil_task(Zb, OGb, LSEb, P.S, task, wl, lane);
            } else if (k == 5) {
                for (int it = bx * 512 + tid; it < CH * 32; it += G * 512) { const int row = it >> 5, j = (it >> 3) & 3, d8 = (it & 7) * 8;
                    const float l0 = LSEb[row * 12 + j], l1 = LSEb[row * 12 + 4 + j], l2 = LSEb[row * 12 + 8 + j]; const float mx = fmaxf(l0, fmaxf(l1, l2));
                    float w0 = __expf(l0 - mx), w1 = __expf(l1 - mx), w2 = __expf(l2 - mx); const float inv = 1.0f / (w0 + w1 + w2); w0 *= inv; w1 *= inv; w2 *= inv;
                    const float* p0 = OGb + ((size_t)row * 12 + j) * 64 + d8; const float* p1 = p0 + 4 * 64; const float* p2 = p0 + 8 * 64;
                    const f32x4 a0 = *(const GAS f32x4*)p0 * w0 + *(const GAS f32x4*)p1 * w1 + *(const GAS f32x4*)p2 * w2;
                    const f32x4 a1 = *(const GAS f32x4*)(p0 + 4) * w0 + *(const GAS f32x4*)(p1 + 4) * w1 + *(const GAS f32x4*)(p2 + 4) * w2;
                    *(GAS u32x4*)(OBb + (size_t)row * 256 + j * 64 + d8) = pg8::pack8(a0, a1); }
                const int nqb = P.S >> 9, nunits = P.nseq * 16 * nqb;
                for (int uidx = vcu; uidx < nunits; uidx += G) { const int pair = uidx / nqb, qb = uidx - pair * nqb; const int seq = pair >> 4, head = pair & 15;
                    const size_t hb = (size_t)pair << P.Sshift;
                    mla::attn_unit(Qb + hb * 96, KFb + hb * 96, Vb + hb * 64, OAb + ((size_t)seq << P.Sshift) * D + head * 64, P.S, qb, lds, tid); }
            } else if (k == 9) {
                for (int m = gw; m < CH; m += 2 * NGW) { const int m2 = m + NGW; const bool ok2 = m2 < CH;
                    f32x4 va[4], vb[4]; ld_b16(X1b + (size_t)m * D, lane, va); ld_b16(X1b + (size_t)(ok2 ? m2 : m) * D, lane, vb);
                    const float ra = RSTD_OF(ssq4(va)), rb = RSTD_OF(ssq4(vb));
                    const float* md = MOD + (size_t)(P.seqbase + (m >> P.Sshift)) * 6144; st_mod_b16(Hb + (size_t)m * D, lane, va, ra, args.in[15], md + 4096, md + 3072);
                    if (ok2) { const float* md2 = MOD + (size_t)(P.seqbase + (m2 >> P.Sshift)) * 6144; st_mod_b16(Hb + (size_t)m2 * D, lane, vb, rb, args.in[15], md2 + 4096, md2 + 3072); } }
            } else if (k == 11) {
                for (int it = bx * 512 + tid; it < 128 * 352; it += G * 512) {
                    const int r = it / 352, f0 = (it - r * 352) * 8; const int which = r & 1, pm = r >> 1; const int pos0 = (pm * 256) & (P.S - 1);
                    const bool has_nb = which == 0 ? (pos0 > 0) : (pos0 + 256 < P.S);
                    const float* nb = EDGEb + (size_t)(which == 0 ? (pm - 1) * 2 + 1 : (pm + 1) * 2) * DFF + f0;
                    const float* wv = args.in[17] + (which == 0 ? 0 : 2 * DFF) + f0;
                    const float* pp = EDGEb + (size_t)128 * DFF + (size_t)r * DFF + f0; const float* pg = EDGEb + (size_t)256 * DFF + (size_t)r * DFF + f0;
                    float o[8];
#pragma unroll
                    for (int h = 0; h < 2; ++h) { const f32x4 p4 = *(const GAS f32x4*)(pp + 4 * h), g4 = *(const GAS f32x4*)(pg + 4 * h), w4 = *(const GAS f32x4*)(wv + 4 * h);
                        f32x4 n4 = (f32x4){0.f, 0.f, 0.f, 0.f}; if (has_nb) n4 = *(const GAS f32x4*)(nb + 4 * h);
#pragma unroll
                        for (int e = 0; e < 4; ++e) o[4 * h + e] = pg8::gelu_tanh_(p4[e] + w4[e] * n4[e]) * g4[e]; }
                    u32x4 w; w.x = cvt_pk_bf16(o[0], o[1]); w.y = cvt_pk_bf16(o[2], o[3]); w.z = cvt_pk_bf16(o[4], o[5]); w.w = cvt_pk_bf16(o[6], o[7]);
                    *(GAS u32x4*)(ACTb + (size_t)(pm * 256 + (which ? 255 : 0)) * DFF + f0) = w;
                }
            }
        }
#if MEGA
        if (sync_after && ph + 1 < args.ph_hi) { if (ph == 0) cg::this_grid().sync(); else { int tb = tid; asm volatile("" : "+v"(tb)); xcd_barrier(xbar, tb); } }
#else
        (void)sync_after;
#endif
    }
}

extern "C" void kernel_launch(void* const* d_in, const int* in_sizes, int n_in, void* d_out, int out_size, void* d_ws, size_t ws_size, hipStream_t stream) {
    static int grid = 0;
    if (grid == 0) {
        if (n_in != 21 || ws_size < WS_END) { fprintf(stderr, "kernel_launch: unexpected n_in %d / ws_size %zu\n", n_in, ws_size); grid = -1; return; }
        int dev = 0, cus = 0, per_cu = 0;
        (void)hipGetDevice(&dev); (void)hipDeviceGetAttribute(&cus, hipDeviceAttributeMultiprocessorCount, dev);
        (void)hipFuncSetAttribute((const void*)fwd_kernel, hipFuncAttributeMaxDynamicSharedMemorySize, LDS_BYTES);
        (void)hipOccupancyMaxActiveBlocksPerMultiprocessor(&per_cu, (const void*)fwd_kernel, 512, LDS_BYTES);
        (void)hipGetLastError();
        if (per_cu < 1) fprintf(stderr, "kernel_launch: occupancy query says %d blocks/CU\n", per_cu);
        grid = cus;
    }
    if (grid < 0) return;
    Args a{};
    for (int i = 0; i < 21; ++i) a.in[i] = (const float*)d_in[i];
    a.out = (float*)d_out; a.ws = (unsigned char*)d_ws;
#if MEGA
    (void)hipMemsetAsync(d_ws, 0, 65536, stream);
    a.ph_lo = 0; a.ph_hi = NSTEP;
    void* kargs[] = {&a};
    hipError_t e = hipLaunchCooperativeKernel((const void*)fwd_kernel, dim3(grid), dim3(512), kargs, LDS_BYTES, stream);
    if (e != hipSuccess) fprintf(stderr, "cooperative launch failed: %s (grid %d)\n", hipGetErrorString(e), grid);
#else
    for (int ph = 0; ph < NSTEP; ++ph) { a.ph_lo = ph; a.ph_hi = ph + 1; hipLaunchKernelGGL(fwd_kernel, dim3(grid), dim3(512), LDS_BYTES, stream, a);
#ifdef PROBE_DUP
        if (ph > 0 && ph < NSTEP - 1 && ((PROBE_DUP >> ((ph - 1) % SPC)) & 1)) hipLaunchKernelGGL(fwd_kernel, dim3(grid), dim3(512), LDS_BYTES, stream, a);
#endif
    }
#endif
}
```

```cpp
#include <hip/hip_runtime.h>
#include <hip/hip_cooperative_groups.h>
#include <cstdio>
#include <cstdint>
namespace cg = cooperative_groups;

#ifndef MEGA
#define MEGA 1
#endif

#define LAS __attribute__((address_space(3)))
#define GAS __attribute__((address_space(1)))
#define GLD(T, p) (*(const GAS T*)(p))
#define GST(T, p, v) (*(GAS T*)(p) = (v))
typedef unsigned short bf16_t;
typedef short bf16x8 __attribute__((ext_vector_type(8)));
typedef short s16x4 __attribute__((ext_vector_type(4)));
typedef float f32x2 __attribute__((ext_vector_type(2)));
typedef float f32x4 __attribute__((ext_vector_type(4)));
typedef float f32x16 __attribute__((ext_vector_type(16)));
typedef unsigned u32x2 __attribute__((ext_vector_type(2)));
typedef unsigned u32x4 __attribute__((ext_vector_type(4)));

constexpr int D = 1024, CH = 16384, NCHUNK = 3, ZLD = 5120, NUP = 5632, DFF = 2816;

constexpr float EPS = 1e-6f, LOG2E = 1.4426950408889634f, LN2 = 0.6931471805599453f;
constexpr float QSCALE = 0.10206207261596577f * LOG2E;
constexpr float DSCALE = 0.125f * LOG2E;

constexpr size_t MiB = 1u << 20;
constexpr size_t WS_WIN = 2 * MiB, WS_WUQ = 12 * MiB, WS_WUKV = 14 * MiB, WS_PA = 15 * MiB, WS_PB = 17 * MiB, WS_WOUT = 18 * MiB,
                 WS_WUP = 20 * MiB, WS_WDOWN = 31 * MiB;
constexpr size_t WS_MOD = 37 * MiB, WS_ROPE = 38 * MiB  , WS_RSTD = 39 * MiB + 512 * 1024;
constexpr size_t WS_H = 40 * MiB, WS_Z = 72 * MiB, WS_Q = 232 * MiB, WS_KF = 280 * MiB, WS_V = 328 * MiB, WS_OA = 360 * MiB, WS_OB = 392 * MiB,
                 WS_OG = 400 * MiB, WS_LSE = 448 * MiB, WS_T = 232 * MiB, WS_MERGED = 296 * MiB, WS_UP = 72 * MiB, WS_ACT = 248 * MiB, WS_EDGE = 449 * MiB  , WS_END = 454 * MiB;

constexpr int LDS_BYTES = 147456;

__device__ __forceinline__ unsigned cvt_pk_bf16(float lo, float hi) { unsigned r; asm volatile("v_cvt_pk_bf16_f32 %0, %1, %2" : "=v"(r) : "v"(lo), "v"(hi)); return r; }
__device__ __forceinline__ float bf2f(unsigned short b) { return __uint_as_float((unsigned)b << 16); }
__device__ __forceinline__ float bflo(unsigned w) { return __uint_as_float(w << 16); }
__device__ __forceinline__ float bfhi(unsigned w) { return __uint_as_float(w & 0xffff0000u); }
__device__ __forceinline__ float swap_add(float m);
#define DPP_ROR(v, n) __int_as_float(__builtin_amdgcn_update_dpp(0, __float_as_int(v), 0x120 + (n), 0xf, 0xf, false))
__device__ __forceinline__ float wave_sum(float v) {
    v += DPP_ROR(v, 1); v += DPP_ROR(v, 2); v += DPP_ROR(v, 4); v += DPP_ROR(v, 8);
    v += __shfl_xor(v, 16);
    return swap_add(v);
}
__device__ __forceinline__ float swap_max(float m) { auto rr = __builtin_amdgcn_permlane32_swap(__float_as_uint(m), __float_as_uint(m), false, false); return fmaxf(__uint_as_float(rr[0]), __uint_as_float(rr[1])); }
__device__ __forceinline__ float swap_add(float m) { auto rr = __builtin_amdgcn_permlane32_swap(__float_as_uint(m), __float_as_uint(m), false, false); return __uint_as_float(rr[0]) + __uint_as_float(rr[1]); }
__device__ __forceinline__ s16x4 vtr(LAS const unsigned char* p) { return __builtin_bit_cast(s16x4, __builtin_amdgcn_ds_read_tr16_b64_v4i16((LAS s16x4*)p)); }
__device__ __forceinline__ float sigmoidf_(float x) { return __builtin_amdgcn_rcpf(1.0f + __builtin_amdgcn_exp2f(-x * LOG2E)); }

struct ChunkP { const float* x; float* out; int S, Sshift, nseq, seqbase; };

namespace pg8 {
constexpr int BM = 256, BK = 64, HALF = 128, HTB = HALF * BK * 2, STAGE_BYTES = 8 * HTB, NXCD = 8, WGM = 8;
__host__ __device__ __forceinline__ int lds_byte(int r, int c) { const int st = (r >> 4) * 2 + (c >> 5), rr = r & 15, cc = c & 31, ob = rr * 64 + cc * 2; return st * 1024 + (ob ^ (((ob >> 9) & 1) << 5)); }
__host__ __device__ __forceinline__ void stage_rc(int b, int& R, int& C) { const int st = b / 1024, sb = b % 1024, swz = sb ^ (((sb >> 9) & 1) << 5); R = (st >> 1) * 16 + swz / 64; C = (st & 1) * 32 + (swz % 64) / 2; }
__host__ __device__ __forceinline__ int perm32(int rho) { const int n = rho >> 4, i = rho & 15; return 8 * (i >> 2) + 4 * n + (i & 3); }
struct Unit { int pm, pn; };
struct Gemm { const bf16_t* A; const bf16_t* Bt; int M, N, K, lda; };
struct StaticOrder {
    int nM, nN, nwg, G, c;
    __device__ void init(int M, int N, int G_, int c_) { nM = M / BM; nN = N / BM; nwg = nM * nN; G = G_; c = c_; }
    __device__ bool next(int i, Unit& u) const {
        const long L = (long)i * G + c; if (L >= nwg) return false;
        int wgid = (int)L; { const int q = nwg / NXCD, r = nwg % NXCD, xcd = wgid % NXCD, off = wgid / NXCD; wgid = (xcd < r ? xcd * (q + 1) : r * (q + 1) + (xcd - r) * q) + off; }
        const int nig = WGM * nN, gid = wgid / nig, fm = gid * WGM, gsz = (nM - fm) < WGM ? (nM - fm) : WGM;
        u.pm = fm + ((wgid % nig) % gsz); u.pn = (wgid % nig) / gsz; return true;
    }
};

template <class Epi, class Sched>
__device__ __forceinline__ void gemm_phase(LAS unsigned char* lds, const Gemm g, const Sched& S, const Epi& E, int tid_in) {
    int tid_ = tid_in; asm volatile("" : "+v"(tid_));
    const int tid = tid_, wid = __builtin_amdgcn_readfirstlane(tid >> 6), lane = tid & 63, wr = wid >> 2, wc = wid & 3, fr = lane & 15, fq = lane >> 4;
    const int K = g.K, nt = K / BK, lda = g.lda;
    unsigned voffA[2], voffB[2];
#pragma unroll
    for (int i = 0; i < 2; ++i) { int R, C; stage_rc(tid * 16 + i * 8192, R, C); const int Rb = (R & ~31) + perm32(R & 31);
        voffA[i] = (unsigned)(R * lda + C) * 2u; voffB[i] = (unsigned)(Rb * K + C) * 2u; }
    const size_t kstep = (size_t)(BK * 2);
    const size_t hstepA = (size_t)HALF * lda * 2, hstepB = (size_t)HALF * K * 2;
    const size_t tstepA = 2 * hstepA, tstepB = 2 * hstepB;
    const unsigned ldsw = (unsigned)wid * 1024u;
    const int aoff = lds_byte(wr * 64 + fr, fq * 8), boff = lds_byte(wc * 32 + fr, fq * 8);
#define PG8_SA(b, h) (((b) * 2 + (h)) * HTB)
#define PG8_SB(b, h) ((4 + (b) * 2 + (h)) * HTB)
#define PG8_STAGE(bufoff, gbase, voff) do { _Pragma("unroll") for (int _i = 0; _i < 2; ++_i) \
        __builtin_amdgcn_global_load_lds((const unsigned*)((const char*)(gbase) + (voff)[_i]), (LAS unsigned*)(lds + (bufoff) + ldsw + _i * 8192), 16, 0, 0); } while (0)
#define PG8_LDA(dst, b, h) do { _Pragma("unroll") for (int m = 0; m < 4; ++m) _Pragma("unroll") for (int k = 0; k < 2; ++k) dst[m][k] = *(const LAS bf16x8*)(lds + PG8_SA(b, h) + aoff + m * 2048 + k * 1024); } while (0)
#define PG8_LDB(dst, b, h) do { _Pragma("unroll") for (int n = 0; n < 2; ++n) _Pragma("unroll") for (int k = 0; k < 2; ++k) dst[n][k] = *(const LAS bf16x8*)(lds + PG8_SB(b, h) + boff + n * 2048 + k * 1024); } while (0)
#define PG8_MMA(ai, bj, At, Bt) do { __builtin_amdgcn_s_setprio(1); _Pragma("unroll") for (int m = 0; m < 4; ++m) _Pragma("unroll") for (int n = 0; n < 2; ++n) _Pragma("unroll") for (int k = 0; k < 2; ++k) \
        acc[ai][bj][m][n] = __builtin_amdgcn_mfma_f32_16x16x32_bf16(Bt[n][k], At[m][k], acc[ai][bj][m][n], 0, 0, 0); __builtin_amdgcn_s_setprio(0); } while (0)
#define PG8_WAIT_V(n) asm volatile("s_waitcnt vmcnt(" #n ")" ::: "memory")
#define PG8_WAIT_L(n) asm volatile("s_waitcnt lgkmcnt(" #n ")" ::: "memory")
#define PG8_BAR __builtin_amdgcn_s_barrier()
#define PG8_SCHED __builtin_amdgcn_sched_barrier(0)
    Unit cur, nxt; int ui = 0;
    if (!S.next(0, cur)) return;
    f32x4 acc[2][2][4][2];
#pragma unroll
    for (int a = 0; a < 2; ++a)
#pragma unroll
        for (int b = 0; b < 2; ++b)
#pragma unroll
            for (int m = 0; m < 4; ++m)
#pragma unroll
                for (int n = 0; n < 2; ++n) acc[a][b][m][n] = (f32x4){0.f, 0.f, 0.f, 0.f};
    bf16x8 At[4][2], B0[2][2], B1[2][2];
    const char* cA = (const char*)g.A + (size_t)cur.pm * tstepA; const char* cB = (const char*)g.Bt + (size_t)cur.pn * tstepB;
    PG8_STAGE(PG8_SB(0, 0), cB, voffB); PG8_STAGE(PG8_SB(0, 1), cB + hstepB, voffB); PG8_STAGE(PG8_SA(0, 0), cA, voffA); PG8_STAGE(PG8_SA(0, 1), cA + hstepA, voffA);
    if (wr == 1) PG8_BAR;
    PG8_WAIT_V(2); PG8_BAR;
    PG8_STAGE(PG8_SB(1, 0), cB + kstep, voffB); PG8_STAGE(PG8_SA(1, 0), cA + kstep, voffA); PG8_STAGE(PG8_SB(1, 1), cB + hstepB + kstep, voffB);
    PG8_WAIT_V(6); PG8_BAR;
    for (;;) {
        const bool has_next = S.next(ui + 1, nxt);
        const char* nA = has_next ? (const char*)g.A + (size_t)nxt.pm * tstepA : cA; const char* nB = has_next ? (const char*)g.Bt + (size_t)nxt.pn * tstepB : cB;
        for (int t = 0; t < nt; t += 2) {
            const bool last = (t == nt - 2);
            const char* a1 = cA + (size_t)(t + 1) * kstep;
            const char* a2 = last ? nA : cA + (size_t)(t + 2) * kstep; const char* b2 = last ? nB : cB + (size_t)(t + 2) * kstep;
            const char* a3 = a2 + kstep; const char* b3 = b2 + kstep;
            PG8_LDB(B0, 0, 0); PG8_LDB(B1, 0, 1); PG8_SCHED; PG8_LDA(At, 0, 0); PG8_STAGE(PG8_SA(1, 1), a1 + hstepA, voffA);
            PG8_WAIT_V(8); PG8_WAIT_L(0); PG8_BAR; PG8_MMA(0, 0, At, B0); PG8_MMA(0, 1, At, B1); PG8_BAR; PG8_SCHED;
            PG8_LDA(At, 0, 1); PG8_STAGE(PG8_SB(0, 0), b2, voffB); PG8_STAGE(PG8_SB(0, 1), b2 + hstepB, voffB); PG8_STAGE(PG8_SA(0, 0), a2, voffA);
            PG8_WAIT_V(8); PG8_WAIT_L(0); PG8_BAR; PG8_MMA(1, 0, At, B0); PG8_MMA(1, 1, At, B1); PG8_BAR; PG8_SCHED;
            PG8_LDB(B0, 1, 0); PG8_LDB(B1, 1, 1); PG8_SCHED; PG8_LDA(At, 1, 0); PG8_STAGE(PG8_SA(0, 1), a2 + hstepA, voffA);
            PG8_WAIT_V(8); PG8_WAIT_L(0); PG8_BAR; PG8_MMA(0, 0, At, B0); PG8_MMA(0, 1, At, B1); PG8_BAR; PG8_SCHED;
            PG8_LDA(At, 1, 1); PG8_STAGE(PG8_SB(1, 0), b3, voffB); PG8_STAGE(PG8_SB(1, 1), b3 + hstepB, voffB); PG8_STAGE(PG8_SA(1, 0), a3, voffA);
            PG8_WAIT_V(8); PG8_WAIT_L(0); PG8_BAR; PG8_MMA(1, 0, At, B0); PG8_MMA(1, 1, At, B1); PG8_BAR; PG8_SCHED;
        }
        if (wr == 0) PG8_BAR;
        E(acc, cur, wr, wc, fr, fq);
        if (!has_next) break;
#pragma unroll
        for (int a = 0; a < 2; ++a)
#pragma unroll
            for (int b = 0; b < 2; ++b)
#pragma unroll
                for (int m = 0; m < 4; ++m)
#pragma unroll
                    for (int n = 0; n < 2; ++n) acc[a][b][m][n] = (f32x4){0.f, 0.f, 0.f, 0.f};
        cur = nxt; cA = nA; cB = nB; ++ui;
        if (wr == 1) PG8_BAR;
    }
    PG8_WAIT_V(0);
    PG8_BAR;
#undef PG8_SA
#undef PG8_SB
#undef PG8_STAGE
#undef PG8_LDA
#undef PG8_LDB
#undef PG8_MMA
#undef PG8_WAIT_V
#undef PG8_WAIT_L
#undef PG8_BAR
#undef PG8_SCHED
}

#define EPI_ARGS const f32x4 (&acc)[2][2][4][2], const Unit& u, int wr, int wc, int fr, int fq
__device__ __forceinline__ u32x4 pack8(f32x4 v0, f32x4 v1) { u32x4 w; w.x = cvt_pk_bf16(v0[0], v0[1]); w.y = cvt_pk_bf16(v0[2], v0[3]); w.z = cvt_pk_bf16(v1[0], v1[1]); w.w = cvt_pk_bf16(v1[2], v1[3]); return w; }

struct EpiStore {
    bf16_t* O; int ldc; int sig_pn;
    __device__ __forceinline__ void operator()(EPI_ARGS) const {
        const int row0 = u.pm * BM + wr * 64 + fr, col0 = u.pn * BM + wc * 32 + 8 * fq; const bool sig = u.pn >= sig_pn;
#pragma unroll
        for (int ai = 0; ai < 2; ++ai)
#pragma unroll
            for (int m = 0; m < 4; ++m) { bf16_t* rowp = O + (size_t)(row0 + ai * HALF + m * 16) * ldc + col0;
#pragma unroll
                for (int bj = 0; bj < 2; ++bj) { f32x4 v0 = acc[ai][bj][m][0], v1 = acc[ai][bj][m][1];
                    if (sig) {
#pragma unroll
                        for (int e = 0; e < 4; ++e) { v0[e] = sigmoidf_(v0[e]); v1[e] = sigmoidf_(v1[e]); } }
                    *(GAS u32x4*)(rowp + bj * HALF) = pack8(v0, v1); } }
    }
};
struct EpiQ {
    bf16_t* Q; const float* rstd; const float* rope; int S, Sshift;
    __device__ __forceinline__ void operator()(EPI_ARGS) const {
        const int row0 = u.pm * BM + wr * 64 + fr;
#pragma unroll
        for (int ai = 0; ai < 2; ++ai)
#pragma unroll
            for (int m = 0; m < 4; ++m) { const int row = row0 + ai * HALF + m * 16; const int seq = row >> Sshift, pos = row & (S - 1);
                const float sc = rstd[2 * row] * QSCALE;
#pragma unroll
                for (int bj = 0; bj < 2; ++bj) { const int g32 = 8 * u.pn + 4 * bj + wc; const int head = g32 / 3, gl = g32 - 3 * head;
                    f32x4 v0 = acc[ai][bj][m][0] * sc, v1 = acc[ai][bj][m][1] * sc;
                    if (gl == 2) { const f32x4 cs = *(const GAS f32x4*)(rope + (size_t)pos * 16 + 4 * fq), sn = *(const GAS f32x4*)(rope + 131072 + (size_t)pos * 16 + 4 * fq);
                        f32x4 w0, w1;
                        w0[0] = v0[0] * cs[0] - v0[1] * sn[0]; w0[1] = v0[0] * sn[0] + v0[1] * cs[0];
                        w0[2] = v0[2] * cs[1] - v0[3] * sn[1]; w0[3] = v0[2] * sn[1] + v0[3] * cs[1];
                        w1[0] = v1[0] * cs[2] - v1[1] * sn[2]; w1[1] = v1[0] * sn[2] + v1[1] * cs[2];
                        w1[2] = v1[2] * cs[3] - v1[3] * sn[3]; w1[3] = v1[2] * sn[3] + v1[3] * cs[3];
                        v0 = w0; v1 = w1; }
                    *(GAS u32x4*)(Q + ((size_t)((seq * 16 + head) << Sshift) + pos) * 96 + gl * 32 + 8 * fq) = pack8(v0, v1); }
                asm volatile("" ::: "memory"); }
    }
};
struct EpiKV {
    bf16_t* KF; bf16_t* V; const float* rstd; int S, Sshift;
    __device__ __forceinline__ void operator()(EPI_ARGS) const {
        const int row0 = u.pm * BM + wr * 64 + fr; const bool isv = u.pn >= 4;
#pragma unroll
        for (int ai = 0; ai < 2; ++ai)
#pragma unroll
            for (int m = 0; m < 4; ++m) { const int row = row0 + ai * HALF + m * 16; const int seq = row >> Sshift, pos = row & (S - 1);
                const float sc = rstd[2 * row + 1];
#pragma unroll
                for (int bj = 0; bj < 2; ++bj) { const int col = (u.pn & 3) * BM + bj * HALF + wc * 32 + 8 * fq; const int head = col >> 6, d = col & 63;
                    const f32x4 v0 = acc[ai][bj][m][0] * sc, v1 = acc[ai][bj][m][1] * sc; const size_t tok = (size_t)((seq * 16 + head) << Sshift) + pos;
                    bf16_t* p = isv ? V + tok * 64 + d : KF + tok * 96 + d;
                    *(GAS u32x4*)p = pack8(v0, v1); }
                asm volatile("" ::: "memory"); }
    }
};
struct EpiGateA {
    bf16_t* T; const bf16_t* Z;
    __device__ __forceinline__ void operator()(EPI_ARGS) const {
        const int row0 = u.pm * BM + wr * 64 + fr, col0 = u.pn * BM + wc * 32 + 8 * fq;
#pragma unroll
        for (int ai = 0; ai < 2; ++ai)
#pragma unroll
            for (int m = 0; m < 4; ++m) { const int row = row0 + ai * HALF + m * 16;
#pragma unroll
                for (int bj = 0; bj < 2; ++bj) { const int col = col0 + bj * HALF; const u32x4 gw = *(const GAS u32x4*)(Z + (size_t)row * ZLD + 3072 + col);
                    f32x4 v0 = acc[ai][bj][m][0], v1 = acc[ai][bj][m][1];
                    v0[0] *= bflo(gw.x); v0[1] *= bfhi(gw.x); v0[2] *= bflo(gw.y); v0[3] *= bfhi(gw.y); v1[0] *= bflo(gw.z); v1[1] *= bfhi(gw.z); v1[2] *= bflo(gw.w); v1[3] *= bfhi(gw.w);
                    *(GAS u32x4*)(T + (size_t)row * D + col) = pack8(v0, v1); }
                asm volatile("" ::: "memory"); }
    }
};
struct EpiGateB {
    const bf16_t* T; const bf16_t* Z; bf16_t* O;
    __device__ __forceinline__ void operator()(EPI_ARGS) const {
        const int row0 = u.pm * BM + wr * 64 + fr, col0 = u.pn * BM + wc * 32 + 8 * fq;
#pragma unroll
        for (int ai = 0; ai < 2; ++ai)
#pragma unroll
            for (int m = 0; m < 4; ++m) { const int row = row0 + ai * HALF + m * 16;
#pragma unroll
                for (int bj = 0; bj < 2; ++bj) { const int col = col0 + bj * HALF; const u32x4 gw = *(const GAS u32x4*)(Z + (size_t)row * ZLD + 4096 + col);
                    const u32x4 tw = *(const GAS u32x4*)(T + (size_t)row * D + col); f32x4 v0 = {bflo(tw.x), bfhi(tw.x), bflo(tw.y), bfhi(tw.y)}, v1 = {bflo(tw.z), bfhi(tw.z), bflo(tw.w), bfhi(tw.w)};
                    const f32x4 a0 = acc[ai][bj][m][0], a1 = acc[ai][bj][m][1];
                    v0[0] += a0[0] * bflo(gw.x); v0[1] += a0[1] * bfhi(gw.x); v0[2] += a0[2] * bflo(gw.y); v0[3] += a0[3] * bfhi(gw.y);
                    v1[0] += a1[0] * bflo(gw.z); v1[1] += a1[1] * bfhi(gw.z); v1[2] += a1[2] * bflo(gw.w); v1[3] += a1[3] * bfhi(gw.w);
                    *(GAS u32x4*)(O + (size_t)row * D + col) = pack8(v0, v1); }
                asm volatile("" ::: "memory"); }
    }
};
struct EpiResid {
    const float* base; float* out; const float* mod; int goff, Sshift, seqbase; int mode; bf16_t* x1;
    __device__ __forceinline__ void operator()(EPI_ARGS) const {
        const int row0 = u.pm * BM + wr * 64 + fr, col0 = u.pn * BM + wc * 32 + 8 * fq;
        const float* gt = mod + (size_t)(seqbase + ((u.pm * BM) >> Sshift)) * 6144 + goff + col0;
        f32x4 g[2][2];
#pragma unroll
        for (int bj = 0; bj < 2; ++bj) { g[bj][0] = *(const GAS f32x4*)(gt + bj * HALF); g[bj][1] = *(const GAS f32x4*)(gt + bj * HALF + 4); }
#pragma unroll
        for (int ai = 0; ai < 2; ++ai)
#pragma unroll
            for (int m = 0; m < 4; ++m) { const size_t off = (size_t)(row0 + ai * HALF + m * 16) * D + col0;
#pragma unroll
                for (int bj = 0; bj < 2; ++bj) {
                    if (mode == 0) { const f32x4 b0 = *(const GAS f32x4*)(base + off + bj * HALF), b1 = *(const GAS f32x4*)(base + off + bj * HALF + 4);
                        *(GAS u32x4*)(x1 + off + bj * HALF) = pack8(b0 + g[bj][0] * acc[ai][bj][m][0], b1 + g[bj][1] * acc[ai][bj][m][1]); }
                    else { const u32x4 w = *(const GAS u32x4*)(x1 + off + bj * HALF); const f32x4 b0 = {bflo(w.x), bfhi(w.x), bflo(w.y), bfhi(w.y)}, b1 = {bflo(w.z), bfhi(w.z), bflo(w.w), bfhi(w.w)};
                        *(GAS u32x4*)(x1 + off + bj * HALF) = pack8(b0 + g[bj][0] * acc[ai][bj][m][0], b1 + g[bj][1] * acc[ai][bj][m][1]); } }
                if (m & 1) asm volatile("" ::: "memory"); }
    }
};

__device__ __forceinline__ float dpp_prev(float oldv, float v) { return __int_as_float(__builtin_amdgcn_update_dpp(__float_as_int(oldv), __float_as_int(v), 0x111, 0xf, 0xf, false)); }
__device__ __forceinline__ float dpp_next(float oldv, float v) { return __int_as_float(__builtin_amdgcn_update_dpp(__float_as_int(oldv), __float_as_int(v), 0x101, 0xf, 0xf, false)); }
__device__ __forceinline__ float dpp_ror1(float v)  { return __int_as_float(__builtin_amdgcn_update_dpp(0, __float_as_int(v), 0x121, 0xf, 0xf, false)); }
__device__ __forceinline__ float dpp_ror15(float v) { return __int_as_float(__builtin_amdgcn_update_dpp(0, __float_as_int(v), 0x12F, 0xf, 0xf, false)); }
__device__ __forceinline__ float gelu_tanh_(float x) { const float y = 0.7978845608028654f * (x + 0.044715f * x * x * x); return x * sigmoidf_(2.0f * y); }
struct EpiConv {
    bf16_t* ACT; const float* cw; const float* cbias; float* EDGEU; float* PARTP; float* PARTG; LAS unsigned char* xl;
    __device__ __forceinline__ void operator()(EPI_ARGS) const {
#define UU(ai, m, e) acc[ai][0][m][(e) >> 2][(e) & 3]
#define GG(ai, m, e) acc[ai][1][m][(e) >> 2][(e) & 3]
        const int c0 = u.pn * 128 + wc * 32 + 8 * fq;
        float w0[8], w1[8], w2[8], cb[8];
        { const GAS f32x4* wp = (const GAS f32x4*)(cw + c0); const f32x4 a0 = wp[0], a1 = wp[1], b0 = wp[DFF / 4], b1 = wp[DFF / 4 + 1], d0 = wp[2 * DFF / 4], d1 = wp[2 * DFF / 4 + 1];
          const GAS f32x4* bp = (const GAS f32x4*)(cbias + c0); const f32x4 e0 = bp[0], e1 = bp[1];
#pragma unroll
          for (int e = 0; e < 4; ++e) { w0[e] = a0[e]; w0[4 + e] = a1[e]; w1[e] = b0[e]; w1[4 + e] = b1[e]; w2[e] = d0[e]; w2[4 + e] = d1[e]; cb[e] = e0[e]; cb[4 + e] = e1[e]; } }
        LAS float* XE = (LAS float*)xl;
#pragma unroll
        for (int ai = 0; ai < 2; ++ai) { const int blk = 2 * ai + wr;
            if (fr == 0) {
#pragma unroll
                for (int e = 0; e < 8; ++e) XE[((blk * 2 + 0) * 4 + wc) * 32 + fq * 8 + e] = UU(ai, 0, e); }
            if (fr == 15) {
#pragma unroll
                for (int e = 0; e < 8; ++e) XE[((blk * 2 + 1) * 4 + wc) * 32 + fq * 8 + e] = UU(ai, 3, e); } }
        if (wr == 0 && fr == 0) { float* ep = EDGEU + (size_t)(u.pm * 2 + 0) * DFF + c0; *(GAS f32x4*)ep = acc[0][0][0][0]; *(GAS f32x4*)(ep + 4) = acc[0][0][0][1]; }
        if (wr == 1 && fr == 15) { float* ep = EDGEU + (size_t)(u.pm * 2 + 1) * DFF + c0; *(GAS f32x4*)ep = acc[1][0][3][0]; *(GAS f32x4*)(ep + 4) = acc[1][0][3][1]; }
        asm volatile("s_waitcnt lgkmcnt(0)" ::: "memory"); __builtin_amdgcn_s_barrier(); asm volatile("" ::: "memory");
#pragma unroll
        for (int ai = 0; ai < 2; ++ai) { const int blk = 2 * ai + wr;
#pragma unroll
            for (int m = 0; m < 4; ++m) { const int row = u.pm * BM + ai * HALF + wr * 64 + m * 16 + fr;
                float pre[8], r[8], ex[8];
#pragma unroll
                for (int e = 0; e < 8; ++e) ex[e] = 0.f;
                if (m == 0 && blk > 0 && fr == 0) {
#pragma unroll
                    for (int e = 0; e < 8; ++e) ex[e] = XE[(((blk - 1) * 2 + 1) * 4 + wc) * 32 + fq * 8 + e]; }
                if (m == 3 && blk < 3 && fr == 15) {
#pragma unroll
                    for (int e = 0; e < 8; ++e) ex[e] = XE[(((blk + 1) * 2 + 0) * 4 + wc) * 32 + fq * 8 + e]; }
#pragma unroll
                for (int e = 0; e < 8; ++e) { const float uc = UU(ai, m, e);
                    const float oldp = (m == 0) ? ex[e] : dpp_ror1(UU(ai, m == 0 ? 0 : m - 1, e));
                    const float oldn = (m == 3) ? ex[e] : dpp_ror15(UU(ai, m == 3 ? 3 : m + 1, e));
                    const float up_ = dpp_prev(oldp, uc), un_ = dpp_next(oldn, uc);
                    pre[e] = cb[e] + w0[e] * up_ + w1[e] * uc + w2[e] * un_; r[e] = gelu_tanh_(pre[e]) * GG(ai, m, e); }
                const bool edge0 = (blk == 0 && m == 0 && fr == 0), edge1 = (blk == 3 && m == 3 && fr == 15);
                if (edge0 || edge1) { const size_t o = (size_t)(u.pm * 2 + (edge1 ? 1 : 0)) * DFF + c0;
                    *(GAS f32x4*)(PARTP + o) = (f32x4){pre[0], pre[1], pre[2], pre[3]}; *(GAS f32x4*)(PARTP + o + 4) = (f32x4){pre[4], pre[5], pre[6], pre[7]};
                    *(GAS f32x4*)(PARTG + o) = acc[ai][1][m][0]; *(GAS f32x4*)(PARTG + o + 4) = acc[ai][1][m][1]; }
                else { u32x4 w; w.x = cvt_pk_bf16(r[0], r[1]); w.y = cvt_pk_bf16(r[2], r[3]); w.z = cvt_pk_bf16(r[4], r[5]); w.w = cvt_pk_bf16(r[6], r[7]);
                    *(GAS u32x4*)(ACT + (size_t)row * DFF + c0) = w; }
                asm volatile("" ::: "memory"); }
        }
#undef UU
#undef GG
    }
};

struct EpiAny {
    int kind;
    unsigned char* ws;
    int S, Sshift, seqbase, goff, rmode; const float* base; const float* cw; const float* cbias; LAS unsigned char* xl;
    __device__ __forceinline__ void operator()(EPI_ARGS) const {
        if (kind == 0) { EpiStore e{(bf16_t*)(ws + WS_Z), ZLD, 12}; e(acc, u, wr, wc, fr, fq); }
        else if (kind == 1) { EpiQ e{(bf16_t*)(ws + WS_Q), (const float*)(ws + WS_RSTD), (const float*)(ws + WS_ROPE), S, Sshift}; e(acc, u, wr, wc, fr, fq); }
        else if (kind == 2) { EpiKV e{(bf16_t*)(ws + WS_KF), (bf16_t*)(ws + WS_V), (const float*)(ws + WS_RSTD), S, Sshift}; e(acc, u, wr, wc, fr, fq); }
        else if (kind == 3) { EpiGateA e{(bf16_t*)(ws + WS_T), (const bf16_t*)(ws + WS_Z)}; e(acc, u, wr, wc, fr, fq); }
        else if (kind == 4) { EpiGateB e{(const bf16_t*)(ws + WS_T), (const bf16_t*)(ws + WS_Z), (bf16_t*)(ws + WS_MERGED)}; e(acc, u, wr, wc, fr, fq); }
        else if (kind == 5) { EpiResid e{base, nullptr, (const float*)(ws + WS_MOD), goff, Sshift, seqbase, rmode, (bf16_t*)(ws + WS_OA)}; e(acc, u, wr, wc, fr, fq); }
        else { float* ed = (float*)(ws + WS_EDGE); EpiConv e{(bf16_t*)(ws + WS_ACT), cw, cbias, ed, ed + 128 * DFF, ed + 256 * DFF, xl}; e(acc, u, wr, wc, fr, fq); }
    }
};
}

__device__ const float ROPE_INV[16] = {1.000000000e+00f, 5.623413324e-01f, 3.162277639e-01f, 1.778279394e-01f, 1.000000015e-01f, 5.623413250e-02f, 3.162277490e-02f, 1.778279431e-02f,
                                       9.999999776e-03f, 5.623413250e-03f, 3.162277630e-03f, 1.778279431e-03f, 1.000000047e-03f, 5.623413017e-04f, 3.162277571e-04f, 1.778279402e-04f};
__device__ __forceinline__ int perm_rope(int i) { return i < 16 ? 2 * i : 2 * (i - 16) + 1; }
__device__ __forceinline__ int rowmap(int kind, int n) {
    if (kind == 1) return n < 640 ? n : (n < 672 ? 640 + perm_rope(n - 640) : n + 96);
    if (kind == 2) { const int h = n / 96, c = n - h * 96; return c < 64 ? n : h * 96 + 64 + perm_rope(c - 64); }
    if (kind == 3) { const int h = n >> 7, c = n & 127; return c < 64 ? h * 64 + c : 1024 + h * 64 + (c - 64); }
    if (kind == 4) { const int f = n < DFF ? n : n - DFF; return (f >> 7) * 256 + (n < DFF ? 0 : 128) + (f & 127); }
    return n;
}
__device__ __forceinline__ void transpose_item(const float* W, int K, int N, bf16_t* WT, int kind, const float* ks, LAS float* scr, int item, int lane) {
    const int nblk = N / 32, kb = item / nblk, nb = item - kb * nblk, k0 = 64 * kb, n0 = 32 * nb;
#pragma unroll 8
    for (int i = 0; i < 32; ++i) { const int kk = 2 * i + (lane >> 5); float w = W[(size_t)(k0 + kk) * N + n0 + (lane & 31)]; if (ks) w *= ks[k0 + kk]; scr[kk * 33 + (lane & 31)] = w; }
    asm volatile("s_waitcnt lgkmcnt(0)" ::: "memory");
    const int c = lane & 7;
#pragma unroll
    for (int j = 0; j < 4; ++j) { const int n = (lane >> 3) + 8 * j; const LAS float* s = scr + (8 * c) * 33 + n;
        u32x4 o; o.x = cvt_pk_bf16(s[0 * 33], s[1 * 33]); o.y = cvt_pk_bf16(s[2 * 33], s[3 * 33]); o.z = cvt_pk_bf16(s[4 * 33], s[5 * 33]); o.w = cvt_pk_bf16(s[6 * 33], s[7 * 33]);
        *(GAS u32x4*)(WT + (size_t)rowmap(kind, n0 + n) * K + k0 + 8 * c) = o; }
    asm volatile("s_waitcnt lgkmcnt(0)" ::: "memory");
}

__device__ __forceinline__ void norm_mod_row(const float* xrow, bf16_t* orow, const float* g, const float* sc, const float* sh, int lane) {
    const GAS f32x4* xr = (const GAS f32x4*)xrow + lane; f32x4 v[4]; float s = 0.f;
#pragma unroll
    for (int j = 0; j < 4; ++j) { v[j] = xr[64 * j]; s += (v[j].x * v[j].x + v[j].y * v[j].y) + (v[j].z * v[j].z + v[j].w * v[j].w); }
    const float rstd = 1.0f / sqrtf(wave_sum(s) * (1.f / D) + EPS);
    GAS u32x2* o8 = (GAS u32x2*)orow + lane;
#pragma unroll
    for (int j = 0; j < 4; ++j) { const f32x4 gg = ((const GAS f32x4*)g)[lane + 64 * j], ss = ((const GAS f32x4*)sc)[lane + 64 * j], hh = ((const GAS f32x4*)sh)[lane + 64 * j];
        const f32x4 o = v[j] * rstd * gg * (ss + 1.0f) + hh; u32x2 w; w.x = cvt_pk_bf16(o.x, o.y); w.y = cvt_pk_bf16(o.z, o.w); o8[64 * j] = w; }
}
__device__ __forceinline__ void norm_mod_row16(const bf16_t* xrow, bf16_t* orow, const float* g, const float* sc, const float* sh, int lane) {
    const GAS u32x2* xr = (const GAS u32x2*)xrow + lane; f32x4 v[4]; float s = 0.f;
#pragma unroll
    for (int j = 0; j < 4; ++j) { const u32x2 w = xr[64 * j]; v[j] = (f32x4){bflo(w.x), bfhi(w.x), bflo(w.y), bfhi(w.y)}; s += (v[j].x * v[j].x + v[j].y * v[j].y) + (v[j].z * v[j].z + v[j].w * v[j].w); }
    const float rstd = 1.0f / sqrtf(wave_sum(s) * (1.f / D) + EPS);
    GAS u32x2* o8 = (GAS u32x2*)orow + lane;
#pragma unroll
    for (int j = 0; j < 4; ++j) { const f32x4 gg = ((const GAS f32x4*)g)[lane + 64 * j], ss = ((const GAS f32x4*)sc)[lane + 64 * j], hh = ((const GAS f32x4*)sh)[lane + 64 * j];
        const f32x4 o = v[j] * rstd * gg * (ss + 1.0f) + hh; u32x2 w; w.x = cvt_pk_bf16(o.x, o.y); w.y = cvt_pk_bf16(o.z, o.w); o8[64 * j] = w; }
}
__device__ __forceinline__ void final_norm_row(const bf16_t* xin, float* xrow, const float* g, int lane) {
    GAS f32x4* xr = (GAS f32x4*)xrow + lane; const GAS u32x2* xi = (const GAS u32x2*)xin + lane; f32x4 v[4]; float s = 0.f;
#pragma unroll
    for (int j = 0; j < 4; ++j) { const u32x2 w = xi[64 * j]; v[j] = (f32x4){bflo(w.x), bfhi(w.x), bflo(w.y), bfhi(w.y)}; s += (v[j].x * v[j].x + v[j].y * v[j].y) + (v[j].z * v[j].z + v[j].w * v[j].w); }
    const float rstd = 1.0f / sqrtf(wave_sum(s) * (1.f / D) + EPS);
#pragma unroll
    for (int j = 0; j < 4; ++j) xr[64 * j] = v[j] * rstd * ((const GAS f32x4*)g)[lane + 64 * j];
}

__device__ __forceinline__ void ld_f32(const float* p, int lane, f32x4 (&v)[4]) { const GAS f32x4* r = (const GAS f32x4*)p + lane;
#pragma unroll
    for (int j = 0; j < 4; ++j) v[j] = r[64 * j]; }
__device__ __forceinline__ void ld_b16(const bf16_t* p, int lane, f32x4 (&v)[4]) { const GAS u32x2* r = (const GAS u32x2*)p + lane;
#pragma unroll
    for (int j = 0; j < 4; ++j) { const u32x2 w = r[64 * j]; v[j] = (f32x4){bflo(w.x), bfhi(w.x), bflo(w.y), bfhi(w.y)}; } }
__device__ __forceinline__ float ssq4(const f32x4 (&v)[4]) { float s = 0.f;
#pragma unroll
    for (int j = 0; j < 4; ++j) s += (v[j].x * v[j].x + v[j].y * v[j].y) + (v[j].z * v[j].z + v[j].w * v[j].w);
    return s; }
__device__ __forceinline__ void st_mod_b16(bf16_t* orow, int lane, const f32x4 (&v)[4], float rstd, const float* g, const float* sc, const float* sh) { GAS u32x2* o8 = (GAS u32x2*)orow + lane;
#pragma unroll
    for (int j = 0; j < 4; ++j) { const f32x4 gg = ((const GAS f32x4*)g)[lane + 64 * j], ss = ((const GAS f32x4*)sc)[lane + 64 * j], hh = ((const GAS f32x4*)sh)[lane + 64 * j];
        const f32x4 o = v[j] * rstd * gg * (ss + 1.0f) + hh; u32x2 w; w.x = cvt_pk_bf16(o.x, o.y); w.y = cvt_pk_bf16(o.z, o.w); o8[64 * j] = w; } }
__device__ __forceinline__ void st_fin_f32(float* orow, int lane, const f32x4 (&v)[4], float rstd, const float* g) { GAS f32x4* xr = (GAS f32x4*)orow + lane;
#pragma unroll
    for (int j = 0; j < 4; ++j) xr[64 * j] = v[j] * rstd * ((const GAS f32x4*)g)[lane + 64 * j]; }
#define RSTD_OF(s) (1.0f / sqrtf(wave_sum(s) * (1.f / D) + EPS))

__device__ __forceinline__ void dil_task(const bf16_t* Z, bf16_t* OG, float* LSE, int S, int task, LAS unsigned char* wl, int lane_in) {
    int lane = lane_in; asm volatile("" : "+v"(lane));
    const int r32 = lane & 31, hi = lane >> 5;
    const int bps = S >> 5, tps = 12 * bps;
    const int seq = task / tps; const int rem = task - seq * tps; const int hd = rem / bps; const int blk = rem - hd * bps;
    const int g = hd >> 2, sh = 2 * g, dl = 1 << sh; const int r = blk & (dl - 1), bi = blk >> sh;
    const int i0 = bi * 32, nsub = S >> sh;
    const size_t rowbase = (size_t)seq * S;
    const int tq = r + ((i0 + r32) << sh);
    const bf16_t* qp = Z + (rowbase + tq) * ZLD + 768 + hd * 64 + 8 * hi;
    bf16x8 qf[4];
#pragma unroll
    for (int s = 0; s < 4; ++s) qf[s] = *(const GAS bf16x8*)(qp + 16 * s);
    f32x16 sc[5];
    {
        bf16x8 kf[5][4];
#pragma unroll
        for (int c = 0; c < 5; ++c) {
            int ik = i0 - 64 + 32 * c + r32; ik = ik < 0 ? 0 : (ik > nsub - 1 ? nsub - 1 : ik);
            const bf16_t* kp = Z + (rowbase + r + ((size_t)ik << sh)) * ZLD + 1536 + hd * 64 + 8 * hi;
#pragma unroll
            for (int s = 0; s < 4; ++s) kf[c][s] = *(const GAS bf16x8*)(kp + 16 * s);
        }
#pragma unroll
        for (int c = 0; c < 5; ++c) {
            f32x16 a = {};
#pragma unroll
            for (int s = 0; s < 4; ++s) a = __builtin_amdgcn_mfma_f32_32x32x16_bf16(kf[c][s], qf[s], a, 0, 0, 0);
            sc[c] = a;
        }
    }
    asm volatile("" ::: "memory");
    u32x4 vv[5][4];
#pragma unroll
    for (int c = 0; c < 5; ++c)
#pragma unroll
        for (int i = 0; i < 4; ++i) { const int row = (lane >> 3) + 8 * i; int ik = i0 - 64 + 32 * c + row; ik = ik < 0 ? 0 : (ik > nsub - 1 ? nsub - 1 : ik);
            vv[c][i] = *(const GAS u32x4*)(Z + (rowbase + r + ((size_t)ik << sh)) * ZLD + 2304 + hd * 64 + (lane & 7) * 8); }
    asm volatile("" ::: "memory");
    const float cb = __builtin_amdgcn_exp2f(-0.6666666667f * (float)(hd + 1)) * LOG2E * (float)dl;
    float mx = -INFINITY;
#pragma unroll
    for (int c = 0; c < 5; ++c)
#pragma unroll
        for (int e = 0; e < 16; ++e) {
            const int kvl = 32 * c + (e & 3) + 8 * (e >> 2) + 4 * hi; const int delta = kvl - 64 - r32; const int ik = i0 + r32 + delta;
            const int ad = delta < 0 ? -delta : delta; const bool valid = (ad <= 64) && (ik >= 0) && (ik < nsub);
            float v = sc[c][e] * DSCALE - cb * (float)ad; v = valid ? v : -INFINITY; sc[c][e] = v; mx = fmaxf(mx, v);
        }
    mx = swap_max(mx);
    float ls = 0.f;
#pragma unroll
    for (int c = 0; c < 5; ++c)
#pragma unroll
        for (int e = 0; e < 16; ++e) { const float p = __builtin_amdgcn_exp2f(sc[c][e] - mx); sc[c][e] = p; ls += p; }
    ls = swap_add(ls);
    f32x16 o0 = {}, o1 = {};
    const int vb = ((lane >> 4) & 1) * 32 + (lane & 3) * 8 + (4 * hi + ((lane & 15) >> 2)) * 64;
#pragma unroll
    for (int c = 0; c < 5; ++c) {
        asm volatile("s_waitcnt lgkmcnt(0)" ::: "memory");
#pragma unroll
        for (int i = 0; i < 4; ++i) { const int row = (lane >> 3) + 8 * i; *(LAS u32x4*)(wl + ((lane & 7) >> 2) * 2048 + row * 64 + (lane & 3) * 16) = vv[c][i]; }
        asm volatile("s_waitcnt lgkmcnt(0)" ::: "memory");
#pragma unroll
        for (int s = 0; s < 2; ++s) {
            u32x4 pw; pw.x = cvt_pk_bf16(sc[c][8 * s + 0], sc[c][8 * s + 1]); pw.y = cvt_pk_bf16(sc[c][8 * s + 2], sc[c][8 * s + 3]); pw.z = cvt_pk_bf16(sc[c][8 * s + 4], sc[c][8 * s + 5]); pw.w = cvt_pk_bf16(sc[c][8 * s + 6], sc[c][8 * s + 7]);
            const bf16x8 pf = __builtin_bit_cast(bf16x8, pw);
            { const s16x4 lo = vtr(wl + vb + s * 1024), hh = vtr(wl + vb + s * 1024 + 512); const bf16x8 vf = {lo[0], lo[1], lo[2], lo[3], hh[0], hh[1], hh[2], hh[3]};
              o0 = __builtin_amdgcn_mfma_f32_32x32x16_bf16(vf, pf, o0, 0, 0, 0); }
            { const s16x4 lo = vtr(wl + vb + 2048 + s * 1024), hh = vtr(wl + vb + 2048 + s * 1024 + 512); const bf16x8 vf = {lo[0], lo[1], lo[2], lo[3], hh[0], hh[1], hh[2], hh[3]};
              o1 = __builtin_amdgcn_mfma_f32_32x32x16_bf16(vf, pf, o1, 0, 0, 0); }
        }
    }
    const float inv = 1.0f / ls; const size_t rq = rowbase + tq;
    bf16_t* op = OG + (rq * 12 + hd) * 64 + 4 * hi;
#pragma unroll
    for (int i = 0; i < 4; ++i) {
        u32x2 w0; w0.x = cvt_pk_bf16(o0[4 * i] * inv, o0[4 * i + 1] * inv); w0.y = cvt_pk_bf16(o0[4 * i + 2] * inv, o0[4 * i + 3] * inv); *(GAS u32x2*)(op + 8 * i) = w0;
        u32x2 w1; w1.x = cvt_pk_bf16(o1[4 * i] * inv, o1[4 * i + 1] * inv); w1.y = cvt_pk_bf16(o1[4 * i + 2] * inv, o1[4 * i + 3] * inv); *(GAS u32x2*)(op + 32 + 8 * i) = w1;
    }
    if (hi == 0) LSE[rq * 12 + hd] = (mx + __builtin_amdgcn_logf(ls)) * LN2;
}

namespace mla {
constexpr int KPITCH = 208, KBYTES = 64 * KPITCH, VBYTES = 8192, BUF = KBYTES + VBYTES, QOFF = 2 * BUF, DUMMY = QOFF + 8 * 12288;
#define MLA_PACK(P, b) (u32x4){cvt_pk_bf16(P[b], P[b + 1]), cvt_pk_bf16(P[b + 2], P[b + 3]), cvt_pk_bf16(P[b + 4], P[b + 5]), cvt_pk_bf16(P[b + 6], P[b + 7])}
#define SGB(mask, n) __builtin_amdgcn_sched_group_barrier(mask, n, 0)
__device__ __forceinline__ float max2_(float a, float b) { return __builtin_amdgcn_fmed3f(a, b, INFINITY); }
constexpr float THR = 8.0f;
__device__ __forceinline__ void softmax_blk(f32x16& p0, f32x16& p1, f32x16& o0, f32x16& o1, float& mhat, float& lrun, u32x4 (&pf)[4], bool first) {
    float r0 = max2_(p0[0], p0[1]), r1 = max2_(p1[0], p1[1]);
#pragma unroll
    for (int e = 2; e < 16; ++e) { r0 = max2_(r0, p0[e]); r1 = max2_(r1, p1[e]); }
    const float rm = swap_max(max2_(r0, r1));
    if (first || __any(rm - mhat > THR)) {
        const float mn = first ? rm : fmaxf(rm, mhat); const float f = first ? 0.f : __builtin_amdgcn_exp2f(mhat - mn); mhat = mn; lrun *= f;
#pragma unroll
        for (int e = 0; e < 16; ++e) { o0[e] *= f; o1[e] *= f; }
    }
    float s0 = 0.f, s1 = 0.f;
#pragma unroll
    for (int e = 0; e < 16; ++e) { p0[e] = __builtin_amdgcn_exp2f(p0[e] - mhat); p1[e] = __builtin_amdgcn_exp2f(p1[e] - mhat); s0 += p0[e]; s1 += p1[e]; }
    lrun += s0 + s1;
    pf[0] = MLA_PACK(p0, 0); pf[1] = MLA_PACK(p0, 8); pf[2] = MLA_PACK(p1, 0); pf[3] = MLA_PACK(p1, 8);
}
__device__ __forceinline__ void pv_blk(const u32x4 (&pf)[4], f32x16& o0, f32x16& o1, LAS const unsigned char* vbase) {
#pragma unroll
    for (int ks = 0; ks < 4; ++ks) {
        const bf16x8 p = __builtin_bit_cast(bf16x8, pf[ks]);
        { const s16x4 lo = vtr(vbase + ks * 1024), hh = vtr(vbase + ks * 1024 + 512); const bf16x8 vf = {lo[0], lo[1], lo[2], lo[3], hh[0], hh[1], hh[2], hh[3]};
          o0 = __builtin_amdgcn_mfma_f32_32x32x16_bf16(vf, p, o0, 0, 0, 0); }
        { const s16x4 lo = vtr(vbase + 4096 + ks * 1024), hh = vtr(vbase + 4096 + ks * 1024 + 512); const bf16x8 vf = {lo[0], lo[1], lo[2], lo[3], hh[0], hh[1], hh[2], hh[3]};
          o1 = __builtin_amdgcn_mfma_f32_32x32x16_bf16(vf, p, o1, 0, 0, 0); }
    }
}
__device__ __forceinline__ void store_o(bf16_t* op, const f32x16& o0, const f32x16& o1, float inv) {
#pragma unroll
    for (int i = 0; i < 4; ++i) {
        u32x2 w0; w0.x = cvt_pk_bf16(o0[4 * i] * inv, o0[4 * i + 1] * inv); w0.y = cvt_pk_bf16(o0[4 * i + 2] * inv, o0[4 * i + 3] * inv); GST(u32x2, op + 8 * i, w0);
        u32x2 w1; w1.x = cvt_pk_bf16(o1[4 * i] * inv, o1[4 * i + 1] * inv); w1.y = cvt_pk_bf16(o1[4 * i + 2] * inv, o1[4 * i + 3] * inv); GST(u32x2, op + 32 + 8 * i, w1);
    }
}
__device__ __forceinline__ void attn_unit(const bf16_t* Qh, const bf16_t* Kh, const bf16_t* Vh, bf16_t* Oh  , int S, int qb, LAS unsigned char* lds, int tid) {
    const int lane = tid & 63, r32 = lane & 31, hi = lane >> 5; const int wid = __builtin_amdgcn_readfirstlane(tid >> 6);
    const int qrow = qb * 512 + wid * 64 + r32;
    const bf16_t* Qw = Qh + (size_t)qrow * 96 + 8 * hi;
    LAS unsigned char* ql = lds + QOFF + wid * 12288 + lane * 16;
#pragma unroll
    for (int s = 0; s < 6; ++s) { *(LAS bf16x8*)(ql + s * 1024) = GLD(bf16x8, Qw + 16 * s); *(LAS bf16x8*)(ql + (6 + s) * 1024) = GLD(bf16x8, Qw + 32 * 96 + 16 * s); }
    const bool has1 = tid < 256; const int kc0 = tid, kc1 = has1 ? tid + 512 : tid;
    const unsigned kd0 = (unsigned)((kc0 / 12) * KPITCH + (kc0 % 12) * 16);
    const unsigned kd1 = has1 ? (unsigned)((kc1 / 12) * KPITCH + (kc1 % 12) * 16) : (unsigned)(DUMMY + (tid - 256) * 16);
    const unsigned kd1n = has1 ? BUF : 0u;
    const unsigned vd = (unsigned)(KBYTES + ((tid & 7) >> 2) * 4096 + (tid >> 3) * 64 + (tid & 3) * 16);
    const GAS u32x4* Kg = (const GAS u32x4*)Kh; const GAS u32x4* Vg = (const GAS u32x4*)Vh;
    const int NT = S >> 6;
    u32x4 ka = GLD(u32x4, Kg + kc0), kb = GLD(u32x4, Kg + kc1), va = GLD(u32x4, Vg + tid);
    *(LAS u32x4*)(lds + kd0) = ka; *(LAS u32x4*)(lds + kd1) = kb; *(LAS u32x4*)(lds + vd) = va;
    __syncthreads();
    f32x16 oa0 = {}, oa1 = {}, ob0 = {}, ob1 = {}; float ma = 0.f, la = 0.f, mb = 0.f, lb = 0.f;
    const unsigned kfo = (unsigned)(r32 * KPITCH + hi * 16);
    const unsigned vb = (unsigned)(KBYTES + ((lane >> 4) & 1) * 32 + (lane & 3) * 8 + (4 * hi + ((lane & 15) >> 2)) * 64);
    for (int t = 0; t < NT; ++t) {
        const unsigned cur = (unsigned)(t & 1) * BUF, nxt = BUF - cur;
        const int tn = t + 1 < NT ? t + 1 : t;
        ka = GLD(u32x4, Kg + (size_t)tn * 768 + kc0); kb = GLD(u32x4, Kg + (size_t)tn * 768 + kc1); va = GLD(u32x4, Vg + (size_t)tn * 512 + tid);
        u32x4 pf[4];
        {
            f32x16 p0 = {}, p1 = {};
#pragma unroll
            for (int s = 0; s < 6; ++s) {
                const bf16x8 a0 = *(const LAS bf16x8*)(lds + cur + kfo + s * 32), a1 = *(const LAS bf16x8*)(lds + cur + kfo + 32 * KPITCH + s * 32);
                const bf16x8 q = *(const LAS bf16x8*)(ql + s * 1024);
                p0 = __builtin_amdgcn_mfma_f32_32x32x16_bf16(a0, q, p0, 0, 0, 0); p1 = __builtin_amdgcn_mfma_f32_32x32x16_bf16(a1, q, p1, 0, 0, 0);
            }
            softmax_blk(p0, p1, oa0, oa1, ma, la, pf, t == 0);
            pv_blk(pf, oa0, oa1, lds + cur + vb);
        }
        __builtin_amdgcn_sched_barrier(0);
        {
            f32x16 p0 = {}, p1 = {};
#pragma unroll
            for (int s = 0; s < 6; ++s) {
                const bf16x8 a0 = *(const LAS bf16x8*)(lds + cur + kfo + s * 32), a1 = *(const LAS bf16x8*)(lds + cur + kfo + 32 * KPITCH + s * 32);
                const bf16x8 q = *(const LAS bf16x8*)(ql + (6 + s) * 1024);
                p0 = __builtin_amdgcn_mfma_f32_32x32x16_bf16(a0, q, p0, 0, 0, 0); p1 = __builtin_amdgcn_mfma_f32_32x32x16_bf16(a1, q, p1, 0, 0, 0);
            }
            softmax_blk(p0, p1, ob0, ob1, mb, lb, pf, t == 0);
            pv_blk(pf, ob0, ob1, lds + cur + vb);
        }
        *(LAS u32x4*)(lds + nxt + kd0) = ka; *(LAS u32x4*)(lds + (has1 ? nxt : 0u) + kd1) = kb; *(LAS u32x4*)(lds + nxt + vd) = va;
        __syncthreads();
    }
    bf16_t* op = Oh + (size_t)qrow * D + 4 * hi;
    store_o(op, oa0, oa1, 1.0f / swap_add(la));
    store_o(op + 32 * D, ob0, ob1, 1.0f / swap_add(lb));
}
#undef SGB
}

#define XB_TMO      128
#define XB_XCNT(j)  (256  + 64 * (j))
#define XB_XSUB(j)  (1280 + 64 * (j))
#define XB_XGEN(j)  (2304 + 64 * (j))
#define XB_TOP      3328
#define XB_TOPGEN   3392
#define XCD_BAR_WORDS 3456
#define XB_SPIN_CAP (1u << 20)
__device__ __forceinline__ unsigned xb_ld(unsigned* p)              { return __hip_atomic_load(p, __ATOMIC_RELAXED, __HIP_MEMORY_SCOPE_AGENT); }
__device__ __forceinline__ unsigned xb_add(unsigned* p, unsigned v) { return __hip_atomic_fetch_add(p, v, __ATOMIC_RELAXED, __HIP_MEMORY_SCOPE_AGENT); }
__device__ __forceinline__ unsigned xb_xcc_id() { return (unsigned)__builtin_amdgcn_s_getreg((3 << 11) | 20) & 0xFu; }
#define XB_SPIN(cond, bar) do { unsigned _sp = 0; while (cond) { __builtin_amdgcn_s_sleep(1); \
    if ((++_sp & 255u) == 0u) { if (xb_ld(&(bar)[XB_TMO])) break; if (_sp > XB_SPIN_CAP) { atomicAdd(&(bar)[XB_TMO], 1u); break; } } } } while (0)
struct XcdBarrier { unsigned* bar; unsigned x; volatile LAS unsigned* st; };
__device__ __forceinline__ XcdBarrier xcd_barrier_post(unsigned* bar, volatile LAS unsigned* st, int tid) {
    XcdBarrier b; b.bar = bar; b.x = xb_xcc_id(); b.st = st;
    if (tid == 0) (void)xb_add(&bar[XB_XCNT(b.x)], 1u);
    return b;
}
__device__ __forceinline__ void xcd_barrier_complete(unsigned* bar, unsigned x, unsigned& nloc, unsigned& nx) {
    const unsigned G = gridDim.x * gridDim.y * gridDim.z;
    unsigned sum, cnt, mine, sp = 0u;
    for (;;) {
        sum = 0u; cnt = 0u; mine = 0u;
#pragma unroll
        for (unsigned j = 0; j < 16; ++j) { const unsigned c = xb_ld(&bar[XB_XCNT(j)]); sum += c; cnt += (c > 0u) ? 1u : 0u; mine = (j == x) ? c : mine; }
        if (sum == G) break;
        __builtin_amdgcn_s_sleep(1);
        if ((++sp & 255u) == 0u) { if (xb_ld(&bar[XB_TMO])) break; if (sp > XB_SPIN_CAP) { atomicAdd(&bar[XB_TMO], 1u); break; } }
    }
    nloc = mine > 0u ? mine : 1u; nx = cnt > 0u ? cnt : 1u;
}
__device__ __forceinline__ void xcd_barrier(const XcdBarrier& b, int tid) {
    asm volatile("s_waitcnt vmcnt(0)" ::: "memory");
    __syncthreads();
    if (tid == 0) {
        unsigned* bar = b.bar;
        __builtin_amdgcn_s_waitcnt(0);
        unsigned nloc = b.st[0], nx = b.st[1];
        if (nloc == 0u) { xcd_barrier_complete(bar, b.x, nloc, nx); b.st[0] = nloc; b.st[1] = nx; }
        const unsigned old = xb_add(&bar[XB_XSUB(b.x)], 1u);
        const unsigned gen = old / nloc;
        if (old + 1u == (gen + 1u) * nloc) {
            __builtin_amdgcn_fence(__ATOMIC_RELEASE, "agent");
            asm volatile("s_waitcnt vmcnt(0)" ::: "memory");
            const unsigned og = xb_add(&bar[XB_TOP], 1u);
            const unsigned tg = og / nx;
            if (og + 1u == (tg + 1u) * nx) xb_add(&bar[XB_TOPGEN], 1u);
            else XB_SPIN(xb_ld(&bar[XB_TOPGEN]) == tg, bar);
            __builtin_amdgcn_fence(__ATOMIC_ACQUIRE, "agent");
            xb_add(&bar[XB_XGEN(b.x)], 1u);
            asm volatile("s_waitcnt vmcnt(0)" ::: "memory");
        } else {
            XB_SPIN(xb_ld(&bar[XB_XGEN(b.x)]) == gen, bar);
            __builtin_amdgcn_fence(__ATOMIC_ACQUIRE, "agent");
            asm volatile("s_waitcnt vmcnt(0)" ::: "memory");
        }
    }
    __syncthreads();
}

constexpr int SPC = 13, NSTEP = 1 + SPC * NCHUNK + 1;
struct Args { const float* in[21]; float* out; unsigned char* ws; int ph_lo, ph_hi; };

__global__ void __launch_bounds__(512, 2) fwd_kernel(Args args) {
    extern __shared__ __attribute__((aligned(16))) unsigned char lds_raw[];
    LAS unsigned char* lds = (LAS unsigned char*)lds_raw;
    const int wave0 = __builtin_amdgcn_readfirstlane(threadIdx.x >> 6);
#if MEGA
    volatile LAS unsigned* bst = (volatile LAS unsigned*)(lds + LDS_BYTES - 16);
    if (threadIdx.x < 2) bst[threadIdx.x] = 0u;
    __syncthreads();
    XcdBarrier xbar = xcd_barrier_post((unsigned*)args.ws + 4096, bst, (int)threadIdx.x);
#endif
    for (int ph = args.ph_lo; ph < args.ph_hi; ++ph) {
    unsigned zl = 0u; asm volatile("" : "+s"(zl)); int wave_l = wave0; asm volatile("" : "+s"(wave_l));
    int tid_l = wave_l * 64 + (int)__builtin_amdgcn_mbcnt_hi(~0u, __builtin_amdgcn_mbcnt_lo(~0u, zl)); asm volatile("" : "+v"(tid_l));
    unsigned char* ws = args.ws; asm volatile("" : "+s"(ws));
    const int tid = tid_l, lane = tid & 63; const int wave = wave_l;
    const int G = gridDim.x, bx = blockIdx.x; const int vcu = (G % 8 == 0) ? (bx % 8) * (G / 8) + bx / 8 : bx;
    const int gw = vcu * 8 + wave, NGW = G * 8;
    bf16_t* Win_t = (bf16_t*)(ws + WS_WIN); bf16_t* Wuq_t = (bf16_t*)(ws + WS_WUQ); bf16_t* Wukv_t = (bf16_t*)(ws + WS_WUKV); bf16_t* Pa_t = (bf16_t*)(ws + WS_PA);
    bf16_t* Pb_t = (bf16_t*)(ws + WS_PB); bf16_t* Wout_t = (bf16_t*)(ws + WS_WOUT); bf16_t* Wup_t = (bf16_t*)(ws + WS_WUP); bf16_t* Wdown_t = (bf16_t*)(ws + WS_WDOWN);
    float* MOD = (float*)(ws + WS_MOD); float* ROPE = (float*)(ws + WS_ROPE); float* RSTD = (float*)(ws + WS_RSTD);
    bf16_t* Hb = (bf16_t*)(ws + WS_H); bf16_t* Zb = (bf16_t*)(ws + WS_Z); bf16_t* Qb = (bf16_t*)(ws + WS_Q); bf16_t* KFb = (bf16_t*)(ws + WS_KF); bf16_t* Vb = (bf16_t*)(ws + WS_V);
    bf16_t* OAb = (bf16_t*)(ws + WS_OA); bf16_t* OBb = (bf16_t*)(ws + WS_OB); bf16_t* OGb = (bf16_t*)(ws + WS_OG); float* LSEb = (float*)(ws + WS_LSE);
    bf16_t* Tb = (bf16_t*)(ws + WS_T); bf16_t* MGb = (bf16_t*)(ws + WS_MERGED); float* EDGEb = (float*)(ws + WS_EDGE); bf16_t* X1b = (bf16_t*)(ws + WS_OA); bf16_t* UPb = (bf16_t*)(ws + WS_UP); bf16_t* ACTb = (bf16_t*)(ws + WS_ACT);
    bool sync_after = true;
        if (ph == 0) {
            if (bx < 96) {
                LAS float* sl = (LAS float*)lds;
                LAS float* part = (LAS float*)(lds + 49152);
                for (int idx = tid; idx < 12 * 1024; idx += 512) { const int b = idx >> 10, d = idx & 1023; const float c = b < 8 ? args.in[2][b * 1024 + d] : args.in[3][(b - 8) * 1024 + d];
                    sl[d * 12 + b] = c / (1.0f + __expf(-c)); }
                __syncthreads();
                const int e = bx * 64 + lane; float acc[12];
#pragma unroll
                for (int b = 0; b < 12; ++b) acc[b] = 0.f;
                const float* wp = args.in[4] + (size_t)(wave * 128) * 6144 + e;
#pragma unroll 8
                for (int d = 0; d < 128; ++d) { const float w = wp[(size_t)d * 6144]; const LAS f32x4* s4 = (const LAS f32x4*)(sl + (wave * 128 + d) * 12);
                    const f32x4 a = s4[0], b4 = s4[1], c4 = s4[2];
                    acc[0] += a.x * w; acc[1] += a.y * w; acc[2] += a.z * w; acc[3] += a.w * w; acc[4] += b4.x * w; acc[5] += b4.y * w; acc[6] += b4.z * w; acc[7] += b4.w * w;
                    acc[8] += c4.x * w; acc[9] += c4.y * w; acc[10] += c4.z * w; acc[11] += c4.w * w; }
#pragma unroll
                for (int b = 0; b < 12; ++b) part[(wave * 12 + b) * 64 + lane] = acc[b];
                __syncthreads();
                if (wave == 0) {
#pragma unroll
                    for (int b = 0; b < 12; ++b) { float s = args.in[5][e];
#pragma unroll
                        for (int w = 0; w < 8; ++w) s += part[(w * 12 + b) * 64 + lane];
                        MOD[b * 6144 + e] = s; } }
                __syncthreads();
            }
            for (int idx = bx * 512 + tid; idx < 8192 * 16; idx += G * 512) { const int pos = idx >> 4, i = idx & 15; const float ang = (float)pos * ROPE_INV[i];
                const double tt = (double)ang * 0.15915494309189535; const float fr_ = (float)(tt - floor(tt));
                ROPE[idx] = __builtin_amdgcn_cosf(fr_); ROPE[131072 + idx] = __builtin_amdgcn_sinf(fr_); }
            {
                LAS float* scr = (LAS float*)(lds + wave * 16384);
                constexpr int I_IN = 16 * 157, I_UQ = 6 * 48, I_UKV = 4 * 64, I_PA = 16 * 32, I_PB = 4 * 32, I_OUT = 16 * 32, I_UP = 16 * 176, I_DOWN = 44 * 32;
                constexpr int NITEMS = I_IN + I_UQ + I_UKV + I_PA + I_PB + I_OUT + I_UP + I_DOWN;
                for (int it = gw; it < NITEMS; it += NGW) {
                    int r = it; const float* W; int K, N, kind = 0; bf16_t* WT; const float* ks = nullptr;
                    if (r < I_IN) { W = args.in[7]; K = 1024; N = 5024; WT = Win_t; kind = 1; }
                    else if ((r -= I_IN) < I_UQ) { W = args.in[10]; K = 384; N = 1536; WT = Wuq_t; kind = 2; ks = args.in[8]; }
                    else if ((r -= I_UQ) < I_UKV) { W = args.in[11]; K = 256; N = 2048; WT = Wukv_t; kind = 3; ks = args.in[9]; }
                    else if ((r -= I_UKV) < I_PA) { W = args.in[12]; K = 1024; N = 1024; WT = Pa_t; }
                    else if ((r -= I_PA) < I_PB) { W = args.in[13]; K = 256; N = 1024; WT = Pb_t; }
                    else if ((r -= I_PB) < I_OUT) { W = args.in[14]; K = 1024; N = 1024; WT = Wout_t; }
                    else if ((r -= I_OUT) < I_UP) { W = args.in[16]; K = 1024; N = 5632; WT = Wup_t; kind = 4; }
                    else { r -= I_UP; W = args.in[19]; K = 2816; N = 1024; WT = Wdown_t; }
                    transpose_item(W, K, N, WT, kind, ks, scr, r, lane);
                }
                for (int idx = bx * 512 + tid; idx < 96 * 128; idx += G * 512) *(GAS u32x4*)(Win_t + (size_t)672 * 1024 + (size_t)idx * 8) = (u32x4){zl, zl, zl, zl};
            }
            __syncthreads();
        } else if (ph == NSTEP - 1) {
            float* o = args.out + (size_t)(NCHUNK - 1) * CH * D;
            for (int m = gw; m < CH; m += 2 * NGW) { const int m2 = m + NGW; const bool ok2 = m2 < CH;
                    f32x4 va[4], vb[4]; ld_b16(X1b + (size_t)m * D, lane, va); ld_b16(X1b + (size_t)(ok2 ? m2 : m) * D, lane, vb);
                    const float ra = RSTD_OF(ssq4(va)), rb = RSTD_OF(ssq4(vb));
                    st_fin_f32(o + (size_t)m * D, lane, va, ra, args.in[20]); if (ok2) st_fin_f32(o + (size_t)m2 * D, lane, vb, rb, args.in[20]); }
        } else {
            const int c = (ph - 1) / SPC, k = (ph - 1) - SPC * c;
            ChunkP P;
            if (c == 0) { P.x = args.in[0]; P.S = 2048; P.Sshift = 11; P.nseq = 8; P.seqbase = 0; }
            else { P.x = args.in[1] + (size_t)(c - 1) * CH * D; P.S = 8192; P.Sshift = 13; P.nseq = 2; P.seqbase = 8 + 2 * (c - 1); }
            P.out = args.out + (size_t)c * CH * D;
            sync_after = !(k == 3 || k == 6);
            pg8::Gemm g{}; pg8::EpiAny E{}; bool is_gemm = true;
            E.ws = ws; E.S = P.S; E.Sshift = P.Sshift; E.seqbase = P.seqbase;
            if (k == 1) { g = pg8::Gemm{Hb, Win_t, CH, ZLD, 1024, 1024}; E.kind = 0; }
            else if (k == 3) { g = pg8::Gemm{Zb, Wuq_t, CH, 1536, 384, ZLD}; E.kind = 1; }
            else if (k == 4) { g = pg8::Gemm{Zb + 384, Wukv_t, CH, 2048, 256, ZLD}; E.kind = 2; }
            else if (k == 6) { g = pg8::Gemm{OAb, Pa_t, CH, 1024, 1024, 1024}; E.kind = 3; }
            else if (k == 7) { g = pg8::Gemm{OBb, Pb_t, CH, 1024, 256, 256}; E.kind = 4; }
            else if (k == 8) { g = pg8::Gemm{MGb, Wout_t, CH, 1024, 1024, 1024}; E.kind = 5; E.base = P.x; E.goff = 2048; E.rmode = 0; }
            else if (k == 10) { g = pg8::Gemm{Hb, Wup_t, CH, NUP, 1024, 1024}; E.kind = 6; E.cw = args.in[17]; E.cbias = args.in[18]; E.xl = lds + 131072; }
            else if (k == 12) { g = pg8::Gemm{ACTb, Wdown_t, CH, 1024, DFF, DFF}; E.kind = 5; E.base = nullptr; E.goff = 5120; E.rmode = 1; }
            else is_gemm = false;
            if (is_gemm) { pg8::StaticOrder S; S.init(g.M, g.N, G, bx); pg8::gemm_phase(lds, g, S, E, tid); }
            else if (k == 0) {
                if (c > 0) { float* o = args.out + (size_t)(c - 1) * CH * D; for (int m = gw; m < CH; m += 2 * NGW) { const int m2 = m + NGW; const bool ok2 = m2 < CH;
                    f32x4 va[4], vb[4]; ld_b16(X1b + (size_t)m * D, lane, va); ld_b16(X1b + (size_t)(ok2 ? m2 : m) * D, lane, vb);
                    const float ra = RSTD_OF(ssq4(va)), rb = RSTD_OF(ssq4(vb));
                    st_fin_f32(o + (size_t)m * D, lane, va, ra, args.in[20]); if (ok2) st_fin_f32(o + (size_t)m2 * D, lane, vb, rb, args.in[20]); } }
                for (int m = gw; m < CH; m += 2 * NGW) { const int m2 = m + NGW; const bool ok2 = m2 < CH;
                    f32x4 va[4], vb[4]; ld_f32(P.x + (size_t)m * D, lane, va); if (ok2) ld_f32(P.x + (size_t)m2 * D, lane, vb); else ld_f32(P.x + (size_t)m * D, lane, vb);
                    const float ra = RSTD_OF(ssq4(va)), rb = RSTD_OF(ssq4(vb));
                    const float* md = MOD + (size_t)(P.seqbase + (m >> P.Sshift)) * 6144; st_mod_b16(Hb + (size_t)m * D, lane, va, ra, args.in[6], md + 1024, md);
                    if (ok2) { const float* md2 = MOD + (size_t)(P.seqbase + (m2 >> P.Sshift)) * 6144; st_mod_b16(Hb + (size_t)m2 * D, lane, vb, rb, args.in[6], md2 + 1024, md2); } }
            } else if (k == 2) {
                for (int m = gw; m < CH; m += NGW) {
                    const GAS unsigned* zr = (const GAS unsigned*)(Zb + (size_t)m * ZLD);
                    float sq = 0.f, skv = 0.f;
#pragma unroll
                    for (int j = 0; j < 3; ++j) { const unsigned w = zr[lane + 64 * j]; const float a = bflo(w), b = bfhi(w); sq += a * a + b * b; }
#pragma unroll
                    for (int j = 0; j < 2; ++j) { const unsigned w = zr[192 + lane + 64 * j]; const float a = bflo(w), b = bfhi(w); skv += a * a + b * b; }
                    sq = wave_sum(sq); skv = wave_sum(skv);
                    if (lane == 0) { RSTD[2 * m] = 1.0f / sqrtf(sq * (1.f / 384.f) + EPS); RSTD[2 * m + 1] = 1.0f / sqrtf(skv * (1.f / 256.f) + EPS); }
                    const int seq = m >> P.Sshift, pos = m & (P.S - 1);
                    unsigned pr = 0u;
                    { const int i = lane & 15; const unsigned w = zr[320 + i]; const float a = bflo(w), b = bfhi(w); const float cs = ROPE[pos * 16 + i], sn = ROPE[131072 + pos * 16 + i];
                      pr = cvt_pk_bf16(a * cs - b * sn, a * sn + b * cs); }
                    u32x4 o; const int b4 = 4 * (lane & 3);
                    o.x = __shfl(pr, b4); o.y = __shfl(pr, b4 + 1); o.z = __shfl(pr, b4 + 2); o.w = __shfl(pr, b4 + 3);
                    const int head = lane >> 2;
                    *(GAS u32x4*)(KFb + ((size_t)((seq * 16 + head) << P.Sshift) + pos) * 96 + 64 + 8 * (lane & 3)) = o;
                }
                LAS unsigned char* wl = lds + wave * 4096;
                for (int task = gw; task < CH * 12 / 32; task += NGW) dil_task(Zb, OGb, LSEb, P.S, task, wl, lane);
            } else if (k == 5) {
                for (int it = bx * 512 + tid; it < CH * 32; it += G * 512) { const int row = it >> 5, j = (it >> 3) & 3, d8 = (it & 7) * 8;
                    const float l0 = LSEb[row * 12 + j], l1 = LSEb[row * 12 + 4 + j], l2 = LSEb[row * 12 + 8 + j]; const float mx = fmaxf(l0, fmaxf(l1, l2));
                    float w0 = __expf(l0 - mx), w1 = __expf(l1 - mx), w2 = __expf(l2 - mx); const float inv = 1.0f / (w0 + w1 + w2); w0 *= inv; w1 *= inv; w2 *= inv;
                    const bf16_t* p0 = OGb + ((size_t)row * 12 + j) * 64 + d8; const u32x4 q0 = *(const GAS u32x4*)p0, q1 = *(const GAS u32x4*)(p0 + 4 * 64), q2 = *(const GAS u32x4*)(p0 + 8 * 64);
                    const f32x4 a0 = (f32x4){bflo(q0.x), bfhi(q0.x), bflo(q0.y), bfhi(q0.y)} * w0 + (f32x4){bflo(q1.x), bfhi(q1.x), bflo(q1.y), bfhi(q1.y)} * w1 + (f32x4){bflo(q2.x), bfhi(q2.x), bflo(q2.y), bfhi(q2.y)} * w2;
                    const f32x4 a1 = (f32x4){bflo(q0.z), bfhi(q0.z), bflo(q0.w), bfhi(q0.w)} * w0 + (f32x4){bflo(q1.z), bfhi(q1.z), bflo(q1.w), bfhi(q1.w)} * w1 + (f32x4){bflo(q2.z), bfhi(q2.z), bflo(q2.w), bfhi(q2.w)} * w2;
                    *(GAS u32x4*)(OBb + (size_t)row * 256 + j * 64 + d8) = pg8::pack8(a0, a1); }
                const int nqb = P.S >> 9, nunits = P.nseq * 16 * nqb;
                for (int uidx = vcu; uidx < nunits; uidx += G) { const int pair = uidx / nqb, qb = uidx - pair * nqb; const int seq = pair >> 4, head = pair & 15;
                    const size_t hb = (size_t)pair << P.Sshift;
                    mla::attn_unit(Qb + hb * 96, KFb + hb * 96, Vb + hb * 64, OAb + ((size_t)seq << P.Sshift) * D + head * 64, P.S, qb, lds, tid); }
            } else if (k == 9) {
                for (int m = gw; m < CH; m += 2 * NGW) { const int m2 = m + NGW; const bool ok2 = m2 < CH;
                    f32x4 va[4], vb[4]; ld_b16(X1b + (size_t)m * D, lane, va); ld_b16(X1b + (size_t)(ok2 ? m2 : m) * D, lane, vb);
                    const float ra = RSTD_OF(ssq4(va)), rb = RSTD_OF(ssq4(vb));
                    const float* md = MOD + (size_t)(P.seqbase + (m >> P.Sshift)) * 6144; st_mod_b16(Hb + (size_t)m * D, lane, va, ra, args.in[15], md + 4096, md + 3072);
                    if (ok2) { const float* md2 = MOD + (size_t)(P.seqbase + (m2 >> P.Sshift)) * 6144; st_mod_b16(Hb + (size_t)m2 * D, lane, vb, rb, args.in[15], md2 + 4096, md2 + 3072); } }
            } else if (k == 11) {
                for (int it = bx * 512 + tid; it < 128 * 352; it += G * 512) {
                    const int r = it / 352, f0 = (it - r * 352) * 8; const int which = r & 1, pm = r >> 1; const int pos0 = (pm * 256) & (P.S - 1);
                    const bool has_nb = which == 0 ? (pos0 > 0) : (pos0 + 256 < P.S);
                    const float* nb = EDGEb + (size_t)(which == 0 ? (pm - 1) * 2 + 1 : (pm + 1) * 2) * DFF + f0;
                    const float* wv = args.in[17] + (which == 0 ? 0 : 2 * DFF) + f0;
                    const float* pp = EDGEb + (size_t)128 * DFF + (size_t)r * DFF + f0; const float* pg = EDGEb + (size_t)256 * DFF + (size_t)r * DFF + f0;
                    float o[8];
#pragma unroll
                    for (int h = 0; h < 2; ++h) { const f32x4 p4 = *(const GAS f32x4*)(pp + 4 * h), g4 = *(const GAS f32x4*)(pg + 4 * h), w4 = *(const GAS f32x4*)(wv + 4 * h);
                        const float zf = __uint_as_float(zl); f32x4 n4 = (f32x4){zf, zf, zf, zf}; if (has_nb) n4 = *(const GAS f32x4*)(nb + 4 * h);
#pragma unroll
                        for (int e = 0; e < 4; ++e) o[4 * h + e] = pg8::gelu_tanh_(p4[e] + w4[e] * n4[e]) * g4[e]; }
                    u32x4 w; w.x = cvt_pk_bf16(o[0], o[1]); w.y = cvt_pk_bf16(o[2], o[3]); w.z = cvt_pk_bf16(o[4], o[5]); w.w = cvt_pk_bf16(o[6], o[7]);
                    *(GAS u32x4*)(ACTb + (size_t)(pm * 256 + (which ? 255 : 0)) * DFF + f0) = w;
                }
            }
        }
#if MEGA
        if (sync_after && ph + 1 < args.ph_hi) { if (ph == 0) cg::this_grid().sync(); else { int tb = tid; asm volatile("" : "+v"(tb)); xcd_barrier(xbar, tb); } }
#else
        (void)sync_after;
#endif
    }
}

extern "C" void kernel_launch(void* const* d_in, const int* in_sizes, int n_in, void* d_out, int out_size, void* d_ws, size_t ws_size, hipStream_t stream) {
    static int grid = 0;
    if (grid == 0) {
        if (n_in != 21 || ws_size < WS_END) { fprintf(stderr, "kernel_launch: unexpected n_in %d / ws_size %zu\n", n_in, ws_size); grid = -1; return; }
        int dev = 0, cus = 0, per_cu = 0;
        (void)hipGetDevice(&dev); (void)hipDeviceGetAttribute(&cus, hipDeviceAttributeMultiprocessorCount, dev);
        (void)hipFuncSetAttribute((const void*)fwd_kernel, hipFuncAttributeMaxDynamicSharedMemorySize, LDS_BYTES);
        (void)hipOccupancyMaxActiveBlocksPerMultiprocessor(&per_cu, (const void*)fwd_kernel, 512, LDS_BYTES);
        (void)hipGetLastError();
        if (per_cu < 1) fprintf(stderr, "kernel_launch: occupancy query says %d blocks/CU\n", per_cu);
        grid = cus;
    }
    if (grid < 0) return;
    Args a{};
    for (int i = 0; i < 21; ++i) a.in[i] = (const float*)d_in[i];
    a.out = (float*)d_out; a.ws = (unsigned char*)d_ws;
#if MEGA
    (void)hipMemsetAsync(d_ws, 0, 65536, stream);
    a.ph_lo = 0; a.ph_hi = NSTEP;
    void* kargs[] = {&a};
    hipError_t e = hipLaunchCooperativeKernel((const void*)fwd_kernel, dim3(grid), dim3(512), kargs, LDS_BYTES, stream);
    if (e != hipSuccess) fprintf(stderr, "cooperative launch failed: %s (grid %d)\n", hipGetErrorString(e), grid);
#else
    for (int ph = 0; ph < NSTEP; ++ph) { a.ph_lo = ph; a.ph_hi = ph + 1; hipLaunchKernelGGL(fwd_kernel, dim3(grid), dim3(512), LDS_BYTES, stream, a);
#ifdef PROBE_DUP
        if (ph > 0 && ph < NSTEP - 1 && ((PROBE_DUP >> ((ph - 1) % SPC)) & 1)) hipLaunchKernelGGL(fwd_kernel, dim3(grid), dim3(512), LDS_BYTES, stream, a);
#endif
    }
#endif
}
```
